# Optimizing an MI355X kernel written in HIP

```python
import jax, jax.numpy as jnp
from jax import lax
import numpy as np

D_MODEL = 1024
BATCH = 4
SEQ = 4096
DEPTH = 4
DEC_BATCH = 128
DEC_SEQ = 8
PAST_LEN = 8192
PAGE_SIZE = 128

HEAD_DIM = 64
N_HEADS = 8
N_KV_HEADS = 2
GQA_GROUP = N_HEADS // N_KV_HEADS
D_ATTN = N_HEADS * HEAD_DIM
D_KV = N_KV_HEADS * HEAD_DIM
WINDOW = 128
BLOCK = 128
D_CONV = D_MODEL // 2
CONV_WIDTH = 31
POOL_WINDOWS = (2, 4, 8, 16)
N_POOL_GROUPS = len(POOL_WINDOWS)
POOL_GROUP_DIM = D_MODEL // N_POOL_GROUPS
POOL_BUF = max(POOL_WINDOWS) - 1
D_FF = -(-(8 * D_MODEL) // (3 * 256)) * 256
N_EVEN = (DEPTH + 1) // 2
N_ODD = DEPTH // 2
D_IN_EVEN = 2 * D_CONV + D_ATTN + 2 * D_KV
RMS_EPS = 1e-6
LN_EPS = 1e-5
NEG_INF = -1e30

kernel_name = 'hybrid_conv_swa_pool_decoder_step'


def _rmsnorm(x, g):
    xf = x.astype(jnp.float32)
    y = xf * lax.rsqrt(jnp.mean(xf * xf, axis=-1, keepdims=True) + RMS_EPS)
    return (y * g.astype(jnp.float32)).astype(x.dtype)


def _layernorm(x, g, b):
    xf = x.astype(jnp.float32)
    mu = jnp.mean(xf, axis=-1, keepdims=True)
    var = jnp.mean(jnp.square(xf - mu), axis=-1, keepdims=True)
    y = (xf - mu) * lax.rsqrt(var + LN_EPS)
    return (y * g.astype(jnp.float32) + b.astype(jnp.float32)).astype(x.dtype)


def _alibi_slopes():
    return jnp.asarray(np.array([2.0 ** (-8.0 * (h + 1) / N_HEADS) for h in range(N_HEADS)], dtype=np.float32))


def _sink_attend(q, k, v, dist, valid, sinks):
    s = jnp.einsum('...qkgd,...skd->...kgqs', q, k).astype(jnp.float32) * (HEAD_DIM ** -0.5)
    slopes = _alibi_slopes().reshape(N_KV_HEADS, GQA_GROUP, 1, 1)
    s = s - slopes * dist.astype(jnp.float32)[..., None, None, :, :]
    s = jnp.where(valid[..., None, None, :, :], s, NEG_INF)
    sink = sinks.astype(jnp.float32).reshape(N_KV_HEADS, GQA_GROUP, 1, 1)
    m = jnp.maximum(jnp.max(s, axis=-1, keepdims=True), sink)
    p = jnp.exp(s - m)
    denom = jnp.sum(p, axis=-1, keepdims=True) + jnp.exp(sink - m)
    probs = (p / denom).astype(v.dtype)
    return jnp.einsum('...kgqs,...skd->...qkgd', probs, v)


def _swa_prompt(q, k, v, sinks):
    n, t = q.shape[0], q.shape[1]
    nb = t // BLOCK
    qb = q.reshape(n, nb, BLOCK, N_KV_HEADS, GQA_GROUP, HEAD_DIM)
    kb = k.reshape(n, nb, BLOCK, N_KV_HEADS, HEAD_DIM)
    vb = v.reshape(n, nb, BLOCK, N_KV_HEADS, HEAD_DIM)
    pad = ((0, 0), (1, 0), (0, 0), (0, 0), (0, 0))
    kk = jnp.concatenate([jnp.pad(kb, pad)[:, :-1], kb], axis=2)
    vv = jnp.concatenate([jnp.pad(vb, pad)[:, :-1], vb], axis=2)
    i = jnp.arange(BLOCK)[:, None]
    j = jnp.arange(2 * BLOCK)[None, :]
    dist = BLOCK + i - j
    blk = jnp.arange(nb)[:, None, None]
    valid = (dist >= 0) & (dist < WINDOW) & ((blk > 0) | (j >= BLOCK))
    out = _sink_attend(qb, kk, vv, dist, valid, sinks)
    keep = min(WINDOW, t)
    return out.reshape(n, t, D_ATTN), k[:, -keep:], v[:, -keep:]


def _swa_sample(q, k, v, k_buf, v_buf, sinks):
    n, t = q.shape[0], q.shape[1]
    buf_len = k_buf.shape[1]
    kk = jnp.concatenate([k_buf.astype(k.dtype), k], axis=1)
    vv = jnp.concatenate([v_buf.astype(v.dtype), v], axis=1)
    dist = buf_len + jnp.arange(t)[:, None] - jnp.arange(buf_len + t)[None, :]
    valid = (dist >= 0) & (dist < WINDOW)
    out = _sink_attend(q, kk, vv, dist, valid, sinks)
    return out.reshape(n, t, D_ATTN), kk[:, -buf_len:], vv[:, -buf_len:]


def _conformer_conv(u, buf, w_dw, b_dw, g, b):
    a, gate = jnp.split(u, 2, axis=-1)
    glu = a * jax.nn.sigmoid(gate)
    ext = jnp.concatenate([buf.astype(glu.dtype), glu], axis=1)
    y = lax.conv_general_dilated(ext, w_dw.astype(ext.dtype)[:, None, :], window_strides=(1,), padding='VALID',
                                 dimension_numbers=('NWC', 'WIO', 'NWC'), feature_group_count=D_CONV)
    y = y + b_dw.astype(y.dtype)
    y = jax.nn.silu(_layernorm(y, g, b))
    return y, ext[:, -(CONV_WIDTH - 1):]


def _even_layer(x, conv_buf, k_buf, v_buf, norm_g, w_in, q_norm, k_norm, sinks, w_dw, b_dw, cn_g, cn_b, w_out):
    n, t, _ = x.shape
    xn = _rmsnorm(x, norm_g)
    u = xn @ w_in
    o_q = 2 * D_CONV
    o_k = o_q + D_ATTN
    o_v = o_k + D_KV
    q = _rmsnorm(u[..., o_q:o_k].reshape(n, t, N_KV_HEADS, GQA_GROUP, HEAD_DIM), q_norm)
    k = _rmsnorm(u[..., o_k:o_v].reshape(n, t, N_KV_HEADS, HEAD_DIM), k_norm)
    v = u[..., o_v:].reshape(n, t, N_KV_HEADS, HEAD_DIM)
    conv_out, new_conv = _conformer_conv(u[..., :o_q], conv_buf, w_dw, b_dw, cn_g, cn_b)
    if k_buf is None:
        attn, new_k, new_v = _swa_prompt(q, k, v, sinks)
    else:
        attn, new_k, new_v = _swa_sample(q, k, v, k_buf, v_buf, sinks)
    y = jnp.concatenate([conv_out, attn.astype(conv_out.dtype)], axis=-1) @ w_out
    return x + y, new_conv, new_k, new_v


def _pool_mixer(xn, buf, pos0, w_pool, pool_scale):
    n, t, _ = xn.shape
    ext = jnp.concatenate([buf.astype(xn.dtype), xn], axis=1)
    cs = jnp.pad(jnp.cumsum(ext.astype(jnp.float32), axis=1), ((0, 0), (1, 0), (0, 0)))
    pos = pos0 + jnp.arange(t)
    xf = xn.astype(jnp.float32)
    groups = []
    for g, w in enumerate(POOL_WINDOWS):
        c0, c1 = g * POOL_GROUP_DIM, (g + 1) * POOL_GROUP_DIM
        hi = cs[:, POOL_BUF + 1:POOL_BUF + 1 + t, c0:c1]
        lo = cs[:, POOL_BUF + 1 - w:POOL_BUF + 1 - w + t, c0:c1]
        cnt = jnp.minimum(w, pos + 1).astype(jnp.float32)[:, None]
        groups.append((hi - lo) / cnt - xf[..., c0:c1])
    d = jnp.stack(groups, axis=2).astype(xn.dtype)
    y = jnp.einsum('btgc,gcd->btgd', d, w_pool).reshape(n, t, D_MODEL)
    return y * pool_scale.astype(y.dtype), ext[:, -POOL_BUF:]


def _odd_layer(x, pool_buf, pos0, norm_g, w_pool, pool_scale):
    y, new_buf = _pool_mixer(_rmsnorm(x, norm_g), pool_buf, pos0, w_pool, pool_scale)
    return x + y, new_buf


def _swiglu_ffn(x, g, w_gate, w_up, w_down):
    h = _rmsnorm(x, g)
    return x + (jax.nn.silu(h @ w_gate) * (h @ w_up)) @ w_down


def _trunk(x, conv_bufs, k_bufs, v_bufs, pool_bufs, pos0, norm_mix, norm_ffn, w_in, q_norm, k_norm, sinks,
           w_dw, b_dw, conv_norm_g, conv_norm_b, w_out, w_pool, pool_scale, w_gate, w_up, w_down):
    new_conv, new_k, new_v, new_pool = [], [], [], []
    for layer in range(DEPTH):
        i = layer // 2
        if layer % 2 == 0:
            kb = None if k_bufs is None else k_bufs[i]
            vb = None if v_bufs is None else v_bufs[i]
            x, c, kk, vv = _even_layer(x, conv_bufs[i], kb, vb, norm_mix[layer], w_in[i], q_norm[i], k_norm[i],
                                       sinks[i], w_dw[i], b_dw[i], conv_norm_g[i], conv_norm_b[i], w_out[i])
            new_conv.append(c)
            new_k.append(kk)
            new_v.append(vv)
        else:
            x, pb = _odd_layer(x, pool_bufs[i], pos0, norm_mix[layer], w_pool[i], pool_scale[i])
            new_pool.append(pb)
        x = _swiglu_ffn(x, norm_ffn[layer], w_gate[layer], w_up[layer], w_down[layer])
    return x, jnp.stack(new_conv), jnp.stack(new_k), jnp.stack(new_v), jnp.stack(new_pool)


def setup_inputs(seed: int = 0) -> dict:
    key = jax.random.key(seed)
    ks = jax.random.split(key, 24)
    f32 = jnp.float32

    def nrm(k, shape, scale):
        return jax.random.normal(k, shape, f32) * scale

    win_buf = min(WINDOW, PAST_LEN)
    return {
        'x_prompt': nrm(ks[0], (BATCH, SEQ, D_MODEL), 1.0),
        'x_sample': nrm(ks[1], (DEC_BATCH, DEC_SEQ, D_MODEL), 1.0),
        'cache_conv': nrm(ks[2], (N_EVEN, DEC_BATCH, CONV_WIDTH - 1, D_CONV), 0.5),
        'cache_k': nrm(ks[3], (N_EVEN, DEC_BATCH, win_buf, N_KV_HEADS, HEAD_DIM), 1.0),
        'cache_v': nrm(ks[4], (N_EVEN, DEC_BATCH, win_buf, N_KV_HEADS, HEAD_DIM), 1.0),
        'state_pool': nrm(ks[5], (N_ODD, DEC_BATCH, POOL_BUF, D_MODEL), 1.0),
        'norm_mix': 1.0 + nrm(ks[6], (DEPTH, D_MODEL), 0.02),
        'norm_ffn': 1.0 + nrm(ks[7], (DEPTH, D_MODEL), 0.02),
        'w_in': nrm(ks[8], (N_EVEN, D_MODEL, D_IN_EVEN), D_MODEL ** -0.5),
        'q_norm': 1.0 + nrm(ks[9], (N_EVEN, HEAD_DIM), 0.02),
        'k_norm': 1.0 + nrm(ks[10], (N_EVEN, HEAD_DIM), 0.02),
        'sinks': nrm(ks[11], (N_EVEN, N_HEADS), 0.5),
        'w_dw': nrm(ks[12], (N_EVEN, CONV_WIDTH, D_CONV), CONV_WIDTH ** -0.5),
        'b_dw': nrm(ks[13], (N_EVEN, D_CONV), 0.02),
        'conv_norm_g': 1.0 + nrm(ks[14], (N_EVEN, D_CONV), 0.02),
        'conv_norm_b': nrm(ks[15], (N_EVEN, D_CONV), 0.02),
        'w_out': nrm(ks[16], (N_EVEN, D_CONV + D_ATTN, D_MODEL), (D_CONV + D_ATTN) ** -0.5),
        'w_pool': nrm(ks[17], (N_ODD, N_POOL_GROUPS, POOL_GROUP_DIM, POOL_GROUP_DIM), POOL_GROUP_DIM ** -0.5),
        'pool_scale': 1.0 + nrm(ks[18], (N_ODD, D_MODEL), 0.02),
        'w_gate': nrm(ks[19], (DEPTH, D_MODEL, D_FF), D_MODEL ** -0.5),
        'w_up': nrm(ks[20], (DEPTH, D_MODEL, D_FF), D_MODEL ** -0.5),
        'w_down': nrm(ks[21], (DEPTH, D_FF, D_MODEL), D_FF ** -0.5),
    }


def reference(x_prompt, x_sample, cache_conv, cache_k, cache_v, state_pool, norm_mix, norm_ffn, w_in, q_norm,
              k_norm, sinks, w_dw, b_dw, conv_norm_g, conv_norm_b, w_out, w_pool, pool_scale, w_gate, w_up, w_down):
    n_p = x_prompt.shape[0]
    zero_conv = jnp.zeros((n_p, CONV_WIDTH - 1, D_CONV), x_prompt.dtype)
    zero_pool = jnp.zeros((n_p, POOL_BUF, D_MODEL), x_prompt.dtype)
    y_prompt, conv_p, k_p, v_p, pool_p = _trunk(
        x_prompt, [zero_conv] * N_EVEN, None, None, [zero_pool] * N_ODD, 0,
        norm_mix, norm_ffn, w_in, q_norm, k_norm, sinks, w_dw, b_dw, conv_norm_g, conv_norm_b, w_out,
        w_pool, pool_scale, w_gate, w_up, w_down)
    y_sample, conv_s, k_s, v_s, pool_s = _trunk(
        x_sample, cache_conv, cache_k, cache_v, state_pool, PAST_LEN,
        norm_mix, norm_ffn, w_in, q_norm, k_norm, sinks, w_dw, b_dw, conv_norm_g, conv_norm_b, w_out,
        w_pool, pool_scale, w_gate, w_up, w_down)
    return (y_prompt, y_sample, conv_p, k_p, v_p, pool_p, conv_s, k_s, v_s, pool_s)
```

```cpp
#include <hip/hip_runtime.h>
#include <hip/hip_cooperative_groups.h>
#include <cstdio>
namespace cg = cooperative_groups;

#define LAS __attribute__((address_space(3)))
#ifndef DUP_PREP
#define DUP_PREP 0
#define DUP_IN 0
#define DUP_MIX 0
#define DUP_POOL1 0
#define DUP_GU 0
#define DUP_SYNC 0
#define DUP_DN 0
#endif
#ifndef X_GIN
#define X_GIN 1
#define X_GOUT 1
#define X_GPOOL 1
#define X_GGU 1
#define X_GDN 1
#endif
typedef unsigned short bf16_t;
typedef short bf16x8 __attribute__((ext_vector_type(8)));
typedef float f32x4 __attribute__((ext_vector_type(4)));
typedef unsigned u32x4 __attribute__((ext_vector_type(4)));
typedef unsigned u32x2 __attribute__((ext_vector_type(2)));
typedef float f32x2 __attribute__((ext_vector_type(2)));
typedef unsigned long long ssq_t;

constexpr int DM = 1024, MP = 16384, MS = 1024, MT = 17408, NTM = 68, DFF = 2816, DIN = 1792;
constexpr float RMS_EPS = 1e-6f, LN_EPS = 1e-5f;
enum { I_XP = 0, I_XS, I_CCONV, I_CK, I_CV, I_SPOOL, I_NMIX, I_NFFN, I_WIN, I_QN, I_KN, I_SINK, I_WDW, I_BDW, I_CNG, I_CNB, I_WOUT, I_WPOOL, I_PSCALE, I_WG, I_WU, I_WD, N_IN };
constexpr size_t O_Y = 0;
constexpr size_t O_CONVP = (size_t)MT * DM;
constexpr size_t O_KP = O_CONVP + 2 * 4 * 30 * 512;
constexpr size_t O_VP = O_KP + 2 * 4 * 128 * 128;
constexpr size_t O_POOLP = O_VP + 2 * 4 * 128 * 128;
constexpr size_t O_CONVS = O_POOLP + 2 * 4 * 15 * 1024;
constexpr size_t O_KS = O_CONVS + (size_t)2 * 128 * 30 * 512;
constexpr size_t O_VS = O_KS + (size_t)2 * 128 * 128 * 128;
constexpr size_t O_POOLS = O_VS + (size_t)2 * 128 * 128 * 128;
constexpr size_t WS_WIN = 0;
constexpr size_t WS_WOUT = WS_WIN + (size_t)2 * DIN * DM * 2;
constexpr size_t WS_WGU = WS_WOUT + (size_t)2 * DM * DM * 2;
constexpr size_t WS_WDN = WS_WGU + (size_t)4 * 2 * DFF * DM * 2;
constexpr size_t WS_WPL = WS_WDN + (size_t)4 * DM * DFF * 2;
constexpr size_t WS_XB = WS_WPL + (size_t)2 * 4 * 256 * 256 * 2;
constexpr size_t WS_SSQ = WS_XB + (size_t)MT * DM * 2;
constexpr size_t WS_ACT = WS_SSQ + (size_t)9 * MT * 8;
constexpr size_t WS_QKV = WS_ACT;
constexpr size_t WS_GLU = WS_QKV + (size_t)MT * 768 * 2;
constexpr size_t WS_CAT = WS_GLU + (size_t)MT * 512 * 2;
constexpr size_t WS_DG = WS_ACT;
constexpr size_t WS_BAR = WS_ACT + (size_t)MT * DFF * 2;
constexpr size_t WS_PART = WS_BAR + 16384;
constexpr size_t WS_END = WS_PART + (size_t)176 * 65536 * 4;
constexpr int LDS_BYTES = 131072 + 16;
constexpr int N_PHASES = 21;

struct Params { const float* in[N_IN]; float* out; unsigned char* ws; int ph_lo, ph_hi; };

__device__ __forceinline__ unsigned cvt_pk_bf16(float lo, float hi) { unsigned r; asm("v_cvt_pk_bf16_f32 %0, %1, %2" : "=v"(r) : "v"(lo), "v"(hi)); return r; }
__device__ __forceinline__ float bflo(unsigned w) { return __uint_as_float(w << 16); }
__device__ __forceinline__ float bfhi(unsigned w) { return __uint_as_float(w & 0xffff0000u); }
__device__ __forceinline__ float bf2f(bf16_t b) { return __uint_as_float(((unsigned)b) << 16); }
__device__ __forceinline__ float wave_sum(float v) {
#pragma unroll
    for (int o = 32; o >= 1; o >>= 1) v += __shfl_xor(v, o);
    return v;
}
__device__ __forceinline__ float ssq_rs(ssq_t v) { return rsqrtf((float)v * (1.0f / (1048576.0f * 1024.0f)) + RMS_EPS); }
__device__ __forceinline__ ssq_t ssq_fix(float ss) { return (ssq_t)(ss * 1048576.0f); }
__device__ __forceinline__ void ssq_add(ssq_t* p, float ss) { (void)__hip_atomic_fetch_add(p, ssq_fix(ss), __ATOMIC_RELAXED, __HIP_MEMORY_SCOPE_AGENT); }
__device__ __forceinline__ float fast_sigmoid(float x) { return __builtin_amdgcn_rcpf(1.0f + __expf(-x)); }
__device__ __forceinline__ f32x2 pk_exp2(f32x2 v) { f32x2 r; r.x = __builtin_amdgcn_exp2f(v.x); r.y = __builtin_amdgcn_exp2f(v.y); return r; }
__device__ __forceinline__ f32x2 pk_rcp(f32x2 v) { f32x2 r; r.x = __builtin_amdgcn_rcpf(v.x); r.y = __builtin_amdgcn_rcpf(v.y); return r; }
__device__ __forceinline__ f32x2 pk_sig(f32x2 g, float k2) { return pk_rcp(pk_exp2(g * k2) + 1.0f); }

namespace pg8 {
constexpr int BM = 256, BK = 64, HALF = 128, HTB = HALF * BK * 2, STAGE_BYTES = 8 * HTB, NXCD = 8, WGM = 8;
__host__ __device__ __forceinline__ int lds_byte(int r, int c) { const int st = (r >> 4) * 2 + (c >> 5), rr = r & 15, cc = c & 31, ob = rr * 64 + cc * 2; return st * 1024 + (ob ^ (((ob >> 9) & 1) << 5)); }
__host__ __device__ __forceinline__ void stage_rc(int b, int& R, int& C) { const int st = b / 1024, sb = b % 1024, swz = sb ^ (((sb >> 9) & 1) << 5); R = (st >> 1) * 16 + swz / 64; C = (st & 1) * 32 + (swz % 64) / 2; }
__host__ __device__ __forceinline__ int perm32(int rho) { const int n = rho >> 4, i = rho & 15; return 8 * (i >> 2) + 4 * n + (i & 3); }
struct Unit { int pm, pn, k0, nt, part; };
struct Gemm { const bf16_t* A; const bf16_t* Bt; int M, N, K; };
struct StaticOrder {
    static constexpr bool SPLIT = false, ABLK = false;
    int nM, nN, nwg, G, c, ntk;
    __device__ void init(int M, int N, int K, int G_, int c_) { nM = M / BM; nN = N / BM; nwg = nM * nN; G = G_; c = c_; ntk = K / BK; }
    __device__ void tile(int L, Unit& u) const {
        int wgid = L; { const int q = nwg / NXCD, r = nwg % NXCD, xcd = wgid % NXCD, off = wgid / NXCD; wgid = (xcd < r ? xcd * (q + 1) : r * (q + 1) + (xcd - r) * q) + off; }
        const int nig = WGM * nN, gid = wgid / nig, fm = gid * WGM, gsz = (nM - fm) < WGM ? (nM - fm) : WGM;
        u.pm = fm + ((wgid % nig) % gsz); u.pn = (wgid % nig) / gsz;
    }
    __device__ bool next(int i, Unit& u) const {
        const long L = (long)i * G + c; if (L >= nwg) return false;
        tile((int)L, u); u.k0 = 0; u.nt = ntk; u.part = -1; return true;
    }
};
template <bool ABLK_> struct SplitOrder : StaticOrder {
    static constexpr bool SPLIT = true, ABLK = ABLK_;
    int KS, ntp;
    __device__ void init2(int M, int N, int K, int G_, int c_, int KS_) { init(M, N, K, G_, c_); KS = KS_; ntp = ntk / KS_; }
    __device__ bool next(int i, Unit& u) const {
        const int np = (nwg - G) * KS;
        int j = i;
        if (c < np) { if (i == 0) { tile(G + c / KS, u); u.k0 = (c % KS) * ntp; u.nt = ntp; u.part = c; return true; } j = i - 1; }
        if (j > 0) return false;
        tile(c, u); u.k0 = 0; u.nt = ntk; u.part = -1; return true;
    }
};
struct PoolOrder {
    static constexpr bool SPLIT = false, ABLK = false;
    int G, c;
    __device__ bool next(int i, Unit& u) const { const int L = i * G + c; if (L >= 4 * NTM) return false; u.pm = L; u.pn = L / NTM; u.k0 = 0; u.nt = 4; u.part = -1; return true; }
};

template <class Epi, class Sched>
__device__ __forceinline__ void gemm_phase(LAS unsigned char* lds, const Gemm g, const Sched& S, const Epi& E) {
    int tid = threadIdx.x; asm volatile("" : "+v"(tid));
    const int wid = __builtin_amdgcn_readfirstlane(tid >> 6), lane = tid & 63, wr = wid >> 2, wc = wid & 3, fr = lane & 15, fq = lane >> 4;
    int K = g.K; asm volatile("" : "+s"(K));
    unsigned voffA[2], voffB[2];
#pragma unroll
    for (int i = 0; i < 2; ++i) { int R, C; stage_rc(tid * 16 + i * 8192, R, C); const int Rb = (R & ~31) + perm32(R & 31);
        voffA[i] = Sched::ABLK ? (unsigned)(R * 64 + C) * 2u : (unsigned)(R * K + C) * 2u; voffB[i] = (unsigned)(Rb * K + C) * 2u; }
    const size_t kstep = (size_t)(BK * 2);
    const size_t hstep = (size_t)HALF * K * 2;
    const size_t tstep = 2 * hstep;
    const size_t kstepA = Sched::ABLK ? (size_t)32768 : kstep, hstepA = Sched::ABLK ? (size_t)16384 : hstep;
    const unsigned ldsw = (unsigned)wid * 1024u;
    const int aoff = lds_byte(wr * 64 + fr, fq * 8), boff = lds_byte(wc * 32 + fr, fq * 8);
#define PG8_SA(b, h) (((b) * 2 + (h)) * HTB)
#define PG8_SB(b, h) ((4 + (b) * 2 + (h)) * HTB)
#define PG8_STAGE(bufoff, gbase, voff) do { _Pragma("unroll") for (int _i = 0; _i < 2; ++_i) \
        __builtin_amdgcn_global_load_lds((const unsigned*)((const char*)(gbase) + (voff)[_i]), (LAS unsigned*)(lds + (bufoff) + ldsw + _i * 8192), 16, 0, 0); } while (0)
#define PG8_LDA(dst, b, h) do { _Pragma("unroll") for (int m = 0; m < 4; ++m) _Pragma("unroll") for (int k = 0; k < 2; ++k) dst[m][k] = *(const LAS bf16x8*)(lds + PG8_SA(b, h) + aoff + m * 2048 + k * 1024); } while (0)
#define PG8_LDB(dst, b, h) do { _Pragma("unroll") for (int n = 0; n < 2; ++n) _Pragma("unroll") for (int k = 0; k < 2; ++k) dst[n][k] = *(const LAS bf16x8*)(lds + PG8_SB(b, h) + boff + n * 2048 + k * 1024); } while (0)
#define PG8_MMA(ai, bj, At, Bt) do { __builtin_amdgcn_s_setprio(1); _Pragma("unroll") for (int m = 0; m < 4; ++m) _Pragma("unroll") for (int n = 0; n < 2; ++n) _Pragma("unroll") for (int k = 0; k < 2; ++k) \
        acc[ai][bj][m][n] = __builtin_amdgcn_mfma_f32_16x16x32_bf16(Bt[n][k], At[m][k], acc[ai][bj][m][n], 0, 0, 0); __builtin_amdgcn_s_setprio(0); } while (0)
#define PG8_WAIT_V(n) asm volatile("s_waitcnt vmcnt(" #n ")" ::: "memory")
#define PG8_WAIT_L(n) asm volatile("s_waitcnt lgkmcnt(" #n ")" ::: "memory")
#define PG8_BAR __builtin_amdgcn_s_barrier()
#define PG8_SCHED __builtin_amdgcn_sched_barrier(0)
    Unit cur, nxt; int ui = 0;
    if (!S.next(0, cur)) return;
    f32x4 acc[2][2][4][2];
    E.init(acc, cur, wr, wc, fr, fq);
    bf16x8 At[4][2], B0[2][2], B1[2][2];
    const char* cA = (const char*)g.A + (size_t)cur.pm * tstep; const char* cB = (const char*)g.Bt + (size_t)cur.pn * tstep;
    if constexpr (Sched::SPLIT) { cA += (size_t)cur.k0 * kstepA; cB += (size_t)cur.k0 * kstep; }
    const int ntc = K / BK;
    PG8_STAGE(PG8_SB(0, 0), cB, voffB); PG8_STAGE(PG8_SA(0, 0), cA, voffA); PG8_STAGE(PG8_SB(0, 1), cB + hstep, voffB); PG8_STAGE(PG8_SA(0, 1), cA + hstepA, voffA);
    if (wr == 1) PG8_BAR;
    PG8_WAIT_V(4); PG8_BAR;
    PG8_STAGE(PG8_SB(1, 0), cB + kstep, voffB); PG8_STAGE(PG8_SA(1, 0), cA + kstepA, voffA); PG8_STAGE(PG8_SB(1, 1), cB + hstep + kstep, voffB);
    PG8_WAIT_V(6); PG8_BAR;
    for (;;) {
        const bool has_next = S.next(ui + 1, nxt);
        const char* nA = has_next ? (const char*)g.A + (size_t)nxt.pm * tstep : cA; const char* nB = has_next ? (const char*)g.Bt + (size_t)nxt.pn * tstep : cB;
        if constexpr (Sched::SPLIT) { if (has_next) { nA += (size_t)nxt.k0 * kstepA; nB += (size_t)nxt.k0 * kstep; } }
        const int nt = Sched::SPLIT ? cur.nt : ntc;
        for (int t = 0; t < nt; t += 2) {
            const bool last = (t == nt - 2);
            const char* a1 = cA + (size_t)(t + 1) * kstepA;
            const char* a2 = last ? nA : cA + (size_t)(t + 2) * kstepA; const char* b2 = last ? nB : cB + (size_t)(t + 2) * kstep;
            const char* a3 = a2 + kstepA; const char* b3 = b2 + kstep;
            PG8_LDB(B0, 0, 0); PG8_SCHED; PG8_LDA(At, 0, 0); PG8_STAGE(PG8_SA(1, 1), a1 + hstepA, voffA);
            PG8_WAIT_L(8); PG8_BAR; PG8_WAIT_L(0); PG8_MMA(0, 0, At, B0); PG8_BAR; PG8_SCHED;
            PG8_LDB(B1, 0, 1); PG8_STAGE(PG8_SB(0, 0), b2, voffB);
            PG8_BAR; PG8_WAIT_L(0); PG8_MMA(0, 1, At, B1); PG8_BAR;
            PG8_LDA(At, 0, 1); PG8_STAGE(PG8_SA(0, 0), a2, voffA);
            PG8_BAR; PG8_WAIT_L(0); PG8_MMA(1, 0, At, B0); PG8_BAR; PG8_SCHED;
            PG8_STAGE(PG8_SB(0, 1), b2 + hstep, voffB);
            PG8_WAIT_V(6); PG8_BAR; PG8_MMA(1, 1, At, B1); PG8_BAR;
            PG8_LDB(B0, 1, 0); PG8_SCHED; PG8_LDA(At, 1, 0); PG8_STAGE(PG8_SA(0, 1), a2 + hstepA, voffA);
            PG8_WAIT_L(8); PG8_BAR; PG8_WAIT_L(0); PG8_MMA(0, 0, At, B0); PG8_BAR; PG8_SCHED;
            PG8_LDB(B1, 1, 1); PG8_STAGE(PG8_SB(1, 0), b3, voffB);
            PG8_BAR; PG8_WAIT_L(0); PG8_MMA(0, 1, At, B1); PG8_BAR;
            PG8_LDA(At, 1, 1); PG8_STAGE(PG8_SA(1, 0), a3, voffA);
            PG8_BAR; PG8_WAIT_L(0); PG8_MMA(1, 0, At, B0); PG8_BAR; PG8_SCHED;
            PG8_STAGE(PG8_SB(1, 1), b3 + hstep, voffB);
            PG8_WAIT_V(6); PG8_BAR; PG8_MMA(1, 1, At, B1); PG8_BAR;
        }
        E(acc, cur, wr, wc, fr, fq);
        if (!has_next) break;
        E.init(acc, nxt, wr, wc, fr, fq);
        cur = nxt; cA = nA; cB = nB; ++ui;
    }
    PG8_WAIT_V(0);
    if (wr == 0) PG8_BAR;
    PG8_BAR;
#undef PG8_SA
#undef PG8_SB
#undef PG8_STAGE
#undef PG8_LDA
#undef PG8_LDB
#undef PG8_MMA
#undef PG8_WAIT_V
#undef PG8_WAIT_L
#undef PG8_BAR
#undef PG8_SCHED
}
}

__device__ __forceinline__ void acc_zero(f32x4 (&acc)[2][2][4][2]) {
#pragma unroll
    for (int a = 0; a < 2; ++a)
#pragma unroll
        for (int b = 0; b < 2; ++b)
#pragma unroll
            for (int m = 0; m < 4; ++m)
#pragma unroll
                for (int n = 0; n < 2; ++n) acc[a][b][m][n] = (f32x4){0.f, 0.f, 0.f, 0.f};
}
struct EpiIn {
    const ssq_t* ssq; bf16_t* glu; bf16_t* qkv;
    __device__ __forceinline__ void init(f32x4 (&acc)[2][2][4][2], const pg8::Unit&, int, int, int, int) const { acc_zero(acc); }
    __device__ __forceinline__ void operator()(const f32x4 (&acc)[2][2][4][2], const pg8::Unit& u, int wr, int wc, int fr, int fq) const {
        const int row0 = u.pm * 256 + wr * 64 + fr;
        if (u.pn < 4) {
            const int col0 = u.pn * 128 + wc * 32 + 8 * fq;
#pragma unroll
            for (int ai = 0; ai < 2; ++ai)
#pragma unroll
                for (int m = 0; m < 4; ++m) {
                    const int r = row0 + ai * 128 + m * 16;
                    const float rs = ssq_rs(ssq[r]);
                    const float k2 = rs * -1.4426950408889634f;
                    f32x2 o[4];
#pragma unroll
                    for (int n = 0; n < 2; ++n)
#pragma unroll
                        for (int h = 0; h < 2; ++h) {
                            const f32x2 a = (f32x2){acc[ai][0][m][n][2 * h], acc[ai][0][m][n][2 * h + 1]}, gt = (f32x2){acc[ai][1][m][n][2 * h], acc[ai][1][m][n][2 * h + 1]};
                            o[n * 2 + h] = (a * rs) * pk_sig(gt, k2);
                        }
                    u32x4 w; w.x = cvt_pk_bf16(o[0].x, o[0].y); w.y = cvt_pk_bf16(o[1].x, o[1].y); w.z = cvt_pk_bf16(o[2].x, o[2].y); w.w = cvt_pk_bf16(o[3].x, o[3].y);
                    *(u32x4*)(glu + (size_t)r * 512 + col0) = w;
                }
        } else {
            const int col0 = (u.pn - 4) * 256 + wc * 32 + 8 * fq;
#pragma unroll
            for (int ai = 0; ai < 2; ++ai)
#pragma unroll
                for (int m = 0; m < 4; ++m) {
                    const int r = row0 + ai * 128 + m * 16;
                    const float rs = ssq_rs(ssq[r]);
#pragma unroll
                    for (int bj = 0; bj < 2; ++bj) {
                        const f32x4 v0 = acc[ai][bj][m][0] * rs, v1 = acc[ai][bj][m][1] * rs;
                        u32x4 w; w.x = cvt_pk_bf16(v0[0], v0[1]); w.y = cvt_pk_bf16(v0[2], v0[3]); w.z = cvt_pk_bf16(v1[0], v1[1]); w.w = cvt_pk_bf16(v1[2], v1[3]);
                        *(u32x4*)(qkv + (size_t)r * 768 + col0 + bj * 128) = w;
                    }
                }
        }
    }
};
struct EpiGU {
    const ssq_t* ssq; bf16_t* act;
    __device__ __forceinline__ void init(f32x4 (&acc)[2][2][4][2], const pg8::Unit&, int, int, int, int) const { acc_zero(acc); }
    __device__ __forceinline__ void operator()(const f32x4 (&acc)[2][2][4][2], const pg8::Unit& u, int wr, int wc, int fr, int fq) const {
        const int row0 = u.pm * 256 + wr * 64 + fr, col0 = u.pn * 128 + wc * 32 + 8 * fq;
#pragma unroll
        for (int ai = 0; ai < 2; ++ai)
#pragma unroll
            for (int m = 0; m < 4; ++m) {
                const int r = row0 + ai * 128 + m * 16;
                const float rs = ssq_rs(ssq[r]);
                const float k2 = rs * -1.4426950408889634f, rs2 = rs * rs;
                f32x2 o[4];
#pragma unroll
                for (int n = 0; n < 2; ++n)
#pragma unroll
                    for (int h = 0; h < 2; ++h) {
                        const f32x2 gt = (f32x2){acc[ai][0][m][n][2 * h], acc[ai][0][m][n][2 * h + 1]}, up = (f32x2){acc[ai][1][m][n][2 * h], acc[ai][1][m][n][2 * h + 1]};
                        o[n * 2 + h] = (gt * up) * rs2 * pk_sig(gt, k2);
                    }
                u32x4 w; w.x = cvt_pk_bf16(o[0].x, o[0].y); w.y = cvt_pk_bf16(o[1].x, o[1].y); w.z = cvt_pk_bf16(o[2].x, o[2].y); w.w = cvt_pk_bf16(o[3].x, o[3].y);
                __builtin_nontemporal_store(w, (u32x4*)(act + (size_t)(r >> 8) * (256 * DFF) + (size_t)(col0 >> 6) * (256 * 64) + (size_t)(r & 255) * 64 + (col0 & 63)));
            }
    }
};
__device__ __forceinline__ void bf8_to_f32(u32x4 w, f32x4& lo, f32x4& hi) { lo = (f32x4){bflo(w.x), bfhi(w.x), bflo(w.y), bfhi(w.y)}; hi = (f32x4){bflo(w.z), bfhi(w.z), bflo(w.w), bfhi(w.w)}; }
template <bool POOL> struct EpiRes {
    float* Y; bf16_t* XB; ssq_t* ssq; const float* cscale; float* part;
    __device__ __forceinline__ void init(f32x4 (&acc)[2][2][4][2], const pg8::Unit& u, int wr, int wc, int fr, int fq) const {
        if (!POOL && u.part >= 0) { acc_zero(acc); return; }
        const int pmr = POOL ? (u.pm % NTM) : u.pm, ct = POOL ? (u.pm / NTM) : u.pn;
        const bf16_t* xq = XB + (size_t)(pmr * 256 + wr * 64 + fr) * DM + ct * 256 + wc * 32 + 8 * fq;
#pragma unroll
        for (int ai = 0; ai < 2; ++ai)
#pragma unroll
            for (int bj = 0; bj < 2; ++bj)
#pragma unroll
                for (int m = 0; m < 4; ++m) bf8_to_f32(*(const u32x4*)(xq + (size_t)(ai * 128 + m * 16) * DM + bj * 128), acc[ai][bj][m][0], acc[ai][bj][m][1]);
        if (POOL) {
            const float* cq = cscale + ct * 256 + wc * 32 + 8 * fq;
#pragma unroll
            for (int bj = 0; bj < 2; ++bj)
#pragma unroll
                for (int n = 0; n < 2; ++n) {
                    const f32x4 cv = *(const f32x4*)(cq + bj * 128 + 4 * n);
                    const f32x4 ic = (f32x4){__builtin_amdgcn_rcpf(cv[0]), __builtin_amdgcn_rcpf(cv[1]), __builtin_amdgcn_rcpf(cv[2]), __builtin_amdgcn_rcpf(cv[3])};
#pragma unroll
                    for (int ai = 0; ai < 2; ++ai)
#pragma unroll
                        for (int m = 0; m < 4; ++m) acc[ai][bj][m][n] = acc[ai][bj][m][n] * ic;
                }
        }
    }
    __device__ __forceinline__ void operator()(const f32x4 (&acc)[2][2][4][2], const pg8::Unit& u, int wr, int wc, int fr, int fq) const {
        if (!POOL && u.part >= 0) {
            float* pp = part + (size_t)u.part * 65536 + (size_t)(((wr * 4 + wc) * 64) + fq * 16 + fr) * 4;
#pragma unroll
            for (int ai = 0; ai < 2; ++ai)
#pragma unroll
                for (int m = 0; m < 4; ++m)
#pragma unroll
                    for (int bj = 0; bj < 2; ++bj)
#pragma unroll
                        for (int n = 0; n < 2; ++n) *(f32x4*)(pp + (size_t)((((ai * 4 + m) * 2 + bj) * 2 + n) * 2048)) = acc[ai][bj][m][n];
            return;
        }
        const int pmr = POOL ? (u.pm % NTM) : u.pm, ct = POOL ? (u.pm / NTM) : u.pn;
        const int row0 = pmr * 256 + wr * 64 + fr, col0 = ct * 256 + wc * 32 + 8 * fq;
#pragma unroll
        for (int ai = 0; ai < 2; ++ai)
#pragma unroll
            for (int m = 0; m < 4; ++m) {
                const int r = row0 + ai * 128 + m * 16;
                bf16_t* bp = XB + (size_t)r * DM + col0;
                float ss = 0.f;
#pragma unroll
                for (int bj = 0; bj < 2; ++bj) {
                    f32x4 v0 = acc[ai][bj][m][0], v1 = acc[ai][bj][m][1];
                    if (POOL) { v0 = v0 * *(const f32x4*)(cscale + col0 + bj * 128); v1 = v1 * *(const f32x4*)(cscale + col0 + bj * 128 + 4); }
                    if (Y) { float* yp = Y + (size_t)r * DM + col0 + bj * 128; *(f32x4*)yp = v0; *(f32x4*)(yp + 4) = v1; }
                    u32x4 w; w.x = cvt_pk_bf16(v0[0], v0[1]); w.y = cvt_pk_bf16(v0[2], v0[3]); w.z = cvt_pk_bf16(v1[0], v1[1]); w.w = cvt_pk_bf16(v1[2], v1[3]);
                    *(u32x4*)(bp + bj * 128) = w;
                    ss += (v0[0] * v0[0] + v0[1] * v0[1]) + (v0[2] * v0[2] + v0[3] * v0[3]) + (v1[0] * v1[0] + v1[1] * v1[1]) + (v1[2] * v1[2] + v1[3] * v1[3]);
                }
                ss += __shfl_xor(ss, 16); ss += __shfl_xor(ss, 32);
                if (fq == 0) ssq_add(ssq + r, ss);
            }
    }
};

struct WTile { const float* src0; const float* src1; const float* gain; bf16_t* dst; int ld, K, k0, n0m, mode; };
__device__ __forceinline__ void wt_decode(const Params& p, int t, WTile& w) {
    int kt; w.gain = nullptr;
    if (t < 224) { const int i = t / 112, r = t % 112; w.n0m = (r / 16) * 256; kt = r % 16; w.K = 1024; w.ld = DIN; w.mode = (w.n0m < 1024) ? 1 : 0;
        w.src0 = p.in[I_WIN] + (size_t)i * DM * DIN; w.src1 = w.src0; w.gain = p.in[I_NMIX] + (2 * i) * DM; w.dst = (bf16_t*)(p.ws + WS_WIN) + (size_t)i * DIN * DM; }
    else if (t < 352) { t -= 224; const int i = t / 64, r = t % 64; w.n0m = (r / 16) * 256; kt = r % 16; w.K = 1024; w.ld = DM; w.mode = 0;
        w.src0 = p.in[I_WOUT] + (size_t)i * DM * DM; w.src1 = w.src0; w.dst = (bf16_t*)(p.ws + WS_WOUT) + (size_t)i * DM * DM; }
    else if (t < 1760) { t -= 352; const int l = t / 352, r = t % 352; w.n0m = (r / 16) * 256; kt = r % 16; w.K = 1024; w.ld = DFF; w.mode = 2;
        w.src0 = p.in[I_WG] + (size_t)l * DM * DFF; w.src1 = p.in[I_WU] + (size_t)l * DM * DFF; w.gain = p.in[I_NFFN] + l * DM; w.dst = (bf16_t*)(p.ws + WS_WGU) + (size_t)l * 2 * DFF * DM; }
    else if (t < 2464) { t -= 1760; const int l = t / 176, r = t % 176; w.n0m = (r / 44) * 256; kt = r % 44; w.K = DFF; w.ld = DM; w.mode = 0;
        w.src0 = p.in[I_WD] + (size_t)l * DFF * DM; w.src1 = w.src0; w.dst = (bf16_t*)(p.ws + WS_WDN) + (size_t)l * DM * DFF; }
    else { t -= 2464; const int ig = t / 4; w.n0m = 0; kt = t % 4; w.K = 256; w.ld = 256; w.mode = 0;
        w.src0 = p.in[I_WPOOL] + (size_t)ig * 65536; w.src1 = w.src0; w.dst = (bf16_t*)(p.ws + WS_WPL) + (size_t)ig * 65536; }
    w.k0 = kt * 64;
}
__device__ __forceinline__ void wt_load(const WTile& w, int tid, f32x4 (&v)[4][2], float& gs0, float& gs1) {
    const int row = tid >> 4, col4 = (tid & 15) * 4;
    gs0 = w.gain ? w.gain[w.k0 + row] : 1.0f; gs1 = w.gain ? w.gain[w.k0 + row + 32] : 1.0f;
#pragma unroll
    for (int q = 0; q < 4; ++q) {
        const int n0 = w.n0m + 64 * q; int c0 = n0; const float* src = w.src0;
        if (w.mode == 1) { const int pn = n0 / 256, bj = (n0 / 128) & 1, cc = n0 % 128; c0 = bj * 512 + 128 * pn + cc; }
        else if (w.mode == 2) { const int pn = n0 / 256, bj = (n0 / 128) & 1, cc = n0 % 128; c0 = 128 * pn + cc; src = bj ? w.src1 : w.src0; }
        const float* sp = src + (size_t)(w.k0 + row) * w.ld + c0 + col4;
        v[q][0] = *(const f32x4*)sp; v[q][1] = *(const f32x4*)(sp + (size_t)32 * w.ld);
    }
}
__device__ __forceinline__ void prep_phase(const Params& p, LAS unsigned char* lds) {
    int tid = threadIdx.x; asm volatile("" : "+v"(tid));
    const int G = gridDim.x, bid = blockIdx.x, wave = tid >> 6, lane = tid & 63;
    bf16_t* XB = (bf16_t*)(p.ws + WS_XB); ssq_t* SSQ = (ssq_t*)(p.ws + WS_SSQ);
    for (int r0 = bid * 8 + wave; r0 < MT; r0 += G * 16) {
        const int r1 = r0 + G * 8; const bool h1 = r1 < MT; const int r1c = h1 ? r1 : r0;
        const float* s0 = r0 < MP ? p.in[I_XP] + (size_t)r0 * DM : p.in[I_XS] + (size_t)(r0 - MP) * DM;
        const float* s1 = r1c < MP ? p.in[I_XP] + (size_t)r1c * DM : p.in[I_XS] + (size_t)(r1c - MP) * DM;
        f32x4 va[4], vb[4];
#pragma unroll
        for (int q = 0; q < 4; ++q) { va[q] = *(const f32x4*)(s0 + q * 256 + lane * 4); vb[q] = *(const f32x4*)(s1 + q * 256 + lane * 4); }
        float ssa = 0.f, ssb = 0.f;
#pragma unroll
        for (int q = 0; q < 4; ++q) {
            u32x2 w; w.x = cvt_pk_bf16(va[q][0], va[q][1]); w.y = cvt_pk_bf16(va[q][2], va[q][3]);
            *(u32x2*)(XB + (size_t)r0 * DM + q * 256 + lane * 4) = w;
            ssa += (va[q][0] * va[q][0] + va[q][1] * va[q][1]) + (va[q][2] * va[q][2] + va[q][3] * va[q][3]);
            if (h1) {
                u32x2 w2; w2.x = cvt_pk_bf16(vb[q][0], vb[q][1]); w2.y = cvt_pk_bf16(vb[q][2], vb[q][3]);
                *(u32x2*)(XB + (size_t)r1 * DM + q * 256 + lane * 4) = w2;
            }
            ssb += (vb[q][0] * vb[q][0] + vb[q][1] * vb[q][1]) + (vb[q][2] * vb[q][2] + vb[q][3] * vb[q][3]);
        }
        ssa = wave_sum(ssa); ssb = wave_sum(ssb);
        if (lane == 0) { SSQ[r0] = ssq_fix(ssa); if (h1) SSQ[r1] = ssq_fix(ssb); }
    }
    for (int idx = bid * 512 + tid; idx < 8 * MT; idx += G * 512) SSQ[MT + idx] = 0ull;
    LAS float* tile = (LAS float*)lds;
    WTile cur, nxt; f32x4 v[4][2]; float gs0 = 1.f, gs1 = 1.f;
    int t0 = bid;
    if (t0 < 2496) { wt_decode(p, t0, cur); wt_load(cur, tid, v, gs0, gs1); }
    for (; t0 < 2496; t0 += G) {
        __syncthreads();
        {
            const int row = tid >> 4, col4 = (tid & 15) * 4;
#pragma unroll
            for (int q = 0; q < 4; ++q)
#pragma unroll
                for (int h = 0; h < 2; ++h) { LAS float* tp = tile + q * 4160 + (row + 32 * h) * 65 + col4; const float gs = h ? gs1 : gs0;
                    tp[0] = v[q][h][0] * gs; tp[1] = v[q][h][1] * gs; tp[2] = v[q][h][2] * gs; tp[3] = v[q][h][3] * gs; }
        }
        __syncthreads();
        const bool hn = (t0 + G) < 2496;
        if (hn) { wt_decode(p, t0 + G, nxt); wt_load(nxt, tid, v, gs0, gs1); }
        {
            const int n = tid >> 3, kk = (tid & 7) * 8;
#pragma unroll
            for (int q = 0; q < 4; ++q) {
                float e[8];
#pragma unroll
                for (int j = 0; j < 8; ++j) e[j] = tile[q * 4160 + (kk + j) * 65 + n];
                u32x4 w; w.x = cvt_pk_bf16(e[0], e[1]); w.y = cvt_pk_bf16(e[2], e[3]); w.z = cvt_pk_bf16(e[4], e[5]); w.w = cvt_pk_bf16(e[6], e[7]);
                *(u32x4*)(cur.dst + (size_t)(cur.n0m + 64 * q + n) * cur.K + cur.k0 + kk) = w;
            }
        }
        if (hn) cur = nxt;
    }
    __syncthreads();
}

__device__ __forceinline__ f32x4 ld_bf4(const bf16_t* p) { const u32x2 w = *(const u32x2*)p; return (f32x4){bflo(w.x), bfhi(w.x), bflo(w.y), bfhi(w.y)}; }
template <int W>
__device__ __forceinline__ void pool_prompt_strip(const bf16_t* X, const ssq_t* ssq, int row0, int t0, int c, f32x4 gm, bf16_t* dgp, float* outp_seq) {
    constexpr int TT = 16, NR = TT + W - 1;
    f32x4 xr[NR];
    if (t0 >= W - 1) {
        const bf16_t* xp = X + (size_t)(row0 - (W - 1)) * DM + c; asm volatile("" : "+v"(xp));
        const ssq_t* sp = ssq + (row0 - (W - 1)); asm volatile("" : "+v"(sp));
#pragma unroll
        for (int j = 0; j < NR; ++j) { const float rs = ssq_rs(sp[j]); xr[j] = ld_bf4(xp + (size_t)j * DM) * rs * gm; }
    } else {
        int vz; asm volatile("v_mov_b32 %0, 0" : "=v"(vz));
        const bf16_t* xp = X + (size_t)(row0 - t0) * DM + c; const ssq_t* sp = ssq + (row0 - t0);
#pragma unroll
        for (int j = 0; j < NR; ++j) { const int tj = t0 - (W - 1) + j + vz, tc = tj < 0 ? 0 : tj; const float rs = ssq_rs(sp[tc]);
            const f32x4 v = ld_bf4(xp + (size_t)tc * DM) * rs * gm; xr[j] = tj < 0 ? (f32x4){0.f, 0.f, 0.f, 0.f} : v; }
    }
    f32x4 S = (f32x4){0.f, 0.f, 0.f, 0.f};
#pragma unroll
    for (int j = 0; j < W - 1; ++j) S += xr[j];
#pragma unroll
    for (int tt = 0; tt < TT; ++tt) {
        S += xr[tt + W - 1]; if (tt > 0) S -= xr[tt - 1];
        const int t = t0 + tt, cnt = (t + 1 < W) ? (t + 1) : W;
        const f32x4 cur = xr[tt + W - 1], d = S * __builtin_amdgcn_rcpf((float)cnt) - cur;
        u32x2 wv; wv.x = cvt_pk_bf16(d[0], d[1]); wv.y = cvt_pk_bf16(d[2], d[3]);
        *(u32x2*)(dgp + (size_t)tt * 256) = wv;
        if (t >= 4081) *(f32x4*)(outp_seq + (size_t)(t - 4081) * DM) = cur;
    }
}
template <int W>
__device__ __forceinline__ void pool_sample_strip(const bf16_t* X, const ssq_t* ssq, int row0, int c, f32x4 gm, const float* state_seq, bf16_t* dgp, float* outs_seq) {
    constexpr int TT = 8, NR = TT + W - 1;
    f32x4 xr[NR];
    { const float* stp = state_seq + (size_t)(15 - (W - 1)) * DM; asm volatile("" : "+v"(stp));
#pragma unroll
      for (int j = 0; j < W - 1; ++j) xr[j] = *(const f32x4*)(stp + (size_t)j * DM); }
    { const bf16_t* xp = X + (size_t)row0 * DM + c; asm volatile("" : "+v"(xp));
      const ssq_t* sp = ssq + row0;
#pragma unroll
      for (int j = 0; j < TT; ++j) { const float rs = ssq_rs(sp[j]); xr[W - 1 + j] = ld_bf4(xp + (size_t)j * DM) * rs * gm; } }
    f32x4 S = (f32x4){0.f, 0.f, 0.f, 0.f};
#pragma unroll
    for (int j = 0; j < W - 1; ++j) S += xr[j];
#pragma unroll
    for (int tt = 0; tt < TT; ++tt) {
        S += xr[tt + W - 1]; if (tt > 0) S -= xr[tt - 1];
        const f32x4 cur = xr[tt + W - 1], d = S * (1.0f / (float)W) - cur;
        u32x2 wv; wv.x = cvt_pk_bf16(d[0], d[1]); wv.y = cvt_pk_bf16(d[2], d[3]);
        *(u32x2*)(dgp + (size_t)tt * 256) = wv;
        *(f32x4*)(outs_seq + (size_t)(7 + tt) * DM) = cur;
    }
}
__device__ __forceinline__ void pool1_phase(const Params& p, int l, const ssq_t* ssq) {
    int tid = threadIdx.x; asm volatile("" : "+v"(tid));
    const int G = gridDim.x, bid = blockIdx.x, i = l >> 1;
    const bf16_t* X = (const bf16_t*)(p.ws + WS_XB); bf16_t* DG = (bf16_t*)(p.ws + WS_DG);
    const int cq = tid & 255, c = cq * 4, half = tid >> 8, g = __builtin_amdgcn_readfirstlane(cq >> 6);
    const f32x4 gm = *(const f32x4*)(p.in[I_NMIX] + l * DM + c);
    const float* spool = p.in[I_SPOOL] + (size_t)i * 128 * 15 * DM;
    float* outp = p.out + O_POOLP + (size_t)i * 4 * 15 * DM; float* outs = p.out + O_POOLS + (size_t)i * 128 * 15 * DM;
    for (int u = bid; u < MT / 32; u += G) {
        if (u < MP / 32) {
            const int row0 = u * 32 + half * 16, t0 = row0 & 4095, b = row0 >> 12;
            bf16_t* dgp = DG + ((size_t)g * MT + row0) * 256 + (c - 256 * g); float* op = outp + (size_t)b * 15 * DM + c;
            if (g == 0) pool_prompt_strip<2>(X, ssq, row0, t0, c, gm, dgp, op);
            else if (g == 1) pool_prompt_strip<4>(X, ssq, row0, t0, c, gm, dgp, op);
            else if (g == 2) pool_prompt_strip<8>(X, ssq, row0, t0, c, gm, dgp, op);
            else pool_prompt_strip<16>(X, ssq, row0, t0, c, gm, dgp, op);
        } else {
            const int s0 = (u - MP / 32) * 4;
#pragma unroll 1
            for (int q = 0; q < 2; ++q) {
                const int s = s0 + half * 2 + q, row0 = MP + s * 8;
                bf16_t* dgp = DG + ((size_t)g * MT + row0) * 256 + (c - 256 * g); float* op = outs + (size_t)s * 15 * DM + c; const float* st = spool + (size_t)s * 15 * DM + c;
                if (g == 0) pool_sample_strip<2>(X, ssq, row0, c, gm, st, dgp, op);
                else if (g == 1) pool_sample_strip<4>(X, ssq, row0, c, gm, st, dgp, op);
                else if (g == 2) pool_sample_strip<8>(X, ssq, row0, c, gm, st, dgp, op);
                else pool_sample_strip<16>(X, ssq, row0, c, gm, st, dgp, op);
            }
            for (int idx = tid; idx < 4 * 7 * 256; idx += 512) { const int c4 = (idx & 255) * 4, rr = (idx >> 8) % 7, sl = idx / (7 * 256);
                *(f32x4*)(outs + ((size_t)(s0 + sl) * 15 + rr) * DM + c4) = *(const f32x4*)(spool + ((size_t)(s0 + sl) * 15 + 8 + rr) * DM + c4); }
        }
    }
}

constexpr int KS_STRIDE = 72, VT_STRIDE = 264;

__device__ __forceinline__ void attn_item(const LAS bf16_t* Ks, const LAS bf16_t* Vt, int tile0, int r0, bool first, bool qvalid,
                                          const bf16_t* qptr, const float* qn, float slope, float sink, bf16_t* optr, int fr, int fq) {
    u32x4 raw0 = (u32x4){0u, 0u, 0u, 0u}, raw1 = raw0;
    if (qvalid) { raw0 = *(const u32x4*)(qptr); raw1 = *(const u32x4*)(qptr + 32); }
    float qf[16];
#pragma unroll
    for (int j = 0; j < 4; ++j) { qf[2 * j] = bflo(raw0[j]); qf[2 * j + 1] = bfhi(raw0[j]); qf[8 + 2 * j] = bflo(raw1[j]); qf[8 + 2 * j + 1] = bfhi(raw1[j]); }
    float ss = 0.f;
#pragma unroll
    for (int j = 0; j < 16; ++j) ss += qf[j] * qf[j];
    ss += __shfl_xor(ss, 16); ss += __shfl_xor(ss, 32);
    const float rq = rsqrtf(ss * (1.0f / 64.0f) + RMS_EPS) * 0.125f;
    bf16x8 q0, q1;
    {
        const f32x4 n0 = *(const f32x4*)(qn + fq * 8), n1 = *(const f32x4*)(qn + fq * 8 + 4), n2 = *(const f32x4*)(qn + 32 + fq * 8), n3 = *(const f32x4*)(qn + 32 + fq * 8 + 4);
        u32x4 a, b;
        a.x = cvt_pk_bf16(qf[0] * rq * n0[0], qf[1] * rq * n0[1]); a.y = cvt_pk_bf16(qf[2] * rq * n0[2], qf[3] * rq * n0[3]);
        a.z = cvt_pk_bf16(qf[4] * rq * n1[0], qf[5] * rq * n1[1]); a.w = cvt_pk_bf16(qf[6] * rq * n1[2], qf[7] * rq * n1[3]);
        b.x = cvt_pk_bf16(qf[8] * rq * n2[0], qf[9] * rq * n2[1]); b.y = cvt_pk_bf16(qf[10] * rq * n2[2], qf[11] * rq * n2[3]);
        b.z = cvt_pk_bf16(qf[12] * rq * n3[0], qf[13] * rq * n3[1]); b.w = cvt_pk_bf16(qf[14] * rq * n3[2], qf[15] * rq * n3[3]);
        q0 = __builtin_bit_cast(bf16x8, a); q1 = __builtin_bit_cast(bf16x8, b);
    }
    f32x4 s[9];
#pragma unroll
    for (int T = 0; T < 9; ++T) {
        const LAS bf16_t* kp = Ks + ((tile0 + T) * 16 + fr) * KS_STRIDE + fq * 8;
        const bf16x8 a0 = *(const LAS bf16x8*)(kp), a1 = *(const LAS bf16x8*)(kp + 32);
        f32x4 z = (f32x4){0.f, 0.f, 0.f, 0.f};
        z = __builtin_amdgcn_mfma_f32_16x16x32_bf16(a0, q0, z, 0, 0, 0);
        s[T] = __builtin_amdgcn_mfma_f32_16x16x32_bf16(a1, q1, z, 0, 0, 0);
    }
    __builtin_amdgcn_sched_barrier(0);
    int qi = r0 + fr; asm volatile("" : "+v"(qi));
    const int lim = first ? qi + 1 : 128;
    float mx = sink;
#pragma unroll
    for (int T = 0; T < 9; ++T)
#pragma unroll
        for (int j = 0; j < 4; ++j) {
            const int jk = (tile0 + T) * 16 + 4 * fq + j, dist = 128 + qi - jk;
            const bool valid = (unsigned)dist < (unsigned)lim;
            const float v = valid ? (s[T][j] - slope * (float)dist) : -1e30f;
            s[T][j] = v; mx = fmaxf(mx, v);
        }
    mx = fmaxf(mx, __shfl_xor(mx, 16)); mx = fmaxf(mx, __shfl_xor(mx, 32));
    float sum = 0.f;
#pragma unroll
    for (int T = 0; T < 9; ++T)
#pragma unroll
        for (int j = 0; j < 4; ++j) { const float e = __expf(s[T][j] - mx); s[T][j] = e; sum += e; }
    sum += __shfl_xor(sum, 16); sum += __shfl_xor(sum, 32);
    sum += __expf(sink - mx);
    const float inv = 1.0f / sum;
    __builtin_amdgcn_sched_barrier(0);
    f32x4 o[4];
#pragma unroll
    for (int dt = 0; dt < 4; ++dt) o[dt] = (f32x4){0.f, 0.f, 0.f, 0.f};
#pragma unroll
    for (int pp = 0; pp < 5; ++pp) {
        const int T0 = 2 * pp, T1 = (pp < 4) ? 2 * pp + 1 : 8;
        u32x4 pw;
        pw.x = cvt_pk_bf16(s[T0][0] * inv, s[T0][1] * inv); pw.y = cvt_pk_bf16(s[T0][2] * inv, s[T0][3] * inv);
        if (pp < 4) { pw.z = cvt_pk_bf16(s[T1][0] * inv, s[T1][1] * inv); pw.w = cvt_pk_bf16(s[T1][2] * inv, s[T1][3] * inv); } else { pw.z = 0u; pw.w = 0u; }
        const bf16x8 pf = __builtin_bit_cast(bf16x8, pw);
#pragma unroll
        for (int dt = 0; dt < 4; ++dt) {
            const LAS bf16_t* vp = Vt + (dt * 16 + fr) * VT_STRIDE + 4 * fq;
            const u32x2 v0 = *(const LAS u32x2*)(vp + (tile0 + T0) * 16), v1 = *(const LAS u32x2*)(vp + (tile0 + T1) * 16);
            u32x4 vw; vw.x = v0.x; vw.y = v0.y; vw.z = v1.x; vw.w = v1.y;
            o[dt] = __builtin_amdgcn_mfma_f32_16x16x32_bf16(__builtin_bit_cast(bf16x8, vw), pf, o[dt], 0, 0, 0);
        }
    }
    if (qvalid) {
#pragma unroll
        for (int dt = 0; dt < 4; ++dt) { u32x2 w; w.x = cvt_pk_bf16(o[dt][0], o[dt][1]); w.y = cvt_pk_bf16(o[dt][2], o[dt][3]); *(u32x2*)(optr + dt * 16) = w; }
    }
}

__device__ __forceinline__ void mixer_phase(const Params& p, int l, LAS unsigned char* lds) {
    const int G = gridDim.x, bid = blockIdx.x, i = l >> 1;
    const bf16_t* QKV = (const bf16_t*)(p.ws + WS_QKV); const bf16_t* GLU = (const bf16_t*)(p.ws + WS_GLU); bf16_t* CAT = (bf16_t*)(p.ws + WS_CAT);
    const float* qn = p.in[I_QN] + i * 64; const float* kn = p.in[I_KN] + i * 64; const float* sinks = p.in[I_SINK] + i * 8;
    constexpr int N_PA = 256, N_CV = 544, N_SA = 128;
    for (int u = bid; u < N_PA + N_CV + N_SA; u += G) {
        int tid = threadIdx.x; asm volatile("" : "+v"(tid));
        const int wave = tid >> 6, lane = tid & 63, fr = lane & 15, fq = lane >> 4;
        if (u < N_PA) {
#ifndef X_NOPA
            const int kh = u & 1, blk = (u >> 1) & 31, b = u >> 6;
            const int rowQ0 = b * 4096 + blk * 128, rowK0 = rowQ0 - 128;
            LAS bf16_t* Ks = (LAS bf16_t*)lds; LAS bf16_t* Vt = (LAS bf16_t*)(lds + 256 * KS_STRIDE * 2);
            const int chunk = tid & 7;
            const f32x4 kn0 = *(const f32x4*)(kn + chunk * 8), kn1 = *(const f32x4*)(kn + chunk * 8 + 4);
#pragma unroll 1
            for (int ps = 0; ps < 4; ++ps) {
                const int key = (tid >> 3) + 64 * ps;
                u32x4 kr = (u32x4){0u, 0u, 0u, 0u}, vr = kr;
                const bool have = (blk > 0) || (key >= 128);
                if (have) { const bf16_t* rp = QKV + (size_t)(rowK0 + key) * 768 + 512 + kh * 64 + chunk * 8; kr = *(const u32x4*)rp; vr = *(const u32x4*)(rp + 128); }
                float kf[8], vf[8];
#pragma unroll
                for (int j = 0; j < 4; ++j) { kf[2 * j] = bflo(kr[j]); kf[2 * j + 1] = bfhi(kr[j]); vf[2 * j] = bflo(vr[j]); vf[2 * j + 1] = bfhi(vr[j]); }
                float ss = 0.f;
#pragma unroll
                for (int j = 0; j < 8; ++j) ss += kf[j] * kf[j];
                ss += __shfl_xor(ss, 1); ss += __shfl_xor(ss, 2); ss += __shfl_xor(ss, 4);
                const float rk = rsqrtf(ss * (1.0f / 64.0f) + RMS_EPS);
#pragma unroll
                for (int j = 0; j < 4; ++j) { kf[j] *= rk * kn0[j]; kf[4 + j] *= rk * kn1[j]; }
                u32x4 kw; kw.x = cvt_pk_bf16(kf[0], kf[1]); kw.y = cvt_pk_bf16(kf[2], kf[3]); kw.z = cvt_pk_bf16(kf[4], kf[5]); kw.w = cvt_pk_bf16(kf[6], kf[7]);
                *(LAS u32x4*)(Ks + key * KS_STRIDE + chunk * 8) = kw;
#pragma unroll
                for (int j = 0; j < 4; ++j) { Vt[(chunk * 8 + 2 * j) * VT_STRIDE + key] = (bf16_t)(vr[j] & 0xffffu); Vt[(chunk * 8 + 2 * j + 1) * VT_STRIDE + key] = (bf16_t)(vr[j] >> 16); }
                if (blk == 31 && key >= 128) {
                    float* ko = p.out + O_KP + ((((size_t)i * 4 + b) * 128 + (key - 128)) * 2 + kh) * 64 + chunk * 8;
                    float* vo = p.out + O_VP + ((((size_t)i * 4 + b) * 128 + (key - 128)) * 2 + kh) * 64 + chunk * 8;
                    *(f32x4*)ko = (f32x4){kf[0], kf[1], kf[2], kf[3]}; *(f32x4*)(ko + 4) = (f32x4){kf[4], kf[5], kf[6], kf[7]};
                    *(f32x4*)vo = (f32x4){vf[0], vf[1], vf[2], vf[3]}; *(f32x4*)(vo + 4) = (f32x4){vf[4], vf[5], vf[6], vf[7]};
                }
            }
            __syncthreads();
            const int r0 = wave * 16;
#pragma unroll 1
            for (int g = 0; g < 4; ++g) {
                const int h = kh * 4 + g;
                const float slope = exp2f(-(float)(h + 1)), sink = sinks[h];
                const size_t row = (size_t)(rowQ0 + r0 + fr);
                attn_item(Ks, Vt, wave, r0, blk == 0, true, QKV + row * 768 + h * 64 + fq * 8, qn, slope, sink, CAT + row * DM + 512 + h * 64 + 4 * fq, fr, fq);
            }
            __syncthreads();
#endif
        } else if (u < N_PA + N_CV) {
#ifndef X_NOCV
            const int cu = u - N_PA, c2 = tid & 255, half = tid >> 8, c = c2 * 2; const bool prm = cu < 512;
            LAS float* ybuf = (LAS float*)lds;
            f32x2 wdw[31];
            { const float* wp = p.in[I_WDW] + (size_t)i * 31 * 512 + c; asm volatile("" : "+v"(wp));
#pragma unroll
              for (int j = 0; j < 31; ++j) { wdw[j] = *(const f32x2*)wp; wp += 512; asm volatile("" : "+v"(wp)); } }
            const f32x2 bias = *(const f32x2*)(p.in[I_BDW] + i * 512 + c);
            if (prm) {
#pragma unroll 1
                for (int q = 0; q < 2; ++q) {
                    const int b = cu >> 7, tl = half * 16 + q * 8, tb = (cu & 127) * 32 + tl;
                    f32x2 win[38];
                    if (tb >= 30) {
                        const bf16_t* gp = GLU + ((size_t)b * 4096 + tb - 30) * 512 + c; asm volatile("" : "+v"(gp));
#pragma unroll
                        for (int j = 0; j < 38; ++j) { const unsigned w = *(const unsigned*)gp; gp += 512; asm volatile("" : "+v"(gp)); win[j] = (f32x2){bflo(w), bfhi(w)}; }
                    } else {
                        int vz; asm volatile("v_mov_b32 %0, 0" : "=v"(vz));
                        const bf16_t* gp = GLU + (size_t)b * 4096 * 512 + c; asm volatile("" : "+v"(gp));
#pragma unroll
                        for (int j = 0; j < 38; ++j) { const int tj = tb - 30 + j + vz; const unsigned w = *(const unsigned*)gp; if (tj >= 0) gp += 512; asm volatile("" : "+v"(gp));
                            win[j] = tj < 0 ? (f32x2){0.f, 0.f} : (f32x2){bflo(w), bfhi(w)}; }
                    }
                    if (tb >= 4064) {
                        float* oc = p.out + O_CONVP + (((size_t)i * 4 + b) * 30) * 512 + c; asm volatile("" : "+v"(oc));
#pragma unroll
                        for (int j = 0; j < 8; ++j) { const int t = tb + j; if (t >= 4066) *(f32x2*)(oc + (size_t)(t - 4066) * 512) = win[30 + j]; }
                    }
#pragma unroll
                    for (int t = 0; t < 8; ++t) {
                        f32x2 y = bias;
#pragma unroll
                        for (int j = 0; j < 31; ++j) y += wdw[j] * win[t + j];
                        *(LAS f32x2*)(ybuf + (tl + t) * 512 + c) = y;
                    }
                }
            } else {
#pragma unroll 1
                for (int q = 0; q < 2; ++q) {
                    const int sl = half * 2 + q, s = (cu - 512) * 4 + sl;
                    f32x2 win[38];
                    const float* cc = p.in[I_CCONV] + (((size_t)i * 128 + s) * 30) * 512 + c; asm volatile("" : "+v"(cc));
                    const bf16_t* gs = GLU + ((size_t)MP + s * 8) * 512 + c; asm volatile("" : "+v"(gs));
#pragma unroll
                    for (int j = 0; j < 30; ++j) { win[j] = *(const f32x2*)cc; cc += 512; asm volatile("" : "+v"(cc)); }
#pragma unroll
                    for (int j = 0; j < 8; ++j) { const unsigned w = *(const unsigned*)gs; gs += 512; asm volatile("" : "+v"(gs)); win[30 + j] = (f32x2){bflo(w), bfhi(w)}; }
                    float* oc = p.out + O_CONVS + (((size_t)i * 128 + s) * 30) * 512 + c; asm volatile("" : "+v"(oc));
#pragma unroll
                    for (int j = 0; j < 30; ++j) { *(f32x2*)oc = win[8 + j]; oc += 512; asm volatile("" : "+v"(oc)); }
#pragma unroll
                    for (int t = 0; t < 8; ++t) {
                        f32x2 y = bias;
#pragma unroll
                        for (int j = 0; j < 31; ++j) y += wdw[j] * win[t + j];
                        *(LAS f32x2*)(ybuf + (sl * 8 + t) * 512 + c) = y;
                    }
                }
            }
            __syncthreads();
            {
                const float* gp = p.in[I_CNG] + i * 512 + lane * 8; const float* bp = p.in[I_CNB] + i * 512 + lane * 8;
                const f32x4 g0 = *(const f32x4*)gp, g1 = *(const f32x4*)(gp + 4), b0 = *(const f32x4*)bp, b1 = *(const f32x4*)(bp + 4);
#pragma unroll 1
                for (int q = 0; q < 4; ++q) {
                    const int tk = wave * 4 + q; const size_t row = prm ? (size_t)cu * 32 + tk : (size_t)MP + (size_t)(cu - 512) * 32 + tk;
                    const f32x4 v0 = *(const LAS f32x4*)(ybuf + tk * 512 + lane * 8), v1 = *(const LAS f32x4*)(ybuf + tk * 512 + lane * 8 + 4);
                    const float mean = wave_sum((v0[0] + v0[1]) + (v0[2] + v0[3]) + (v1[0] + v1[1]) + (v1[2] + v1[3])) * (1.0f / 512.0f);
                    const f32x4 d0 = v0 - mean, d1 = v1 - mean;
                    const float var = wave_sum((d0[0] * d0[0] + d0[1] * d0[1]) + (d0[2] * d0[2] + d0[3] * d0[3]) + (d1[0] * d1[0] + d1[1] * d1[1]) + (d1[2] * d1[2] + d1[3] * d1[3])) * (1.0f / 512.0f);
                    const float rs = rsqrtf(var + LN_EPS);
                    f32x4 o0 = d0 * rs * g0 + b0, o1 = d1 * rs * g1 + b1;
#pragma unroll
                    for (int j = 0; j < 4; ++j) { o0[j] = o0[j] * fast_sigmoid(o0[j]); o1[j] = o1[j] * fast_sigmoid(o1[j]); }
                    u32x4 w; w.x = cvt_pk_bf16(o0[0], o0[1]); w.y = cvt_pk_bf16(o0[2], o0[3]); w.z = cvt_pk_bf16(o1[0], o1[1]); w.w = cvt_pk_bf16(o1[2], o1[3]);
                    *(u32x4*)(CAT + row * DM + lane * 8) = w;
                }
            }
            __syncthreads();
#endif
        } else {
#ifndef X_NOSA
            const int s = u - N_PA - N_CV;
            LAS bf16_t* Ks = (LAS bf16_t*)lds; LAS bf16_t* Vt = (LAS bf16_t*)(lds + 2 * 144 * KS_STRIDE * 2);
            const int chunk = tid & 7;
            const f32x4 kn0 = *(const f32x4*)(kn + chunk * 8), kn1 = *(const f32x4*)(kn + chunk * 8 + 4);
#pragma unroll 1
            for (int it = tid; it < 2 * 144 * 8; it += 512) {
                const int kk = it >> 3, kh = kk / 144, key = kk % 144;
                float kf[8], vf[8];
#pragma unroll
                for (int j = 0; j < 8; ++j) { kf[j] = 0.f; vf[j] = 0.f; }
                const bool isnew = (key >= 128) && (key < 136);
                if (key < 128) {
                    const size_t off = ((((size_t)i * 128 + s) * 128 + key) * 2 + kh) * 64 + chunk * 8;
                    const f32x4 a0 = *(const f32x4*)(p.in[I_CK] + off), a1 = *(const f32x4*)(p.in[I_CK] + off + 4), c0 = *(const f32x4*)(p.in[I_CV] + off), c1 = *(const f32x4*)(p.in[I_CV] + off + 4);
#pragma unroll
                    for (int j = 0; j < 4; ++j) { kf[j] = a0[j]; kf[4 + j] = a1[j]; vf[j] = c0[j]; vf[4 + j] = c1[j]; }
                } else if (isnew) {
                    const bf16_t* rp = QKV + ((size_t)MP + s * 8 + (key - 128)) * 768 + 512 + kh * 64 + chunk * 8;
                    const u32x4 kr = *(const u32x4*)rp, vr = *(const u32x4*)(rp + 128);
#pragma unroll
                    for (int j = 0; j < 4; ++j) { kf[2 * j] = bflo(kr[j]); kf[2 * j + 1] = bfhi(kr[j]); vf[2 * j] = bflo(vr[j]); vf[2 * j + 1] = bfhi(vr[j]); }
                }
                float ss = 0.f;
#pragma unroll
                for (int j = 0; j < 8; ++j) ss += kf[j] * kf[j];
                ss += __shfl_xor(ss, 1); ss += __shfl_xor(ss, 2); ss += __shfl_xor(ss, 4);
                const float rk = rsqrtf(ss * (1.0f / 64.0f) + RMS_EPS);
                if (isnew) {
#pragma unroll
                    for (int j = 0; j < 4; ++j) { kf[j] *= rk * kn0[j]; kf[4 + j] *= rk * kn1[j]; }
                }
                u32x4 kw; kw.x = cvt_pk_bf16(kf[0], kf[1]); kw.y = cvt_pk_bf16(kf[2], kf[3]); kw.z = cvt_pk_bf16(kf[4], kf[5]); kw.w = cvt_pk_bf16(kf[6], kf[7]);
                *(LAS u32x4*)(Ks + (kh * 144 + key) * KS_STRIDE + chunk * 8) = kw;
                u32x4 vw; vw.x = cvt_pk_bf16(vf[0], vf[1]); vw.y = cvt_pk_bf16(vf[2], vf[3]); vw.z = cvt_pk_bf16(vf[4], vf[5]); vw.w = cvt_pk_bf16(vf[6], vf[7]);
#pragma unroll
                for (int j = 0; j < 4; ++j) { Vt[(kh * 64 + chunk * 8 + 2 * j) * VT_STRIDE + key] = (bf16_t)(vw[j] & 0xffffu); Vt[(kh * 64 + chunk * 8 + 2 * j + 1) * VT_STRIDE + key] = (bf16_t)(vw[j] >> 16); }
                if (key >= 8 && key < 136) {
                    const size_t oo = ((((size_t)i * 128 + s) * 128 + (key - 8)) * 2 + kh) * 64 + chunk * 8;
                    float* ko = p.out + O_KS + oo; float* vo = p.out + O_VS + oo;
                    *(f32x4*)ko = (f32x4){kf[0], kf[1], kf[2], kf[3]}; *(f32x4*)(ko + 4) = (f32x4){kf[4], kf[5], kf[6], kf[7]};
                    *(f32x4*)vo = (f32x4){vf[0], vf[1], vf[2], vf[3]}; *(f32x4*)(vo + 4) = (f32x4){vf[4], vf[5], vf[6], vf[7]};
                }
            }
            __syncthreads();
            {
                const int kh = wave >> 2, g = wave & 3, h = kh * 4 + g;
                const float slope = exp2f(-(float)(h + 1)), sink = sinks[h];
                const size_t row = (size_t)MP + s * 8 + (fr & 7);
                attn_item(Ks + kh * 144 * KS_STRIDE, Vt + kh * 64 * VT_STRIDE, 0, 0, false, fr < 8, QKV + row * 768 + h * 64 + fq * 8, qn, slope, sink, CAT + row * DM + 512 + h * 64 + 4 * fq, fr, fq);
            }
            __syncthreads();
#endif
        }
    }
}


__device__ __forceinline__ void splitk_reduce(float* Y, bf16_t* XB, ssq_t* ssq, const float* part, const pg8::StaticOrder& S, int KS) {
    int tid = threadIdx.x; asm volatile("" : "+v"(tid));
    const int wid = tid >> 6, lane = tid & 63, wr = wid >> 2, wc = wid & 3, fr = lane & 15, fq = lane >> 4;
    for (int task = blockIdx.x; task < 256; task += gridDim.x) {
        const int e = task >> 4, ai = (task >> 3) & 1, m = (task >> 1) & 3, bj = task & 1;
        pg8::Unit u; S.tile(256 + e, u);
        const float* pp = part + (size_t)(e * KS) * 65536 + (size_t)((((ai * 4 + m) * 2 + bj) * 2) * 2048) + (size_t)tid * 4;
        f32x4 a0 = (f32x4){0.f, 0.f, 0.f, 0.f}, a1 = a0;
        for (int k = 0; k < KS; ++k) { a0 += *(const f32x4*)(pp + (size_t)k * 65536); a1 += *(const f32x4*)(pp + (size_t)k * 65536 + 2048); }
        const int r = u.pm * 256 + ai * 128 + wr * 64 + m * 16 + fr, col = u.pn * 256 + bj * 128 + wc * 32 + 8 * fq;
        bf16_t* bp = XB + (size_t)r * DM + col;
        f32x4 x0, x1; bf8_to_f32(*(const u32x4*)bp, x0, x1);
        const f32x4 v0 = x0 + a0, v1 = x1 + a1;
        if (Y) { float* yp = Y + (size_t)r * DM + col; *(f32x4*)yp = v0; *(f32x4*)(yp + 4) = v1; }
        u32x4 w; w.x = cvt_pk_bf16(v0[0], v0[1]); w.y = cvt_pk_bf16(v0[2], v0[3]); w.z = cvt_pk_bf16(v1[0], v1[1]); w.w = cvt_pk_bf16(v1[2], v1[3]);
        *(u32x4*)bp = w;
        float ss = (v0[0] * v0[0] + v0[1] * v0[1]) + (v0[2] * v0[2] + v0[3] * v0[3]) + (v1[0] * v1[0] + v1[1] * v1[1]) + (v1[2] * v1[2] + v1[3] * v1[3]);
        ss += __shfl_xor(ss, 16); ss += __shfl_xor(ss, 32);
        if (fq == 0) ssq_add(ssq + r, ss);
    }
}

#define XB_TMO      128
#define XB_XCNT(j)  (256  + 64 * (j))
#define XB_XSUB(j)  (1280 + 64 * (j))
#define XB_XGEN(j)  (2304 + 64 * (j))
#define XB_TOP      3328
#define XB_TOPGEN   3392
#define XCD_BAR_WORDS 3456
#define XB_SPIN_CAP (1u << 22)
__device__ __forceinline__ unsigned xb_ld(unsigned* p)              { return __hip_atomic_load(p, __ATOMIC_RELAXED, __HIP_MEMORY_SCOPE_AGENT); }
__device__ __forceinline__ unsigned xb_add(unsigned* p, unsigned v) { return __hip_atomic_fetch_add(p, v, __ATOMIC_RELAXED, __HIP_MEMORY_SCOPE_AGENT); }
__device__ __forceinline__ unsigned xb_xcc_id() { return (unsigned)__builtin_amdgcn_s_getreg((3 << 11) | 20) & 0xFu; }
#define XB_SPIN(cond, bar) do { unsigned _sp = 0; while (cond) { __builtin_amdgcn_s_sleep(1); \
    if ((++_sp & 255u) == 0u) { if (xb_ld(&(bar)[XB_TMO])) break; if (_sp > XB_SPIN_CAP) { atomicAdd(&(bar)[XB_TMO], 1u); break; } } } } while (0)
struct XcdBarrier { unsigned* bar; unsigned x; volatile LAS unsigned* st; };
__device__ __forceinline__ XcdBarrier xcd_barrier_post(unsigned* bar, volatile LAS unsigned* st) {
    XcdBarrier b; b.bar = bar; b.x = xb_xcc_id(); b.st = st;
    if (threadIdx.x == 0) (void)xb_add(&bar[XB_XCNT(b.x)], 1u);
    return b;
}
__device__ __forceinline__ void xcd_barrier_complete(unsigned* bar, unsigned x, unsigned& nloc, unsigned& nx) {
    const unsigned G = gridDim.x * gridDim.y * gridDim.z;
    unsigned sum, cnt, mine, sp = 0u;
    for (;;) {
        sum = 0u; cnt = 0u; mine = 0u;
#pragma unroll
        for (unsigned j = 0; j < 16; ++j) { const unsigned c = xb_ld(&bar[XB_XCNT(j)]); sum += c; cnt += (c > 0u) ? 1u : 0u; mine = (j == x) ? c : mine; }
        if (sum == G) break;
        __builtin_amdgcn_s_sleep(1);
        if ((++sp & 255u) == 0u) { if (xb_ld(&bar[XB_TMO])) break; if (sp > XB_SPIN_CAP) { atomicAdd(&bar[XB_TMO], 1u); break; } }
    }
    nloc = mine > 0u ? mine : 1u; nx = cnt > 0u ? cnt : 1u;
}
__device__ __forceinline__ void xcd_barrier(const XcdBarrier& b) {
    asm volatile("s_waitcnt vmcnt(0)" ::: "memory");
    __syncthreads();
    if (threadIdx.x == 0) {
        unsigned* bar = b.bar;
        __builtin_amdgcn_s_waitcnt(0);
        unsigned nloc = b.st[0], nx = b.st[1];
        if (nloc == 0u) { xcd_barrier_complete(bar, b.x, nloc, nx); b.st[0] = nloc; b.st[1] = nx; }
        const unsigned old = xb_add(&bar[XB_XSUB(b.x)], 1u);
        const unsigned gen = old / nloc;
        if (old + 1u == (gen + 1u) * nloc) {
            __builtin_amdgcn_fence(__ATOMIC_RELEASE, "agent");
            asm volatile("s_waitcnt vmcnt(0)" ::: "memory");
            const unsigned og = xb_add(&bar[XB_TOP], 1u);
            const unsigned tg = og / nx;
            if (og + 1u == (tg + 1u) * nx) xb_add(&bar[XB_TOPGEN], 1u);
            else XB_SPIN(xb_ld(&bar[XB_TOPGEN]) == tg, bar);
            __builtin_amdgcn_fence(__ATOMIC_ACQUIRE, "agent");
            xb_add(&bar[XB_XGEN(b.x)], 1u);
            asm volatile("s_waitcnt vmcnt(0)" ::: "memory");
        } else {
            XB_SPIN(xb_ld(&bar[XB_XGEN(b.x)]) == gen, bar);
            __builtin_amdgcn_fence(__ATOMIC_ACQUIRE, "agent");
            asm volatile("s_waitcnt vmcnt(0)" ::: "memory");
        }
    }
    __syncthreads();
}

__global__ void __launch_bounds__(512, 2) fwd_megakernel(Params p) {
    extern __shared__ __attribute__((aligned(16))) unsigned char lds_raw[];
    LAS unsigned char* lds = (LAS unsigned char*)lds_raw;
    cg::grid_group grid = cg::this_grid();
    const int G = gridDim.x, bid = blockIdx.x;
    bf16_t* XB = (bf16_t*)(p.ws + WS_XB); ssq_t* SSQ = (ssq_t*)(p.ws + WS_SSQ); float* PART = (float*)(p.ws + WS_PART);
#define IN(k) (p.ph_lo <= (k) && (k) < p.ph_hi)
#define SYNC(k) do { if (p.ph_hi > (k) + 1) xcd_barrier(bar); } while (0)
    unsigned* barw = (unsigned*)(p.ws + WS_BAR);
    volatile LAS unsigned* bst = (volatile LAS unsigned*)(lds + 131072);
    if (threadIdx.x < 4) bst[threadIdx.x] = 0u;
    __syncthreads();
    XcdBarrier bar = xcd_barrier_post(barw, bst);
#ifndef X_NOPREP
    if (IN(0)) prep_phase(p, lds);
    if (p.ph_lo < 0) grid.sync();
    xcd_barrier(bar);
    for (int rep = 0; rep < DUP_SYNC; ++rep) xcd_barrier(bar);
#endif
#pragma unroll 1
    for (int l = 0; l < 4; ++l) {
        const int pb = 1 + 5 * l, i = l >> 1;
        ssq_t* ssq_in = SSQ + (size_t)(2 * l) * MT;
        ssq_t* ssq_mid = SSQ + (size_t)(2 * l + 1) * MT;
        ssq_t* ssq_out = SSQ + (size_t)(2 * l + 2) * MT;
        if ((l & 1) == 0) {
            if (IN(pb) && X_GIN) {
                pg8::Gemm g{XB, (const bf16_t*)(p.ws + WS_WIN) + (size_t)i * DIN * DM, MT, DIN, DM}; pg8::StaticOrder S; S.init(MT, DIN, DM, G, bid);
                EpiIn E{ssq_in, (bf16_t*)(p.ws + WS_GLU), (bf16_t*)(p.ws + WS_QKV)};
                for (int rep = 0; rep <= DUP_IN; ++rep) { pg8::gemm_phase(lds, g, S, E); SYNC(pb); }
            }
#ifndef X_NOMIX
            if (IN(pb + 1)) { for (int rep = 0; rep <= DUP_MIX; ++rep) { mixer_phase(p, l, lds); SYNC(pb + 1); } }
#endif
            if (IN(pb + 2) && X_GOUT) {
                pg8::Gemm g{(const bf16_t*)(p.ws + WS_CAT), (const bf16_t*)(p.ws + WS_WOUT) + (size_t)i * DM * DM, MT, DM, DM}; pg8::SplitOrder<false> S; S.init2(MT, DM, DM, G, bid, 4);
                EpiRes<false> E{nullptr, XB, ssq_mid, nullptr, PART};
                pg8::gemm_phase(lds, g, S, E);
                xcd_barrier(bar);
                splitk_reduce(nullptr, XB, ssq_mid, PART, S, 4);
                SYNC(pb + 2);
            }
        } else {
#ifndef X_NOPOOL1
            if (IN(pb)) { for (int rep = 0; rep <= DUP_POOL1; ++rep) { pool1_phase(p, l, ssq_in); SYNC(pb); } }
#endif
            if (IN(pb + 1) && X_GPOOL) {
                pg8::Gemm g{(const bf16_t*)(p.ws + WS_DG), (const bf16_t*)(p.ws + WS_WPL) + (size_t)i * 4 * 65536, 4 * MT, 256, 256}; pg8::PoolOrder S{G, bid};
                EpiRes<true> E{nullptr, XB, ssq_mid, p.in[I_PSCALE] + i * DM, PART};
                pg8::gemm_phase(lds, g, S, E);
                SYNC(pb + 2);
            }
        }
        if (IN(pb + 3) && X_GGU) {
            pg8::Gemm g{XB, (const bf16_t*)(p.ws + WS_WGU) + (size_t)l * 2 * DFF * DM, MT, 2 * DFF, DM}; pg8::StaticOrder S; S.init(MT, 2 * DFF, DM, G, bid);
            EpiGU E{ssq_mid, (bf16_t*)(p.ws + WS_ACT)};
            for (int rep = 0; rep <= DUP_GU; ++rep) { pg8::gemm_phase(lds, g, S, E); SYNC(pb + 3); }
        }
        if (IN(pb + 4) && X_GDN) {
            pg8::Gemm g{(const bf16_t*)(p.ws + WS_ACT), (const bf16_t*)(p.ws + WS_WDN) + (size_t)l * DM * DFF, MT, DM, DFF}; pg8::SplitOrder<true> S; S.init2(MT, DM, DFF, G, bid, 11);
            float* Yout = (l == 3) ? p.out : nullptr;
            EpiRes<false> E{Yout, XB, ssq_out, nullptr, PART};
            pg8::gemm_phase(lds, g, S, E);
            xcd_barrier(bar);
            splitk_reduce(Yout, XB, ssq_out, PART, S, 11);
            SYNC(pb + 4);
        }
    }
#undef IN
#undef SYNC
}

extern "C" void kernel_launch(void* const* d_in, const int* in_sizes, int n_in, void* d_out, int out_size, void* d_ws, size_t ws_size, hipStream_t stream) {
    static int grid_blocks = 0;
    if (grid_blocks == 0) {
        if (n_in != N_IN || ws_size < WS_END) { fprintf(stderr, "kernel_launch: unexpected n_in %d or ws_size %zu (< %zu)\n", n_in, ws_size, (size_t)WS_END); grid_blocks = -1; return; }
        int dev = 0, cus = 0, per_cu = 0;
        hipGetDevice(&dev);
        hipDeviceGetAttribute(&cus, hipDeviceAttributeMultiprocessorCount, dev);
        hipFuncSetAttribute((const void*)fwd_megakernel, hipFuncAttributeMaxDynamicSharedMemorySize, LDS_BYTES);
        hipOccupancyMaxActiveBlocksPerMultiprocessor(&per_cu, (const void*)fwd_megakernel, 512, LDS_BYTES);
        if (per_cu < 1) { fprintf(stderr, "kernel_launch: occupancy query reports %d blocks per CU\n", per_cu); per_cu = 1; }
        grid_blocks = cus * 1;
    }
    if (grid_blocks < 0) return;
    Params p{};
    for (int k = 0; k < N_IN; ++k) p.in[k] = (const float*)d_in[k];
    p.out = (float*)d_out; p.ws = (unsigned char*)d_ws; p.ph_lo = 0; p.ph_hi = N_PHASES;
    void* args[] = {&p};
    if (hipMemsetAsync((unsigned char*)d_ws + WS_BAR, 0, 16384, stream) != hipSuccess) { fprintf(stderr, "kernel_launch: memset of the barrier words failed\n"); return; }
    hipError_t e = hipLaunchCooperativeKernel((const void*)fwd_megakernel, dim3(grid_blocks), dim3(512), args, LDS_BYTES, stream);
    if (e != hipSuccess) fprintf(stderr, "cooperative launch failed: %s (grid %d)\n", hipGetErrorString(e), grid_blocks);
}
```

```cpp
#include <hip/hip_runtime.h>
#include <hip/hip_cooperative_groups.h>
#include <cstdio>
namespace cg = cooperative_groups;

#define LAS __attribute__((address_space(3)))
#ifndef DUP_PREP
#define DUP_PREP 0
#define DUP_IN 0
#define DUP_MIX 0
#define DUP_POOL1 0
#define DUP_GU 0
#define DUP_SYNC 0
#define DUP_DN 0
#endif
#ifndef X_GIN
#define X_GIN 1
#define X_GOUT 1
#define X_GPOOL 1
#define X_GGU 1
#define X_GDN 1
#endif
typedef unsigned short bf16_t;
typedef short bf16x8 __attribute__((ext_vector_type(8)));
typedef float f32x4 __attribute__((ext_vector_type(4)));
typedef unsigned u32x4 __attribute__((ext_vector_type(4)));
typedef unsigned u32x2 __attribute__((ext_vector_type(2)));
typedef float f32x2 __attribute__((ext_vector_type(2)));
typedef unsigned long long ssq_t;

constexpr int DM = 1024, MP = 16384, MS = 1024, MT = 17408, NTM = 68, DFF = 2816, DIN = 1792;
constexpr float RMS_EPS = 1e-6f, LN_EPS = 1e-5f;
enum { I_XP = 0, I_XS, I_CCONV, I_CK, I_CV, I_SPOOL, I_NMIX, I_NFFN, I_WIN, I_QN, I_KN, I_SINK, I_WDW, I_BDW, I_CNG, I_CNB, I_WOUT, I_WPOOL, I_PSCALE, I_WG, I_WU, I_WD, N_IN };
constexpr size_t O_Y = 0;
constexpr size_t O_CONVP = (size_t)MT * DM;
constexpr size_t O_KP = O_CONVP + 2 * 4 * 30 * 512;
constexpr size_t O_VP = O_KP + 2 * 4 * 128 * 128;
constexpr size_t O_POOLP = O_VP + 2 * 4 * 128 * 128;
constexpr size_t O_CONVS = O_POOLP + 2 * 4 * 15 * 1024;
constexpr size_t O_KS = O_CONVS + (size_t)2 * 128 * 30 * 512;
constexpr size_t O_VS = O_KS + (size_t)2 * 128 * 128 * 128;
constexpr size_t O_POOLS = O_VS + (size_t)2 * 128 * 128 * 128;
constexpr size_t WS_WIN = 0;
constexpr size_t WS_WOUT = WS_WIN + (size_t)2 * DIN * DM * 2;
constexpr size_t WS_WGU = WS_WOUT + (size_t)2 * DM * DM * 2;
constexpr size_t WS_WDN = WS_WGU + (size_t)4 * 2 * DFF * DM * 2;
constexpr size_t WS_WPL = WS_WDN + (size_t)4 * DM * DFF * 2;
constexpr size_t WS_XB = WS_WPL + (size_t)2 * 4 * 256 * 256 * 2;
constexpr size_t WS_SSQ = WS_XB + (size_t)MT * DM * 2;
constexpr size_t WS_ACT = WS_SSQ + (size_t)9 * MT * 8;
constexpr size_t WS_QKV = WS_ACT;
constexpr size_t WS_GLU = WS_QKV + (size_t)MT * 768 * 2;
constexpr size_t WS_CAT = WS_GLU + (size_t)MT * 512 * 2;
constexpr size_t WS_DG = WS_ACT;
constexpr size_t WS_BAR = WS_ACT + (size_t)MT * DFF * 2;
constexpr size_t WS_PART = WS_BAR + 16384;
constexpr size_t WS_END = WS_PART + (size_t)176 * 65536 * 4;
constexpr int LDS_BYTES = 131072 + 16;
constexpr int N_PHASES = 21;

struct Params { const float* in[N_IN]; float* out; unsigned char* ws; int ph_lo, ph_hi; };

__device__ __forceinline__ unsigned cvt_pk_bf16(float lo, float hi) { unsigned r; asm("v_cvt_pk_bf16_f32 %0, %1, %2" : "=v"(r) : "v"(lo), "v"(hi)); return r; }
__device__ __forceinline__ float bflo(unsigned w) { return __uint_as_float(w << 16); }
__device__ __forceinline__ float bfhi(unsigned w) { return __uint_as_float(w & 0xffff0000u); }
__device__ __forceinline__ float bf2f(bf16_t b) { return __uint_as_float(((unsigned)b) << 16); }
__device__ __forceinline__ float wave_sum(float v) {
#pragma unroll
    for (int o = 32; o >= 1; o >>= 1) v += __shfl_xor(v, o);
    return v;
}
__device__ __forceinline__ float ssq_rs(ssq_t v) { return rsqrtf((float)v * (1.0f / (1048576.0f * 1024.0f)) + RMS_EPS); }
__device__ __forceinline__ ssq_t ssq_fix(float ss) { return (ssq_t)(ss * 1048576.0f); }
__device__ __forceinline__ void ssq_add(ssq_t* p, float ss) { (void)__hip_atomic_fetch_add(p, ssq_fix(ss), __ATOMIC_RELAXED, __HIP_MEMORY_SCOPE_AGENT); }
__device__ __forceinline__ float fast_sigmoid(float x) { return __builtin_amdgcn_rcpf(1.0f + __expf(-x)); }
__device__ __forceinline__ f32x2 pk_exp2(f32x2 v) { f32x2 r; r.x = __builtin_amdgcn_exp2f(v.x); r.y = __builtin_amdgcn_exp2f(v.y); return r; }
__device__ __forceinline__ f32x2 pk_rcp(f32x2 v) { f32x2 r; r.x = __builtin_amdgcn_rcpf(v.x); r.y = __builtin_amdgcn_rcpf(v.y); return r; }
__device__ __forceinline__ f32x2 pk_sig(f32x2 g, float k2) { return pk_rcp(pk_exp2(g * k2) + 1.0f); }

namespace pg8 {
constexpr int BM = 256, BK = 64, HALF = 128, HTB = HALF * BK * 2, STAGE_BYTES = 8 * HTB, NXCD = 8, WGM = 8;
__host__ __device__ __forceinline__ int lds_byte(int r, int c) { const int st = (r >> 4) * 2 + (c >> 5), rr = r & 15, cc = c & 31, ob = rr * 64 + cc * 2; return st * 1024 + (ob ^ (((ob >> 9) & 1) << 5)); }
__host__ __device__ __forceinline__ void stage_rc(int b, int& R, int& C) { const int st = b / 1024, sb = b % 1024, swz = sb ^ (((sb >> 9) & 1) << 5); R = (st >> 1) * 16 + swz / 64; C = (st & 1) * 32 + (swz % 64) / 2; }
__host__ __device__ __forceinline__ int perm32(int rho) { const int n = rho >> 4, i = rho & 15; return 8 * (i >> 2) + 4 * n + (i & 3); }
struct Unit { int pm, pn, k0, nt, part; };
struct Gemm { const bf16_t* A; const bf16_t* Bt; int M, N, K; };
struct StaticOrder {
    static constexpr bool SPLIT = false, ABLK = false;
    int nM, nN, nwg, G, c, ntk;
    __device__ void init(int M, int N, int K, int G_, int c_) { nM = M / BM; nN = N / BM; nwg = nM * nN; G = G_; c = c_; ntk = K / BK; }
    __device__ void tile(int L, Unit& u) const {
        int wgid = L; { const int q = nwg / NXCD, r = nwg % NXCD, xcd = wgid % NXCD, off = wgid / NXCD; wgid = (xcd < r ? xcd * (q + 1) : r * (q + 1) + (xcd - r) * q) + off; }
        const int nig = WGM * nN, gid = wgid / nig, fm = gid * WGM, gsz = (nM - fm) < WGM ? (nM - fm) : WGM;
        u.pm = fm + ((wgid % nig) % gsz); u.pn = (wgid % nig) / gsz;
    }
    __device__ bool next(int i, Unit& u) const {
        const long L = (long)i * G + c; if (L >= nwg) return false;
        tile((int)L, u); u.k0 = 0; u.nt = ntk; u.part = -1; return true;
    }
};
template <bool ABLK_> struct SplitOrder : StaticOrder {
    static constexpr bool SPLIT = true, ABLK = ABLK_;
    int KS, ntp;
    __device__ void init2(int M, int N, int K, int G_, int c_, int KS_) { init(M, N, K, G_, c_); KS = KS_; ntp = ntk / KS_; }
    __device__ bool next(int i, Unit& u) const {
        const int np = (nwg - G) * KS;
        int j = i;
        if (c < np) { if (i == 0) { tile(G + c / KS, u); u.k0 = (c % KS) * ntp; u.nt = ntp; u.part = c; return true; } j = i - 1; }
        if (j > 0) return false;
        tile(c, u); u.k0 = 0; u.nt = ntk; u.part = -1; return true;
    }
};
struct PoolOrder {
    static constexpr bool SPLIT = false, ABLK = false;
    int G, c;
    __device__ bool next(int i, Unit& u) const { const int L = i * G + c; if (L >= 4 * NTM) return false; u.pm = L; u.pn = L / NTM; u.k0 = 0; u.nt = 4; u.part = -1; return true; }
};

template <class Epi, class Sched>
__device__ __forceinline__ void gemm_phase(LAS unsigned char* lds, const Gemm g, const Sched& S, const Epi& E) {
    int tid = threadIdx.x; asm volatile("" : "+v"(tid));
    const int wid = __builtin_amdgcn_readfirstlane(tid >> 6), lane = tid & 63, wr = wid >> 2, wc = wid & 3, fr = lane & 15, fq = lane >> 4;
    int K = g.K; asm volatile("" : "+s"(K));
    unsigned voffA[2], voffB[2];
#pragma unroll
    for (int i = 0; i < 2; ++i) { int R, C; stage_rc(tid * 16 + i * 8192, R, C); const int Rb = (R & ~31) + perm32(R & 31);
        voffA[i] = Sched::ABLK ? (unsigned)(R * 64 + C) * 2u : (unsigned)(R * K + C) * 2u; voffB[i] = (unsigned)(Rb * K + C) * 2u; }
    const size_t kstep = (size_t)(BK * 2);
    const size_t hstep = (size_t)HALF * K * 2;
    const size_t tstep = 2 * hstep;
    const size_t kstepA = Sched::ABLK ? (size_t)32768 : kstep, hstepA = Sched::ABLK ? (size_t)16384 : hstep;
    const unsigned ldsw = (unsigned)wid * 1024u;
    const int aoff = lds_byte(wr * 64 + fr, fq * 8), boff = lds_byte(wc * 32 + fr, fq * 8);
#define PG8_SA(b, h) (((b) * 2 + (h)) * HTB)
#define PG8_SB(b, h) ((4 + (b) * 2 + (h)) * HTB)
#define PG8_STAGE(bufoff, gbase, voff) do { _Pragma("unroll") for (int _i = 0; _i < 2; ++_i) \
        __builtin_amdgcn_global_load_lds((const unsigned*)((const char*)(gbase) + (voff)[_i]), (LAS unsigned*)(lds + (bufoff) + ldsw + _i * 8192), 16, 0, 0); } while (0)
#define PG8_LDA(dst, b, h) do { _Pragma("unroll") for (int m = 0; m < 4; ++m) _Pragma("unroll") for (int k = 0; k < 2; ++k) dst[m][k] = *(const LAS bf16x8*)(lds + PG8_SA(b, h) + aoff + m * 2048 + k * 1024); } while (0)
#define PG8_LDB(dst, b, h) do { _Pragma("unroll") for (int n = 0; n < 2; ++n) _Pragma("unroll") for (int k = 0; k < 2; ++k) dst[n][k] = *(const LAS bf16x8*)(lds + PG8_SB(b, h) + boff + n * 2048 + k * 1024); } while (0)
#define PG8_MMA(ai, bj, At, Bt) do { __builtin_amdgcn_s_setprio(1); _Pragma("unroll") for (int m = 0; m < 4; ++m) _Pragma("unroll") for (int n = 0; n < 2; ++n) _Pragma("unroll") for (int k = 0; k < 2; ++k) \
        acc[ai][bj][m][n] = __builtin_amdgcn_mfma_f32_16x16x32_bf16(Bt[n][k], At[m][k], acc[ai][bj][m][n], 0, 0, 0); __builtin_amdgcn_s_setprio(0); } while (0)
#define PG8_WAIT_V(n) asm volatile("s_waitcnt vmcnt(" #n ")" ::: "memory")
#define PG8_WAIT_L(n) asm volatile("s_waitcnt lgkmcnt(" #n ")" ::: "memory")
#define PG8_BAR __builtin_amdgcn_s_barrier()
#define PG8_SCHED __builtin_amdgcn_sched_barrier(0)
    Unit cur, nxt; int ui = 0;
    if (!S.next(0, cur)) return;
    f32x4 acc[2][2][4][2];
    E.init(acc, cur, wr, wc, fr, fq);
    bf16x8 At[4][2], B0[2][2], B1[2][2];
    const char* cA = (const char*)g.A + (size_t)cur.pm * tstep; const char* cB = (const char*)g.Bt + (size_t)cur.pn * tstep;
    if constexpr (Sched::SPLIT) { cA += (size_t)cur.k0 * kstepA; cB += (size_t)cur.k0 * kstep; }
    const int ntc = K / BK;
    PG8_STAGE(PG8_SB(0, 0), cB, voffB); PG8_STAGE(PG8_SA(0, 0), cA, voffA); PG8_STAGE(PG8_SB(0, 1), cB + hstep, voffB); PG8_STAGE(PG8_SA(0, 1), cA + hstepA, voffA);
    if (wr == 1) PG8_BAR;
    PG8_WAIT_V(4); PG8_BAR;
    PG8_STAGE(PG8_SB(1, 0), cB + kstep, voffB); PG8_STAGE(PG8_SA(1, 0), cA + kstepA, voffA); PG8_STAGE(PG8_SB(1, 1), cB + hstep + kstep, voffB);
    PG8_WAIT_V(6); PG8_BAR;
    for (;;) {
        const bool has_next = S.next(ui + 1, nxt);
        const char* nA = has_next ? (const char*)g.A + (size_t)nxt.pm * tstep : cA; const char* nB = has_next ? (const char*)g.Bt + (size_t)nxt.pn * tstep : cB;
        if constexpr (Sched::SPLIT) { if (has_next) { nA += (size_t)nxt.k0 * kstepA; nB += (size_t)nxt.k0 * kstep; } }
        const int nt = Sched::SPLIT ? cur.nt : ntc;
        for (int t = 0; t < nt; t += 2) {
            const bool last = (t == nt - 2);
            const char* a1 = cA + (size_t)(t + 1) * kstepA;
            const char* a2 = last ? nA : cA + (size_t)(t + 2) * kstepA; const char* b2 = last ? nB : cB + (size_t)(t + 2) * kstep;
            const char* a3 = a2 + kstepA; const char* b3 = b2 + kstep;
            PG8_LDB(B0, 0, 0); PG8_SCHED; PG8_LDA(At, 0, 0); PG8_STAGE(PG8_SA(1, 1), a1 + hstepA, voffA);
            PG8_WAIT_L(8); PG8_BAR; PG8_WAIT_L(0); PG8_MMA(0, 0, At, B0); PG8_BAR; PG8_SCHED;
            PG8_LDB(B1, 0, 1); PG8_STAGE(PG8_SB(0, 0), b2, voffB);
            PG8_BAR; PG8_WAIT_L(0); PG8_MMA(0, 1, At, B1); PG8_BAR;
            PG8_LDA(At, 0, 1); PG8_STAGE(PG8_SA(0, 0), a2, voffA);
            PG8_BAR; PG8_WAIT_L(0); PG8_MMA(1, 0, At, B0); PG8_BAR; PG8_SCHED;
            PG8_STAGE(PG8_SB(0, 1), b2 + hstep, voffB);
            PG8_WAIT_V(6); PG8_BAR; PG8_MMA(1, 1, At, B1); PG8_BAR;
            PG8_LDB(B0, 1, 0); PG8_SCHED; PG8_LDA(At, 1, 0); PG8_STAGE(PG8_SA(0, 1), a2 + hstepA, voffA);
            PG8_WAIT_L(8); PG8_BAR; PG8_WAIT_L(0); PG8_MMA(0, 0, At, B0); PG8_BAR; PG8_SCHED;
            PG8_LDB(B1, 1, 1); PG8_STAGE(PG8_SB(1, 0), b3, voffB);
            PG8_BAR; PG8_WAIT_L(0); PG8_MMA(0, 1, At, B1); PG8_BAR;
            PG8_LDA(At, 1, 1); PG8_STAGE(PG8_SA(1, 0), a3, voffA);
            PG8_BAR; PG8_WAIT_L(0); PG8_MMA(1, 0, At, B0); PG8_BAR; PG8_SCHED;
            PG8_STAGE(PG8_SB(1, 1), b3 + hstep, voffB);
            PG8_WAIT_V(6); PG8_BAR; PG8_MMA(1, 1, At, B1); PG8_BAR;
        }
        E(acc, cur, wr, wc, fr, fq);
        if (!has_next) break;
        E.init(acc, nxt, wr, wc, fr, fq);
        cur = nxt; cA = nA; cB = nB; ++ui;
    }
    PG8_WAIT_V(0);
    if (wr == 0) PG8_BAR;
    PG8_BAR;
#undef PG8_SA
#undef PG8_SB
#undef PG8_STAGE
#undef PG8_LDA
#undef PG8_LDB
#undef PG8_MMA
#undef PG8_WAIT_V
#undef PG8_WAIT_L
#undef PG8_BAR
#undef PG8_SCHED
}
}

__device__ __forceinline__ void acc_zero(f32x4 (&acc)[2][2][4][2]) {
#pragma unroll
    for (int a = 0; a < 2; ++a)
#pragma unroll
        for (int b = 0; b < 2; ++b)
#pragma unroll
            for (int m = 0; m < 4; ++m)
#pragma unroll
                for (int n = 0; n < 2; ++n) acc[a][b][m][n] = (f32x4){0.f, 0.f, 0.f, 0.f};
}
struct EpiIn {
    const ssq_t* ssq; bf16_t* glu; bf16_t* qkv;
    __device__ __forceinline__ void init(f32x4 (&acc)[2][2][4][2], const pg8::Unit&, int, int, int, int) const { acc_zero(acc); }
    __device__ __forceinline__ void operator()(const f32x4 (&acc)[2][2][4][2], const pg8::Unit& u, int wr, int wc, int fr, int fq) const {
        const int row0 = u.pm * 256 + wr * 64 + fr;
        if (u.pn < 4) {
            const int col0 = u.pn * 128 + wc * 32 + 8 * fq;
#pragma unroll
            for (int ai = 0; ai < 2; ++ai)
#pragma unroll
                for (int m = 0; m < 4; ++m) {
                    const int r = row0 + ai * 128 + m * 16;
                    const float rs = ssq_rs(ssq[r]);
                    const float k2 = rs * -1.4426950408889634f;
                    f32x2 o[4];
#pragma unroll
                    for (int n = 0; n < 2; ++n)
#pragma unroll
                        for (int h = 0; h < 2; ++h) {
                            const f32x2 a = (f32x2){acc[ai][0][m][n][2 * h], acc[ai][0][m][n][2 * h + 1]}, gt = (f32x2){acc[ai][1][m][n][2 * h], acc[ai][1][m][n][2 * h + 1]};
                            o[n * 2 + h] = (a * rs) * pk_sig(gt, k2);
                        }
                    u32x4 w; w.x = cvt_pk_bf16(o[0].x, o[0].y); w.y = cvt_pk_bf16(o[1].x, o[1].y); w.z = cvt_pk_bf16(o[2].x, o[2].y); w.w = cvt_pk_bf16(o[3].x, o[3].y);
                    *(u32x4*)(glu + (size_t)r * 512 + col0) = w;
                }
        } else {
            const int col0 = (u.pn - 4) * 256 + wc * 32 + 8 * fq;
#pragma unroll
            for (int ai = 0; ai < 2; ++ai)
#pragma unroll
                for (int m = 0; m < 4; ++m) {
                    const int r = row0 + ai * 128 + m * 16;
                    const float rs = ssq_rs(ssq[r]);
#pragma unroll
                    for (int bj = 0; bj < 2; ++bj) {
                        const f32x4 v0 = acc[ai][bj][m][0] * rs, v1 = acc[ai][bj][m][1] * rs;
                        u32x4 w; w.x = cvt_pk_bf16(v0[0], v0[1]); w.y = cvt_pk_bf16(v0[2], v0[3]); w.z = cvt_pk_bf16(v1[0], v1[1]); w.w = cvt_pk_bf16(v1[2], v1[3]);
                        *(u32x4*)(qkv + (size_t)r * 768 + col0 + bj * 128) = w;
                    }
                }
        }
    }
};
struct EpiGU {
    const ssq_t* ssq; bf16_t* act;
    __device__ __forceinline__ void init(f32x4 (&acc)[2][2][4][2], const pg8::Unit&, int, int, int, int) const { acc_zero(acc); }
    __device__ __forceinline__ void operator()(const f32x4 (&acc)[2][2][4][2], const pg8::Unit& u, int wr, int wc, int fr, int fq) const {
        const int row0 = u.pm * 256 + wr * 64 + fr, col0 = u.pn * 128 + wc * 32 + 8 * fq;
#pragma unroll
        for (int ai = 0; ai < 2; ++ai)
#pragma unroll
            for (int m = 0; m < 4; ++m) {
                const int r = row0 + ai * 128 + m * 16;
                const float rs = ssq_rs(ssq[r]);
                const float k2 = rs * -1.4426950408889634f, rs2 = rs * rs;
                f32x2 o[4];
#pragma unroll
                for (int n = 0; n < 2; ++n)
#pragma unroll
                    for (int h = 0; h < 2; ++h) {
                        const f32x2 gt = (f32x2){acc[ai][0][m][n][2 * h], acc[ai][0][m][n][2 * h + 1]}, up = (f32x2){acc[ai][1][m][n][2 * h], acc[ai][1][m][n][2 * h + 1]};
                        o[n * 2 + h] = (gt * up) * rs2 * pk_sig(gt, k2);
                    }
                u32x4 w; w.x = cvt_pk_bf16(o[0].x, o[0].y); w.y = cvt_pk_bf16(o[1].x, o[1].y); w.z = cvt_pk_bf16(o[2].x, o[2].y); w.w = cvt_pk_bf16(o[3].x, o[3].y);
                *(u32x4*)(act + (size_t)(r >> 8) * (256 * DFF) + (size_t)(col0 >> 6) * (256 * 64) + (size_t)(r & 255) * 64 + (col0 & 63)) = w;
            }
    }
};
__device__ __forceinline__ void bf8_to_f32(u32x4 w, f32x4& lo, f32x4& hi) { lo = (f32x4){bflo(w.x), bfhi(w.x), bflo(w.y), bfhi(w.y)}; hi = (f32x4){bflo(w.z), bfhi(w.z), bflo(w.w), bfhi(w.w)}; }
template <bool POOL> struct EpiRes {
    float* Y; bf16_t* XB; ssq_t* ssq; const float* cscale; float* part;
    __device__ __forceinline__ void init(f32x4 (&acc)[2][2][4][2], const pg8::Unit& u, int wr, int wc, int fr, int fq) const {
        if (!POOL && u.part >= 0) { acc_zero(acc); return; }
        const int pmr = POOL ? (u.pm % NTM) : u.pm, ct = POOL ? (u.pm / NTM) : u.pn;
        const bf16_t* xq = XB + (size_t)(pmr * 256 + wr * 64 + fr) * DM + ct * 256 + wc * 32 + 8 * fq;
#pragma unroll
        for (int ai = 0; ai < 2; ++ai)
#pragma unroll
            for (int bj = 0; bj < 2; ++bj)
#pragma unroll
                for (int m = 0; m < 4; ++m) bf8_to_f32(*(const u32x4*)(xq + (size_t)(ai * 128 + m * 16) * DM + bj * 128), acc[ai][bj][m][0], acc[ai][bj][m][1]);
        if (POOL) {
            const float* cq = cscale + ct * 256 + wc * 32 + 8 * fq;
#pragma unroll
            for (int bj = 0; bj < 2; ++bj)
#pragma unroll
                for (int n = 0; n < 2; ++n) {
                    const f32x4 cv = *(const f32x4*)(cq + bj * 128 + 4 * n);
                    const f32x4 ic = (f32x4){__builtin_amdgcn_rcpf(cv[0]), __builtin_amdgcn_rcpf(cv[1]), __builtin_amdgcn_rcpf(cv[2]), __builtin_amdgcn_rcpf(cv[3])};
#pragma unroll
                    for (int ai = 0; ai < 2; ++ai)
#pragma unroll
                        for (int m = 0; m < 4; ++m) acc[ai][bj][m][n] = acc[ai][bj][m][n] * ic;
                }
        }
    }
    __device__ __forceinline__ void operator()(const f32x4 (&acc)[2][2][4][2], const pg8::Unit& u, int wr, int wc, int fr, int fq) const {
        if (!POOL && u.part >= 0) {
            float* pp = part + (size_t)u.part * 65536 + (size_t)(((wr * 4 + wc) * 64) + fq * 16 + fr) * 4;
#pragma unroll
            for (int ai = 0; ai < 2; ++ai)
#pragma unroll
                for (int m = 0; m < 4; ++m)
#pragma unroll
                    for (int bj = 0; bj < 2; ++bj)
#pragma unroll
                        for (int n = 0; n < 2; ++n) *(f32x4*)(pp + (size_t)((((ai * 4 + m) * 2 + bj) * 2 + n) * 2048)) = acc[ai][bj][m][n];
            return;
        }
        const int pmr = POOL ? (u.pm % NTM) : u.pm, ct = POOL ? (u.pm / NTM) : u.pn;
        const int row0 = pmr * 256 + wr * 64 + fr, col0 = ct * 256 + wc * 32 + 8 * fq;
#pragma unroll
        for (int ai = 0; ai < 2; ++ai)
#pragma unroll
            for (int m = 0; m < 4; ++m) {
                const int r = row0 + ai * 128 + m * 16;
                bf16_t* bp = XB + (size_t)r * DM + col0;
                float ss = 0.f;
#pragma unroll
                for (int bj = 0; bj < 2; ++bj) {
                    f32x4 v0 = acc[ai][bj][m][0], v1 = acc[ai][bj][m][1];
                    if (POOL) { v0 = v0 * *(const f32x4*)(cscale + col0 + bj * 128); v1 = v1 * *(const f32x4*)(cscale + col0 + bj * 128 + 4); }
                    if (Y) { float* yp = Y + (size_t)r * DM + col0 + bj * 128; *(f32x4*)yp = v0; *(f32x4*)(yp + 4) = v1; }
                    u32x4 w; w.x = cvt_pk_bf16(v0[0], v0[1]); w.y = cvt_pk_bf16(v0[2], v0[3]); w.z = cvt_pk_bf16(v1[0], v1[1]); w.w = cvt_pk_bf16(v1[2], v1[3]);
                    *(u32x4*)(bp + bj * 128) = w;
                    ss += (v0[0] * v0[0] + v0[1] * v0[1]) + (v0[2] * v0[2] + v0[3] * v0[3]) + (v1[0] * v1[0] + v1[1] * v1[1]) + (v1[2] * v1[2] + v1[3] * v1[3]);
                }
                ss += __shfl_xor(ss, 16); ss += __shfl_xor(ss, 32);
                if (fq == 0) ssq_add(ssq + r, ss);
            }
    }
};

struct WTile { const float* src0; const float* src1; const float* gain; bf16_t* dst; int ld, K, k0, n0m, mode; };
__device__ __forceinline__ void wt_decode(const Params& p, int t, WTile& w) {
    int kt; w.gain = nullptr;
    if (t < 224) { const int i = t / 112, r = t % 112; w.n0m = (r / 16) * 256; kt = r % 16; w.K = 1024; w.ld = DIN; w.mode = (w.n0m < 1024) ? 1 : 0;
        w.src0 = p.in[I_WIN] + (size_t)i * DM * DIN; w.src1 = w.src0; w.gain = p.in[I_NMIX] + (2 * i) * DM; w.dst = (bf16_t*)(p.ws + WS_WIN) + (size_t)i * DIN * DM; }
    else if (t < 352) { t -= 224; const int i = t / 64, r = t % 64; w.n0m = (r / 16) * 256; kt = r % 16; w.K = 1024; w.ld = DM; w.mode = 0;
        w.src0 = p.in[I_WOUT] + (size_t)i * DM * DM; w.src1 = w.src0; w.dst = (bf16_t*)(p.ws + WS_WOUT) + (size_t)i * DM * DM; }
    else if (t < 1760) { t -= 352; const int l = t / 352, r = t % 352; w.n0m = (r / 16) * 256; kt = r % 16; w.K = 1024; w.ld = DFF; w.mode = 2;
        w.src0 = p.in[I_WG] + (size_t)l * DM * DFF; w.src1 = p.in[I_WU] + (size_t)l * DM * DFF; w.gain = p.in[I_NFFN] + l * DM; w.dst = (bf16_t*)(p.ws + WS_WGU) + (size_t)l * 2 * DFF * DM; }
    else if (t < 2464) { t -= 1760; const int l = t / 176, r = t % 176; w.n0m = (r / 44) * 256; kt = r % 44; w.K = DFF; w.ld = DM; w.mode = 0;
        w.src0 = p.in[I_WD] + (size_t)l * DFF * DM; w.src1 = w.src0; w.dst = (bf16_t*)(p.ws + WS_WDN) + (size_t)l * DM * DFF; }
    else { t -= 2464; const int ig = t / 4; w.n0m = 0; kt = t % 4; w.K = 256; w.ld = 256; w.mode = 0;
        w.src0 = p.in[I_WPOOL] + (size_t)ig * 65536; w.src1 = w.src0; w.dst = (bf16_t*)(p.ws + WS_WPL) + (size_t)ig * 65536; }
    w.k0 = kt * 64;
}
__device__ __forceinline__ void wt_load(const WTile& w, int tid, f32x4 (&v)[4][2], float& gs0, float& gs1) {
    const int row = tid >> 4, col4 = (tid & 15) * 4;
    gs0 = w.gain ? w.gain[w.k0 + row] : 1.0f; gs1 = w.gain ? w.gain[w.k0 + row + 32] : 1.0f;
#pragma unroll
    for (int q = 0; q < 4; ++q) {
        const int n0 = w.n0m + 64 * q; int c0 = n0; const float* src = w.src0;
        if (w.mode == 1) { const int pn = n0 / 256, bj = (n0 / 128) & 1, cc = n0 % 128; c0 = bj * 512 + 128 * pn + cc; }
        else if (w.mode == 2) { const int pn = n0 / 256, bj = (n0 / 128) & 1, cc = n0 % 128; c0 = 128 * pn + cc; src = bj ? w.src1 : w.src0; }
        const float* sp = src + (size_t)(w.k0 + row) * w.ld + c0 + col4;
        v[q][0] = *(const f32x4*)sp; v[q][1] = *(const f32x4*)(sp + (size_t)32 * w.ld);
    }
}
__device__ __forceinline__ void prep_phase(const Params& p, LAS unsigned char* lds) {
    int tid = threadIdx.x; asm volatile("" : "+v"(tid));
    const int G = gridDim.x, bid = blockIdx.x, wave = tid >> 6, lane = tid & 63;
    bf16_t* XB = (bf16_t*)(p.ws + WS_XB); ssq_t* SSQ = (ssq_t*)(p.ws + WS_SSQ);
    for (int r0 = bid * 8 + wave; r0 < MT; r0 += G * 16) {
        const int r1 = r0 + G * 8; const bool h1 = r1 < MT; const int r1c = h1 ? r1 : r0;
        const float* s0 = r0 < MP ? p.in[I_XP] + (size_t)r0 * DM : p.in[I_XS] + (size_t)(r0 - MP) * DM;
        const float* s1 = r1c < MP ? p.in[I_XP] + (size_t)r1c * DM : p.in[I_XS] + (size_t)(r1c - MP) * DM;
        f32x4 va[4], vb[4];
#pragma unroll
        for (int q = 0; q < 4; ++q) { va[q] = *(const f32x4*)(s0 + q * 256 + lane * 4); vb[q] = *(const f32x4*)(s1 + q * 256 + lane * 4); }
        float ssa = 0.f, ssb = 0.f;
#pragma unroll
        for (int q = 0; q < 4; ++q) {
            u32x2 w; w.x = cvt_pk_bf16(va[q][0], va[q][1]); w.y = cvt_pk_bf16(va[q][2], va[q][3]);
            *(u32x2*)(XB + (size_t)r0 * DM + q * 256 + lane * 4) = w;
            ssa += (va[q][0] * va[q][0] + va[q][1] * va[q][1]) + (va[q][2] * va[q][2] + va[q][3] * va[q][3]);
            if (h1) {
                u32x2 w2; w2.x = cvt_pk_bf16(vb[q][0], vb[q][1]); w2.y = cvt_pk_bf16(vb[q][2], vb[q][3]);
                *(u32x2*)(XB + (size_t)r1 * DM + q * 256 + lane * 4) = w2;
            }
            ssb += (vb[q][0] * vb[q][0] + vb[q][1] * vb[q][1]) + (vb[q][2] * vb[q][2] + vb[q][3] * vb[q][3]);
        }
        ssa = wave_sum(ssa); ssb = wave_sum(ssb);
        if (lane == 0) { SSQ[r0] = ssq_fix(ssa); if (h1) SSQ[r1] = ssq_fix(ssb); }
    }
    for (int idx = bid * 512 + tid; idx < 8 * MT; idx += G * 512) SSQ[MT + idx] = 0ull;
    LAS float* tile = (LAS float*)lds;
    WTile cur, nxt; f32x4 v[4][2]; float gs0 = 1.f, gs1 = 1.f;
    int t0 = bid;
    if (t0 < 2496) { wt_decode(p, t0, cur); wt_load(cur, tid, v, gs0, gs1); }
    for (; t0 < 2496; t0 += G) {
        __syncthreads();
        {
            const int row = tid >> 4, col4 = (tid & 15) * 4;
#pragma unroll
            for (int q = 0; q < 4; ++q)
#pragma unroll
                for (int h = 0; h < 2; ++h) { LAS float* tp = tile + q * 4160 + (row + 32 * h) * 65 + col4; const float gs = h ? gs1 : gs0;
                    tp[0] = v[q][h][0] * gs; tp[1] = v[q][h][1] * gs; tp[2] = v[q][h][2] * gs; tp[3] = v[q][h][3] * gs; }
        }
        __syncthreads();
        const bool hn = (t0 + G) < 2496;
        if (hn) { wt_decode(p, t0 + G, nxt); wt_load(nxt, tid, v, gs0, gs1); }
        {
            const int n = tid >> 3, kk = (tid & 7) * 8;
#pragma unroll
            for (int q = 0; q < 4; ++q) {
                float e[8];
#pragma unroll
                for (int j = 0; j < 8; ++j) e[j] = tile[q * 4160 + (kk + j) * 65 + n];
                u32x4 w; w.x = cvt_pk_bf16(e[0], e[1]); w.y = cvt_pk_bf16(e[2], e[3]); w.z = cvt_pk_bf16(e[4], e[5]); w.w = cvt_pk_bf16(e[6], e[7]);
                *(u32x4*)(cur.dst + (size_t)(cur.n0m + 64 * q + n) * cur.K + cur.k0 + kk) = w;
            }
        }
        if (hn) cur = nxt;
    }
    __syncthreads();
}

__device__ __forceinline__ f32x4 ld_bf4(const bf16_t* p) { const u32x2 w = *(const u32x2*)p; return (f32x4){bflo(w.x), bfhi(w.x), bflo(w.y), bfhi(w.y)}; }
template <int W>
__device__ __forceinline__ void pool_prompt_strip(const bf16_t* X, const ssq_t* ssq, int row0, int t0, int c, f32x4 gm, bf16_t* dgp, float* outp_seq) {
    constexpr int TT = 16, NR = TT + W - 1;
    f32x4 xr[NR];
    if (t0 >= W - 1) {
        const bf16_t* xp = X + (size_t)(row0 - (W - 1)) * DM + c; asm volatile("" : "+v"(xp));
        const ssq_t* sp = ssq + (row0 - (W - 1)); asm volatile("" : "+v"(sp));
#pragma unroll
        for (int j = 0; j < NR; ++j) { const float rs = ssq_rs(sp[j]); xr[j] = ld_bf4(xp + (size_t)j * DM) * rs * gm; }
    } else {
        int vz; asm volatile("v_mov_b32 %0, 0" : "=v"(vz));
        const bf16_t* xp = X + (size_t)(row0 - t0) * DM + c; const ssq_t* sp = ssq + (row0 - t0);
#pragma unroll
        for (int j = 0; j < NR; ++j) { const int tj = t0 - (W - 1) + j + vz, tc = tj < 0 ? 0 : tj; const float rs = ssq_rs(sp[tc]);
            const f32x4 v = ld_bf4(xp + (size_t)tc * DM) * rs * gm; xr[j] = tj < 0 ? (f32x4){0.f, 0.f, 0.f, 0.f} : v; }
    }
    f32x4 S = (f32x4){0.f, 0.f, 0.f, 0.f};
#pragma unroll
    for (int j = 0; j < W - 1; ++j) S += xr[j];
#pragma unroll
    for (int tt = 0; tt < TT; ++tt) {
        S += xr[tt + W - 1]; if (tt > 0) S -= xr[tt - 1];
        const int t = t0 + tt, cnt = (t + 1 < W) ? (t + 1) : W;
        const f32x4 cur = xr[tt + W - 1], d = S * __builtin_amdgcn_rcpf((float)cnt) - cur;
        u32x2 wv; wv.x = cvt_pk_bf16(d[0], d[1]); wv.y = cvt_pk_bf16(d[2], d[3]);
        *(u32x2*)(dgp + (size_t)tt * 256) = wv;
        if (t >= 4081) *(f32x4*)(outp_seq + (size_t)(t - 4081) * DM) = cur;
    }
}
template <int W>
__device__ __forceinline__ void pool_sample_strip(const bf16_t* X, const ssq_t* ssq, int row0, int c, f32x4 gm, const float* state_seq, bf16_t* dgp, float* outs_seq) {
    constexpr int TT = 8, NR = TT + W - 1;
    f32x4 xr[NR];
    { const float* stp = state_seq + (size_t)(15 - (W - 1)) * DM; asm volatile("" : "+v"(stp));
#pragma unroll
      for (int j = 0; j < W - 1; ++j) xr[j] = *(const f32x4*)(stp + (size_t)j * DM); }
    { const bf16_t* xp = X + (size_t)row0 * DM + c; asm volatile("" : "+v"(xp));
      const ssq_t* sp = ssq + row0;
#pragma unroll
      for (int j = 0; j < TT; ++j) { const float rs = ssq_rs(sp[j]); xr[W - 1 + j] = ld_bf4(xp + (size_t)j * DM) * rs * gm; } }
    f32x4 S = (f32x4){0.f, 0.f, 0.f, 0.f};
#pragma unroll
    for (int j = 0; j < W - 1; ++j) S += xr[j];
#pragma unroll
    for (int tt = 0; tt < TT; ++tt) {
        S += xr[tt + W - 1]; if (tt > 0) S -= xr[tt - 1];
        const f32x4 cur = xr[tt + W - 1], d = S * (1.0f / (float)W) - cur;
        u32x2 wv; wv.x = cvt_pk_bf16(d[0], d[1]); wv.y = cvt_pk_bf16(d[2], d[3]);
        *(u32x2*)(dgp + (size_t)tt * 256) = wv;
        *(f32x4*)(outs_seq + (size_t)(7 + tt) * DM) = cur;
    }
}
__device__ __forceinline__ void pool1_phase(const Params& p, int l, const ssq_t* ssq) {
    int tid = threadIdx.x; asm volatile("" : "+v"(tid));
    const int G = gridDim.x, bid = blockIdx.x, i = l >> 1;
    const bf16_t* X = (const bf16_t*)(p.ws + WS_XB); bf16_t* DG = (bf16_t*)(p.ws + WS_DG);
    const int cq = tid & 255, c = cq * 4, half = tid >> 8, g = __builtin_amdgcn_readfirstlane(cq >> 6);
    const f32x4 gm = *(const f32x4*)(p.in[I_NMIX] + l * DM + c);
    const float* spool = p.in[I_SPOOL] + (size_t)i * 128 * 15 * DM;
    float* outp = p.out + O_POOLP + (size_t)i * 4 * 15 * DM; float* outs = p.out + O_POOLS + (size_t)i * 128 * 15 * DM;
    for (int u = bid; u < MT / 32; u += G) {
        if (u < MP / 32) {
            const int row0 = u * 32 + half * 16, t0 = row0 & 4095, b = row0 >> 12;
            bf16_t* dgp = DG + ((size_t)g * MT + row0) * 256 + (c - 256 * g); float* op = outp + (size_t)b * 15 * DM + c;
            if (g == 0) pool_prompt_strip<2>(X, ssq, row0, t0, c, gm, dgp, op);
            else if (g == 1) pool_prompt_strip<4>(X, ssq, row0, t0, c, gm, dgp, op);
            else if (g == 2) pool_prompt_strip<8>(X, ssq, row0, t0, c, gm, dgp, op);
            else pool_prompt_strip<16>(X, ssq, row0, t0, c, gm, dgp, op);
        } else {
            const int s0 = (u - MP / 32) * 4;
#pragma unroll 1
            for (int q = 0; q < 2; ++q) {
                const int s = s0 + half * 2 + q, row0 = MP + s * 8;
                bf16_t* dgp = DG + ((size_t)g * MT + row0) * 256 + (c - 256 * g); float* op = outs + (size_t)s * 15 * DM + c; const float* st = spool + (size_t)s * 15 * DM + c;
                if (g == 0) pool_sample_strip<2>(X, ssq, row0, c, gm, st, dgp, op);
                else if (g == 1) pool_sample_strip<4>(X, ssq, row0, c, gm, st, dgp, op);
                else if (g == 2) pool_sample_strip<8>(X, ssq, row0, c, gm, st, dgp, op);
                else pool_sample_strip<16>(X, ssq, row0, c, gm, st, dgp, op);
            }
            for (int idx = tid; idx < 4 * 7 * 256; idx += 512) { const int c4 = (idx & 255) * 4, rr = (idx >> 8) % 7, sl = idx / (7 * 256);
                *(f32x4*)(outs + ((size_t)(s0 + sl) * 15 + rr) * DM + c4) = *(const f32x4*)(spool + ((size_t)(s0 + sl) * 15 + 8 + rr) * DM + c4); }
        }
    }
}

constexpr int KS_STRIDE = 72, VT_STRIDE = 264;

__device__ __forceinline__ void attn_item(const LAS bf16_t* Ks, const LAS bf16_t* Vt, int tile0, int r0, bool first, bool qvalid,
                                          const bf16_t* qptr, const float* qn, float slope, float sink, bf16_t* optr, int fr, int fq) {
    u32x4 raw0 = (u32x4){0u, 0u, 0u, 0u}, raw1 = raw0;
    if (qvalid) { raw0 = *(const u32x4*)(qptr); raw1 = *(const u32x4*)(qptr + 32); }
    float qf[16];
#pragma unroll
    for (int j = 0; j < 4; ++j) { qf[2 * j] = bflo(raw0[j]); qf[2 * j + 1] = bfhi(raw0[j]); qf[8 + 2 * j] = bflo(raw1[j]); qf[8 + 2 * j + 1] = bfhi(raw1[j]); }
    float ss = 0.f;
#pragma unroll
    for (int j = 0; j < 16; ++j) ss += qf[j] * qf[j];
    ss += __shfl_xor(ss, 16); ss += __shfl_xor(ss, 32);
    const float rq = rsqrtf(ss * (1.0f / 64.0f) + RMS_EPS) * 0.125f;
    bf16x8 q0, q1;
    {
        const f32x4 n0 = *(const f32x4*)(qn + fq * 8), n1 = *(const f32x4*)(qn + fq * 8 + 4), n2 = *(const f32x4*)(qn + 32 + fq * 8), n3 = *(const f32x4*)(qn + 32 + fq * 8 + 4);
        u32x4 a, b;
        a.x = cvt_pk_bf16(qf[0] * rq * n0[0], qf[1] * rq * n0[1]); a.y = cvt_pk_bf16(qf[2] * rq * n0[2], qf[3] * rq * n0[3]);
        a.z = cvt_pk_bf16(qf[4] * rq * n1[0], qf[5] * rq * n1[1]); a.w = cvt_pk_bf16(qf[6] * rq * n1[2], qf[7] * rq * n1[3]);
        b.x = cvt_pk_bf16(qf[8] * rq * n2[0], qf[9] * rq * n2[1]); b.y = cvt_pk_bf16(qf[10] * rq * n2[2], qf[11] * rq * n2[3]);
        b.z = cvt_pk_bf16(qf[12] * rq * n3[0], qf[13] * rq * n3[1]); b.w = cvt_pk_bf16(qf[14] * rq * n3[2], qf[15] * rq * n3[3]);
        q0 = __builtin_bit_cast(bf16x8, a); q1 = __builtin_bit_cast(bf16x8, b);
    }
    f32x4 s[9];
#pragma unroll
    for (int T = 0; T < 9; ++T) {
        const LAS bf16_t* kp = Ks + ((tile0 + T) * 16 + fr) * KS_STRIDE + fq * 8;
        const bf16x8 a0 = *(const LAS bf16x8*)(kp), a1 = *(const LAS bf16x8*)(kp + 32);
        f32x4 z = (f32x4){0.f, 0.f, 0.f, 0.f};
        z = __builtin_amdgcn_mfma_f32_16x16x32_bf16(a0, q0, z, 0, 0, 0);
        s[T] = __builtin_amdgcn_mfma_f32_16x16x32_bf16(a1, q1, z, 0, 0, 0);
    }
    __builtin_amdgcn_sched_barrier(0);
    int qi = r0 + fr; asm volatile("" : "+v"(qi));
    const int lim = first ? qi + 1 : 128;
    float mx = sink;
#pragma unroll
    for (int T = 0; T < 9; ++T)
#pragma unroll
        for (int j = 0; j < 4; ++j) {
            const int jk = (tile0 + T) * 16 + 4 * fq + j, dist = 128 + qi - jk;
            const bool valid = (unsigned)dist < (unsigned)lim;
            const float v = valid ? (s[T][j] - slope * (float)dist) : -1e30f;
            s[T][j] = v; mx = fmaxf(mx, v);
        }
    mx = fmaxf(mx, __shfl_xor(mx, 16)); mx = fmaxf(mx, __shfl_xor(mx, 32));
    float sum = 0.f;
#pragma unroll
    for (int T = 0; T < 9; ++T)
#pragma unroll
        for (int j = 0; j < 4; ++j) { const float e = __expf(s[T][j] - mx); s[T][j] = e; sum += e; }
    sum += __shfl_xor(sum, 16); sum += __shfl_xor(sum, 32);
    sum += __expf(sink - mx);
    const float inv = 1.0f / sum;
    __builtin_amdgcn_sched_barrier(0);
    f32x4 o[4];
#pragma unroll
    for (int dt = 0; dt < 4; ++dt) o[dt] = (f32x4){0.f, 0.f, 0.f, 0.f};
#pragma unroll
    for (int pp = 0; pp < 5; ++pp) {
        const int T0 = 2 * pp, T1 = (pp < 4) ? 2 * pp + 1 : 8;
        u32x4 pw;
        pw.x = cvt_pk_bf16(s[T0][0] * inv, s[T0][1] * inv); pw.y = cvt_pk_bf16(s[T0][2] * inv, s[T0][3] * inv);
        if (pp < 4) { pw.z = cvt_pk_bf16(s[T1][0] * inv, s[T1][1] * inv); pw.w = cvt_pk_bf16(s[T1][2] * inv, s[T1][3] * inv); } else { pw.z = 0u; pw.w = 0u; }
        const bf16x8 pf = __builtin_bit_cast(bf16x8, pw);
#pragma unroll
        for (int dt = 0; dt < 4; ++dt) {
            const LAS bf16_t* vp = Vt + (dt * 16 + fr) * VT_STRIDE + 4 * fq;
            const u32x2 v0 = *(const LAS u32x2*)(vp + (tile0 + T0) * 16), v1 = *(const LAS u32x2*)(vp + (tile0 + T1) * 16);
            u32x4 vw; vw.x = v0.x; vw.y = v0.y; vw.z = v1.x; vw.w = v1.y;
            o[dt] = __builtin_amdgcn_mfma_f32_16x16x32_bf16(__builtin_bit_cast(bf16x8, vw), pf, o[dt], 0, 0, 0);
        }
    }
    if (qvalid) {
#pragma unroll
        for (int dt = 0; dt < 4; ++dt) { u32x2 w; w.x = cvt_pk_bf16(o[dt][0], o[dt][1]); w.y = cvt_pk_bf16(o[dt][2], o[dt][3]); *(u32x2*)(optr + dt * 16) = w; }
    }
}

__device__ __forceinline__ void mixer_phase(const Params& p, int l, LAS unsigned char* lds) {
    const int G = gridDim.x, bid = blockIdx.x, i = l >> 1;
    const bf16_t* QKV = (const bf16_t*)(p.ws + WS_QKV); const bf16_t* GLU = (const bf16_t*)(p.ws + WS_GLU); bf16_t* CAT = (bf16_t*)(p.ws + WS_CAT);
    const float* qn = p.in[I_QN] + i * 64; const float* kn = p.in[I_KN] + i * 64; const float* sinks = p.in[I_SINK] + i * 8;
    constexpr int N_PA = 256, N_CV = 544, N_SA = 128;
    for (int u = bid; u < N_PA + N_CV + N_SA; u += G) {
        int tid = threadIdx.x; asm volatile("" : "+v"(tid));
        const int wave = tid >> 6, lane = tid & 63, fr = lane & 15, fq = lane >> 4;
        if (u < N_PA) {
#ifndef X_NOPA
            const int kh = u & 1, blk = (u >> 1) & 31, b = u >> 6;
            const int rowQ0 = b * 4096 + blk * 128, rowK0 = rowQ0 - 128;
            LAS bf16_t* Ks = (LAS bf16_t*)lds; LAS bf16_t* Vt = (LAS bf16_t*)(lds + 256 * KS_STRIDE * 2);
            const int chunk = tid & 7;
            const f32x4 kn0 = *(const f32x4*)(kn + chunk * 8), kn1 = *(const f32x4*)(kn + chunk * 8 + 4);
#pragma unroll 1
            for (int ps = 0; ps < 4; ++ps) {
                const int key = (tid >> 3) + 64 * ps;
                u32x4 kr = (u32x4){0u, 0u, 0u, 0u}, vr = kr;
                const bool have = (blk > 0) || (key >= 128);
                if (have) { const bf16_t* rp = QKV + (size_t)(rowK0 + key) * 768 + 512 + kh * 64 + chunk * 8; kr = *(const u32x4*)rp; vr = *(const u32x4*)(rp + 128); }
                float kf[8], vf[8];
#pragma unroll
                for (int j = 0; j < 4; ++j) { kf[2 * j] = bflo(kr[j]); kf[2 * j + 1] = bfhi(kr[j]); vf[2 * j] = bflo(vr[j]); vf[2 * j + 1] = bfhi(vr[j]); }
                float ss = 0.f;
#pragma unroll
                for (int j = 0; j < 8; ++j) ss += kf[j] * kf[j];
                ss += __shfl_xor(ss, 1); ss += __shfl_xor(ss, 2); ss += __shfl_xor(ss, 4);
                const float rk = rsqrtf(ss * (1.0f / 64.0f) + RMS_EPS);
#pragma unroll
                for (int j = 0; j < 4; ++j) { kf[j] *= rk * kn0[j]; kf[4 + j] *= rk * kn1[j]; }
                u32x4 kw; kw.x = cvt_pk_bf16(kf[0], kf[1]); kw.y = cvt_pk_bf16(kf[2], kf[3]); kw.z = cvt_pk_bf16(kf[4], kf[5]); kw.w = cvt_pk_bf16(kf[6], kf[7]);
                *(LAS u32x4*)(Ks + key * KS_STRIDE + chunk * 8) = kw;
#pragma unroll
                for (int j = 0; j < 4; ++j) { Vt[(chunk * 8 + 2 * j) * VT_STRIDE + key] = (bf16_t)(vr[j] & 0xffffu); Vt[(chunk * 8 + 2 * j + 1) * VT_STRIDE + key] = (bf16_t)(vr[j] >> 16); }
                if (blk == 31 && key >= 128) {
                    float* ko = p.out + O_KP + ((((size_t)i * 4 + b) * 128 + (key - 128)) * 2 + kh) * 64 + chunk * 8;
                    float* vo = p.out + O_VP + ((((size_t)i * 4 + b) * 128 + (key - 128)) * 2 + kh) * 64 + chunk * 8;
                    *(f32x4*)ko = (f32x4){kf[0], kf[1], kf[2], kf[3]}; *(f32x4*)(ko + 4) = (f32x4){kf[4], kf[5], kf[6], kf[7]};
                    *(f32x4*)vo = (f32x4){vf[0], vf[1], vf[2], vf[3]}; *(f32x4*)(vo + 4) = (f32x4){vf[4], vf[5], vf[6], vf[7]};
                }
            }
            __syncthreads();
            const int r0 = wave * 16;
#pragma unroll 1
            for (int g = 0; g < 4; ++g) {
                const int h = kh * 4 + g;
                const float slope = exp2f(-(float)(h + 1)), sink = sinks[h];
                const size_t row = (size_t)(rowQ0 + r0 + fr);
                attn_item(Ks, Vt, wave, r0, blk == 0, true, QKV + row * 768 + h * 64 + fq * 8, qn, slope, sink, CAT + row * DM + 512 + h * 64 + 4 * fq, fr, fq);
            }
            __syncthreads();
#endif
        } else if (u < N_PA + N_CV) {
#ifndef X_NOCV
            const int cu = u - N_PA, c2 = tid & 255, half = tid >> 8, c = c2 * 2; const bool prm = cu < 512;
            LAS float* ybuf = (LAS float*)lds;
            f32x2 wdw[31];
            { const float* wp = p.in[I_WDW] + (size_t)i * 31 * 512 + c; asm volatile("" : "+v"(wp));
#pragma unroll
              for (int j = 0; j < 31; ++j) { wdw[j] = *(const f32x2*)wp; wp += 512; asm volatile("" : "+v"(wp)); } }
            const f32x2 bias = *(const f32x2*)(p.in[I_BDW] + i * 512 + c);
            if (prm) {
#pragma unroll 1
                for (int q = 0; q < 2; ++q) {
                    const int b = cu >> 7, tl = half * 16 + q * 8, tb = (cu & 127) * 32 + tl;
                    f32x2 win[38];
                    if (tb >= 30) {
                        const bf16_t* gp = GLU + ((size_t)b * 4096 + tb - 30) * 512 + c; asm volatile("" : "+v"(gp));
#pragma unroll
                        for (int j = 0; j < 38; ++j) { const unsigned w = *(const unsigned*)gp; gp += 512; asm volatile("" : "+v"(gp)); win[j] = (f32x2){bflo(w), bfhi(w)}; }
                    } else {
                        int vz; asm volatile("v_mov_b32 %0, 0" : "=v"(vz));
                        const bf16_t* gp = GLU + (size_t)b * 4096 * 512 + c; asm volatile("" : "+v"(gp));
#pragma unroll
                        for (int j = 0; j < 38; ++j) { const int tj = tb - 30 + j + vz; const unsigned w = *(const unsigned*)gp; if (tj >= 0) gp += 512; asm volatile("" : "+v"(gp));
                            win[j] = tj < 0 ? (f32x2){0.f, 0.f} : (f32x2){bflo(w), bfhi(w)}; }
                    }
                    if (tb >= 4064) {
                        float* oc = p.out + O_CONVP + (((size_t)i * 4 + b) * 30) * 512 + c; asm volatile("" : "+v"(oc));
#pragma unroll
                        for (int j = 0; j < 8; ++j) { const int t = tb + j; if (t >= 4066) *(f32x2*)(oc + (size_t)(t - 4066) * 512) = win[30 + j]; }
                    }
#pragma unroll
                    for (int t = 0; t < 8; ++t) {
                        f32x2 y = bias;
#pragma unroll
                        for (int j = 0; j < 31; ++j) y += wdw[j] * win[t + j];
                        *(LAS f32x2*)(ybuf + (tl + t) * 512 + c) = y;
                    }
                }
            } else {
#pragma unroll 1
                for (int q = 0; q < 2; ++q) {
                    const int sl = half * 2 + q, s = (cu - 512) * 4 + sl;
                    f32x2 win[38];
                    const float* cc = p.in[I_CCONV] + (((size_t)i * 128 + s) * 30) * 512 + c; asm volatile("" : "+v"(cc));
                    const bf16_t* gs = GLU + ((size_t)MP + s * 8) * 512 + c; asm volatile("" : "+v"(gs));
#pragma unroll
                    for (int j = 0; j < 30; ++j) { win[j] = *(const f32x2*)cc; cc += 512; asm volatile("" : "+v"(cc)); }
#pragma unroll
                    for (int j = 0; j < 8; ++j) { const unsigned w = *(const unsigned*)gs; gs += 512; asm volatile("" : "+v"(gs)); win[30 + j] = (f32x2){bflo(w), bfhi(w)}; }
                    float* oc = p.out + O_CONVS + (((size_t)i * 128 + s) * 30) * 512 + c; asm volatile("" : "+v"(oc));
#pragma unroll
                    for (int j = 0; j < 30; ++j) { *(f32x2*)oc = win[8 + j]; oc += 512; asm volatile("" : "+v"(oc)); }
#pragma unroll
                    for (int t = 0; t < 8; ++t) {
                        f32x2 y = bias;
#pragma unroll
                        for (int j = 0; j < 31; ++j) y += wdw[j] * win[t + j];
                        *(LAS f32x2*)(ybuf + (sl * 8 + t) * 512 + c) = y;
                    }
                }
            }
            __syncthreads();
            {
                const float* gp = p.in[I_CNG] + i * 512 + lane * 8; const float* bp = p.in[I_CNB] + i * 512 + lane * 8;
                const f32x4 g0 = *(const f32x4*)gp, g1 = *(const f32x4*)(gp + 4), b0 = *(const f32x4*)bp, b1 = *(const f32x4*)(bp + 4);
#pragma unroll 1
                for (int q = 0; q < 4; ++q) {
                    const int tk = wave * 4 + q; const size_t row = prm ? (size_t)cu * 32 + tk : (size_t)MP + (size_t)(cu - 512) * 32 + tk;
                    const f32x4 v0 = *(const LAS f32x4*)(ybuf + tk * 512 + lane * 8), v1 = *(const LAS f32x4*)(ybuf + tk * 512 + lane * 8 + 4);
                    const float mean = wave_sum((v0[0] + v0[1]) + (v0[2] + v0[3]) + (v1[0] + v1[1]) + (v1[2] + v1[3])) * (1.0f / 512.0f);
                    const f32x4 d0 = v0 - mean, d1 = v1 - mean;
                    const float var = wave_sum((d0[0] * d0[0] + d0[1] * d0[1]) + (d0[2] * d0[2] + d0[3] * d0[3]) + (d1[0] * d1[0] + d1[1] * d1[1]) + (d1[2] * d1[2] + d1[3] * d1[3])) * (1.0f / 512.0f);
                    const float rs = rsqrtf(var + LN_EPS);
                    f32x4 o0 = d0 * rs * g0 + b0, o1 = d1 * rs * g1 + b1;
#pragma unroll
                    for (int j = 0; j < 4; ++j) { o0[j] = o0[j] * fast_sigmoid(o0[j]); o1[j] = o1[j] * fast_sigmoid(o1[j]); }
                    u32x4 w; w.x = cvt_pk_bf16(o0[0], o0[1]); w.y = cvt_pk_bf16(o0[2], o0[3]); w.z = cvt_pk_bf16(o1[0], o1[1]); w.w = cvt_pk_bf16(o1[2], o1[3]);
                    *(u32x4*)(CAT + row * DM + lane * 8) = w;
                }
            }
            __syncthreads();
#endif
        } else {
#ifndef X_NOSA
            const int s = u - N_PA - N_CV;
            LAS bf16_t* Ks = (LAS bf16_t*)lds; LAS bf16_t* Vt = (LAS bf16_t*)(lds + 2 * 144 * KS_STRIDE * 2);
            const int chunk = tid & 7;
            const f32x4 kn0 = *(const f32x4*)(kn + chunk * 8), kn1 = *(const f32x4*)(kn + chunk * 8 + 4);
#pragma unroll 1
            for (int it = tid; it < 2 * 144 * 8; it += 512) {
                const int kk = it >> 3, kh = kk / 144, key = kk % 144;
                float kf[8], vf[8];
#pragma unroll
                for (int j = 0; j < 8; ++j) { kf[j] = 0.f; vf[j] = 0.f; }
                const bool isnew = (key >= 128) && (key < 136);
                if (key < 128) {
                    const size_t off = ((((size_t)i * 128 + s) * 128 + key) * 2 + kh) * 64 + chunk * 8;
                    const f32x4 a0 = *(const f32x4*)(p.in[I_CK] + off), a1 = *(const f32x4*)(p.in[I_CK] + off + 4), c0 = *(const f32x4*)(p.in[I_CV] + off), c1 = *(const f32x4*)(p.in[I_CV] + off + 4);
#pragma unroll
                    for (int j = 0; j < 4; ++j) { kf[j] = a0[j]; kf[4 + j] = a1[j]; vf[j] = c0[j]; vf[4 + j] = c1[j]; }
                } else if (isnew) {
                    const bf16_t* rp = QKV + ((size_t)MP + s * 8 + (key - 128)) * 768 + 512 + kh * 64 + chunk * 8;
                    const u32x4 kr = *(const u32x4*)rp, vr = *(const u32x4*)(rp + 128);
#pragma unroll
                    for (int j = 0; j < 4; ++j) { kf[2 * j] = bflo(kr[j]); kf[2 * j + 1] = bfhi(kr[j]); vf[2 * j] = bflo(vr[j]); vf[2 * j + 1] = bfhi(vr[j]); }
                }
                float ss = 0.f;
#pragma unroll
                for (int j = 0; j < 8; ++j) ss += kf[j] * kf[j];
                ss += __shfl_xor(ss, 1); ss += __shfl_xor(ss, 2); ss += __shfl_xor(ss, 4);
                const float rk = rsqrtf(ss * (1.0f / 64.0f) + RMS_EPS);
                if (isnew) {
#pragma unroll
                    for (int j = 0; j < 4; ++j) { kf[j] *= rk * kn0[j]; kf[4 + j] *= rk * kn1[j]; }
                }
                u32x4 kw; kw.x = cvt_pk_bf16(kf[0], kf[1]); kw.y = cvt_pk_bf16(kf[2], kf[3]); kw.z = cvt_pk_bf16(kf[4], kf[5]); kw.w = cvt_pk_bf16(kf[6], kf[7]);
                *(LAS u32x4*)(Ks + (kh * 144 + key) * KS_STRIDE + chunk * 8) = kw;
                u32x4 vw; vw.x = cvt_pk_bf16(vf[0], vf[1]); vw.y = cvt_pk_bf16(vf[2], vf[3]); vw.z = cvt_pk_bf16(vf[4], vf[5]); vw.w = cvt_pk_bf16(vf[6], vf[7]);
#pragma unroll
                for (int j = 0; j < 4; ++j) { Vt[(kh * 64 + chunk * 8 + 2 * j) * VT_STRIDE + key] = (bf16_t)(vw[j] & 0xffffu); Vt[(kh * 64 + chunk * 8 + 2 * j + 1) * VT_STRIDE + key] = (bf16_t)(vw[j] >> 16); }
                if (key >= 8 && key < 136) {
                    const size_t oo = ((((size_t)i * 128 + s) * 128 + (key - 8)) * 2 + kh) * 64 + chunk * 8;
                    float* ko = p.out + O_KS + oo; float* vo = p.out + O_VS + oo;
                    *(f32x4*)ko = (f32x4){kf[0], kf[1], kf[2], kf[3]}; *(f32x4*)(ko + 4) = (f32x4){kf[4], kf[5], kf[6], kf[7]};
                    *(f32x4*)vo = (f32x4){vf[0], vf[1], vf[2], vf[3]}; *(f32x4*)(vo + 4) = (f32x4){vf[4], vf[5], vf[6], vf[7]};
                }
            }
            __syncthreads();
            {
                const int kh = wave >> 2, g = wave & 3, h = kh * 4 + g;
                const float slope = exp2f(-(float)(h + 1)), sink = sinks[h];
                const size_t row = (size_t)MP + s * 8 + (fr & 7);
                attn_item(Ks + kh * 144 * KS_STRIDE, Vt + kh * 64 * VT_STRIDE, 0, 0, false, fr < 8, QKV + row * 768 + h * 64 + fq * 8, qn, slope, sink, CAT + row * DM + 512 + h * 64 + 4 * fq, fr, fq);
            }
            __syncthreads();
#endif
        }
    }
}


__device__ __forceinline__ void splitk_reduce(float* Y, bf16_t* XB, ssq_t* ssq, const float* part, const pg8::StaticOrder& S, int KS) {
    int tid = threadIdx.x; asm volatile("" : "+v"(tid));
    const int wid = tid >> 6, lane = tid & 63, wr = wid >> 2, wc = wid & 3, fr = lane & 15, fq = lane >> 4;
    for (int task = blockIdx.x; task < 256; task += gridDim.x) {
        const int e = task >> 4, ai = (task >> 3) & 1, m = (task >> 1) & 3, bj = task & 1;
        pg8::Unit u; S.tile(256 + e, u);
        const float* pp = part + (size_t)(e * KS) * 65536 + (size_t)((((ai * 4 + m) * 2 + bj) * 2) * 2048) + (size_t)tid * 4;
        f32x4 a0 = (f32x4){0.f, 0.f, 0.f, 0.f}, a1 = a0;
        for (int k = 0; k < KS; ++k) { a0 += *(const f32x4*)(pp + (size_t)k * 65536); a1 += *(const f32x4*)(pp + (size_t)k * 65536 + 2048); }
        const int r = u.pm * 256 + ai * 128 + wr * 64 + m * 16 + fr, col = u.pn * 256 + bj * 128 + wc * 32 + 8 * fq;
        bf16_t* bp = XB + (size_t)r * DM + col;
        f32x4 x0, x1; bf8_to_f32(*(const u32x4*)bp, x0, x1);
        const f32x4 v0 = x0 + a0, v1 = x1 + a1;
        if (Y) { float* yp = Y + (size_t)r * DM + col; *(f32x4*)yp = v0; *(f32x4*)(yp + 4) = v1; }
        u32x4 w; w.x = cvt_pk_bf16(v0[0], v0[1]); w.y = cvt_pk_bf16(v0[2], v0[3]); w.z = cvt_pk_bf16(v1[0], v1[1]); w.w = cvt_pk_bf16(v1[2], v1[3]);
        *(u32x4*)bp = w;
        float ss = (v0[0] * v0[0] + v0[1] * v0[1]) + (v0[2] * v0[2] + v0[3] * v0[3]) + (v1[0] * v1[0] + v1[1] * v1[1]) + (v1[2] * v1[2] + v1[3] * v1[3]);
        ss += __shfl_xor(ss, 16); ss += __shfl_xor(ss, 32);
        if (fq == 0) ssq_add(ssq + r, ss);
    }
}

#define XB_TMO      128
#define XB_XCNT(j)  (256  + 64 * (j))
#define XB_XSUB(j)  (1280 + 64 * (j))
#define XB_XGEN(j)  (2304 + 64 * (j))
#define XB_TOP      3328
#define XB_TOPGEN   3392
#define XCD_BAR_WORDS 3456
#define XB_SPIN_CAP (1u << 22)
__device__ __forceinline__ unsigned xb_ld(unsigned* p)              { return __hip_atomic_load(p, __ATOMIC_RELAXED, __HIP_MEMORY_SCOPE_AGENT); }
__device__ __forceinline__ unsigned xb_add(unsigned* p, unsigned v) { return __hip_atomic_fetch_add(p, v, __ATOMIC_RELAXED, __HIP_MEMORY_SCOPE_AGENT); }
__device__ __forceinline__ unsigned xb_xcc_id() { return (unsigned)__builtin_amdgcn_s_getreg((3 << 11) | 20) & 0xFu; }
#define XB_SPIN(cond, bar) do { unsigned _sp = 0; while (cond) { __builtin_amdgcn_s_sleep(1); \
    if ((++_sp & 255u) == 0u) { if (xb_ld(&(bar)[XB_TMO])) break; if (_sp > XB_SPIN_CAP) { atomicAdd(&(bar)[XB_TMO], 1u); break; } } } } while (0)
struct XcdBarrier { unsigned* bar; unsigned x; volatile LAS unsigned* st; };
__device__ __forceinline__ XcdBarrier xcd_barrier_post(unsigned* bar, volatile LAS unsigned* st) {
    XcdBarrier b; b.bar = bar; b.x = xb_xcc_id(); b.st = st;
    if (threadIdx.x == 0) (void)xb_add(&bar[XB_XCNT(b.x)], 1u);
    return b;
}
__device__ __forceinline__ void xcd_barrier_complete(unsigned* bar, unsigned x, unsigned& nloc, unsigned& nx) {
    const unsigned G = gridDim.x * gridDim.y * gridDim.z;
    unsigned sum, cnt, mine, sp = 0u;
    for (;;) {
        sum = 0u; cnt = 0u; mine = 0u;
#pragma unroll
        for (unsigned j = 0; j < 16; ++j) { const unsigned c = xb_ld(&bar[XB_XCNT(j)]); sum += c; cnt += (c > 0u) ? 1u : 0u; mine = (j == x) ? c : mine; }
        if (sum == G) break;
        __builtin_amdgcn_s_sleep(1);
        if ((++sp & 255u) == 0u) { if (xb_ld(&bar[XB_TMO])) break; if (sp > XB_SPIN_CAP) { atomicAdd(&bar[XB_TMO], 1u); break; } }
    }
    nloc = mine > 0u ? mine : 1u; nx = cnt > 0u ? cnt : 1u;
}
__device__ __forceinline__ void xcd_barrier(const XcdBarrier& b) {
    asm volatile("s_waitcnt vmcnt(0)" ::: "memory");
    __syncthreads();
    if (threadIdx.x == 0) {
        unsigned* bar = b.bar;
        __builtin_amdgcn_s_waitcnt(0);
        unsigned nloc = b.st[0], nx = b.st[1];
        if (nloc == 0u) { xcd_barrier_complete(bar, b.x, nloc, nx); b.st[0] = nloc; b.st[1] = nx; }
        const unsigned old = xb_add(&bar[XB_XSUB(b.x)], 1u);
        const unsigned gen = old / nloc;
        if (old + 1u == (gen + 1u) * nloc) {
            __builtin_amdgcn_fence(__ATOMIC_RELEASE, "agent");
            asm volatile("s_waitcnt vmcnt(0)" ::: "memory");
            const unsigned og = xb_add(&bar[XB_TOP], 1u);
            const unsigned tg = og / nx;
            if (og + 1u == (tg + 1u) * nx) xb_add(&bar[XB_TOPGEN], 1u);
            else XB_SPIN(xb_ld(&bar[XB_TOPGEN]) == tg, bar);
            __builtin_amdgcn_fence(__ATOMIC_ACQUIRE, "agent");
            xb_add(&bar[XB_XGEN(b.x)], 1u);
            asm volatile("s_waitcnt vmcnt(0)" ::: "memory");
        } else {
            XB_SPIN(xb_ld(&bar[XB_XGEN(b.x)]) == gen, bar);
            __builtin_amdgcn_fence(__ATOMIC_ACQUIRE, "agent");
            asm volatile("s_waitcnt vmcnt(0)" ::: "memory");
        }
    }
    __syncthreads();
}

__global__ void __launch_bounds__(512, 2) fwd_megakernel(Params p) {
    extern __shared__ __attribute__((aligned(16))) unsigned char lds_raw[];
    LAS unsigned char* lds = (LAS unsigned char*)lds_raw;
    cg::grid_group grid = cg::this_grid();
    const int G = gridDim.x, bid = blockIdx.x;
    bf16_t* XB = (bf16_t*)(p.ws + WS_XB); ssq_t* SSQ = (ssq_t*)(p.ws + WS_SSQ); float* PART = (float*)(p.ws + WS_PART);
#define IN(k) (p.ph_lo <= (k) && (k) < p.ph_hi)
#define SYNC(k) do { if (p.ph_hi > (k) + 1) xcd_barrier(bar); } while (0)
    unsigned* barw = (unsigned*)(p.ws + WS_BAR);
    volatile LAS unsigned* bst = (volatile LAS unsigned*)(lds + 131072);
    if (threadIdx.x < 4) bst[threadIdx.x] = 0u;
    __syncthreads();
    XcdBarrier bar = xcd_barrier_post(barw, bst);
#ifndef X_NOPREP
    if (IN(0)) prep_phase(p, lds);
    if (p.ph_lo < 0) grid.sync();
    xcd_barrier(bar);
    for (int rep = 0; rep < DUP_SYNC; ++rep) xcd_barrier(bar);
#endif
#pragma unroll 1
    for (int l = 0; l < 4; ++l) {
        const int pb = 1 + 5 * l, i = l >> 1;
        ssq_t* ssq_in = SSQ + (size_t)(2 * l) * MT;
        ssq_t* ssq_mid = SSQ + (size_t)(2 * l + 1) * MT;
        ssq_t* ssq_out = SSQ + (size_t)(2 * l + 2) * MT;
        if ((l & 1) == 0) {
            if (IN(pb) && X_GIN) {
                pg8::Gemm g{XB, (const bf16_t*)(p.ws + WS_WIN) + (size_t)i * DIN * DM, MT, DIN, DM}; pg8::StaticOrder S; S.init(MT, DIN, DM, G, bid);
                EpiIn E{ssq_in, (bf16_t*)(p.ws + WS_GLU), (bf16_t*)(p.ws + WS_QKV)};
                for (int rep = 0; rep <= DUP_IN; ++rep) { pg8::gemm_phase(lds, g, S, E); SYNC(pb); }
            }
#ifndef X_NOMIX
            if (IN(pb + 1)) { for (int rep = 0; rep <= DUP_MIX; ++rep) { mixer_phase(p, l, lds); SYNC(pb + 1); } }
#endif
            if (IN(pb + 2) && X_GOUT) {
                pg8::Gemm g{(const bf16_t*)(p.ws + WS_CAT), (const bf16_t*)(p.ws + WS_WOUT) + (size_t)i * DM * DM, MT, DM, DM}; pg8::SplitOrder<false> S; S.init2(MT, DM, DM, G, bid, 4);
                EpiRes<false> E{nullptr, XB, ssq_mid, nullptr, PART};
                pg8::gemm_phase(lds, g, S, E);
                xcd_barrier(bar);
                splitk_reduce(nullptr, XB, ssq_mid, PART, S, 4);
                SYNC(pb + 2);
            }
        } else {
#ifndef X_NOPOOL1
            if (IN(pb)) { for (int rep = 0; rep <= DUP_POOL1; ++rep) { pool1_phase(p, l, ssq_in); SYNC(pb); } }
#endif
            if (IN(pb + 1) && X_GPOOL) {
                pg8::Gemm g{(const bf16_t*)(p.ws + WS_DG), (const bf16_t*)(p.ws + WS_WPL) + (size_t)i * 4 * 65536, 4 * MT, 256, 256}; pg8::PoolOrder S{G, bid};
                EpiRes<true> E{nullptr, XB, ssq_mid, p.in[I_PSCALE] + i * DM, PART};
                pg8::gemm_phase(lds, g, S, E);
                SYNC(pb + 2);
            }
        }
        if (IN(pb + 3) && X_GGU) {
            pg8::Gemm g{XB, (const bf16_t*)(p.ws + WS_WGU) + (size_t)l * 2 * DFF * DM, MT, 2 * DFF, DM}; pg8::StaticOrder S; S.init(MT, 2 * DFF, DM, G, bid);
            EpiGU E{ssq_mid, (bf16_t*)(p.ws + WS_ACT)};
            for (int rep = 0; rep <= DUP_GU; ++rep) { pg8::gemm_phase(lds, g, S, E); SYNC(pb + 3); }
        }
        if (IN(pb + 4) && X_GDN) {
            pg8::Gemm g{(const bf16_t*)(p.ws + WS_ACT), (const bf16_t*)(p.ws + WS_WDN) + (size_t)l * DM * DFF, MT, DM, DFF}; pg8::SplitOrder<true> S; S.init2(MT, DM, DFF, G, bid, 11);
            float* Yout = (l == 3) ? p.out : nullptr;
            EpiRes<false> E{Yout, XB, ssq_out, nullptr, PART};
            pg8::gemm_phase(lds, g, S, E);
            xcd_barrier(bar);
            splitk_reduce(Yout, XB, ssq_out, PART, S, 11);
            SYNC(pb + 4);
        }
    }
#undef IN
#undef SYNC
}

extern "C" void kernel_launch(void* const* d_in, const int* in_sizes, int n_in, void* d_out, int out_size, void* d_ws, size_t ws_size, hipStream_t stream) {
    static int grid_blocks = 0;
    if (grid_blocks == 0) {
        if (n_in != N_IN || ws_size < WS_END) { fprintf(stderr, "kernel_launch: unexpected n_in %d or ws_size %zu (< %zu)\n", n_in, ws_size, (size_t)WS_END); grid_blocks = -1; return; }
        int dev = 0, cus = 0, per_cu = 0;
        hipGetDevice(&dev);
        hipDeviceGetAttribute(&cus, hipDeviceAttributeMultiprocessorCount, dev);
        hipFuncSetAttribute((const void*)fwd_megakernel, hipFuncAttributeMaxDynamicSharedMemorySize, LDS_BYTES);
        hipOccupancyMaxActiveBlocksPerMultiprocessor(&per_cu, (const void*)fwd_megakernel, 512, LDS_BYTES);
        if (per_cu < 1) { fprintf(stderr, "kernel_launch: occupancy query reports %d blocks per CU\n", per_cu); per_cu = 1; }
        grid_blocks = cus * 1;
    }
    if (grid_blocks < 0) return;
    Params p{};
    for (int k = 0; k < N_IN; ++k) p.in[k] = (const float*)d_in[k];
    p.out = (float*)d_out; p.ws = (unsigned char*)d_ws; p.ph_lo = 0; p.ph_hi = N_PHASES;
    void* args[] = {&p};
    if (hipMemsetAsync((unsigned char*)d_ws + WS_BAR, 0, 16384, stream) != hipSuccess) { fprintf(stderr, "kernel_launch: memset of the barrier words failed\n"); return; }
    hipError_t e = hipLaunchCooperativeKernel((const void*)fwd_megakernel, dim3(grid_blocks), dim3(512), args, LDS_BYTES, stream);
    if (e != hipSuccess) fprintf(stderr, "cooperative launch failed: %s (grid %d)\n", hipGetErrorString(e), grid_blocks);
}
```

```cpp
#include <hip/hip_runtime.h>
#include <hip/hip_cooperative_groups.h>
#include <cstdio>
namespace cg = cooperative_groups;

#define LAS __attribute__((address_space(3)))
#ifndef DUP_PREP
#define DUP_PREP 0
#define DUP_IN 0
#define DUP_MIX 0
#define DUP_POOL1 0
#define DUP_GU 0
#define DUP_SYNC 0
#define DUP_DN 0
#endif
#ifndef X_GIN
#define X_GIN 1
#define X_GOUT 1
#define X_GPOOL 1
#define X_GGU 1
#define X_GDN 1
#endif
typedef unsigned short bf16_t;
typedef short bf16x8 __attribute__((ext_vector_type(8)));
typedef float f32x4 __attribute__((ext_vector_type(4)));
typedef unsigned u32x4 __attribute__((ext_vector_type(4)));
typedef unsigned u32x2 __attribute__((ext_vector_type(2)));
typedef float f32x2 __attribute__((ext_vector_type(2)));
typedef unsigned long long ssq_t;

constexpr int DM = 1024, MP = 16384, MS = 1024, MT = 17408, NTM = 68, DFF = 2816, DIN = 1792;
constexpr float RMS_EPS = 1e-6f, LN_EPS = 1e-5f;
enum { I_XP = 0, I_XS, I_CCONV, I_CK, I_CV, I_SPOOL, I_NMIX, I_NFFN, I_WIN, I_QN, I_KN, I_SINK, I_WDW, I_BDW, I_CNG, I_CNB, I_WOUT, I_WPOOL, I_PSCALE, I_WG, I_WU, I_WD, N_IN };
constexpr size_t O_Y = 0;
constexpr size_t O_CONVP = (size_t)MT * DM;
constexpr size_t O_KP = O_CONVP + 2 * 4 * 30 * 512;
constexpr size_t O_VP = O_KP + 2 * 4 * 128 * 128;
constexpr size_t O_POOLP = O_VP + 2 * 4 * 128 * 128;
constexpr size_t O_CONVS = O_POOLP + 2 * 4 * 15 * 1024;
constexpr size_t O_KS = O_CONVS + (size_t)2 * 128 * 30 * 512;
constexpr size_t O_VS = O_KS + (size_t)2 * 128 * 128 * 128;
constexpr size_t O_POOLS = O_VS + (size_t)2 * 128 * 128 * 128;
constexpr size_t WS_WIN = 0;
constexpr size_t WS_WOUT = WS_WIN + (size_t)2 * DIN * DM * 2;
constexpr size_t WS_WGU = WS_WOUT + (size_t)2 * DM * DM * 2;
constexpr size_t WS_WDN = WS_WGU + (size_t)4 * 2 * DFF * DM * 2;
constexpr size_t WS_WPL = WS_WDN + (size_t)4 * DM * DFF * 2;
constexpr size_t WS_XB = WS_WPL + (size_t)2 * 4 * 256 * 256 * 2;
constexpr size_t WS_SSQ = WS_XB + (size_t)MT * DM * 2;
constexpr size_t WS_ACT = WS_SSQ + (size_t)9 * MT * 8;
constexpr size_t WS_QKV = WS_ACT;
constexpr size_t WS_GLU = WS_QKV + (size_t)MT * 768 * 2;
constexpr size_t WS_CAT = WS_GLU + (size_t)MT * 512 * 2;
constexpr size_t WS_DG = WS_ACT;
constexpr size_t WS_BAR = WS_ACT + (size_t)MT * DFF * 2;
constexpr size_t WS_PART = WS_BAR + 16384;
constexpr size_t WS_END = WS_PART + (size_t)176 * 65536 * 4;
constexpr int LDS_BYTES = 131072 + 16;
constexpr int N_PHASES = 21;

struct Params { const float* in[N_IN]; float* out; unsigned char* ws; int ph_lo, ph_hi; };

__device__ __forceinline__ unsigned cvt_pk_bf16(float lo, float hi) { unsigned r; asm("v_cvt_pk_bf16_f32 %0, %1, %2" : "=v"(r) : "v"(lo), "v"(hi)); return r; }
__device__ __forceinline__ float bflo(unsigned w) { return __uint_as_float(w << 16); }
__device__ __forceinline__ float bfhi(unsigned w) { return __uint_as_float(w & 0xffff0000u); }
__device__ __forceinline__ float bf2f(bf16_t b) { return __uint_as_float(((unsigned)b) << 16); }
__device__ __forceinline__ float wave_sum(float v) {
#pragma unroll
    for (int o = 32; o >= 1; o >>= 1) v += __shfl_xor(v, o);
    return v;
}
__device__ __forceinline__ float ssq_rs(ssq_t v) { return rsqrtf((float)v * (1.0f / (1048576.0f * 1024.0f)) + RMS_EPS); }
__device__ __forceinline__ ssq_t ssq_fix(float ss) { return (ssq_t)(ss * 1048576.0f); }
__device__ __forceinline__ void ssq_add(ssq_t* p, float ss) { (void)__hip_atomic_fetch_add(p, ssq_fix(ss), __ATOMIC_RELAXED, __HIP_MEMORY_SCOPE_AGENT); }
__device__ __forceinline__ float fast_sigmoid(float x) { return __builtin_amdgcn_rcpf(1.0f + __expf(-x)); }
__device__ __forceinline__ f32x2 pk_exp2(f32x2 v) { f32x2 r; r.x = __builtin_amdgcn_exp2f(v.x); r.y = __builtin_amdgcn_exp2f(v.y); return r; }
__device__ __forceinline__ f32x2 pk_rcp(f32x2 v) { f32x2 r; r.x = __builtin_amdgcn_rcpf(v.x); r.y = __builtin_amdgcn_rcpf(v.y); return r; }
__device__ __forceinline__ f32x2 pk_sig(f32x2 g, float k2) { return pk_rcp(pk_exp2(g * k2) + 1.0f); }

namespace pg8 {
constexpr int BM = 256, BK = 64, HALF = 128, HTB = HALF * BK * 2, STAGE_BYTES = 8 * HTB, NXCD = 8, WGM = 8;
__host__ __device__ __forceinline__ int lds_byte(int r, int c) { const int st = (r >> 4) * 2 + (c >> 5), rr = r & 15, cc = c & 31, ob = rr * 64 + cc * 2; return st * 1024 + (ob ^ (((ob >> 9) & 1) << 5)); }
__host__ __device__ __forceinline__ void stage_rc(int b, int& R, int& C) { const int st = b / 1024, sb = b % 1024, swz = sb ^ (((sb >> 9) & 1) << 5); R = (st >> 1) * 16 + swz / 64; C = (st & 1) * 32 + (swz % 64) / 2; }
__host__ __device__ __forceinline__ int perm32(int rho) { const int n = rho >> 4, i = rho & 15; return 8 * (i >> 2) + 4 * n + (i & 3); }
struct Unit { int pm, pn, k0, nt, part; };
struct Gemm { const bf16_t* A; const bf16_t* Bt; int M, N, K; };
struct StaticOrder {
    static constexpr bool SPLIT = false, ABLK = false;
    int nM, nN, nwg, G, c, ntk;
    __device__ void init(int M, int N, int K, int G_, int c_) { nM = M / BM; nN = N / BM; nwg = nM * nN; G = G_; c = c_; ntk = K / BK; }
    __device__ void tile(int L, Unit& u) const {
        int wgid = L; { const int q = nwg / NXCD, r = nwg % NXCD, xcd = wgid % NXCD, off = wgid / NXCD; wgid = (xcd < r ? xcd * (q + 1) : r * (q + 1) + (xcd - r) * q) + off; }
        const int nig = WGM * nN, gid = wgid / nig, fm = gid * WGM, gsz = (nM - fm) < WGM ? (nM - fm) : WGM;
        u.pm = fm + ((wgid % nig) % gsz); u.pn = (wgid % nig) / gsz;
    }
    __device__ bool next(int i, Unit& u) const {
        const long L = (long)i * G + c; if (L >= nwg) return false;
        tile((int)L, u); u.k0 = 0; u.nt = ntk; u.part = -1; return true;
    }
};
template <bool ABLK_> struct SplitOrder : StaticOrder {
    static constexpr bool SPLIT = true, ABLK = ABLK_;
    int KS, ntp;
    __device__ void init2(int M, int N, int K, int G_, int c_, int KS_) { init(M, N, K, G_, c_); KS = KS_; ntp = ntk / KS_; }
    __device__ bool next(int i, Unit& u) const {
        const int np = (nwg - G) * KS;
        int j = i;
        if (c < np) { if (i == 0) { tile(G + c / KS, u); u.k0 = (c % KS) * ntp; u.nt = ntp; u.part = c; return true; } j = i - 1; }
        if (j > 0) return false;
        tile(c, u); u.k0 = 0; u.nt = ntk; u.part = -1; return true;
    }
};
struct PoolOrder {
    static constexpr bool SPLIT = false, ABLK = false;
    int G, c;
    __device__ bool next(int i, Unit& u) const { const int L = i * G + c; if (L >= 4 * NTM) return false; u.pm = L; u.pn = L / NTM; u.k0 = 0; u.nt = 4; u.part = -1; return true; }
};

template <class Epi, class Sched>
__device__ __forceinline__ void gemm_phase(LAS unsigned char* lds, const Gemm g, const Sched& S, const Epi& E) {
    int tid = threadIdx.x; asm volatile("" : "+v"(tid));
    const int wid = __builtin_amdgcn_readfirstlane(tid >> 6), lane = tid & 63, wr = wid >> 2, wc = wid & 3, fr = lane & 15, fq = lane >> 4;
    int K = g.K; asm volatile("" : "+s"(K));
    unsigned voffA[2], voffB[2];
#pragma unroll
    for (int i = 0; i < 2; ++i) { int R, C; stage_rc(tid * 16 + i * 8192, R, C); const int Rb = (R & ~31) + perm32(R & 31);
        voffA[i] = Sched::ABLK ? (unsigned)(R * 64 + C) * 2u : (unsigned)(R * K + C) * 2u; voffB[i] = (unsigned)(Rb * K + C) * 2u; }
    const size_t kstep = (size_t)(BK * 2);
    const size_t hstep = (size_t)HALF * K * 2;
    const size_t tstep = 2 * hstep;
    const size_t kstepA = Sched::ABLK ? (size_t)32768 : kstep, hstepA = Sched::ABLK ? (size_t)16384 : hstep;
    const unsigned ldsw = (unsigned)wid * 1024u;
    const int aoff = lds_byte(wr * 64 + fr, fq * 8), boff = lds_byte(wc * 32 + fr, fq * 8);
#define PG8_SA(b, h) (((b) * 2 + (h)) * HTB)
#define PG8_SB(b, h) ((4 + (b) * 2 + (h)) * HTB)
#define PG8_STAGE(bufoff, gbase, voff) do { _Pragma("unroll") for (int _i = 0; _i < 2; ++_i) \
        __builtin_amdgcn_global_load_lds((const unsigned*)((const char*)(gbase) + (voff)[_i]), (LAS unsigned*)(lds + (bufoff) + ldsw + _i * 8192), 16, 0, 0); } while (0)
#define PG8_LDA(dst, b, h) do { _Pragma("unroll") for (int m = 0; m < 4; ++m) _Pragma("unroll") for (int k = 0; k < 2; ++k) dst[m][k] = *(const LAS bf16x8*)(lds + PG8_SA(b, h) + aoff + m * 2048 + k * 1024); } while (0)
#define PG8_LDB(dst, b, h) do { _Pragma("unroll") for (int n = 0; n < 2; ++n) _Pragma("unroll") for (int k = 0; k < 2; ++k) dst[n][k] = *(const LAS bf16x8*)(lds + PG8_SB(b, h) + boff + n * 2048 + k * 1024); } while (0)
#define PG8_MMA(ai, bj, At, Bt) do { __builtin_amdgcn_s_setprio(1); _Pragma("unroll") for (int m = 0; m < 4; ++m) _Pragma("unroll") for (int n = 0; n < 2; ++n) _Pragma("unroll") for (int k = 0; k < 2; ++k) \
        acc[ai][bj][m][n] = __builtin_amdgcn_mfma_f32_16x16x32_bf16(Bt[n][k], At[m][k], acc[ai][bj][m][n], 0, 0, 0); __builtin_amdgcn_s_setprio(0); } while (0)
#define PG8_WAIT_V(n) asm volatile("s_waitcnt vmcnt(" #n ")" ::: "memory")
#define PG8_WAIT_L(n) asm volatile("s_waitcnt lgkmcnt(" #n ")" ::: "memory")
#define PG8_BAR __builtin_amdgcn_s_barrier()
#define PG8_SCHED __builtin_amdgcn_sched_barrier(0)
    Unit cur, nxt; int ui = 0;
    if (!S.next(0, cur)) return;
    f32x4 acc[2][2][4][2];
    E.init(acc, cur, wr, wc, fr, fq);
    bf16x8 At[4][2], B0[2][2], B1[2][2];
    const char* cA = (const char*)g.A + (size_t)cur.pm * tstep; const char* cB = (const char*)g.Bt + (size_t)cur.pn * tstep;
    if constexpr (Sched::SPLIT) { cA += (size_t)cur.k0 * kstepA; cB += (size_t)cur.k0 * kstep; }
    const int ntc = K / BK;
    PG8_STAGE(PG8_SB(0, 0), cB, voffB); PG8_STAGE(PG8_SA(0, 0), cA, voffA); PG8_STAGE(PG8_SB(0, 1), cB + hstep, voffB); PG8_STAGE(PG8_SA(0, 1), cA + hstepA, voffA);
    if (wr == 1) PG8_BAR;
    PG8_WAIT_V(4); PG8_BAR;
    PG8_STAGE(PG8_SB(1, 0), cB + kstep, voffB); PG8_STAGE(PG8_SA(1, 0), cA + kstepA, voffA); PG8_STAGE(PG8_SB(1, 1), cB + hstep + kstep, voffB);
    PG8_WAIT_V(6); PG8_BAR;
    for (;;) {
        const bool has_next = S.next(ui + 1, nxt);
        const char* nA = has_next ? (const char*)g.A + (size_t)nxt.pm * tstep : cA; const char* nB = has_next ? (const char*)g.Bt + (size_t)nxt.pn * tstep : cB;
        if constexpr (Sched::SPLIT) { if (has_next) { nA += (size_t)nxt.k0 * kstepA; nB += (size_t)nxt.k0 * kstep; } }
        const int nt = Sched::SPLIT ? cur.nt : ntc;
        for (int t = 0; t < nt; t += 2) {
            const bool last = (t == nt - 2);
            const char* a1 = cA + (size_t)(t + 1) * kstepA;
            const char* a2 = last ? nA : cA + (size_t)(t + 2) * kstepA; const char* b2 = last ? nB : cB + (size_t)(t + 2) * kstep;
            const char* a3 = a2 + kstepA; const char* b3 = b2 + kstep;
            PG8_LDB(B0, 0, 0); PG8_SCHED; PG8_LDA(At, 0, 0); PG8_STAGE(PG8_SA(1, 1), a1 + hstepA, voffA);
            PG8_WAIT_L(8); PG8_BAR; PG8_WAIT_L(0); PG8_MMA(0, 0, At, B0); PG8_BAR; PG8_SCHED;
            PG8_LDB(B1, 0, 1); PG8_STAGE(PG8_SB(0, 0), b2, voffB);
            PG8_BAR; PG8_WAIT_L(0); PG8_MMA(0, 1, At, B1); PG8_BAR;
            PG8_LDA(At, 0, 1); PG8_STAGE(PG8_SA(0, 0), a2, voffA);
            PG8_BAR; PG8_WAIT_L(0); PG8_MMA(1, 0, At, B0); PG8_BAR; PG8_SCHED;
            PG8_STAGE(PG8_SB(0, 1), b2 + hstep, voffB);
            PG8_WAIT_V(6); PG8_BAR; PG8_MMA(1, 1, At, B1); PG8_BAR;
            PG8_LDB(B0, 1, 0); PG8_SCHED; PG8_LDA(At, 1, 0); PG8_STAGE(PG8_SA(0, 1), a2 + hstepA, voffA);
            PG8_WAIT_L(8); PG8_BAR; PG8_WAIT_L(0); PG8_MMA(0, 0, At, B0); PG8_BAR; PG8_SCHED;
            PG8_LDB(B1, 1, 1); PG8_STAGE(PG8_SB(1, 0), b3, voffB);
            PG8_BAR; PG8_WAIT_L(0); PG8_MMA(0, 1, At, B1); PG8_BAR;
            PG8_LDA(At, 1, 1); PG8_STAGE(PG8_SA(1, 0), a3, voffA);
            PG8_BAR; PG8_WAIT_L(0); PG8_MMA(1, 0, At, B0); PG8_BAR; PG8_SCHED;
            PG8_STAGE(PG8_SB(1, 1), b3 + hstep, voffB);
            PG8_WAIT_V(6); PG8_BAR; PG8_MMA(1, 1, At, B1); PG8_BAR;
        }
        E(acc, cur, wr, wc, fr, fq);
        if (!has_next) break;
        E.init(acc, nxt, wr, wc, fr, fq);
        cur = nxt; cA = nA; cB = nB; ++ui;
    }
    PG8_WAIT_V(0);
    if (wr == 0) PG8_BAR;
    PG8_BAR;
#undef PG8_SA
#undef PG8_SB
#undef PG8_STAGE
#undef PG8_LDA
#undef PG8_LDB
#undef PG8_MMA
#undef PG8_WAIT_V
#undef PG8_WAIT_L
#undef PG8_BAR
#undef PG8_SCHED
}
}

__device__ __forceinline__ void acc_zero(f32x4 (&acc)[2][2][4][2]) {
#pragma unroll
    for (int a = 0; a < 2; ++a)
#pragma unroll
        for (int b = 0; b < 2; ++b)
#pragma unroll
            for (int m = 0; m < 4; ++m)
#pragma unroll
                for (int n = 0; n < 2; ++n) acc[a][b][m][n] = (f32x4){0.f, 0.f, 0.f, 0.f};
}
struct EpiIn {
    const ssq_t* ssq; bf16_t* glu; bf16_t* qkv;
    __device__ __forceinline__ void init(f32x4 (&acc)[2][2][4][2], const pg8::Unit&, int, int, int, int) const { acc_zero(acc); }
    __device__ __forceinline__ void operator()(const f32x4 (&acc)[2][2][4][2], const pg8::Unit& u, int wr, int wc, int fr, int fq) const {
        const int row0 = u.pm * 256 + wr * 64 + fr;
        if (u.pn < 4) {
            const int col0 = u.pn * 128 + wc * 32 + 8 * fq;
#pragma unroll
            for (int ai = 0; ai < 2; ++ai)
#pragma unroll
                for (int m = 0; m < 4; ++m) {
                    const int r = row0 + ai * 128 + m * 16;
                    const float rs = ssq_rs(ssq[r]);
                    const float k2 = rs * -1.4426950408889634f;
                    f32x2 o[4];
#pragma unroll
                    for (int n = 0; n < 2; ++n)
#pragma unroll
                        for (int h = 0; h < 2; ++h) {
                            const f32x2 a = (f32x2){acc[ai][0][m][n][2 * h], acc[ai][0][m][n][2 * h + 1]}, gt = (f32x2){acc[ai][1][m][n][2 * h], acc[ai][1][m][n][2 * h + 1]};
                            o[n * 2 + h] = (a * rs) * pk_sig(gt, k2);
                        }
                    u32x4 w; w.x = cvt_pk_bf16(o[0].x, o[0].y); w.y = cvt_pk_bf16(o[1].x, o[1].y); w.z = cvt_pk_bf16(o[2].x, o[2].y); w.w = cvt_pk_bf16(o[3].x, o[3].y);
                    *(u32x4*)(glu + (size_t)r * 512 + col0) = w;
                }
        } else {
            const int col0 = (u.pn - 4) * 256 + wc * 32 + 8 * fq;
#pragma unroll
            for (int ai = 0; ai < 2; ++ai)
#pragma unroll
                for (int m = 0; m < 4; ++m) {
                    const int r = row0 + ai * 128 + m * 16;
                    const float rs = ssq_rs(ssq[r]);
#pragma unroll
                    for (int bj = 0; bj < 2; ++bj) {
                        const f32x4 v0 = acc[ai][bj][m][0] * rs, v1 = acc[ai][bj][m][1] * rs;
                        u32x4 w; w.x = cvt_pk_bf16(v0[0], v0[1]); w.y = cvt_pk_bf16(v0[2], v0[3]); w.z = cvt_pk_bf16(v1[0], v1[1]); w.w = cvt_pk_bf16(v1[2], v1[3]);
                        *(u32x4*)(qkv + (size_t)r * 768 + col0 + bj * 128) = w;
                    }
                }
        }
    }
};
struct EpiGU {
    const ssq_t* ssq; bf16_t* act;
    __device__ __forceinline__ void init(f32x4 (&acc)[2][2][4][2], const pg8::Unit&, int, int, int, int) const { acc_zero(acc); }
    __device__ __forceinline__ void operator()(const f32x4 (&acc)[2][2][4][2], const pg8::Unit& u, int wr, int wc, int fr, int fq) const {
        const int row0 = u.pm * 256 + wr * 64 + fr, col0 = u.pn * 128 + wc * 32 + 8 * fq;
#pragma unroll
        for (int ai = 0; ai < 2; ++ai)
#pragma unroll
            for (int m = 0; m < 4; ++m) {
                const int r = row0 + ai * 128 + m * 16;
                const float rs = ssq_rs(ssq[r]);
                const float k2 = rs * -1.4426950408889634f, rs2 = rs * rs;
                f32x2 o[4];
#pragma unroll
                for (int n = 0; n < 2; ++n)
#pragma unroll
                    for (int h = 0; h < 2; ++h) {
                        const f32x2 gt = (f32x2){acc[ai][0][m][n][2 * h], acc[ai][0][m][n][2 * h + 1]}, up = (f32x2){acc[ai][1][m][n][2 * h], acc[ai][1][m][n][2 * h + 1]};
                        o[n * 2 + h] = (gt * up) * rs2 * pk_sig(gt, k2);
                    }
                u32x4 w; w.x = cvt_pk_bf16(o[0].x, o[0].y); w.y = cvt_pk_bf16(o[1].x, o[1].y); w.z = cvt_pk_bf16(o[2].x, o[2].y); w.w = cvt_pk_bf16(o[3].x, o[3].y);
                *(u32x4*)(act + (size_t)(r >> 8) * (256 * DFF) + (size_t)(col0 >> 6) * (256 * 64) + (size_t)(r & 255) * 64 + (col0 & 63)) = w;
            }
    }
};
__device__ __forceinline__ void bf8_to_f32(u32x4 w, f32x4& lo, f32x4& hi) { lo = (f32x4){bflo(w.x), bfhi(w.x), bflo(w.y), bfhi(w.y)}; hi = (f32x4){bflo(w.z), bfhi(w.z), bflo(w.w), bfhi(w.w)}; }
template <bool POOL> struct EpiRes {
    float* Y; bf16_t* XB; ssq_t* ssq; const float* cscale; float* part;
    __device__ __forceinline__ void init(f32x4 (&acc)[2][2][4][2], const pg8::Unit& u, int wr, int wc, int fr, int fq) const {
        if (!POOL && u.part >= 0) { acc_zero(acc); return; }
        const int pmr = POOL ? (u.pm % NTM) : u.pm, ct = POOL ? (u.pm / NTM) : u.pn;
        const bf16_t* xq = XB + (size_t)(pmr * 256 + wr * 64 + fr) * DM + ct * 256 + wc * 32 + 8 * fq;
#pragma unroll
        for (int ai = 0; ai < 2; ++ai)
#pragma unroll
            for (int bj = 0; bj < 2; ++bj)
#pragma unroll
                for (int m = 0; m < 4; ++m) bf8_to_f32(*(const u32x4*)(xq + (size_t)(ai * 128 + m * 16) * DM + bj * 128), acc[ai][bj][m][0], acc[ai][bj][m][1]);
        if (POOL) {
            const float* cq = cscale + ct * 256 + wc * 32 + 8 * fq;
#pragma unroll
            for (int bj = 0; bj < 2; ++bj)
#pragma unroll
                for (int n = 0; n < 2; ++n) {
                    const f32x4 cv = *(const f32x4*)(cq + bj * 128 + 4 * n);
                    const f32x4 ic = (f32x4){__builtin_amdgcn_rcpf(cv[0]), __builtin_amdgcn_rcpf(cv[1]), __builtin_amdgcn_rcpf(cv[2]), __builtin_amdgcn_rcpf(cv[3])};
#pragma unroll
                    for (int ai = 0; ai < 2; ++ai)
#pragma unroll
                        for (int m = 0; m < 4; ++m) acc[ai][bj][m][n] = acc[ai][bj][m][n] * ic;
                }
        }
    }
    __device__ __forceinline__ void operator()(const f32x4 (&acc)[2][2][4][2], const pg8::Unit& u, int wr, int wc, int fr, int fq) const {
        if (!POOL && u.part >= 0) {
            float* pp = part + (size_t)u.part * 65536 + (size_t)(((wr * 4 + wc) * 64) + fq * 16 + fr) * 4;
#pragma unroll
            for (int ai = 0; ai < 2; ++ai)
#pragma unroll
                for (int m = 0; m < 4; ++m)
#pragma unroll
                    for (int bj = 0; bj < 2; ++bj)
#pragma unroll
                        for (int n = 0; n < 2; ++n) *(f32x4*)(pp + (size_t)((((ai * 4 + m) * 2 + bj) * 2 + n) * 2048)) = acc[ai][bj][m][n];
            return;
        }
        const int pmr = POOL ? (u.pm % NTM) : u.pm, ct = POOL ? (u.pm / NTM) : u.pn;
        const int row0 = pmr * 256 + wr * 64 + fr, col0 = ct * 256 + wc * 32 + 8 * fq;
#pragma unroll
        for (int ai = 0; ai < 2; ++ai)
#pragma unroll
            for (int m = 0; m < 4; ++m) {
                const int r = row0 + ai * 128 + m * 16;
                bf16_t* bp = XB + (size_t)r * DM + col0;
                float ss = 0.f;
#pragma unroll
                for (int bj = 0; bj < 2; ++bj) {
                    f32x4 v0 = acc[ai][bj][m][0], v1 = acc[ai][bj][m][1];
                    if (POOL) { v0 = v0 * *(const f32x4*)(cscale + col0 + bj * 128); v1 = v1 * *(const f32x4*)(cscale + col0 + bj * 128 + 4); }
                    if (Y) { float* yp = Y + (size_t)r * DM + col0 + bj * 128; *(f32x4*)yp = v0; *(f32x4*)(yp + 4) = v1; }
                    u32x4 w; w.x = cvt_pk_bf16(v0[0], v0[1]); w.y = cvt_pk_bf16(v0[2], v0[3]); w.z = cvt_pk_bf16(v1[0], v1[1]); w.w = cvt_pk_bf16(v1[2], v1[3]);
                    *(u32x4*)(bp + bj * 128) = w;
                    ss += (v0[0] * v0[0] + v0[1] * v0[1]) + (v0[2] * v0[2] + v0[3] * v0[3]) + (v1[0] * v1[0] + v1[1] * v1[1]) + (v1[2] * v1[2] + v1[3] * v1[3]);
                }
                ss += __shfl_xor(ss, 16); ss += __shfl_xor(ss, 32);
                if (fq == 0) ssq_add(ssq + r, ss);
            }
    }
};

struct WTile { const float* src0; const float* src1; const float* gain; bf16_t* dst; int ld, K, k0, n0m, mode; };
__device__ __forceinline__ void wt_decode(const Params& p, int t, WTile& w) {
    int kt; w.gain = nullptr;
    if (t < 224) { const int i = t / 112, r = t % 112; w.n0m = (r / 16) * 256; kt = r % 16; w.K = 1024; w.ld = DIN; w.mode = (w.n0m < 1024) ? 1 : 0;
        w.src0 = p.in[I_WIN] + (size_t)i * DM * DIN; w.src1 = w.src0; w.gain = p.in[I_NMIX] + (2 * i) * DM; w.dst = (bf16_t*)(p.ws + WS_WIN) + (size_t)i * DIN * DM; }
    else if (t < 352) { t -= 224; const int i = t / 64, r = t % 64; w.n0m = (r / 16) * 256; kt = r % 16; w.K = 1024; w.ld = DM; w.mode = 0;
        w.src0 = p.in[I_WOUT] + (size_t)i * DM * DM; w.src1 = w.src0; w.dst = (bf16_t*)(p.ws + WS_WOUT) + (size_t)i * DM * DM; }
    else if (t < 1760) { t -= 352; const int l = t / 352, r = t % 352; w.n0m = (r / 16) * 256; kt = r % 16; w.K = 1024; w.ld = DFF; w.mode = 2;
        w.src0 = p.in[I_WG] + (size_t)l * DM * DFF; w.src1 = p.in[I_WU] + (size_t)l * DM * DFF; w.gain = p.in[I_NFFN] + l * DM; w.dst = (bf16_t*)(p.ws + WS_WGU) + (size_t)l * 2 * DFF * DM; }
    else if (t < 2464) { t -= 1760; const int l = t / 176, r = t % 176; w.n0m = (r / 44) * 256; kt = r % 44; w.K = DFF; w.ld = DM; w.mode = 0;
        w.src0 = p.in[I_WD] + (size_t)l * DFF * DM; w.src1 = w.src0; w.dst = (bf16_t*)(p.ws + WS_WDN) + (size_t)l * DM * DFF; }
    else { t -= 2464; const int ig = t / 4; w.n0m = 0; kt = t % 4; w.K = 256; w.ld = 256; w.mode = 0;
        w.src0 = p.in[I_WPOOL] + (size_t)ig * 65536; w.src1 = w.src0; w.dst = (bf16_t*)(p.ws + WS_WPL) + (size_t)ig * 65536; }
    w.k0 = kt * 64;
}
__device__ __forceinline__ void wt_load(const WTile& w, int tid, f32x4 (&v)[4][2], float& gs0, float& gs1) {
    const int row = tid >> 4, col4 = (tid & 15) * 4;
    gs0 = w.gain ? w.gain[w.k0 + row] : 1.0f; gs1 = w.gain ? w.gain[w.k0 + row + 32] : 1.0f;
#pragma unroll
    for (int q = 0; q < 4; ++q) {
        const int n0 = w.n0m + 64 * q; int c0 = n0; const float* src = w.src0;
        if (w.mode == 1) { const int pn = n0 / 256, bj = (n0 / 128) & 1, cc = n0 % 128; c0 = bj * 512 + 128 * pn + cc; }
        else if (w.mode == 2) { const int pn = n0 / 256, bj = (n0 / 128) & 1, cc = n0 % 128; c0 = 128 * pn + cc; src = bj ? w.src1 : w.src0; }
        const float* sp = src + (size_t)(w.k0 + row) * w.ld + c0 + col4;
        v[q][0] = *(const f32x4*)sp; v[q][1] = *(const f32x4*)(sp + (size_t)32 * w.ld);
    }
}
__device__ __forceinline__ void prep_phase(const Params& p, LAS unsigned char* lds) {
    int tid = threadIdx.x; asm volatile("" : "+v"(tid));
    const int G = gridDim.x, bid = blockIdx.x, wave = tid >> 6, lane = tid & 63;
    bf16_t* XB = (bf16_t*)(p.ws + WS_XB); ssq_t* SSQ = (ssq_t*)(p.ws + WS_SSQ);
    for (int r0 = bid * 8 + wave; r0 < MT; r0 += G * 16) {
        const int r1 = r0 + G * 8; const bool h1 = r1 < MT; const int r1c = h1 ? r1 : r0;
        const float* s0 = r0 < MP ? p.in[I_XP] + (size_t)r0 * DM : p.in[I_XS] + (size_t)(r0 - MP) * DM;
        const float* s1 = r1c < MP ? p.in[I_XP] + (size_t)r1c * DM : p.in[I_XS] + (size_t)(r1c - MP) * DM;
        f32x4 va[4], vb[4];
#pragma unroll
        for (int q = 0; q < 4; ++q) { va[q] = *(const f32x4*)(s0 + q * 256 + lane * 4); vb[q] = *(const f32x4*)(s1 + q * 256 + lane * 4); }
        float ssa = 0.f, ssb = 0.f;
#pragma unroll
        for (int q = 0; q < 4; ++q) {
            u32x2 w; w.x = cvt_pk_bf16(va[q][0], va[q][1]); w.y = cvt_pk_bf16(va[q][2], va[q][3]);
            *(u32x2*)(XB + (size_t)r0 * DM + q * 256 + lane * 4) = w;
            ssa += (va[q][0] * va[q][0] + va[q][1] * va[q][1]) + (va[q][2] * va[q][2] + va[q][3] * va[q][3]);
            if (h1) {
                u32x2 w2; w2.x = cvt_pk_bf16(vb[q][0], vb[q][1]); w2.y = cvt_pk_bf16(vb[q][2], vb[q][3]);
                *(u32x2*)(XB + (size_t)r1 * DM + q * 256 + lane * 4) = w2;
            }
            ssb += (vb[q][0] * vb[q][0] + vb[q][1] * vb[q][1]) + (vb[q][2] * vb[q][2] + vb[q][3] * vb[q][3]);
        }
        ssa = wave_sum(ssa); ssb = wave_sum(ssb);
        if (lane == 0) { SSQ[r0] = ssq_fix(ssa); if (h1) SSQ[r1] = ssq_fix(ssb); }
    }
    for (int idx = bid * 512 + tid; idx < 8 * MT; idx += G * 512) SSQ[MT + idx] = 0ull;
    LAS float* tile = (LAS float*)lds;
    WTile cur, nxt; f32x4 v[4][2]; float gs0 = 1.f, gs1 = 1.f;
    int t0 = bid;
    if (t0 < 2496) { wt_decode(p, t0, cur); wt_load(cur, tid, v, gs0, gs1); }
    for (; t0 < 2496; t0 += G) {
        __syncthreads();
        {
            const int row = tid >> 4, col4 = (tid & 15) * 4;
#pragma unroll
            for (int q = 0; q < 4; ++q)
#pragma unroll
                for (int h = 0; h < 2; ++h) { LAS float* tp = tile + q * 4160 + (row + 32 * h) * 65 + col4; const float gs = h ? gs1 : gs0;
                    tp[0] = v[q][h][0] * gs; tp[1] = v[q][h][1] * gs; tp[2] = v[q][h][2] * gs; tp[3] = v[q][h][3] * gs; }
        }
        __syncthreads();
        const bool hn = (t0 + G) < 2496;
        if (hn) { wt_decode(p, t0 + G, nxt); wt_load(nxt, tid, v, gs0, gs1); }
        {
            const int n = tid >> 3, kk = (tid & 7) * 8;
#pragma unroll
            for (int q = 0; q < 4; ++q) {
                float e[8];
#pragma unroll
                for (int j = 0; j < 8; ++j) e[j] = tile[q * 4160 + (kk + j) * 65 + n];
                u32x4 w; w.x = cvt_pk_bf16(e[0], e[1]); w.y = cvt_pk_bf16(e[2], e[3]); w.z = cvt_pk_bf16(e[4], e[5]); w.w = cvt_pk_bf16(e[6], e[7]);
                *(u32x4*)(cur.dst + (size_t)(cur.n0m + 64 * q + n) * cur.K + cur.k0 + kk) = w;
            }
        }
        if (hn) cur = nxt;
    }
    __syncthreads();
}

__device__ __forceinline__ f32x4 ld_bf4(const bf16_t* p) { const u32x2 w = *(const u32x2*)p; return (f32x4){bflo(w.x), bfhi(w.x), bflo(w.y), bfhi(w.y)}; }
template <int W>
__device__ __forceinline__ void pool_prompt_strip(const bf16_t* X, const ssq_t* ssq, int row0, int t0, int c, f32x4 gm, bf16_t* dgp, float* outp_seq) {
    constexpr int TT = 16, NR = TT + W - 1;
    f32x4 xr[NR];
    if (t0 >= W - 1) {
        const bf16_t* xp = X + (size_t)(row0 - (W - 1)) * DM + c; asm volatile("" : "+v"(xp));
        const ssq_t* sp = ssq + (row0 - (W - 1)); asm volatile("" : "+v"(sp));
#pragma unroll
        for (int j = 0; j < NR; ++j) { const float rs = ssq_rs(sp[j]); xr[j] = ld_bf4(xp + (size_t)j * DM) * rs * gm; }
    } else {
        int vz; asm volatile("v_mov_b32 %0, 0" : "=v"(vz));
        const bf16_t* xp = X + (size_t)(row0 - t0) * DM + c; const ssq_t* sp = ssq + (row0 - t0);
#pragma unroll
        for (int j = 0; j < NR; ++j) { const int tj = t0 - (W - 1) + j + vz, tc = tj < 0 ? 0 : tj; const float rs = ssq_rs(sp[tc]);
            const f32x4 v = ld_bf4(xp + (size_t)tc * DM) * rs * gm; xr[j] = tj < 0 ? (f32x4){0.f, 0.f, 0.f, 0.f} : v; }
    }
    f32x4 S = (f32x4){0.f, 0.f, 0.f, 0.f};
#pragma unroll
    for (int j = 0; j < W - 1; ++j) S += xr[j];
#pragma unroll
    for (int tt = 0; tt < TT; ++tt) {
        S += xr[tt + W - 1]; if (tt > 0) S -= xr[tt - 1];
        const int t = t0 + tt, cnt = (t + 1 < W) ? (t + 1) : W;
        const f32x4 cur = xr[tt + W - 1], d = S * __builtin_amdgcn_rcpf((float)cnt) - cur;
        u32x2 wv; wv.x = cvt_pk_bf16(d[0], d[1]); wv.y = cvt_pk_bf16(d[2], d[3]);
        *(u32x2*)(dgp + (size_t)tt * 256) = wv;
        if (t >= 4081) *(f32x4*)(outp_seq + (size_t)(t - 4081) * DM) = cur;
    }
}
template <int W>
__device__ __forceinline__ void pool_sample_strip(const bf16_t* X, const ssq_t* ssq, int row0, int c, f32x4 gm, const float* state_seq, bf16_t* dgp, float* outs_seq) {
    constexpr int TT = 8, NR = TT + W - 1;
    f32x4 xr[NR];
    { const float* stp = state_seq + (size_t)(15 - (W - 1)) * DM; asm volatile("" : "+v"(stp));
#pragma unroll
      for (int j = 0; j < W - 1; ++j) xr[j] = *(const f32x4*)(stp + (size_t)j * DM); }
    { const bf16_t* xp = X + (size_t)row0 * DM + c; asm volatile("" : "+v"(xp));
      const ssq_t* sp = ssq + row0;
#pragma unroll
      for (int j = 0; j < TT; ++j) { const float rs = ssq_rs(sp[j]); xr[W - 1 + j] = ld_bf4(xp + (size_t)j * DM) * rs * gm; } }
    f32x4 S = (f32x4){0.f, 0.f, 0.f, 0.f};
#pragma unroll
    for (int j = 0; j < W - 1; ++j) S += xr[j];
#pragma unroll
    for (int tt = 0; tt < TT; ++tt) {
        S += xr[tt + W - 1]; if (tt > 0) S -= xr[tt - 1];
        const f32x4 cur = xr[tt + W - 1], d = S * (1.0f / (float)W) - cur;
        u32x2 wv; wv.x = cvt_pk_bf16(d[0], d[1]); wv.y = cvt_pk_bf16(d[2], d[3]);
        *(u32x2*)(dgp + (size_t)tt * 256) = wv;
        *(f32x4*)(outs_seq + (size_t)(7 + tt) * DM) = cur;
    }
}
__device__ __forceinline__ void pool1_phase(const Params& p, int l, const ssq_t* ssq) {
    int tid = threadIdx.x; asm volatile("" : "+v"(tid));
    const int G = gridDim.x, bid = blockIdx.x, i = l >> 1;
    const bf16_t* X = (const bf16_t*)(p.ws + WS_XB); bf16_t* DG = (bf16_t*)(p.ws + WS_DG);
    const int cq = tid & 255, c = cq * 4, half = tid >> 8, g = __builtin_amdgcn_readfirstlane(cq >> 6);
    const f32x4 gm = *(const f32x4*)(p.in[I_NMIX] + l * DM + c);
    const float* spool = p.in[I_SPOOL] + (size_t)i * 128 * 15 * DM;
    float* outp = p.out + O_POOLP + (size_t)i * 4 * 15 * DM; float* outs = p.out + O_POOLS + (size_t)i * 128 * 15 * DM;
    for (int u = bid; u < MT / 32; u += G) {
        if (u < MP / 32) {
            const int row0 = u * 32 + half * 16, t0 = row0 & 4095, b = row0 >> 12;
            bf16_t* dgp = DG + ((size_t)g * MT + row0) * 256 + (c - 256 * g); float* op = outp + (size_t)b * 15 * DM + c;
            if (g == 0) pool_prompt_strip<2>(X, ssq, row0, t0, c, gm, dgp, op);
            else if (g == 1) pool_prompt_strip<4>(X, ssq, row0, t0, c, gm, dgp, op);
            else if (g == 2) pool_prompt_strip<8>(X, ssq, row0, t0, c, gm, dgp, op);
            else pool_prompt_strip<16>(X, ssq, row0, t0, c, gm, dgp, op);
        } else {
            const int s0 = (u - MP / 32) * 4;
#pragma unroll 1
            for (int q = 0; q < 2; ++q) {
                const int s = s0 + half * 2 + q, row0 = MP + s * 8;
                bf16_t* dgp = DG + ((size_t)g * MT + row0) * 256 + (c - 256 * g); float* op = outs + (size_t)s * 15 * DM + c; const float* st = spool + (size_t)s * 15 * DM + c;
                if (g == 0) pool_sample_strip<2>(X, ssq, row0, c, gm, st, dgp, op);
                else if (g == 1) pool_sample_strip<4>(X, ssq, row0, c, gm, st, dgp, op);
                else if (g == 2) pool_sample_strip<8>(X, ssq, row0, c, gm, st, dgp, op);
                else pool_sample_strip<16>(X, ssq, row0, c, gm, st, dgp, op);
            }
            for (int idx = tid; idx < 4 * 7 * 256; idx += 512) { const int c4 = (idx & 255) * 4, rr = (idx >> 8) % 7, sl = idx / (7 * 256);
                *(f32x4*)(outs + ((size_t)(s0 + sl) * 15 + rr) * DM + c4) = *(const f32x4*)(spool + ((size_t)(s0 + sl) * 15 + 8 + rr) * DM + c4); }
        }
    }
}

constexpr int KS_STRIDE = 72, VT_STRIDE = 264;

__device__ __forceinline__ void attn_item(const LAS bf16_t* Ks, const LAS bf16_t* Vt, int tile0, int r0, bool first, bool qvalid,
                                          const bf16_t* qptr, const float* qn, float slope, float sink, bf16_t* optr, int fr, int fq) {
    u32x4 raw0 = (u32x4){0u, 0u, 0u, 0u}, raw1 = raw0;
    if (qvalid) { raw0 = *(const u32x4*)(qptr); raw1 = *(const u32x4*)(qptr + 32); }
    float qf[16];
#pragma unroll
    for (int j = 0; j < 4; ++j) { qf[2 * j] = bflo(raw0[j]); qf[2 * j + 1] = bfhi(raw0[j]); qf[8 + 2 * j] = bflo(raw1[j]); qf[8 + 2 * j + 1] = bfhi(raw1[j]); }
    float ss = 0.f;
#pragma unroll
    for (int j = 0; j < 16; ++j) ss += qf[j] * qf[j];
    ss += __shfl_xor(ss, 16); ss += __shfl_xor(ss, 32);
    const float rq = rsqrtf(ss * (1.0f / 64.0f) + RMS_EPS) * 0.125f;
    bf16x8 q0, q1;
    {
        const f32x4 n0 = *(const f32x4*)(qn + fq * 8), n1 = *(const f32x4*)(qn + fq * 8 + 4), n2 = *(const f32x4*)(qn + 32 + fq * 8), n3 = *(const f32x4*)(qn + 32 + fq * 8 + 4);
        u32x4 a, b;
        a.x = cvt_pk_bf16(qf[0] * rq * n0[0], qf[1] * rq * n0[1]); a.y = cvt_pk_bf16(qf[2] * rq * n0[2], qf[3] * rq * n0[3]);
        a.z = cvt_pk_bf16(qf[4] * rq * n1[0], qf[5] * rq * n1[1]); a.w = cvt_pk_bf16(qf[6] * rq * n1[2], qf[7] * rq * n1[3]);
        b.x = cvt_pk_bf16(qf[8] * rq * n2[0], qf[9] * rq * n2[1]); b.y = cvt_pk_bf16(qf[10] * rq * n2[2], qf[11] * rq * n2[3]);
        b.z = cvt_pk_bf16(qf[12] * rq * n3[0], qf[13] * rq * n3[1]); b.w = cvt_pk_bf16(qf[14] * rq * n3[2], qf[15] * rq * n3[3]);
        q0 = __builtin_bit_cast(bf16x8, a); q1 = __builtin_bit_cast(bf16x8, b);
    }
    f32x4 s[9];
#pragma unroll
    for (int T = 0; T < 9; ++T) {
        const LAS bf16_t* kp = Ks + ((tile0 + T) * 16 + fr) * KS_STRIDE + fq * 8;
        const bf16x8 a0 = *(const LAS bf16x8*)(kp), a1 = *(const LAS bf16x8*)(kp + 32);
        f32x4 z = (f32x4){0.f, 0.f, 0.f, 0.f};
        z = __builtin_amdgcn_mfma_f32_16x16x32_bf16(a0, q0, z, 0, 0, 0);
        s[T] = __builtin_amdgcn_mfma_f32_16x16x32_bf16(a1, q1, z, 0, 0, 0);
    }
    __builtin_amdgcn_sched_barrier(0);
    int qi = r0 + fr; asm volatile("" : "+v"(qi));
    const int lim = first ? qi + 1 : 128;
    float mx = sink;
#pragma unroll
    for (int T = 0; T < 9; ++T)
#pragma unroll
        for (int j = 0; j < 4; ++j) {
            const int jk = (tile0 + T) * 16 + 4 * fq + j, dist = 128 + qi - jk;
            const bool valid = (unsigned)dist < (unsigned)lim;
            const float v = valid ? (s[T][j] - slope * (float)dist) : -1e30f;
            s[T][j] = v; mx = fmaxf(mx, v);
        }
    mx = fmaxf(mx, __shfl_xor(mx, 16)); mx = fmaxf(mx, __shfl_xor(mx, 32));
    float sum = 0.f;
#pragma unroll
    for (int T = 0; T < 9; ++T)
#pragma unroll
        for (int j = 0; j < 4; ++j) { const float e = __expf(s[T][j] - mx); s[T][j] = e; sum += e; }
    sum += __shfl_xor(sum, 16); sum += __shfl_xor(sum, 32);
    sum += __expf(sink - mx);
    const float inv = 1.0f / sum;
    __builtin_amdgcn_sched_barrier(0);
    f32x4 o[4];
#pragma unroll
    for (int dt = 0; dt < 4; ++dt) o[dt] = (f32x4){0.f, 0.f, 0.f, 0.f};
#pragma unroll
    for (int pp = 0; pp < 5; ++pp) {
        const int T0 = 2 * pp, T1 = (pp < 4) ? 2 * pp + 1 : 8;
        u32x4 pw;
        pw.x = cvt_pk_bf16(s[T0][0] * inv, s[T0][1] * inv); pw.y = cvt_pk_bf16(s[T0][2] * inv, s[T0][3] * inv);
        if (pp < 4) { pw.z = cvt_pk_bf16(s[T1][0] * inv, s[T1][1] * inv); pw.w = cvt_pk_bf16(s[T1][2] * inv, s[T1][3] * inv); } else { pw.z = 0u; pw.w = 0u; }
        const bf16x8 pf = __builtin_bit_cast(bf16x8, pw);
#pragma unroll
        for (int dt = 0; dt < 4; ++dt) {
            const LAS bf16_t* vp = Vt + (dt * 16 + fr) * VT_STRIDE + 4 * fq;
            const u32x2 v0 = *(const LAS u32x2*)(vp + (tile0 + T0) * 16), v1 = *(const LAS u32x2*)(vp + (tile0 + T1) * 16);
            u32x4 vw; vw.x = v0.x; vw.y = v0.y; vw.z = v1.x; vw.w = v1.y;
            o[dt] = __builtin_amdgcn_mfma_f32_16x16x32_bf16(__builtin_bit_cast(bf16x8, vw), pf, o[dt], 0, 0, 0);
        }
    }
    if (qvalid) {
#pragma unroll
        for (int dt = 0; dt < 4; ++dt) { u32x2 w; w.x = cvt_pk_bf16(o[dt][0], o[dt][1]); w.y = cvt_pk_bf16(o[dt][2], o[dt][3]); *(u32x2*)(optr + dt * 16) = w; }
    }
}

__device__ __forceinline__ void mixer_phase(const Params& p, int l, LAS unsigned char* lds) {
    const int G = gridDim.x, bid = blockIdx.x, i = l >> 1;
    const bf16_t* QKV = (const bf16_t*)(p.ws + WS_QKV); const bf16_t* GLU = (const bf16_t*)(p.ws + WS_GLU); bf16_t* CAT = (bf16_t*)(p.ws + WS_CAT);
    const float* qn = p.in[I_QN] + i * 64; const float* kn = p.in[I_KN] + i * 64; const float* sinks = p.in[I_SINK] + i * 8;
    constexpr int N_PA = 256, N_CV = 640, N_SA = 128;
#define MIX_PRE int tid = threadIdx.x; asm volatile("" : "+v"(tid)); const int wave = tid >> 6, lane = tid & 63, fr = lane & 15, fq = lane >> 4; (void)wave; (void)fr; (void)fq;
    for (int u = bid; u < N_PA; u += G) {
        MIX_PRE
        {
#ifndef X_NOPA
            const int kh = u & 1, blk = (u >> 1) & 31, b = u >> 6;
            const int rowQ0 = b * 4096 + blk * 128, rowK0 = rowQ0 - 128;
            LAS bf16_t* Ks = (LAS bf16_t*)lds; LAS bf16_t* Vt = (LAS bf16_t*)(lds + 256 * KS_STRIDE * 2);
            const int chunk = tid & 7;
            const f32x4 kn0 = *(const f32x4*)(kn + chunk * 8), kn1 = *(const f32x4*)(kn + chunk * 8 + 4);
#pragma unroll 1
            for (int ps = 0; ps < 4; ++ps) {
                const int key = (tid >> 3) + 64 * ps;
                u32x4 kr = (u32x4){0u, 0u, 0u, 0u}, vr = kr;
                const bool have = (blk > 0) || (key >= 128);
                if (have) { const bf16_t* rp = QKV + (size_t)(rowK0 + key) * 768 + 512 + kh * 64 + chunk * 8; kr = *(const u32x4*)rp; vr = *(const u32x4*)(rp + 128); }
                float kf[8], vf[8];
#pragma unroll
                for (int j = 0; j < 4; ++j) { kf[2 * j] = bflo(kr[j]); kf[2 * j + 1] = bfhi(kr[j]); vf[2 * j] = bflo(vr[j]); vf[2 * j + 1] = bfhi(vr[j]); }
                float ss = 0.f;
#pragma unroll
                for (int j = 0; j < 8; ++j) ss += kf[j] * kf[j];
                ss += __shfl_xor(ss, 1); ss += __shfl_xor(ss, 2); ss += __shfl_xor(ss, 4);
                const float rk = rsqrtf(ss * (1.0f / 64.0f) + RMS_EPS);
#pragma unroll
                for (int j = 0; j < 4; ++j) { kf[j] *= rk * kn0[j]; kf[4 + j] *= rk * kn1[j]; }
                u32x4 kw; kw.x = cvt_pk_bf16(kf[0], kf[1]); kw.y = cvt_pk_bf16(kf[2], kf[3]); kw.z = cvt_pk_bf16(kf[4], kf[5]); kw.w = cvt_pk_bf16(kf[6], kf[7]);
                *(LAS u32x4*)(Ks + key * KS_STRIDE + chunk * 8) = kw;
#pragma unroll
                for (int j = 0; j < 4; ++j) { Vt[(chunk * 8 + 2 * j) * VT_STRIDE + key] = (bf16_t)(vr[j] & 0xffffu); Vt[(chunk * 8 + 2 * j + 1) * VT_STRIDE + key] = (bf16_t)(vr[j] >> 16); }
                if (blk == 31 && key >= 128) {
                    float* ko = p.out + O_KP + ((((size_t)i * 4 + b) * 128 + (key - 128)) * 2 + kh) * 64 + chunk * 8;
                    float* vo = p.out + O_VP + ((((size_t)i * 4 + b) * 128 + (key - 128)) * 2 + kh) * 64 + chunk * 8;
                    *(f32x4*)ko = (f32x4){kf[0], kf[1], kf[2], kf[3]}; *(f32x4*)(ko + 4) = (f32x4){kf[4], kf[5], kf[6], kf[7]};
                    *(f32x4*)vo = (f32x4){vf[0], vf[1], vf[2], vf[3]}; *(f32x4*)(vo + 4) = (f32x4){vf[4], vf[5], vf[6], vf[7]};
                }
            }
            __syncthreads();
            const int r0 = wave * 16;
#pragma unroll 1
            for (int g = 0; g < 4; ++g) {
                const int h = kh * 4 + g;
                const float slope = exp2f(-(float)(h + 1)), sink = sinks[h];
                const size_t row = (size_t)(rowQ0 + r0 + fr);
                attn_item(Ks, Vt, wave, r0, blk == 0, true, QKV + row * 768 + h * 64 + fq * 8, qn, slope, sink, CAT + row * DM + 512 + h * 64 + 4 * fq, fr, fq);
            }
            __syncthreads();
#endif
        }
    }
#ifndef X_NOCV
    f32x2 wdw[31]; f32x2 bias;
    { int t0 = threadIdx.x; asm volatile("" : "+v"(t0)); const int c0 = (t0 & 255) * 2;
      const float* wp = p.in[I_WDW] + (size_t)i * 31 * 512 + c0; asm volatile("" : "+v"(wp));
#pragma unroll
      for (int j = 0; j < 31; ++j) { wdw[j] = *(const f32x2*)wp; wp += 512; asm volatile("" : "+v"(wp)); }
      bias = *(const f32x2*)(p.in[I_BDW] + i * 512 + c0); }
    for (int cu = bid; cu < N_CV; cu += G) {
        MIX_PRE
        {
            const int c2 = tid & 255, half = tid >> 8, c = c2 * 2; const bool prm = cu < 512;
            LAS float* ybuf = (LAS float*)lds;
            if (prm && ((cu & 127) * 32 + half * 16) >= 30) {
                const int b = cu >> 7, tb0 = (cu & 127) * 32 + half * 16;
                unsigned raw[46];
                { const bf16_t* gp = GLU + ((size_t)b * 4096 + tb0 - 30) * 512 + c; asm volatile("" : "+v"(gp));
#pragma unroll
                  for (int j = 0; j < 46; ++j) { raw[j] = *(const unsigned*)gp; gp += 512; asm volatile("" : "+v"(gp)); } }
                if (tb0 >= 4064) {
                    float* oc = p.out + O_CONVP + (((size_t)i * 4 + b) * 30) * 512 + c; asm volatile("" : "+v"(oc));
#pragma unroll
                    for (int j = 0; j < 16; ++j) { const int t = tb0 + j; if (t >= 4066) *(f32x2*)(oc + (size_t)(t - 4066) * 512) = (f32x2){bflo(raw[30 + j]), bfhi(raw[30 + j])}; }
                }
#pragma unroll
                for (int q = 0; q < 2; ++q) {
                    f32x2 win[38];
#pragma unroll
                    for (int j = 0; j < 38; ++j) win[j] = (f32x2){bflo(raw[q * 8 + j]), bfhi(raw[q * 8 + j])};
#pragma unroll
                    for (int t = 0; t < 8; ++t) {
                        f32x2 y = bias;
#pragma unroll
                        for (int j = 0; j < 31; ++j) y += wdw[j] * win[t + j];
                        *(LAS f32x2*)(ybuf + (half * 16 + q * 8 + t) * 512 + c) = y;
                    }
                    __builtin_amdgcn_sched_barrier(0);
                }
            } else if (prm) {
#pragma unroll 1
                for (int q = 0; q < 2; ++q) {
                    const int b = cu >> 7, tl = half * 16 + q * 8, tb = (cu & 127) * 32 + tl;
                    f32x2 win[38];
                    {
                        int vz; asm volatile("v_mov_b32 %0, 0" : "=v"(vz));
                        const bf16_t* gp = GLU + (size_t)b * 4096 * 512 + c; asm volatile("" : "+v"(gp));
#pragma unroll
                        for (int j = 0; j < 38; ++j) { const int tj = tb - 30 + j + vz; const unsigned w = *(const unsigned*)gp; if (tj >= 0) gp += 512; asm volatile("" : "+v"(gp));
                            win[j] = tj < 0 ? (f32x2){0.f, 0.f} : (f32x2){bflo(w), bfhi(w)}; }
                    }
#pragma unroll
                    for (int t = 0; t < 8; ++t) {
                        f32x2 y = bias;
#pragma unroll
                        for (int j = 0; j < 31; ++j) y += wdw[j] * win[t + j];
                        *(LAS f32x2*)(ybuf + (tl + t) * 512 + c) = y;
                    }
                }
            } else {
                const int sq = cu - 512;
                f32x2 win[34];
                const float* cc = p.in[I_CCONV] + (((size_t)i * 128 + sq) * 30 + half * 4) * 512 + c; asm volatile("" : "+v"(cc));
                const bf16_t* gs = GLU + ((size_t)MP + sq * 8) * 512 + c; asm volatile("" : "+v"(gs));
                float* oc = p.out + O_CONVS + (((size_t)i * 128 + sq) * 30 + half * 15) * 512 + c; asm volatile("" : "+v"(oc));
                if (half == 0) {
#pragma unroll
                    for (int j = 0; j < 30; ++j) { win[j] = *(const f32x2*)cc; cc += 512; asm volatile("" : "+v"(cc)); }
#pragma unroll
                    for (int j = 0; j < 4; ++j) { const unsigned w = *(const unsigned*)gs; gs += 512; asm volatile("" : "+v"(gs)); win[30 + j] = (f32x2){bflo(w), bfhi(w)}; }
#pragma unroll
                    for (int j = 0; j < 15; ++j) { *(f32x2*)oc = win[8 + j]; oc += 512; asm volatile("" : "+v"(oc)); }
                } else {
#pragma unroll
                    for (int j = 0; j < 26; ++j) { win[j] = *(const f32x2*)cc; cc += 512; asm volatile("" : "+v"(cc)); }
#pragma unroll
                    for (int j = 0; j < 8; ++j) { const unsigned w = *(const unsigned*)gs; gs += 512; asm volatile("" : "+v"(gs)); win[26 + j] = (f32x2){bflo(w), bfhi(w)}; }
#pragma unroll
                    for (int j = 0; j < 15; ++j) { *(f32x2*)oc = win[19 + j]; oc += 512; asm volatile("" : "+v"(oc)); }
                }
#pragma unroll
                for (int t = 0; t < 4; ++t) {
                    f32x2 y = bias;
#pragma unroll
                    for (int j = 0; j < 31; ++j) y += wdw[j] * win[t + j];
                    *(LAS f32x2*)(ybuf + (half * 4 + t) * 512 + c) = y;
                }
            }
            __syncthreads();
            {
                const float* gp = p.in[I_CNG] + i * 512 + lane * 8; const float* bp = p.in[I_CNB] + i * 512 + lane * 8;
                const f32x4 g0 = *(const f32x4*)gp, g1 = *(const f32x4*)(gp + 4), b0 = *(const f32x4*)bp, b1 = *(const f32x4*)(bp + 4);
#pragma unroll 1
                for (int q = 0; q < (prm ? 4 : 1); ++q) {
                    const int tk = prm ? wave * 4 + q : wave; const size_t row = prm ? (size_t)cu * 32 + tk : (size_t)MP + (size_t)(cu - 512) * 8 + tk;
                    const f32x4 v0 = *(const LAS f32x4*)(ybuf + tk * 512 + lane * 8), v1 = *(const LAS f32x4*)(ybuf + tk * 512 + lane * 8 + 4);
                    const float mean = wave_sum((v0[0] + v0[1]) + (v0[2] + v0[3]) + (v1[0] + v1[1]) + (v1[2] + v1[3])) * (1.0f / 512.0f);
                    const f32x4 d0 = v0 - mean, d1 = v1 - mean;
                    const float var = wave_sum((d0[0] * d0[0] + d0[1] * d0[1]) + (d0[2] * d0[2] + d0[3] * d0[3]) + (d1[0] * d1[0] + d1[1] * d1[1]) + (d1[2] * d1[2] + d1[3] * d1[3])) * (1.0f / 512.0f);
                    const float rs = rsqrtf(var + LN_EPS);
                    f32x4 o0 = d0 * rs * g0 + b0, o1 = d1 * rs * g1 + b1;
#pragma unroll
                    for (int j = 0; j < 4; ++j) { o0[j] = o0[j] * fast_sigmoid(o0[j]); o1[j] = o1[j] * fast_sigmoid(o1[j]); }
                    u32x4 w; w.x = cvt_pk_bf16(o0[0], o0[1]); w.y = cvt_pk_bf16(o0[2], o0[3]); w.z = cvt_pk_bf16(o1[0], o1[1]); w.w = cvt_pk_bf16(o1[2], o1[3]);
                    *(u32x4*)(CAT + row * DM + lane * 8) = w;
                }
            }
            __syncthreads();
        }
    }
#endif
    for (int s = bid - 128; s < N_SA; s += G) {
        if (s < 0) continue;
        MIX_PRE
        {
#ifndef X_NOSA
            LAS bf16_t* Ks = (LAS bf16_t*)lds; LAS bf16_t* Vt = (LAS bf16_t*)(lds + 2 * 144 * KS_STRIDE * 2);
            const int chunk = tid & 7;
            const f32x4 kn0 = *(const f32x4*)(kn + chunk * 8), kn1 = *(const f32x4*)(kn + chunk * 8 + 4);
#pragma unroll 1
            for (int it = tid; it < 2 * 144 * 8; it += 512) {
                const int kk = it >> 3, kh = kk / 144, key = kk % 144;
                float kf[8], vf[8];
#pragma unroll
                for (int j = 0; j < 8; ++j) { kf[j] = 0.f; vf[j] = 0.f; }
                const bool isnew = (key >= 128) && (key < 136);
                if (key < 128) {
                    const size_t off = ((((size_t)i * 128 + s) * 128 + key) * 2 + kh) * 64 + chunk * 8;
                    const f32x4 a0 = *(const f32x4*)(p.in[I_CK] + off), a1 = *(const f32x4*)(p.in[I_CK] + off + 4), c0 = *(const f32x4*)(p.in[I_CV] + off), c1 = *(const f32x4*)(p.in[I_CV] + off + 4);
#pragma unroll
                    for (int j = 0; j < 4; ++j) { kf[j] = a0[j]; kf[4 + j] = a1[j]; vf[j] = c0[j]; vf[4 + j] = c1[j]; }
                } else if (isnew) {
                    const bf16_t* rp = QKV + ((size_t)MP + s * 8 + (key - 128)) * 768 + 512 + kh * 64 + chunk * 8;
                    const u32x4 kr = *(const u32x4*)rp, vr = *(const u32x4*)(rp + 128);
#pragma unroll
                    for (int j = 0; j < 4; ++j) { kf[2 * j] = bflo(kr[j]); kf[2 * j + 1] = bfhi(kr[j]); vf[2 * j] = bflo(vr[j]); vf[2 * j + 1] = bfhi(vr[j]); }
                }
                float ss = 0.f;
#pragma unroll
                for (int j = 0; j < 8; ++j) ss += kf[j] * kf[j];
                ss += __shfl_xor(ss, 1); ss += __shfl_xor(ss, 2); ss += __shfl_xor(ss, 4);
                const float rk = rsqrtf(ss * (1.0f / 64.0f) + RMS_EPS);
                if (isnew) {
#pragma unroll
                    for (int j = 0; j < 4; ++j) { kf[j] *= rk * kn0[j]; kf[4 + j] *= rk * kn1[j]; }
                }
                u32x4 kw; kw.x = cvt_pk_bf16(kf[0], kf[1]); kw.y = cvt_pk_bf16(kf[2], kf[3]); kw.z = cvt_pk_bf16(kf[4], kf[5]); kw.w = cvt_pk_bf16(kf[6], kf[7]);
                *(LAS u32x4*)(Ks + (kh * 144 + key) * KS_STRIDE + chunk * 8) = kw;
                u32x4 vw; vw.x = cvt_pk_bf16(vf[0], vf[1]); vw.y = cvt_pk_bf16(vf[2], vf[3]); vw.z = cvt_pk_bf16(vf[4], vf[5]); vw.w = cvt_pk_bf16(vf[6], vf[7]);
#pragma unroll
                for (int j = 0; j < 4; ++j) { Vt[(kh * 64 + chunk * 8 + 2 * j) * VT_STRIDE + key] = (bf16_t)(vw[j] & 0xffffu); Vt[(kh * 64 + chunk * 8 + 2 * j + 1) * VT_STRIDE + key] = (bf16_t)(vw[j] >> 16); }
                if (key >= 8 && key < 136) {
                    const size_t oo = ((((size_t)i * 128 + s) * 128 + (key - 8)) * 2 + kh) * 64 + chunk * 8;
                    float* ko = p.out + O_KS + oo; float* vo = p.out + O_VS + oo;
                    *(f32x4*)ko = (f32x4){kf[0], kf[1], kf[2], kf[3]}; *(f32x4*)(ko + 4) = (f32x4){kf[4], kf[5], kf[6], kf[7]};
                    *(f32x4*)vo = (f32x4){vf[0], vf[1], vf[2], vf[3]}; *(f32x4*)(vo + 4) = (f32x4){vf[4], vf[5], vf[6], vf[7]};
                }
            }
            __syncthreads();
            {
                const int kh = wave >> 2, g = wave & 3, h = kh * 4 + g;
                const float slope = exp2f(-(float)(h + 1)), sink = sinks[h];
                const size_t row = (size_t)MP + s * 8 + (fr & 7);
                attn_item(Ks + kh * 144 * KS_STRIDE, Vt + kh * 64 * VT_STRIDE, 0, 0, false, fr < 8, QKV + row * 768 + h * 64 + fq * 8, qn, slope, sink, CAT + row * DM + 512 + h * 64 + 4 * fq, fr, fq);
            }
            __syncthreads();
#endif
        }
    }
}


__device__ __forceinline__ void splitk_reduce(float* Y, bf16_t* XB, ssq_t* ssq, const float* part, const pg8::StaticOrder& S, int KS) {
    int tid = threadIdx.x; asm volatile("" : "+v"(tid));
    const int wid = tid >> 6, lane = tid & 63, wr = wid >> 2, wc = wid & 3, fr = lane & 15, fq = lane >> 4;
    for (int task = blockIdx.x; task < 256; task += gridDim.x) {
        const int e = task >> 4, ai = (task >> 3) & 1, m = (task >> 1) & 3, bj = task & 1;
        pg8::Unit u; S.tile(256 + e, u);
        const float* pp = part + (size_t)(e * KS) * 65536 + (size_t)((((ai * 4 + m) * 2 + bj) * 2) * 2048) + (size_t)tid * 4;
        f32x4 a0 = (f32x4){0.f, 0.f, 0.f, 0.f}, a1 = a0;
        for (int k = 0; k < KS; ++k) { a0 += *(const f32x4*)(pp + (size_t)k * 65536); a1 += *(const f32x4*)(pp + (size_t)k * 65536 + 2048); }
        const int r = u.pm * 256 + ai * 128 + wr * 64 + m * 16 + fr, col = u.pn * 256 + bj * 128 + wc * 32 + 8 * fq;
        bf16_t* bp = XB + (size_t)r * DM + col;
        f32x4 x0, x1; bf8_to_f32(*(const u32x4*)bp, x0, x1);
        const f32x4 v0 = x0 + a0, v1 = x1 + a1;
        if (Y) { float* yp = Y + (size_t)r * DM + col; *(f32x4*)yp = v0; *(f32x4*)(yp + 4) = v1; }
        u32x4 w; w.x = cvt_pk_bf16(v0[0], v0[1]); w.y = cvt_pk_bf16(v0[2], v0[3]); w.z = cvt_pk_bf16(v1[0], v1[1]); w.w = cvt_pk_bf16(v1[2], v1[3]);
        *(u32x4*)bp = w;
        float ss = (v0[0] * v0[0] + v0[1] * v0[1]) + (v0[2] * v0[2] + v0[3] * v0[3]) + (v1[0] * v1[0] + v1[1] * v1[1]) + (v1[2] * v1[2] + v1[3] * v1[3]);
        ss += __shfl_xor(ss, 16); ss += __shfl_xor(ss, 32);
        if (fq == 0) ssq_add(ssq + r, ss);
    }
}

#define XB_TMO      128
#define XB_XCNT(j)  (256  + 64 * (j))
#define XB_XSUB(j)  (1280 + 64 * (j))
#define XB_XGEN(j)  (2304 + 64 * (j))
#define XB_TOP      3328
#define XB_TOPGEN   3392
#define XCD_BAR_WORDS 3456
#define XB_SPIN_CAP (1u << 22)
__device__ __forceinline__ unsigned xb_ld(unsigned* p)              { return __hip_atomic_load(p, __ATOMIC_RELAXED, __HIP_MEMORY_SCOPE_AGENT); }
__device__ __forceinline__ unsigned xb_add(unsigned* p, unsigned v) { return __hip_atomic_fetch_add(p, v, __ATOMIC_RELAXED, __HIP_MEMORY_SCOPE_AGENT); }
__device__ __forceinline__ unsigned xb_xcc_id() { return (unsigned)__builtin_amdgcn_s_getreg((3 << 11) | 20) & 0xFu; }
#define XB_SPIN(cond, bar) do { unsigned _sp = 0; while (cond) { __builtin_amdgcn_s_sleep(1); \
    if ((++_sp & 255u) == 0u) { if (xb_ld(&(bar)[XB_TMO])) break; if (_sp > XB_SPIN_CAP) { atomicAdd(&(bar)[XB_TMO], 1u); break; } } } } while (0)
struct XcdBarrier { unsigned* bar; unsigned x; volatile LAS unsigned* st; };
__device__ __forceinline__ XcdBarrier xcd_barrier_post(unsigned* bar, volatile LAS unsigned* st) {
    XcdBarrier b; b.bar = bar; b.x = xb_xcc_id(); b.st = st;
    if (threadIdx.x == 0) (void)xb_add(&bar[XB_XCNT(b.x)], 1u);
    return b;
}
__device__ __forceinline__ void xcd_barrier_complete(unsigned* bar, unsigned x, unsigned& nloc, unsigned& nx) {
    const unsigned G = gridDim.x * gridDim.y * gridDim.z;
    unsigned sum, cnt, mine, sp = 0u;
    for (;;) {
        sum = 0u; cnt = 0u; mine = 0u;
#pragma unroll
        for (unsigned j = 0; j < 16; ++j) { const unsigned c = xb_ld(&bar[XB_XCNT(j)]); sum += c; cnt += (c > 0u) ? 1u : 0u; mine = (j == x) ? c : mine; }
        if (sum == G) break;
        __builtin_amdgcn_s_sleep(1);
        if ((++sp & 255u) == 0u) { if (xb_ld(&bar[XB_TMO])) break; if (sp > XB_SPIN_CAP) { atomicAdd(&bar[XB_TMO], 1u); break; } }
    }
    nloc = mine > 0u ? mine : 1u; nx = cnt > 0u ? cnt : 1u;
}
__device__ __forceinline__ void xcd_barrier(const XcdBarrier& b) {
    asm volatile("s_waitcnt vmcnt(0)" ::: "memory");
    __syncthreads();
    if (threadIdx.x == 0) {
        unsigned* bar = b.bar;
        __builtin_amdgcn_s_waitcnt(0);
        unsigned nloc = b.st[0], nx = b.st[1];
        if (nloc == 0u) { xcd_barrier_complete(bar, b.x, nloc, nx); b.st[0] = nloc; b.st[1] = nx; }
        const unsigned old = xb_add(&bar[XB_XSUB(b.x)], 1u);
        const unsigned gen = old / nloc;
        if (old + 1u == (gen + 1u) * nloc) {
            __builtin_amdgcn_fence(__ATOMIC_RELEASE, "agent");
            asm volatile("s_waitcnt vmcnt(0)" ::: "memory");
            const unsigned og = xb_add(&bar[XB_TOP], 1u);
            const unsigned tg = og / nx;
            if (og + 1u == (tg + 1u) * nx) xb_add(&bar[XB_TOPGEN], 1u);
            else XB_SPIN(xb_ld(&bar[XB_TOPGEN]) == tg, bar);
            __builtin_amdgcn_fence(__ATOMIC_ACQUIRE, "agent");
            xb_add(&bar[XB_XGEN(b.x)], 1u);
            asm volatile("s_waitcnt vmcnt(0)" ::: "memory");
        } else {
            XB_SPIN(xb_ld(&bar[XB_XGEN(b.x)]) == gen, bar);
            __builtin_amdgcn_fence(__ATOMIC_ACQUIRE, "agent");
            asm volatile("s_waitcnt vmcnt(0)" ::: "memory");
        }
    }
    __syncthreads();
}

__global__ void __launch_bounds__(512, 2) fwd_megakernel(Params p) {
    extern __shared__ __attribute__((aligned(16))) unsigned char lds_raw[];
    LAS unsigned char* lds = (LAS unsigned char*)lds_raw;
    cg::grid_group grid = cg::this_grid();
    const int G = gridDim.x, bid = blockIdx.x;
    bf16_t* XB = (bf16_t*)(p.ws + WS_XB); ssq_t* SSQ = (ssq_t*)(p.ws + WS_SSQ); float* PART = (float*)(p.ws + WS_PART);
#define IN(k) (p.ph_lo <= (k) && (k) < p.ph_hi)
#define SYNC(k) do { if (p.ph_hi > (k) + 1) xcd_barrier(bar); } while (0)
    unsigned* barw = (unsigned*)(p.ws + WS_BAR);
    volatile LAS unsigned* bst = (volatile LAS unsigned*)(lds + 131072);
    if (threadIdx.x < 4) bst[threadIdx.x] = 0u;
    __syncthreads();
    XcdBarrier bar = xcd_barrier_post(barw, bst);
#ifndef X_NOPREP
    if (IN(0)) prep_phase(p, lds);
    if (p.ph_lo < 0) grid.sync();
    xcd_barrier(bar);
    for (int rep = 0; rep < DUP_SYNC; ++rep) xcd_barrier(bar);
#endif
#pragma unroll 1
    for (int l = 0; l < 4; ++l) {
        const int pb = 1 + 5 * l, i = l >> 1;
        ssq_t* ssq_in = SSQ + (size_t)(2 * l) * MT;
        ssq_t* ssq_mid = SSQ + (size_t)(2 * l + 1) * MT;
        ssq_t* ssq_out = SSQ + (size_t)(2 * l + 2) * MT;
        if ((l & 1) == 0) {
            if (IN(pb) && X_GIN) {
                pg8::Gemm g{XB, (const bf16_t*)(p.ws + WS_WIN) + (size_t)i * DIN * DM, MT, DIN, DM}; pg8::StaticOrder S; S.init(MT, DIN, DM, G, bid);
                EpiIn E{ssq_in, (bf16_t*)(p.ws + WS_GLU), (bf16_t*)(p.ws + WS_QKV)};
                for (int rep = 0; rep <= DUP_IN; ++rep) { pg8::gemm_phase(lds, g, S, E); SYNC(pb); }
            }
#ifndef X_NOMIX
            if (IN(pb + 1)) { for (int rep = 0; rep <= DUP_MIX; ++rep) { mixer_phase(p, l, lds); SYNC(pb + 1); } }
#endif
            if (IN(pb + 2) && X_GOUT) {
                pg8::Gemm g{(const bf16_t*)(p.ws + WS_CAT), (const bf16_t*)(p.ws + WS_WOUT) + (size_t)i * DM * DM, MT, DM, DM}; pg8::SplitOrder<false> S; S.init2(MT, DM, DM, G, bid, 4);
                EpiRes<false> E{nullptr, XB, ssq_mid, nullptr, PART};
                pg8::gemm_phase(lds, g, S, E);
                xcd_barrier(bar);
                splitk_reduce(nullptr, XB, ssq_mid, PART, S, 4);
                SYNC(pb + 2);
            }
        } else {
#ifndef X_NOPOOL1
            if (IN(pb)) { for (int rep = 0; rep <= DUP_POOL1; ++rep) { pool1_phase(p, l, ssq_in); SYNC(pb); } }
#endif
            if (IN(pb + 1) && X_GPOOL) {
                pg8::Gemm g{(const bf16_t*)(p.ws + WS_DG), (const bf16_t*)(p.ws + WS_WPL) + (size_t)i * 4 * 65536, 4 * MT, 256, 256}; pg8::PoolOrder S{G, bid};
                EpiRes<true> E{nullptr, XB, ssq_mid, p.in[I_PSCALE] + i * DM, PART};
                pg8::gemm_phase(lds, g, S, E);
                SYNC(pb + 2);
            }
        }
        if (IN(pb + 3) && X_GGU) {
            pg8::Gemm g{XB, (const bf16_t*)(p.ws + WS_WGU) + (size_t)l * 2 * DFF * DM, MT, 2 * DFF, DM}; pg8::StaticOrder S; S.init(MT, 2 * DFF, DM, G, bid);
            EpiGU E{ssq_mid, (bf16_t*)(p.ws + WS_ACT)};
            for (int rep = 0; rep <= DUP_GU; ++rep) { pg8::gemm_phase(lds, g, S, E); SYNC(pb + 3); }
        }
        if (IN(pb + 4) && X_GDN) {
            pg8::Gemm g{(const bf16_t*)(p.ws + WS_ACT), (const bf16_t*)(p.ws + WS_WDN) + (size_t)l * DM * DFF, MT, DM, DFF}; pg8::SplitOrder<true> S; S.init2(MT, DM, DFF, G, bid, 11);
            float* Yout = (l == 3) ? p.out : nullptr;
            EpiRes<false> E{Yout, XB, ssq_out, nullptr, PART};
            pg8::gemm_phase(lds, g, S, E);
            xcd_barrier(bar);
            splitk_reduce(Yout, XB, ssq_out, PART, S, 11);
            SYNC(pb + 4);
        }
    }
#undef IN
#undef SYNC
}

extern "C" void kernel_launch(void* const* d_in, const int* in_sizes, int n_in, void* d_out, int out_size, void* d_ws, size_t ws_size, hipStream_t stream) {
    static int grid_blocks = 0;
    if (grid_blocks == 0) {
        if (n_in != N_IN || ws_size < WS_END) { fprintf(stderr, "kernel_launch: unexpected n_in %d or ws_size %zu (< %zu)\n", n_in, ws_size, (size_t)WS_END); grid_blocks = -1; return; }
        int dev = 0, cus = 0, per_cu = 0;
        hipGetDevice(&dev);
        hipDeviceGetAttribute(&cus, hipDeviceAttributeMultiprocessorCount, dev);
        hipFuncSetAttribute((const void*)fwd_megakernel, hipFuncAttributeMaxDynamicSharedMemorySize, LDS_BYTES);
        hipOccupancyMaxActiveBlocksPerMultiprocessor(&per_cu, (const void*)fwd_megakernel, 512, LDS_BYTES);
        if (per_cu < 1) { fprintf(stderr, "kernel_launch: occupancy query reports %d blocks per CU\n", per_cu); per_cu = 1; }
        grid_blocks = cus * 1;
    }
    if (grid_blocks < 0) return;
    Params p{};
    for (int k = 0; k < N_IN; ++k) p.in[k] = (const float*)d_in[k];
    p.out = (float*)d_out; p.ws = (unsigned char*)d_ws; p.ph_lo = 0; p.ph_hi = N_PHASES;
    void* args[] = {&p};
    if (hipMemsetAsync((unsigned char*)d_ws + WS_BAR, 0, 16384, stream) != hipSuccess) { fprintf(stderr, "kernel_launch: memset of the barrier words failed\n"); return; }
    hipError_t e = hipLaunchCooperativeKernel((const void*)fwd_megakernel, dim3(grid_blocks), dim3(512), args, LDS_BYTES, stream);
    if (e != hipSuccess) fprintf(stderr, "cooperative launch failed: %s (grid %d)\n", hipGetErrorString(e), grid_blocks);
}
```

```cpp
#include <hip/hip_runtime.h>
#include <hip/hip_cooperative_groups.h>
#include <cstdio>
namespace cg = cooperative_groups;

#define LAS __attribute__((address_space(3)))
#ifndef DUP_PREP
#define DUP_PREP 0
#define DUP_IN 0
#define DUP_MIX 0
#define DUP_POOL1 0
#define DUP_GU 0
#define DUP_SYNC 0
#define DUP_DN 0
#endif
#ifndef X_GIN
#define X_GIN 1
#define X_GOUT 1
#define X_GPOOL 1
#define X_GGU 1
#define X_GDN 1
#endif
typedef unsigned short bf16_t;
typedef short bf16x8 __attribute__((ext_vector_type(8)));
typedef float f32x4 __attribute__((ext_vector_type(4)));
typedef unsigned u32x4 __attribute__((ext_vector_type(4)));
typedef unsigned u32x2 __attribute__((ext_vector_type(2)));
typedef float f32x2 __attribute__((ext_vector_type(2)));
typedef unsigned long long ssq_t;

constexpr int DM = 1024, MP = 16384, MS = 1024, MT = 17408, NTM = 68, DFF = 2816, DIN = 1792;
constexpr float RMS_EPS = 1e-6f, LN_EPS = 1e-5f;
enum { I_XP = 0, I_XS, I_CCONV, I_CK, I_CV, I_SPOOL, I_NMIX, I_NFFN, I_WIN, I_QN, I_KN, I_SINK, I_WDW, I_BDW, I_CNG, I_CNB, I_WOUT, I_WPOOL, I_PSCALE, I_WG, I_WU, I_WD, N_IN };
constexpr size_t O_Y = 0;
constexpr size_t O_CONVP = (size_t)MT * DM;
constexpr size_t O_KP = O_CONVP + 2 * 4 * 30 * 512;
constexpr size_t O_VP = O_KP + 2 * 4 * 128 * 128;
constexpr size_t O_POOLP = O_VP + 2 * 4 * 128 * 128;
constexpr size_t O_CONVS = O_POOLP + 2 * 4 * 15 * 1024;
constexpr size_t O_KS = O_CONVS + (size_t)2 * 128 * 30 * 512;
constexpr size_t O_VS = O_KS + (size_t)2 * 128 * 128 * 128;
constexpr size_t O_POOLS = O_VS + (size_t)2 * 128 * 128 * 128;
constexpr size_t WS_WIN = 0;
constexpr size_t WS_WOUT = WS_WIN + (size_t)2 * DIN * DM * 2;
constexpr size_t WS_WGU = WS_WOUT + (size_t)2 * DM * DM * 2;
constexpr size_t WS_WDN = WS_WGU + (size_t)4 * 2 * DFF * DM * 2;
constexpr size_t WS_WPL = WS_WDN + (size_t)4 * DM * DFF * 2;
constexpr size_t WS_XB = WS_WPL + (size_t)2 * 4 * 256 * 256 * 2;
constexpr size_t WS_SSQ = WS_XB + (size_t)MT * DM * 2;
constexpr size_t WS_ACT = WS_SSQ + (size_t)9 * MT * 8;
constexpr size_t WS_QKV = WS_ACT;
constexpr size_t WS_GLU = WS_QKV + (size_t)MT * 768 * 2;
constexpr size_t WS_CAT = WS_GLU + (size_t)MT * 512 * 2;
constexpr size_t WS_DG = WS_ACT;
constexpr size_t WS_BAR = WS_ACT + (size_t)MT * DFF * 2;
constexpr size_t WS_PART = WS_BAR + 16384;
constexpr size_t WS_END = WS_PART + (size_t)176 * 65536 * 4;
constexpr int LDS_BYTES = 131072 + 16;
constexpr int N_PHASES = 21;

struct Params { const float* in[N_IN]; float* out; unsigned char* ws; int ph_lo, ph_hi; };

__device__ __forceinline__ unsigned cvt_pk_bf16(float lo, float hi) { unsigned r; asm("v_cvt_pk_bf16_f32 %0, %1, %2" : "=v"(r) : "v"(lo), "v"(hi)); return r; }
__device__ __forceinline__ float bflo(unsigned w) { return __uint_as_float(w << 16); }
__device__ __forceinline__ float bfhi(unsigned w) { return __uint_as_float(w & 0xffff0000u); }
__device__ __forceinline__ float bf2f(bf16_t b) { return __uint_as_float(((unsigned)b) << 16); }
__device__ __forceinline__ float wave_sum(float v) {
#pragma unroll
    for (int o = 32; o >= 1; o >>= 1) v += __shfl_xor(v, o);
    return v;
}
__device__ __forceinline__ float ssq_rs(ssq_t v) { return rsqrtf((float)v * (1.0f / (1048576.0f * 1024.0f)) + RMS_EPS); }
__device__ __forceinline__ ssq_t ssq_fix(float ss) { return (ssq_t)(ss * 1048576.0f); }
__device__ __forceinline__ void ssq_add(ssq_t* p, float ss) { (void)__hip_atomic_fetch_add(p, ssq_fix(ss), __ATOMIC_RELAXED, __HIP_MEMORY_SCOPE_AGENT); }
__device__ __forceinline__ float fast_sigmoid(float x) { return __builtin_amdgcn_rcpf(1.0f + __expf(-x)); }
__device__ __forceinline__ f32x2 pk_exp2(f32x2 v) { f32x2 r; r.x = __builtin_amdgcn_exp2f(v.x); r.y = __builtin_amdgcn_exp2f(v.y); return r; }
__device__ __forceinline__ f32x2 pk_rcp(f32x2 v) { f32x2 r; r.x = __builtin_amdgcn_rcpf(v.x); r.y = __builtin_amdgcn_rcpf(v.y); return r; }
__device__ __forceinline__ f32x2 pk_sig(f32x2 g, float k2) { return pk_rcp(pk_exp2(g * k2) + 1.0f); }

namespace pg8 {
constexpr int BM = 256, BK = 64, HALF = 128, HTB = HALF * BK * 2, STAGE_BYTES = 8 * HTB, NXCD = 8, WGM = 8;
__host__ __device__ __forceinline__ int lds_byte(int r, int c) { const int st = (r >> 4) * 2 + (c >> 5), rr = r & 15, cc = c & 31, ob = rr * 64 + cc * 2; return st * 1024 + (ob ^ (((ob >> 9) & 1) << 5)); }
__host__ __device__ __forceinline__ void stage_rc(int b, int& R, int& C) { const int st = b / 1024, sb = b % 1024, swz = sb ^ (((sb >> 9) & 1) << 5); R = (st >> 1) * 16 + swz / 64; C = (st & 1) * 32 + (swz % 64) / 2; }
__host__ __device__ __forceinline__ int perm32(int rho) { const int n = rho >> 4, i = rho & 15; return 8 * (i >> 2) + 4 * n + (i & 3); }
struct Unit { int pm, pn, k0, nt, part; };
struct Gemm { const bf16_t* A; const bf16_t* Bt; int M, N, K; };
struct StaticOrder {
    static constexpr bool SPLIT = false, ABLK = false;
    int nM, nN, nwg, G, c, ntk;
    __device__ void init(int M, int N, int K, int G_, int c_) { nM = M / BM; nN = N / BM; nwg = nM * nN; G = G_; c = c_; ntk = K / BK; }
    __device__ void tile(int L, Unit& u) const {
        int wgid = L; { const int q = nwg / NXCD, r = nwg % NXCD, xcd = wgid % NXCD, off = wgid / NXCD; wgid = (xcd < r ? xcd * (q + 1) : r * (q + 1) + (xcd - r) * q) + off; }
        const int nig = WGM * nN, gid = wgid / nig, fm = gid * WGM, gsz = (nM - fm) < WGM ? (nM - fm) : WGM;
        u.pm = fm + ((wgid % nig) % gsz); u.pn = (wgid % nig) / gsz;
    }
    __device__ bool next(int i, Unit& u) const {
        const long L = (long)i * G + c; if (L >= nwg) return false;
        tile((int)L, u); u.k0 = 0; u.nt = ntk; u.part = -1; return true;
    }
};
template <bool ABLK_> struct SplitOrder : StaticOrder {
    static constexpr bool SPLIT = true, ABLK = ABLK_;
    int KS, ntp;
    __device__ void init2(int M, int N, int K, int G_, int c_, int KS_) { init(M, N, K, G_, c_); KS = KS_; ntp = ntk / KS_; }
    __device__ bool next(int i, Unit& u) const {
        const int np = (nwg - G) * KS;
        int j = i;
        if (c < np) { if (i == 0) { tile(G + c / KS, u); u.k0 = (c % KS) * ntp; u.nt = ntp; u.part = c; return true; } j = i - 1; }
        if (j > 0) return false;
        tile(c, u); u.k0 = 0; u.nt = ntk; u.part = -1; return true;
    }
};
struct PoolOrder {
    static constexpr bool SPLIT = false, ABLK = false;
    int G, c;
    __device__ bool next(int i, Unit& u) const { const int L = i * G + c; if (L >= 4 * NTM) return false; u.pm = L; u.pn = L / NTM; u.k0 = 0; u.nt = 4; u.part = -1; return true; }
};

template <class Epi, class Sched>
__device__ __forceinline__ void gemm_phase(LAS unsigned char* lds, const Gemm g, const Sched& S, const Epi& E) {
    int tid = threadIdx.x; asm volatile("" : "+v"(tid));
    const int wid = __builtin_amdgcn_readfirstlane(tid >> 6), lane = tid & 63, wr = wid >> 2, wc = wid & 3, fr = lane & 15, fq = lane >> 4;
    int K = g.K; asm volatile("" : "+s"(K));
    unsigned voffA[2], voffB[2];
#pragma unroll
    for (int i = 0; i < 2; ++i) { int R, C; stage_rc(tid * 16 + i * 8192, R, C); const int Rb = (R & ~31) + perm32(R & 31);
        voffA[i] = Sched::ABLK ? (unsigned)(R * 64 + C) * 2u : (unsigned)(R * K + C) * 2u; voffB[i] = (unsigned)(Rb * K + C) * 2u; }
    const size_t kstep = (size_t)(BK * 2);
    const size_t hstep = (size_t)HALF * K * 2;
    const size_t tstep = 2 * hstep;
    const size_t kstepA = Sched::ABLK ? (size_t)32768 : kstep, hstepA = Sched::ABLK ? (size_t)16384 : hstep;
    const unsigned ldsw = (unsigned)wid * 1024u;
    const int aoff = lds_byte(wr * 64 + fr, fq * 8), boff = lds_byte(wc * 32 + fr, fq * 8);
#define PG8_SA(b, h) (((b) * 2 + (h)) * HTB)
#define PG8_SB(b, h) ((4 + (b) * 2 + (h)) * HTB)
#define PG8_STAGE(bufoff, gbase, voff) do { _Pragma("unroll") for (int _i = 0; _i < 2; ++_i) \
        __builtin_amdgcn_global_load_lds((const unsigned*)((const char*)(gbase) + (voff)[_i]), (LAS unsigned*)(lds + (bufoff) + ldsw + _i * 8192), 16, 0, 0); } while (0)
#define PG8_LDA(dst, b, h) do { _Pragma("unroll") for (int m = 0; m < 4; ++m) _Pragma("unroll") for (int k = 0; k < 2; ++k) dst[m][k] = *(const LAS bf16x8*)(lds + PG8_SA(b, h) + aoff + m * 2048 + k * 1024); } while (0)
#define PG8_LDB(dst, b, h) do { _Pragma("unroll") for (int n = 0; n < 2; ++n) _Pragma("unroll") for (int k = 0; k < 2; ++k) dst[n][k] = *(const LAS bf16x8*)(lds + PG8_SB(b, h) + boff + n * 2048 + k * 1024); } while (0)
#define PG8_MMA(ai, bj, At, Bt) do { __builtin_amdgcn_s_setprio(1); _Pragma("unroll") for (int m = 0; m < 4; ++m) _Pragma("unroll") for (int n = 0; n < 2; ++n) _Pragma("unroll") for (int k = 0; k < 2; ++k) \
        acc[ai][bj][m][n] = __builtin_amdgcn_mfma_f32_16x16x32_bf16(Bt[n][k], At[m][k], acc[ai][bj][m][n], 0, 0, 0); __builtin_amdgcn_s_setprio(0); } while (0)
#define PG8_WAIT_V(n) asm volatile("s_waitcnt vmcnt(" #n ")" ::: "memory")
#define PG8_WAIT_L(n) asm volatile("s_waitcnt lgkmcnt(" #n ")" ::: "memory")
#define PG8_BAR __builtin_amdgcn_s_barrier()
#define PG8_SCHED __builtin_amdgcn_sched_barrier(0)
    Unit cur, nxt; int ui = 0;
    if (!S.next(0, cur)) return;
    f32x4 acc[2][2][4][2];
    E.init(acc, cur, wr, wc, fr, fq);
    bf16x8 At[4][2], B0[2][2], B1[2][2];
    const char* cA = (const char*)g.A + (size_t)cur.pm * tstep; const char* cB = (const char*)g.Bt + (size_t)cur.pn * tstep;
    if constexpr (Sched::SPLIT) { cA += (size_t)cur.k0 * kstepA; cB += (size_t)cur.k0 * kstep; }
    const int ntc = K / BK;
    PG8_STAGE(PG8_SB(0, 0), cB, voffB); PG8_STAGE(PG8_SA(0, 0), cA, voffA); PG8_STAGE(PG8_SB(0, 1), cB + hstep, voffB); PG8_STAGE(PG8_SA(0, 1), cA + hstepA, voffA);
    if (wr == 1) PG8_BAR;
    PG8_WAIT_V(4); PG8_BAR;
    PG8_STAGE(PG8_SB(1, 0), cB + kstep, voffB); PG8_STAGE(PG8_SA(1, 0), cA + kstepA, voffA); PG8_STAGE(PG8_SB(1, 1), cB + hstep + kstep, voffB);
    PG8_WAIT_V(6); PG8_BAR;
    for (;;) {
        const bool has_next = S.next(ui + 1, nxt);
        const char* nA = has_next ? (const char*)g.A + (size_t)nxt.pm * tstep : cA; const char* nB = has_next ? (const char*)g.Bt + (size_t)nxt.pn * tstep : cB;
        if constexpr (Sched::SPLIT) { if (has_next) { nA += (size_t)nxt.k0 * kstepA; nB += (size_t)nxt.k0 * kstep; } }
        const int nt = Sched::SPLIT ? cur.nt : ntc;
        for (int t = 0; t < nt; t += 2) {
            const bool last = (t == nt - 2);
            const char* a1 = cA + (size_t)(t + 1) * kstepA;
            const char* a2 = last ? nA : cA + (size_t)(t + 2) * kstepA; const char* b2 = last ? nB : cB + (size_t)(t + 2) * kstep;
            const char* a3 = a2 + kstepA; const char* b3 = b2 + kstep;
            PG8_LDB(B0, 0, 0); PG8_SCHED; PG8_LDA(At, 0, 0); PG8_STAGE(PG8_SA(1, 1), a1 + hstepA, voffA);
            PG8_WAIT_L(8); PG8_BAR; PG8_WAIT_L(0); PG8_MMA(0, 0, At, B0); PG8_BAR; PG8_SCHED;
            PG8_LDB(B1, 0, 1); PG8_STAGE(PG8_SB(0, 0), b2, voffB);
            PG8_BAR; PG8_WAIT_L(0); PG8_MMA(0, 1, At, B1); PG8_BAR;
            PG8_LDA(At, 0, 1); PG8_STAGE(PG8_SA(0, 0), a2, voffA);
            PG8_BAR; PG8_WAIT_L(0); PG8_MMA(1, 0, At, B0); PG8_BAR; PG8_SCHED;
            PG8_STAGE(PG8_SB(0, 1), b2 + hstep, voffB);
            PG8_WAIT_V(6); PG8_BAR; PG8_MMA(1, 1, At, B1); PG8_BAR;
            PG8_LDB(B0, 1, 0); PG8_SCHED; PG8_LDA(At, 1, 0); PG8_STAGE(PG8_SA(0, 1), a2 + hstepA, voffA);
            PG8_WAIT_L(8); PG8_BAR; PG8_WAIT_L(0); PG8_MMA(0, 0, At, B0); PG8_BAR; PG8_SCHED;
            PG8_LDB(B1, 1, 1); PG8_STAGE(PG8_SB(1, 0), b3, voffB);
            PG8_BAR; PG8_WAIT_L(0); PG8_MMA(0, 1, At, B1); PG8_BAR;
            PG8_LDA(At, 1, 1); PG8_STAGE(PG8_SA(1, 0), a3, voffA);
            PG8_BAR; PG8_WAIT_L(0); PG8_MMA(1, 0, At, B0); PG8_BAR; PG8_SCHED;
            PG8_STAGE(PG8_SB(1, 1), b3 + hstep, voffB);
            PG8_WAIT_V(6); PG8_BAR; PG8_MMA(1, 1, At, B1); PG8_BAR;
        }
        E(acc, cur, wr, wc, fr, fq);
        if (!has_next) break;
        E.init(acc, nxt, wr, wc, fr, fq);
        cur = nxt; cA = nA; cB = nB; ++ui;
    }
    PG8_WAIT_V(0);
    if (wr == 0) PG8_BAR;
    PG8_BAR;
#undef PG8_SA
#undef PG8_SB
#undef PG8_STAGE
#undef PG8_LDA
#undef PG8_LDB
#undef PG8_MMA
#undef PG8_WAIT_V
#undef PG8_WAIT_L
#undef PG8_BAR
#undef PG8_SCHED
}
}

__device__ __forceinline__ void acc_zero(f32x4 (&acc)[2][2][4][2]) {
#pragma unroll
    for (int a = 0; a < 2; ++a)
#pragma unroll
        for (int b = 0; b < 2; ++b)
#pragma unroll
            for (int m = 0; m < 4; ++m)
#pragma unroll
                for (int n = 0; n < 2; ++n) acc[a][b][m][n] = (f32x4){0.f, 0.f, 0.f, 0.f};
}
struct EpiIn {
    const ssq_t* ssq; bf16_t* glu; bf16_t* qkv;
    __device__ __forceinline__ void init(f32x4 (&acc)[2][2][4][2], const pg8::Unit&, int, int, int, int) const { acc_zero(acc); }
    __device__ __forceinline__ void operator()(const f32x4 (&acc)[2][2][4][2], const pg8::Unit& u, int wr, int wc, int fr, int fq) const {
        const int row0 = u.pm * 256 + wr * 64 + fr;
        if (u.pn < 4) {
            const int col0 = u.pn * 128 + wc * 32 + 8 * fq;
#pragma unroll
            for (int ai = 0; ai < 2; ++ai)
#pragma unroll
                for (int m = 0; m < 4; ++m) {
                    const int r = row0 + ai * 128 + m * 16;
                    const float rs = ssq_rs(ssq[r]);
                    const float k2 = rs * -1.4426950408889634f;
                    f32x2 o[4];
#pragma unroll
                    for (int n = 0; n < 2; ++n)
#pragma unroll
                        for (int h = 0; h < 2; ++h) {
                            const f32x2 a = (f32x2){acc[ai][0][m][n][2 * h], acc[ai][0][m][n][2 * h + 1]}, gt = (f32x2){acc[ai][1][m][n][2 * h], acc[ai][1][m][n][2 * h + 1]};
                            o[n * 2 + h] = (a * rs) * pk_sig(gt, k2);
                        }
                    u32x4 w; w.x = cvt_pk_bf16(o[0].x, o[0].y); w.y = cvt_pk_bf16(o[1].x, o[1].y); w.z = cvt_pk_bf16(o[2].x, o[2].y); w.w = cvt_pk_bf16(o[3].x, o[3].y);
                    *(u32x4*)(glu + (size_t)r * 512 + col0) = w;
                }
        } else {
            const int col0 = (u.pn - 4) * 256 + wc * 32 + 8 * fq;
#pragma unroll
            for (int ai = 0; ai < 2; ++ai)
#pragma unroll
                for (int m = 0; m < 4; ++m) {
                    const int r = row0 + ai * 128 + m * 16;
                    const float rs = ssq_rs(ssq[r]);
#pragma unroll
                    for (int bj = 0; bj < 2; ++bj) {
                        const f32x4 v0 = acc[ai][bj][m][0] * rs, v1 = acc[ai][bj][m][1] * rs;
                        u32x4 w; w.x = cvt_pk_bf16(v0[0], v0[1]); w.y = cvt_pk_bf16(v0[2], v0[3]); w.z = cvt_pk_bf16(v1[0], v1[1]); w.w = cvt_pk_bf16(v1[2], v1[3]);
                        *(u32x4*)(qkv + (size_t)r * 768 + col0 + bj * 128) = w;
                    }
                }
        }
    }
};
struct EpiGU {
    const ssq_t* ssq; bf16_t* act;
    __device__ __forceinline__ void init(f32x4 (&acc)[2][2][4][2], const pg8::Unit&, int, int, int, int) const { acc_zero(acc); }
    __device__ __forceinline__ void operator()(const f32x4 (&acc)[2][2][4][2], const pg8::Unit& u, int wr, int wc, int fr, int fq) const {
        const int row0 = u.pm * 256 + wr * 64 + fr, col0 = u.pn * 128 + wc * 32 + 8 * fq;
#pragma unroll
        for (int ai = 0; ai < 2; ++ai)
#pragma unroll
            for (int m = 0; m < 4; ++m) {
                const int r = row0 + ai * 128 + m * 16;
                const float rs = ssq_rs(ssq[r]);
                const float k2 = rs * -1.4426950408889634f, rs2 = rs * rs;
                f32x2 o[4];
#pragma unroll
                for (int n = 0; n < 2; ++n)
#pragma unroll
                    for (int h = 0; h < 2; ++h) {
                        const f32x2 gt = (f32x2){acc[ai][0][m][n][2 * h], acc[ai][0][m][n][2 * h + 1]}, up = (f32x2){acc[ai][1][m][n][2 * h], acc[ai][1][m][n][2 * h + 1]};
                        o[n * 2 + h] = (gt * up) * rs2 * pk_sig(gt, k2);
                    }
                u32x4 w; w.x = cvt_pk_bf16(o[0].x, o[0].y); w.y = cvt_pk_bf16(o[1].x, o[1].y); w.z = cvt_pk_bf16(o[2].x, o[2].y); w.w = cvt_pk_bf16(o[3].x, o[3].y);
                *(u32x4*)(act + (size_t)(r >> 8) * (256 * DFF) + (size_t)(col0 >> 6) * (256 * 64) + (size_t)(r & 255) * 64 + (col0 & 63)) = w;
            }
    }
};
__device__ __forceinline__ void bf8_to_f32(u32x4 w, f32x4& lo, f32x4& hi) { lo = (f32x4){bflo(w.x), bfhi(w.x), bflo(w.y), bfhi(w.y)}; hi = (f32x4){bflo(w.z), bfhi(w.z), bflo(w.w), bfhi(w.w)}; }
template <bool POOL> struct EpiRes {
    float* Y; bf16_t* XB; ssq_t* ssq; const float* cscale; float* part;
    __device__ __forceinline__ void init(f32x4 (&acc)[2][2][4][2], const pg8::Unit& u, int wr, int wc, int fr, int fq) const {
        if (!POOL && u.part >= 0) { acc_zero(acc); return; }
        const int pmr = POOL ? (u.pm % NTM) : u.pm, ct = POOL ? (u.pm / NTM) : u.pn;
        const bf16_t* xq = XB + (size_t)(pmr * 256 + wr * 64 + fr) * DM + ct * 256 + wc * 32 + 8 * fq;
#pragma unroll
        for (int ai = 0; ai < 2; ++ai)
#pragma unroll
            for (int bj = 0; bj < 2; ++bj)
#pragma unroll
                for (int m = 0; m < 4; ++m) bf8_to_f32(*(const u32x4*)(xq + (size_t)(ai * 128 + m * 16) * DM + bj * 128), acc[ai][bj][m][0], acc[ai][bj][m][1]);
        if (POOL) {
            const float* cq = cscale + ct * 256 + wc * 32 + 8 * fq;
#pragma unroll
            for (int bj = 0; bj < 2; ++bj)
#pragma unroll
                for (int n = 0; n < 2; ++n) {
                    const f32x4 cv = *(const f32x4*)(cq + bj * 128 + 4 * n);
                    const f32x4 ic = (f32x4){__builtin_amdgcn_rcpf(cv[0]), __builtin_amdgcn_rcpf(cv[1]), __builtin_amdgcn_rcpf(cv[2]), __builtin_amdgcn_rcpf(cv[3])};
#pragma unroll
                    for (int ai = 0; ai < 2; ++ai)
#pragma unroll
                        for (int m = 0; m < 4; ++m) acc[ai][bj][m][n] = acc[ai][bj][m][n] * ic;
                }
        }
    }
    __device__ __forceinline__ void operator()(const f32x4 (&acc)[2][2][4][2], const pg8::Unit& u, int wr, int wc, int fr, int fq) const {
        if (!POOL && u.part >= 0) {
            float* pp = part + (size_t)u.part * 65536 + (size_t)(((wr * 4 + wc) * 64) + fq * 16 + fr) * 4;
#pragma unroll
            for (int ai = 0; ai < 2; ++ai)
#pragma unroll
                for (int m = 0; m < 4; ++m)
#pragma unroll
                    for (int bj = 0; bj < 2; ++bj)
#pragma unroll
                        for (int n = 0; n < 2; ++n) *(f32x4*)(pp + (size_t)((((ai * 4 + m) * 2 + bj) * 2 + n) * 2048)) = acc[ai][bj][m][n];
            return;
        }
        const int pmr = POOL ? (u.pm % NTM) : u.pm, ct = POOL ? (u.pm / NTM) : u.pn;
        const int row0 = pmr * 256 + wr * 64 + fr, col0 = ct * 256 + wc * 32 + 8 * fq;
#pragma unroll
        for (int ai = 0; ai < 2; ++ai)
#pragma unroll
            for (int m = 0; m < 4; ++m) {
                const int r = row0 + ai * 128 + m * 16;
                bf16_t* bp = XB + (size_t)r * DM + col0;
                float ss = 0.f;
#pragma unroll
                for (int bj = 0; bj < 2; ++bj) {
                    f32x4 v0 = acc[ai][bj][m][0], v1 = acc[ai][bj][m][1];
                    if (POOL) { v0 = v0 * *(const f32x4*)(cscale + col0 + bj * 128); v1 = v1 * *(const f32x4*)(cscale + col0 + bj * 128 + 4); }
                    if (Y) { float* yp = Y + (size_t)r * DM + col0 + bj * 128; *(f32x4*)yp = v0; *(f32x4*)(yp + 4) = v1; }
                    u32x4 w; w.x = cvt_pk_bf16(v0[0], v0[1]); w.y = cvt_pk_bf16(v0[2], v0[3]); w.z = cvt_pk_bf16(v1[0], v1[1]); w.w = cvt_pk_bf16(v1[2], v1[3]);
                    *(u32x4*)(bp + bj * 128) = w;
                    ss += (v0[0] * v0[0] + v0[1] * v0[1]) + (v0[2] * v0[2] + v0[3] * v0[3]) + (v1[0] * v1[0] + v1[1] * v1[1]) + (v1[2] * v1[2] + v1[3] * v1[3]);
                }
                ss += __shfl_xor(ss, 16); ss += __shfl_xor(ss, 32);
                if (fq == 0) ssq_add(ssq + r, ss);
            }
    }
};

struct WTile { const float* src0; const float* src1; const float* gain; bf16_t* dst; int ld, K, k0, n0m, mode; };
__device__ __forceinline__ void wt_decode(const Params& p, int t, WTile& w) {
    int kt; w.gain = nullptr;
    if (t < 224) { const int i = t / 112, r = t % 112; w.n0m = (r / 16) * 256; kt = r % 16; w.K = 1024; w.ld = DIN; w.mode = (w.n0m < 1024) ? 1 : 0;
        w.src0 = p.in[I_WIN] + (size_t)i * DM * DIN; w.src1 = w.src0; w.gain = p.in[I_NMIX] + (2 * i) * DM; w.dst = (bf16_t*)(p.ws + WS_WIN) + (size_t)i * DIN * DM; }
    else if (t < 352) { t -= 224; const int i = t / 64, r = t % 64; w.n0m = (r / 16) * 256; kt = r % 16; w.K = 1024; w.ld = DM; w.mode = 0;
        w.src0 = p.in[I_WOUT] + (size_t)i * DM * DM; w.src1 = w.src0; w.dst = (bf16_t*)(p.ws + WS_WOUT) + (size_t)i * DM * DM; }
    else if (t < 1760) { t -= 352; const int l = t / 352, r = t % 352; w.n0m = (r / 16) * 256; kt = r % 16; w.K = 1024; w.ld = DFF; w.mode = 2;
        w.src0 = p.in[I_WG] + (size_t)l * DM * DFF; w.src1 = p.in[I_WU] + (size_t)l * DM * DFF; w.gain = p.in[I_NFFN] + l * DM; w.dst = (bf16_t*)(p.ws + WS_WGU) + (size_t)l * 2 * DFF * DM; }
    else if (t < 2464) { t -= 1760; const int l = t / 176, r = t % 176; w.n0m = (r / 44) * 256; kt = r % 44; w.K = DFF; w.ld = DM; w.mode = 0;
        w.src0 = p.in[I_WD] + (size_t)l * DFF * DM; w.src1 = w.src0; w.dst = (bf16_t*)(p.ws + WS_WDN) + (size_t)l * DM * DFF; }
    else { t -= 2464; const int ig = t / 4; w.n0m = 0; kt = t % 4; w.K = 256; w.ld = 256; w.mode = 0;
        w.src0 = p.in[I_WPOOL] + (size_t)ig * 65536; w.src1 = w.src0; w.dst = (bf16_t*)(p.ws + WS_WPL) + (size_t)ig * 65536; }
    w.k0 = kt * 64;
}
__device__ __forceinline__ void wt_load(const WTile& w, int tid, f32x4 (&v)[4][2], float& gs0, float& gs1) {
    const int row = tid >> 4, col4 = (tid & 15) * 4;
    gs0 = w.gain ? w.gain[w.k0 + row] : 1.0f; gs1 = w.gain ? w.gain[w.k0 + row + 32] : 1.0f;
#pragma unroll
    for (int q = 0; q < 4; ++q) {
        const int n0 = w.n0m + 64 * q; int c0 = n0; const float* src = w.src0;
        if (w.mode == 1) { const int pn = n0 / 256, bj = (n0 / 128) & 1, cc = n0 % 128; c0 = bj * 512 + 128 * pn + cc; }
        else if (w.mode == 2) { const int pn = n0 / 256, bj = (n0 / 128) & 1, cc = n0 % 128; c0 = 128 * pn + cc; src = bj ? w.src1 : w.src0; }
        const float* sp = src + (size_t)(w.k0 + row) * w.ld + c0 + col4;
        v[q][0] = *(const f32x4*)sp; v[q][1] = *(const f32x4*)(sp + (size_t)32 * w.ld);
    }
}
__device__ __forceinline__ void prep_phase(const Params& p, LAS unsigned char* lds) {
    int tid = threadIdx.x; asm volatile("" : "+v"(tid));
    const int G = gridDim.x, bid = blockIdx.x, wave = tid >> 6, lane = tid & 63;
    bf16_t* XB = (bf16_t*)(p.ws + WS_XB); ssq_t* SSQ = (ssq_t*)(p.ws + WS_SSQ);
    for (int r0 = bid * 8 + wave; r0 < MT; r0 += G * 16) {
        const int r1 = r0 + G * 8; const bool h1 = r1 < MT; const int r1c = h1 ? r1 : r0;
        const float* s0 = r0 < MP ? p.in[I_XP] + (size_t)r0 * DM : p.in[I_XS] + (size_t)(r0 - MP) * DM;
        const float* s1 = r1c < MP ? p.in[I_XP] + (size_t)r1c * DM : p.in[I_XS] + (size_t)(r1c - MP) * DM;
        f32x4 va[4], vb[4];
#pragma unroll
        for (int q = 0; q < 4; ++q) { va[q] = *(const f32x4*)(s0 + q * 256 + lane * 4); vb[q] = *(const f32x4*)(s1 + q * 256 + lane * 4); }
        float ssa = 0.f, ssb = 0.f;
#pragma unroll
        for (int q = 0; q < 4; ++q) {
            u32x2 w; w.x = cvt_pk_bf16(va[q][0], va[q][1]); w.y = cvt_pk_bf16(va[q][2], va[q][3]);
            *(u32x2*)(XB + (size_t)r0 * DM + q * 256 + lane * 4) = w;
            ssa += (va[q][0] * va[q][0] + va[q][1] * va[q][1]) + (va[q][2] * va[q][2] + va[q][3] * va[q][3]);
            if (h1) {
                u32x2 w2; w2.x = cvt_pk_bf16(vb[q][0], vb[q][1]); w2.y = cvt_pk_bf16(vb[q][2], vb[q][3]);
                *(u32x2*)(XB + (size_t)r1 * DM + q * 256 + lane * 4) = w2;
            }
            ssb += (vb[q][0] * vb[q][0] + vb[q][1] * vb[q][1]) + (vb[q][2] * vb[q][2] + vb[q][3] * vb[q][3]);
        }
        ssa = wave_sum(ssa); ssb = wave_sum(ssb);
        if (lane == 0) { SSQ[r0] = ssq_fix(ssa); if (h1) SSQ[r1] = ssq_fix(ssb); }
    }
    for (int idx = bid * 512 + tid; idx < 8 * MT; idx += G * 512) SSQ[MT + idx] = 0ull;
    LAS float* tile = (LAS float*)lds;
    WTile cur, nxt; f32x4 v[4][2]; float gs0 = 1.f, gs1 = 1.f;
    int t0 = bid;
    if (t0 < 2496) { wt_decode(p, t0, cur); wt_load(cur, tid, v, gs0, gs1); }
    for (; t0 < 2496; t0 += G) {
        __syncthreads();
        {
            const int row = tid >> 4, col4 = (tid & 15) * 4;
#pragma unroll
            for (int q = 0; q < 4; ++q)
#pragma unroll
                for (int h = 0; h < 2; ++h) { LAS float* tp = tile + q * 4160 + (row + 32 * h) * 65 + col4; const float gs = h ? gs1 : gs0;
                    tp[0] = v[q][h][0] * gs; tp[1] = v[q][h][1] * gs; tp[2] = v[q][h][2] * gs; tp[3] = v[q][h][3] * gs; }
        }
        __syncthreads();
        const bool hn = (t0 + G) < 2496;
        if (hn) { wt_decode(p, t0 + G, nxt); wt_load(nxt, tid, v, gs0, gs1); }
        {
            const int n = tid >> 3, kk = (tid & 7) * 8;
#pragma unroll
            for (int q = 0; q < 4; ++q) {
                float e[8];
#pragma unroll
                for (int j = 0; j < 8; ++j) e[j] = tile[q * 4160 + (kk + j) * 65 + n];
                u32x4 w; w.x = cvt_pk_bf16(e[0], e[1]); w.y = cvt_pk_bf16(e[2], e[3]); w.z = cvt_pk_bf16(e[4], e[5]); w.w = cvt_pk_bf16(e[6], e[7]);
                *(u32x4*)(cur.dst + (size_t)(cur.n0m + 64 * q + n) * cur.K + cur.k0 + kk) = w;
            }
        }
        if (hn) cur = nxt;
    }
    __syncthreads();
}

__device__ __forceinline__ f32x4 ld_bf4(const bf16_t* p) { const u32x2 w = *(const u32x2*)p; return (f32x4){bflo(w.x), bfhi(w.x), bflo(w.y), bfhi(w.y)}; }
template <int W>
__device__ __forceinline__ void pool_prompt_strip(const bf16_t* X, const ssq_t* ssq, int row0, int t0, int c, f32x4 gm, bf16_t* dgp, float* outp_seq) {
    constexpr int TT = 16, NR = TT + W - 1;
    f32x4 xr[NR];
    if (t0 >= W - 1) {
        const bf16_t* xp = X + (size_t)(row0 - (W - 1)) * DM + c; asm volatile("" : "+v"(xp));
        const ssq_t* sp = ssq + (row0 - (W - 1)); asm volatile("" : "+v"(sp));
#pragma unroll
        for (int j = 0; j < NR; ++j) { const float rs = ssq_rs(sp[j]); xr[j] = ld_bf4(xp + (size_t)j * DM) * rs * gm; }
    } else {
        int vz; asm volatile("v_mov_b32 %0, 0" : "=v"(vz));
        const bf16_t* xp = X + (size_t)(row0 - t0) * DM + c; const ssq_t* sp = ssq + (row0 - t0);
#pragma unroll
        for (int j = 0; j < NR; ++j) { const int tj = t0 - (W - 1) + j + vz, tc = tj < 0 ? 0 : tj; const float rs = ssq_rs(sp[tc]);
            const f32x4 v = ld_bf4(xp + (size_t)tc * DM) * rs * gm; xr[j] = tj < 0 ? (f32x4){0.f, 0.f, 0.f, 0.f} : v; }
    }
    f32x4 S = (f32x4){0.f, 0.f, 0.f, 0.f};
#pragma unroll
    for (int j = 0; j < W - 1; ++j) S += xr[j];
#pragma unroll
    for (int tt = 0; tt < TT; ++tt) {
        S += xr[tt + W - 1]; if (tt > 0) S -= xr[tt - 1];
        const int t = t0 + tt, cnt = (t + 1 < W) ? (t + 1) : W;
        const f32x4 cur = xr[tt + W - 1], d = S * __builtin_amdgcn_rcpf((float)cnt) - cur;
        u32x2 wv; wv.x = cvt_pk_bf16(d[0], d[1]); wv.y = cvt_pk_bf16(d[2], d[3]);
        *(u32x2*)(dgp + (size_t)tt * 256) = wv;
        if (t >= 4081) *(f32x4*)(outp_seq + (size_t)(t - 4081) * DM) = cur;
    }
}
template <int W>
__device__ __forceinline__ void pool_sample_strip(const bf16_t* X, const ssq_t* ssq, int row0, int c, f32x4 gm, const float* state_seq, bf16_t* dgp, float* outs_seq) {
    constexpr int TT = 8, NR = TT + W - 1;
    f32x4 xr[NR];
    { const float* stp = state_seq + (size_t)(15 - (W - 1)) * DM; asm volatile("" : "+v"(stp));
#pragma unroll
      for (int j = 0; j < W - 1; ++j) xr[j] = *(const f32x4*)(stp + (size_t)j * DM); }
    { const bf16_t* xp = X + (size_t)row0 * DM + c; asm volatile("" : "+v"(xp));
      const ssq_t* sp = ssq + row0;
#pragma unroll
      for (int j = 0; j < TT; ++j) { const float rs = ssq_rs(sp[j]); xr[W - 1 + j] = ld_bf4(xp + (size_t)j * DM) * rs * gm; } }
    f32x4 S = (f32x4){0.f, 0.f, 0.f, 0.f};
#pragma unroll
    for (int j = 0; j < W - 1; ++j) S += xr[j];
#pragma unroll
    for (int tt = 0; tt < TT; ++tt) {
        S += xr[tt + W - 1]; if (tt > 0) S -= xr[tt - 1];
        const f32x4 cur = xr[tt + W - 1], d = S * (1.0f / (float)W) - cur;
        u32x2 wv; wv.x = cvt_pk_bf16(d[0], d[1]); wv.y = cvt_pk_bf16(d[2], d[3]);
        *(u32x2*)(dgp + (size_t)tt * 256) = wv;
        *(f32x4*)(outs_seq + (size_t)(7 + tt) * DM) = cur;
    }
}
__device__ __forceinline__ void pool1_phase(const Params& p, int l, const ssq_t* ssq) {
    int tid = threadIdx.x; asm volatile("" : "+v"(tid));
    const int G = gridDim.x, bid = blockIdx.x, i = l >> 1;
    const bf16_t* X = (const bf16_t*)(p.ws + WS_XB); bf16_t* DG = (bf16_t*)(p.ws + WS_DG);
    const int cq = tid & 255, c = cq * 4, half = tid >> 8, g = __builtin_amdgcn_readfirstlane(cq >> 6);
    const f32x4 gm = *(const f32x4*)(p.in[I_NMIX] + l * DM + c);
    const float* spool = p.in[I_SPOOL] + (size_t)i * 128 * 15 * DM;
    float* outp = p.out + O_POOLP + (size_t)i * 4 * 15 * DM; float* outs = p.out + O_POOLS + (size_t)i * 128 * 15 * DM;
    for (int u = bid; u < MP / 64 + 64; u += G) {
        if (u < MP / 64) {
#pragma unroll 1
            for (int k = 0; k < 2; ++k) {
                const int row0 = u * 64 + k * 32 + half * 16, t0 = row0 & 4095, b = row0 >> 12;
                bf16_t* dgp = DG + ((size_t)g * MT + row0) * 256 + (c - 256 * g); float* op = outp + (size_t)b * 15 * DM + c;
                if (g == 0) pool_prompt_strip<2>(X, ssq, row0, t0, c, gm, dgp, op);
                else if (g == 1) pool_prompt_strip<4>(X, ssq, row0, t0, c, gm, dgp, op);
                else if (g == 2) pool_prompt_strip<8>(X, ssq, row0, t0, c, gm, dgp, op);
                else pool_prompt_strip<16>(X, ssq, row0, t0, c, gm, dgp, op);
            }
        } else {
            const int s0 = (u - MP / 64) * 2;
            {
                const int s = s0 + half, row0 = MP + s * 8;
                bf16_t* dgp = DG + ((size_t)g * MT + row0) * 256 + (c - 256 * g); float* op = outs + (size_t)s * 15 * DM + c; const float* st = spool + (size_t)s * 15 * DM + c;
                if (g == 0) pool_sample_strip<2>(X, ssq, row0, c, gm, st, dgp, op);
                else if (g == 1) pool_sample_strip<4>(X, ssq, row0, c, gm, st, dgp, op);
                else if (g == 2) pool_sample_strip<8>(X, ssq, row0, c, gm, st, dgp, op);
                else pool_sample_strip<16>(X, ssq, row0, c, gm, st, dgp, op);
            }
            for (int idx = tid; idx < 2 * 7 * 256; idx += 512) { const int c4 = (idx & 255) * 4, rr = (idx >> 8) % 7, sl = idx / (7 * 256);
                *(f32x4*)(outs + ((size_t)(s0 + sl) * 15 + rr) * DM + c4) = *(const f32x4*)(spool + ((size_t)(s0 + sl) * 15 + 8 + rr) * DM + c4); }
        }
    }
}

constexpr int KS_STRIDE = 72, VT_STRIDE = 264;

__device__ __forceinline__ void attn_item(const LAS bf16_t* Ks, const LAS bf16_t* Vt, int tile0, int r0, bool first, bool qvalid,
                                          const bf16_t* qptr, const float* qn, float slope, float sink, bf16_t* optr, int fr, int fq) {
    u32x4 raw0 = (u32x4){0u, 0u, 0u, 0u}, raw1 = raw0;
    if (qvalid) { raw0 = *(const u32x4*)(qptr); raw1 = *(const u32x4*)(qptr + 32); }
    float qf[16];
#pragma unroll
    for (int j = 0; j < 4; ++j) { qf[2 * j] = bflo(raw0[j]); qf[2 * j + 1] = bfhi(raw0[j]); qf[8 + 2 * j] = bflo(raw1[j]); qf[8 + 2 * j + 1] = bfhi(raw1[j]); }
    float ss = 0.f;
#pragma unroll
    for (int j = 0; j < 16; ++j) ss += qf[j] * qf[j];
    ss += __shfl_xor(ss, 16); ss += __shfl_xor(ss, 32);
    const float rq = rsqrtf(ss * (1.0f / 64.0f) + RMS_EPS) * 0.125f;
    bf16x8 q0, q1;
    {
        const f32x4 n0 = *(const f32x4*)(qn + fq * 8), n1 = *(const f32x4*)(qn + fq * 8 + 4), n2 = *(const f32x4*)(qn + 32 + fq * 8), n3 = *(const f32x4*)(qn + 32 + fq * 8 + 4);
        u32x4 a, b;
        a.x = cvt_pk_bf16(qf[0] * rq * n0[0], qf[1] * rq * n0[1]); a.y = cvt_pk_bf16(qf[2] * rq * n0[2], qf[3] * rq * n0[3]);
        a.z = cvt_pk_bf16(qf[4] * rq * n1[0], qf[5] * rq * n1[1]); a.w = cvt_pk_bf16(qf[6] * rq * n1[2], qf[7] * rq * n1[3]);
        b.x = cvt_pk_bf16(qf[8] * rq * n2[0], qf[9] * rq * n2[1]); b.y = cvt_pk_bf16(qf[10] * rq * n2[2], qf[11] * rq * n2[3]);
        b.z = cvt_pk_bf16(qf[12] * rq * n3[0], qf[13] * rq * n3[1]); b.w = cvt_pk_bf16(qf[14] * rq * n3[2], qf[15] * rq * n3[3]);
        q0 = __builtin_bit_cast(bf16x8, a); q1 = __builtin_bit_cast(bf16x8, b);
    }
    f32x4 s[9];
#pragma unroll
    for (int T = 0; T < 9; ++T) {
        const LAS bf16_t* kp = Ks + ((tile0 + T) * 16 + fr) * KS_STRIDE + fq * 8;
        const bf16x8 a0 = *(const LAS bf16x8*)(kp), a1 = *(const LAS bf16x8*)(kp + 32);
        f32x4 z = (f32x4){0.f, 0.f, 0.f, 0.f};
        z = __builtin_amdgcn_mfma_f32_16x16x32_bf16(a0, q0, z, 0, 0, 0);
        s[T] = __builtin_amdgcn_mfma_f32_16x16x32_bf16(a1, q1, z, 0, 0, 0);
    }
    __builtin_amdgcn_sched_barrier(0);
    int qi = r0 + fr; asm volatile("" : "+v"(qi));
    const int lim = first ? qi + 1 : 128;
    float mx = sink;
#pragma unroll
    for (int T = 0; T < 9; ++T)
#pragma unroll
        for (int j = 0; j < 4; ++j) {
            const int jk = (tile0 + T) * 16 + 4 * fq + j, dist = 128 + qi - jk;
            const bool valid = (unsigned)dist < (unsigned)lim;
            const float v = valid ? (s[T][j] - slope * (float)dist) : -1e30f;
            s[T][j] = v; mx = fmaxf(mx, v);
        }
    mx = fmaxf(mx, __shfl_xor(mx, 16)); mx = fmaxf(mx, __shfl_xor(mx, 32));
    float sum = 0.f;
#pragma unroll
    for (int T = 0; T < 9; ++T)
#pragma unroll
        for (int j = 0; j < 4; ++j) { const float e = __expf(s[T][j] - mx); s[T][j] = e; sum += e; }
    sum += __shfl_xor(sum, 16); sum += __shfl_xor(sum, 32);
    sum += __expf(sink - mx);
    const float inv = 1.0f / sum;
    __builtin_amdgcn_sched_barrier(0);
    f32x4 o[4];
#pragma unroll
    for (int dt = 0; dt < 4; ++dt) o[dt] = (f32x4){0.f, 0.f, 0.f, 0.f};
#pragma unroll
    for (int pp = 0; pp < 5; ++pp) {
        const int T0 = 2 * pp, T1 = (pp < 4) ? 2 * pp + 1 : 8;
        u32x4 pw;
        pw.x = cvt_pk_bf16(s[T0][0] * inv, s[T0][1] * inv); pw.y = cvt_pk_bf16(s[T0][2] * inv, s[T0][3] * inv);
        if (pp < 4) { pw.z = cvt_pk_bf16(s[T1][0] * inv, s[T1][1] * inv); pw.w = cvt_pk_bf16(s[T1][2] * inv, s[T1][3] * inv); } else { pw.z = 0u; pw.w = 0u; }
        const bf16x8 pf = __builtin_bit_cast(bf16x8, pw);
#pragma unroll
        for (int dt = 0; dt < 4; ++dt) {
            const LAS bf16_t* vp = Vt + (dt * 16 + fr) * VT_STRIDE + 4 * fq;
            const u32x2 v0 = *(const LAS u32x2*)(vp + (tile0 + T0) * 16), v1 = *(const LAS u32x2*)(vp + (tile0 + T1) * 16);
            u32x4 vw; vw.x = v0.x; vw.y = v0.y; vw.z = v1.x; vw.w = v1.y;
            o[dt] = __builtin_amdgcn_mfma_f32_16x16x32_bf16(__builtin_bit_cast(bf16x8, vw), pf, o[dt], 0, 0, 0);
        }
    }
    if (qvalid) {
#pragma unroll
        for (int dt = 0; dt < 4; ++dt) { u32x2 w; w.x = cvt_pk_bf16(o[dt][0], o[dt][1]); w.y = cvt_pk_bf16(o[dt][2], o[dt][3]); *(u32x2*)(optr + dt * 16) = w; }
    }
}

__device__ __forceinline__ void mixer_phase(const Params& p, int l, LAS unsigned char* lds) {
    const int G = gridDim.x, bid = blockIdx.x, i = l >> 1;
    const bf16_t* QKV = (const bf16_t*)(p.ws + WS_QKV); const bf16_t* GLU = (const bf16_t*)(p.ws + WS_GLU); bf16_t* CAT = (bf16_t*)(p.ws + WS_CAT);
    const float* qn = p.in[I_QN] + i * 64; const float* kn = p.in[I_KN] + i * 64; const float* sinks = p.in[I_SINK] + i * 8;
    constexpr int N_PA = 256, N_CV = 640, N_SA = 128;
#define MIX_PRE int tid = threadIdx.x; asm volatile("" : "+v"(tid)); const int wave = tid >> 6, lane = tid & 63, fr = lane & 15, fq = lane >> 4; (void)wave; (void)fr; (void)fq;
    for (int u = bid; u < N_PA; u += G) {
        MIX_PRE
        {
#ifndef X_NOPA
            const int kh = u & 1, blk = (u >> 1) & 31, b = u >> 6;
            const int rowQ0 = b * 4096 + blk * 128, rowK0 = rowQ0 - 128;
            LAS bf16_t* Ks = (LAS bf16_t*)lds; LAS bf16_t* Vt = (LAS bf16_t*)(lds + 256 * KS_STRIDE * 2);
            const int chunk = tid & 7;
            const f32x4 kn0 = *(const f32x4*)(kn + chunk * 8), kn1 = *(const f32x4*)(kn + chunk * 8 + 4);
#pragma unroll 1
            for (int ps = 0; ps < 4; ++ps) {
                const int key = (tid >> 3) + 64 * ps;
                u32x4 kr = (u32x4){0u, 0u, 0u, 0u}, vr = kr;
                const bool have = (blk > 0) || (key >= 128);
                if (have) { const bf16_t* rp = QKV + (size_t)(rowK0 + key) * 768 + 512 + kh * 64 + chunk * 8; kr = *(const u32x4*)rp; vr = *(const u32x4*)(rp + 128); }
                float kf[8], vf[8];
#pragma unroll
                for (int j = 0; j < 4; ++j) { kf[2 * j] = bflo(kr[j]); kf[2 * j + 1] = bfhi(kr[j]); vf[2 * j] = bflo(vr[j]); vf[2 * j + 1] = bfhi(vr[j]); }
                float ss = 0.f;
#pragma unroll
                for (int j = 0; j < 8; ++j) ss += kf[j] * kf[j];
                ss += __shfl_xor(ss, 1); ss += __shfl_xor(ss, 2); ss += __shfl_xor(ss, 4);
                const float rk = rsqrtf(ss * (1.0f / 64.0f) + RMS_EPS);
#pragma unroll
                for (int j = 0; j < 4; ++j) { kf[j] *= rk * kn0[j]; kf[4 + j] *= rk * kn1[j]; }
                u32x4 kw; kw.x = cvt_pk_bf16(kf[0], kf[1]); kw.y = cvt_pk_bf16(kf[2], kf[3]); kw.z = cvt_pk_bf16(kf[4], kf[5]); kw.w = cvt_pk_bf16(kf[6], kf[7]);
                *(LAS u32x4*)(Ks + key * KS_STRIDE + chunk * 8) = kw;
#pragma unroll
                for (int j = 0; j < 4; ++j) { Vt[(chunk * 8 + 2 * j) * VT_STRIDE + key] = (bf16_t)(vr[j] & 0xffffu); Vt[(chunk * 8 + 2 * j + 1) * VT_STRIDE + key] = (bf16_t)(vr[j] >> 16); }
                if (blk == 31 && key >= 128) {
                    float* ko = p.out + O_KP + ((((size_t)i * 4 + b) * 128 + (key - 128)) * 2 + kh) * 64 + chunk * 8;
                    float* vo = p.out + O_VP + ((((size_t)i * 4 + b) * 128 + (key - 128)) * 2 + kh) * 64 + chunk * 8;
                    *(f32x4*)ko = (f32x4){kf[0], kf[1], kf[2], kf[3]}; *(f32x4*)(ko + 4) = (f32x4){kf[4], kf[5], kf[6], kf[7]};
                    *(f32x4*)vo = (f32x4){vf[0], vf[1], vf[2], vf[3]}; *(f32x4*)(vo + 4) = (f32x4){vf[4], vf[5], vf[6], vf[7]};
                }
            }
            __syncthreads();
            const int r0 = wave * 16;
#pragma unroll 1
            for (int g = 0; g < 4; ++g) {
                const int h = kh * 4 + g;
                const float slope = exp2f(-(float)(h + 1)), sink = sinks[h];
                const size_t row = (size_t)(rowQ0 + r0 + fr);
                attn_item(Ks, Vt, wave, r0, blk == 0, true, QKV + row * 768 + h * 64 + fq * 8, qn, slope, sink, CAT + row * DM + 512 + h * 64 + 4 * fq, fr, fq);
            }
            __syncthreads();
#endif
        }
    }
#ifndef X_NOCV
    f32x2 wdw[31]; f32x2 bias;
    { int t0 = threadIdx.x; asm volatile("" : "+v"(t0)); const int c0 = (t0 & 255) * 2;
      const float* wp = p.in[I_WDW] + (size_t)i * 31 * 512 + c0; asm volatile("" : "+v"(wp));
#pragma unroll
      for (int j = 0; j < 31; ++j) { wdw[j] = *(const f32x2*)wp; wp += 512; asm volatile("" : "+v"(wp)); }
      bias = *(const f32x2*)(p.in[I_BDW] + i * 512 + c0); }
    for (int cu = bid; cu < N_CV; cu += G) {
        MIX_PRE
        {
            const int c2 = tid & 255, half = tid >> 8, c = c2 * 2; const bool prm = cu < 512;
            LAS float* ybuf = (LAS float*)lds;
            if (prm && ((cu & 127) * 32 + half * 16) >= 30) {
                const int b = cu >> 7, tb0 = (cu & 127) * 32 + half * 16;
                unsigned raw[46];
                { const bf16_t* gp = GLU + ((size_t)b * 4096 + tb0 - 30) * 512 + c; asm volatile("" : "+v"(gp));
#pragma unroll
                  for (int j = 0; j < 46; ++j) { raw[j] = *(const unsigned*)gp; gp += 512; asm volatile("" : "+v"(gp)); } }
                if (tb0 >= 4064) {
                    float* oc = p.out + O_CONVP + (((size_t)i * 4 + b) * 30) * 512 + c; asm volatile("" : "+v"(oc));
#pragma unroll
                    for (int j = 0; j < 16; ++j) { const int t = tb0 + j; if (t >= 4066) *(f32x2*)(oc + (size_t)(t - 4066) * 512) = (f32x2){bflo(raw[30 + j]), bfhi(raw[30 + j])}; }
                }
#pragma unroll
                for (int q = 0; q < 2; ++q) {
                    f32x2 win[38];
#pragma unroll
                    for (int j = 0; j < 38; ++j) win[j] = (f32x2){bflo(raw[q * 8 + j]), bfhi(raw[q * 8 + j])};
#pragma unroll
                    for (int t = 0; t < 8; ++t) {
                        f32x2 y = bias;
#pragma unroll
                        for (int j = 0; j < 31; ++j) y += wdw[j] * win[t + j];
                        *(LAS f32x2*)(ybuf + (half * 16 + q * 8 + t) * 512 + c) = y;
                    }
                    __builtin_amdgcn_sched_barrier(0);
                }
            } else if (prm) {
#pragma unroll 1
                for (int q = 0; q < 2; ++q) {
                    const int b = cu >> 7, tl = half * 16 + q * 8, tb = (cu & 127) * 32 + tl;
                    f32x2 win[38];
                    {
                        int vz; asm volatile("v_mov_b32 %0, 0" : "=v"(vz));
                        const bf16_t* gp = GLU + (size_t)b * 4096 * 512 + c; asm volatile("" : "+v"(gp));
#pragma unroll
                        for (int j = 0; j < 38; ++j) { const int tj = tb - 30 + j + vz; const unsigned w = *(const unsigned*)gp; if (tj >= 0) gp += 512; asm volatile("" : "+v"(gp));
                            win[j] = tj < 0 ? (f32x2){0.f, 0.f} : (f32x2){bflo(w), bfhi(w)}; }
                    }
#pragma unroll
                    for (int t = 0; t < 8; ++t) {
                        f32x2 y = bias;
#pragma unroll
                        for (int j = 0; j < 31; ++j) y += wdw[j] * win[t + j];
                        *(LAS f32x2*)(ybuf + (tl + t) * 512 + c) = y;
                    }
                }
            } else {
                const int sq = cu - 512;
                f32x2 win[34];
                const float* cc = p.in[I_CCONV] + (((size_t)i * 128 + sq) * 30 + half * 4) * 512 + c; asm volatile("" : "+v"(cc));
                const bf16_t* gs = GLU + ((size_t)MP + sq * 8) * 512 + c; asm volatile("" : "+v"(gs));
                float* oc = p.out + O_CONVS + (((size_t)i * 128 + sq) * 30 + half * 15) * 512 + c; asm volatile("" : "+v"(oc));
                if (half == 0) {
#pragma unroll
                    for (int j = 0; j < 30; ++j) { win[j] = *(const f32x2*)cc; cc += 512; asm volatile("" : "+v"(cc)); }
#pragma unroll
                    for (int j = 0; j < 4; ++j) { const unsigned w = *(const unsigned*)gs; gs += 512; asm volatile("" : "+v"(gs)); win[30 + j] = (f32x2){bflo(w), bfhi(w)}; }
#pragma unroll
                    for (int j = 0; j < 15; ++j) { *(f32x2*)oc = win[8 + j]; oc += 512; asm volatile("" : "+v"(oc)); }
                } else {
#pragma unroll
                    for (int j = 0; j < 26; ++j) { win[j] = *(const f32x2*)cc; cc += 512; asm volatile("" : "+v"(cc)); }
#pragma unroll
                    for (int j = 0; j < 8; ++j) { const unsigned w = *(const unsigned*)gs; gs += 512; asm volatile("" : "+v"(gs)); win[26 + j] = (f32x2){bflo(w), bfhi(w)}; }
#pragma unroll
                    for (int j = 0; j < 15; ++j) { *(f32x2*)oc = win[19 + j]; oc += 512; asm volatile("" : "+v"(oc)); }
                }
#pragma unroll
                for (int t = 0; t < 4; ++t) {
                    f32x2 y = bias;
#pragma unroll
                    for (int j = 0; j < 31; ++j) y += wdw[j] * win[t + j];
                    *(LAS f32x2*)(ybuf + (half * 4 + t) * 512 + c) = y;
                }
            }
            __syncthreads();
            {
                const float* gp = p.in[I_CNG] + i * 512 + lane * 8; const float* bp = p.in[I_CNB] + i * 512 + lane * 8;
                const f32x4 g0 = *(const f32x4*)gp, g1 = *(const f32x4*)(gp + 4), b0 = *(const f32x4*)bp, b1 = *(const f32x4*)(bp + 4);
#pragma unroll 1
                for (int q = 0; q < (prm ? 4 : 1); ++q) {
                    const int tk = prm ? wave * 4 + q : wave; const size_t row = prm ? (size_t)cu * 32 + tk : (size_t)MP + (size_t)(cu - 512) * 8 + tk;
                    const f32x4 v0 = *(const LAS f32x4*)(ybuf + tk * 512 + lane * 8), v1 = *(const LAS f32x4*)(ybuf + tk * 512 + lane * 8 + 4);
                    const float mean = wave_sum((v0[0] + v0[1]) + (v0[2] + v0[3]) + (v1[0] + v1[1]) + (v1[2] + v1[3])) * (1.0f / 512.0f);
                    const f32x4 d0 = v0 - mean, d1 = v1 - mean;
                    const float var = wave_sum((d0[0] * d0[0] + d0[1] * d0[1]) + (d0[2] * d0[2] + d0[3] * d0[3]) + (d1[0] * d1[0] + d1[1] * d1[1]) + (d1[2] * d1[2] + d1[3] * d1[3])) * (1.0f / 512.0f);
                    const float rs = rsqrtf(var + LN_EPS);
                    f32x4 o0 = d0 * rs * g0 + b0, o1 = d1 * rs * g1 + b1;
#pragma unroll
                    for (int j = 0; j < 4; ++j) { o0[j] = o0[j] * fast_sigmoid(o0[j]); o1[j] = o1[j] * fast_sigmoid(o1[j]); }
                    u32x4 w; w.x = cvt_pk_bf16(o0[0], o0[1]); w.y = cvt_pk_bf16(o0[2], o0[3]); w.z = cvt_pk_bf16(o1[0], o1[1]); w.w = cvt_pk_bf16(o1[2], o1[3]);
                    *(u32x4*)(CAT + row * DM + lane * 8) = w;
                }
            }
            __syncthreads();
        }
    }
#endif
    for (int s = bid - 128; s < N_SA; s += G) {
        if (s < 0) continue;
        MIX_PRE
        {
#ifndef X_NOSA
            LAS bf16_t* Ks = (LAS bf16_t*)lds; LAS bf16_t* Vt = (LAS bf16_t*)(lds + 2 * 144 * KS_STRIDE * 2);
            const int chunk = tid & 7;
            const f32x4 kn0 = *(const f32x4*)(kn + chunk * 8), kn1 = *(const f32x4*)(kn + chunk * 8 + 4);
#pragma unroll 1
            for (int it = tid; it < 2 * 144 * 8; it += 512) {
                const int kk = it >> 3, kh = kk / 144, key = kk % 144;
                float kf[8], vf[8];
#pragma unroll
                for (int j = 0; j < 8; ++j) { kf[j] = 0.f; vf[j] = 0.f; }
                const bool isnew = (key >= 128) && (key < 136);
                if (key < 128) {
                    const size_t off = ((((size_t)i * 128 + s) * 128 + key) * 2 + kh) * 64 + chunk * 8;
                    const f32x4 a0 = *(const f32x4*)(p.in[I_CK] + off), a1 = *(const f32x4*)(p.in[I_CK] + off + 4), c0 = *(const f32x4*)(p.in[I_CV] + off), c1 = *(const f32x4*)(p.in[I_CV] + off + 4);
#pragma unroll
                    for (int j = 0; j < 4; ++j) { kf[j] = a0[j]; kf[4 + j] = a1[j]; vf[j] = c0[j]; vf[4 + j] = c1[j]; }
                } else if (isnew) {
                    const bf16_t* rp = QKV + ((size_t)MP + s * 8 + (key - 128)) * 768 + 512 + kh * 64 + chunk * 8;
                    const u32x4 kr = *(const u32x4*)rp, vr = *(const u32x4*)(rp + 128);
#pragma unroll
                    for (int j = 0; j < 4; ++j) { kf[2 * j] = bflo(kr[j]); kf[2 * j + 1] = bfhi(kr[j]); vf[2 * j] = bflo(vr[j]); vf[2 * j + 1] = bfhi(vr[j]); }
                }
                float ss = 0.f;
#pragma unroll
                for (int j = 0; j < 8; ++j) ss += kf[j] * kf[j];
                ss += __shfl_xor(ss, 1); ss += __shfl_xor(ss, 2); ss += __shfl_xor(ss, 4);
                const float rk = rsqrtf(ss * (1.0f / 64.0f) + RMS_EPS);
                if (isnew) {
#pragma unroll
                    for (int j = 0; j < 4; ++j) { kf[j] *= rk * kn0[j]; kf[4 + j] *= rk * kn1[j]; }
                }
                u32x4 kw; kw.x = cvt_pk_bf16(kf[0], kf[1]); kw.y = cvt_pk_bf16(kf[2], kf[3]); kw.z = cvt_pk_bf16(kf[4], kf[5]); kw.w = cvt_pk_bf16(kf[6], kf[7]);
                *(LAS u32x4*)(Ks + (kh * 144 + key) * KS_STRIDE + chunk * 8) = kw;
                u32x4 vw; vw.x = cvt_pk_bf16(vf[0], vf[1]); vw.y = cvt_pk_bf16(vf[2], vf[3]); vw.z = cvt_pk_bf16(vf[4], vf[5]); vw.w = cvt_pk_bf16(vf[6], vf[7]);
#pragma unroll
                for (int j = 0; j < 4; ++j) { Vt[(kh * 64 + chunk * 8 + 2 * j) * VT_STRIDE + key] = (bf16_t)(vw[j] & 0xffffu); Vt[(kh * 64 + chunk * 8 + 2 * j + 1) * VT_STRIDE + key] = (bf16_t)(vw[j] >> 16); }
                if (key >= 8 && key < 136) {
                    const size_t oo = ((((size_t)i * 128 + s) * 128 + (key - 8)) * 2 + kh) * 64 + chunk * 8;
                    float* ko = p.out + O_KS + oo; float* vo = p.out + O_VS + oo;
                    *(f32x4*)ko = (f32x4){kf[0], kf[1], kf[2], kf[3]}; *(f32x4*)(ko + 4) = (f32x4){kf[4], kf[5], kf[6], kf[7]};
                    *(f32x4*)vo = (f32x4){vf[0], vf[1], vf[2], vf[3]}; *(f32x4*)(vo + 4) = (f32x4){vf[4], vf[5], vf[6], vf[7]};
                }
            }
            __syncthreads();
            {
                const int kh = wave >> 2, g = wave & 3, h = kh * 4 + g;
                const float slope = exp2f(-(float)(h + 1)), sink = sinks[h];
                const size_t row = (size_t)MP + s * 8 + (fr & 7);
                attn_item(Ks + kh * 144 * KS_STRIDE, Vt + kh * 64 * VT_STRIDE, 0, 0, false, fr < 8, QKV + row * 768 + h * 64 + fq * 8, qn, slope, sink, CAT + row * DM + 512 + h * 64 + 4 * fq, fr, fq);
            }
            __syncthreads();
#endif
        }
    }
}


__device__ __forceinline__ void splitk_reduce(float* Y, bf16_t* XB, ssq_t* ssq, const float* part, const pg8::StaticOrder& S, int KS) {
    int tid = threadIdx.x; asm volatile("" : "+v"(tid));
    const int wid = tid >> 6, lane = tid & 63, wr = wid >> 2, wc = wid & 3, fr = lane & 15, fq = lane >> 4;
    for (int task = blockIdx.x; task < 256; task += gridDim.x) {
        const int e = task >> 4, ai = (task >> 3) & 1, m = (task >> 1) & 3, bj = task & 1;
        pg8::Unit u; S.tile(256 + e, u);
        const float* pp = part + (size_t)(e * KS) * 65536 + (size_t)((((ai * 4 + m) * 2 + bj) * 2) * 2048) + (size_t)tid * 4;
        f32x4 a0 = (f32x4){0.f, 0.f, 0.f, 0.f}, a1 = a0;
        for (int k = 0; k < KS; ++k) { a0 += *(const f32x4*)(pp + (size_t)k * 65536); a1 += *(const f32x4*)(pp + (size_t)k * 65536 + 2048); }
        const int r = u.pm * 256 + ai * 128 + wr * 64 + m * 16 + fr, col = u.pn * 256 + bj * 128 + wc * 32 + 8 * fq;
        bf16_t* bp = XB + (size_t)r * DM + col;
        f32x4 x0, x1; bf8_to_f32(*(const u32x4*)bp, x0, x1);
        const f32x4 v0 = x0 + a0, v1 = x1 + a1;
        if (Y) { float* yp = Y + (size_t)r * DM + col; *(f32x4*)yp = v0; *(f32x4*)(yp + 4) = v1; }
        u32x4 w; w.x = cvt_pk_bf16(v0[0], v0[1]); w.y = cvt_pk_bf16(v0[2], v0[3]); w.z = cvt_pk_bf16(v1[0], v1[1]); w.w = cvt_pk_bf16(v1[2], v1[3]);
        *(u32x4*)bp = w;
        float ss = (v0[0] * v0[0] + v0[1] * v0[1]) + (v0[2] * v0[2] + v0[3] * v0[3]) + (v1[0] * v1[0] + v1[1] * v1[1]) + (v1[2] * v1[2] + v1[3] * v1[3]);
        ss += __shfl_xor(ss, 16); ss += __shfl_xor(ss, 32);
        if (fq == 0) ssq_add(ssq + r, ss);
    }
}

#define XB_TMO      128
#define XB_XCNT(j)  (256  + 64 * (j))
#define XB_XSUB(j)  (1280 + 64 * (j))
#define XB_XGEN(j)  (2304 + 64 * (j))
#define XB_TOP      3328
#define XB_TOPGEN   3392
#define XCD_BAR_WORDS 3456
#define XB_SPIN_CAP (1u << 22)
__device__ __forceinline__ unsigned xb_ld(unsigned* p)              { return __hip_atomic_load(p, __ATOMIC_RELAXED, __HIP_MEMORY_SCOPE_AGENT); }
__device__ __forceinline__ unsigned xb_add(unsigned* p, unsigned v) { return __hip_atomic_fetch_add(p, v, __ATOMIC_RELAXED, __HIP_MEMORY_SCOPE_AGENT); }
__device__ __forceinline__ unsigned xb_xcc_id() { return (unsigned)__builtin_amdgcn_s_getreg((3 << 11) | 20) & 0xFu; }
#define XB_SPIN(cond, bar) do { unsigned _sp = 0; while (cond) { __builtin_amdgcn_s_sleep(1); \
    if ((++_sp & 255u) == 0u) { if (xb_ld(&(bar)[XB_TMO])) break; if (_sp > XB_SPIN_CAP) { atomicAdd(&(bar)[XB_TMO], 1u); break; } } } } while (0)
struct XcdBarrier { unsigned* bar; unsigned x; volatile LAS unsigned* st; };
__device__ __forceinline__ XcdBarrier xcd_barrier_post(unsigned* bar, volatile LAS unsigned* st) {
    XcdBarrier b; b.bar = bar; b.x = xb_xcc_id(); b.st = st;
    if (threadIdx.x == 0) (void)xb_add(&bar[XB_XCNT(b.x)], 1u);
    return b;
}
__device__ __forceinline__ void xcd_barrier_complete(unsigned* bar, unsigned x, unsigned& nloc, unsigned& nx) {
    const unsigned G = gridDim.x * gridDim.y * gridDim.z;
    unsigned sum, cnt, mine, sp = 0u;
    for (;;) {
        sum = 0u; cnt = 0u; mine = 0u;
#pragma unroll
        for (unsigned j = 0; j < 16; ++j) { const unsigned c = xb_ld(&bar[XB_XCNT(j)]); sum += c; cnt += (c > 0u) ? 1u : 0u; mine = (j == x) ? c : mine; }
        if (sum == G) break;
        __builtin_amdgcn_s_sleep(1);
        if ((++sp & 255u) == 0u) { if (xb_ld(&bar[XB_TMO])) break; if (sp > XB_SPIN_CAP) { atomicAdd(&bar[XB_TMO], 1u); break; } }
    }
    nloc = mine > 0u ? mine : 1u; nx = cnt > 0u ? cnt : 1u;
}
__device__ __forceinline__ void xcd_barrier(const XcdBarrier& b) {
    asm volatile("s_waitcnt vmcnt(0)" ::: "memory");
    __syncthreads();
    if (threadIdx.x == 0) {
        unsigned* bar = b.bar;
        __builtin_amdgcn_s_waitcnt(0);
        unsigned nloc = b.st[0], nx = b.st[1];
        if (nloc == 0u) { xcd_barrier_complete(bar, b.x, nloc, nx); b.st[0] = nloc; b.st[1] = nx; }
        const unsigned old = xb_add(&bar[XB_XSUB(b.x)], 1u);
        const unsigned gen = old / nloc;
        if (old + 1u == (gen + 1u) * nloc) {
            __builtin_amdgcn_fence(__ATOMIC_RELEASE, "agent");
            asm volatile("s_waitcnt vmcnt(0)" ::: "memory");
            const unsigned og = xb_add(&bar[XB_TOP], 1u);
            const unsigned tg = og / nx;
            if (og + 1u == (tg + 1u) * nx) xb_add(&bar[XB_TOPGEN], 1u);
            else XB_SPIN(xb_ld(&bar[XB_TOPGEN]) == tg, bar);
            __builtin_amdgcn_fence(__ATOMIC_ACQUIRE, "agent");
            xb_add(&bar[XB_XGEN(b.x)], 1u);
            asm volatile("s_waitcnt vmcnt(0)" ::: "memory");
        } else {
            XB_SPIN(xb_ld(&bar[XB_XGEN(b.x)]) == gen, bar);
            __builtin_amdgcn_fence(__ATOMIC_ACQUIRE, "agent");
            asm volatile("s_waitcnt vmcnt(0)" ::: "memory");
        }
    }
    __syncthreads();
}

__global__ void __launch_bounds__(512, 2) fwd_megakernel(Params p) {
    extern __shared__ __attribute__((aligned(16))) unsigned char lds_raw[];
    LAS unsigned char* lds = (LAS unsigned char*)lds_raw;
    cg::grid_group grid = cg::this_grid();
    const int G = gridDim.x, bid = blockIdx.x;
    bf16_t* XB = (bf16_t*)(p.ws + WS_XB); ssq_t* SSQ = (ssq_t*)(p.ws + WS_SSQ); float* PART = (float*)(p.ws + WS_PART);
#define IN(k) (p.ph_lo <= (k) && (k) < p.ph_hi)
#define SYNC(k) do { if (p.ph_hi > (k) + 1) xcd_barrier(bar); } while (0)
    unsigned* barw = (unsigned*)(p.ws + WS_BAR);
    volatile LAS unsigned* bst = (volatile LAS unsigned*)(lds + 131072);
    if (threadIdx.x < 4) bst[threadIdx.x] = 0u;
    __syncthreads();
    XcdBarrier bar = xcd_barrier_post(barw, bst);
#ifndef X_NOPREP
    if (IN(0)) prep_phase(p, lds);
    if (p.ph_lo < 0) grid.sync();
    xcd_barrier(bar);
    for (int rep = 0; rep < DUP_SYNC; ++rep) xcd_barrier(bar);
#endif
#pragma unroll 1
    for (int l = 0; l < 4; ++l) {
        const int pb = 1 + 5 * l, i = l >> 1;
        ssq_t* ssq_in = SSQ + (size_t)(2 * l) * MT;
        ssq_t* ssq_mid = SSQ + (size_t)(2 * l + 1) * MT;
        ssq_t* ssq_out = SSQ + (size_t)(2 * l + 2) * MT;
        if ((l & 1) == 0) {
            if (IN(pb) && X_GIN) {
                pg8::Gemm g{XB, (const bf16_t*)(p.ws + WS_WIN) + (size_t)i * DIN * DM, MT, DIN, DM}; pg8::StaticOrder S; S.init(MT, DIN, DM, G, bid);
                EpiIn E{ssq_in, (bf16_t*)(p.ws + WS_GLU), (bf16_t*)(p.ws + WS_QKV)};
                for (int rep = 0; rep <= DUP_IN; ++rep) { pg8::gemm_phase(lds, g, S, E); SYNC(pb); }
            }
#ifndef X_NOMIX
            if (IN(pb + 1)) { for (int rep = 0; rep <= DUP_MIX; ++rep) { mixer_phase(p, l, lds); SYNC(pb + 1); } }
#endif
            if (IN(pb + 2) && X_GOUT) {
                pg8::Gemm g{(const bf16_t*)(p.ws + WS_CAT), (const bf16_t*)(p.ws + WS_WOUT) + (size_t)i * DM * DM, MT, DM, DM}; pg8::SplitOrder<false> S; S.init2(MT, DM, DM, G, bid, 4);
                EpiRes<false> E{nullptr, XB, ssq_mid, nullptr, PART};
                pg8::gemm_phase(lds, g, S, E);
                xcd_barrier(bar);
                splitk_reduce(nullptr, XB, ssq_mid, PART, S, 4);
                SYNC(pb + 2);
            }
        } else {
#ifndef X_NOPOOL1
            if (IN(pb)) { for (int rep = 0; rep <= DUP_POOL1; ++rep) { pool1_phase(p, l, ssq_in); SYNC(pb); } }
#endif
            if (IN(pb + 1) && X_GPOOL) {
                pg8::Gemm g{(const bf16_t*)(p.ws + WS_DG), (const bf16_t*)(p.ws + WS_WPL) + (size_t)i * 4 * 65536, 4 * MT, 256, 256}; pg8::PoolOrder S{G, bid};
                EpiRes<true> E{nullptr, XB, ssq_mid, p.in[I_PSCALE] + i * DM, PART};
                pg8::gemm_phase(lds, g, S, E);
                SYNC(pb + 2);
            }
        }
        if (IN(pb + 3) && X_GGU) {
            pg8::Gemm g{XB, (const bf16_t*)(p.ws + WS_WGU) + (size_t)l * 2 * DFF * DM, MT, 2 * DFF, DM}; pg8::StaticOrder S; S.init(MT, 2 * DFF, DM, G, bid);
            EpiGU E{ssq_mid, (bf16_t*)(p.ws + WS_ACT)};
            for (int rep = 0; rep <= DUP_GU; ++rep) { pg8::gemm_phase(lds, g, S, E); SYNC(pb + 3); }
        }
        if (IN(pb + 4) && X_GDN) {
            pg8::Gemm g{(const bf16_t*)(p.ws + WS_ACT), (const bf16_t*)(p.ws + WS_WDN) + (size_t)l * DM * DFF, MT, DM, DFF}; pg8::SplitOrder<true> S; S.init2(MT, DM, DFF, G, bid, 11);
            float* Yout = (l == 3) ? p.out : nullptr;
            EpiRes<false> E{Yout, XB, ssq_out, nullptr, PART};
            pg8::gemm_phase(lds, g, S, E);
            xcd_barrier(bar);
            splitk_reduce(Yout, XB, ssq_out, PART, S, 11);
            SYNC(pb + 4);
        }
    }
#undef IN
#undef SYNC
}

extern "C" void kernel_launch(void* const* d_in, const int* in_sizes, int n_in, void* d_out, int out_size, void* d_ws, size_t ws_size, hipStream_t stream) {
    static int grid_blocks = 0;
    if (grid_blocks == 0) {
        if (n_in != N_IN || ws_size < WS_END) { fprintf(stderr, "kernel_launch: unexpected n_in %d or ws_size %zu (< %zu)\n", n_in, ws_size, (size_t)WS_END); grid_blocks = -1; return; }
        int dev = 0, cus = 0, per_cu = 0;
        hipGetDevice(&dev);
        hipDeviceGetAttribute(&cus, hipDeviceAttributeMultiprocessorCount, dev);
        hipFuncSetAttribute((const void*)fwd_megakernel, hipFuncAttributeMaxDynamicSharedMemorySize, LDS_BYTES);
        hipOccupancyMaxActiveBlocksPerMultiprocessor(&per_cu, (const void*)fwd_megakernel, 512, LDS_BYTES);
        if (per_cu < 1) { fprintf(stderr, "kernel_launch: occupancy query reports %d blocks per CU\n", per_cu); per_cu = 1; }
        grid_blocks = cus * 1;
    }
    if (grid_blocks < 0) return;
    Params p{};
    for (int k = 0; k < N_IN; ++k) p.in[k] = (const float*)d_in[k];
    p.out = (float*)d_out; p.ws = (unsigned char*)d_ws; p.ph_lo = 0; p.ph_hi = N_PHASES;
    void* args[] = {&p};
    if (hipMemsetAsync((unsigned char*)d_ws + WS_BAR, 0, 16384, stream) != hipSuccess) { fprintf(stderr, "kernel_launch: memset of the barrier words failed\n"); return; }
    hipError_t e = hipLaunchCooperativeKernel((const void*)fwd_megakernel, dim3(grid_blocks), dim3(512), args, LDS_BYTES, stream);
    if (e != hipSuccess) fprintf(stderr, "cooperative launch failed: %s (grid %d)\n", hipGetErrorString(e), grid_blocks);
}
```

```cpp
#include <hip/hip_runtime.h>
#include <hip/hip_cooperative_groups.h>
#include <cstdio>
namespace cg = cooperative_groups;

#define LAS __attribute__((address_space(3)))
#ifndef DUP_PREP
#define DUP_PREP 0
#define DUP_IN 0
#define DUP_MIX 0
#define DUP_POOL1 0
#define DUP_GU 0
#define DUP_SYNC 0
#define DUP_DN 0
#endif
#ifndef X_GIN
#define X_GIN 1
#define X_GOUT 1
#define X_GPOOL 1
#define X_GGU 1
#define X_GDN 1
#endif
typedef unsigned short bf16_t;
typedef short bf16x8 __attribute__((ext_vector_type(8)));
typedef float f32x4 __attribute__((ext_vector_type(4)));
typedef unsigned u32x4 __attribute__((ext_vector_type(4)));
typedef unsigned u32x2 __attribute__((ext_vector_type(2)));
typedef float f32x2 __attribute__((ext_vector_type(2)));
typedef unsigned long long ssq_t;

constexpr int DM = 1024, MP = 16384, MS = 1024, MT = 17408, NTM = 68, DFF = 2816, DIN = 1792;
constexpr float RMS_EPS = 1e-6f, LN_EPS = 1e-5f;
enum { I_XP = 0, I_XS, I_CCONV, I_CK, I_CV, I_SPOOL, I_NMIX, I_NFFN, I_WIN, I_QN, I_KN, I_SINK, I_WDW, I_BDW, I_CNG, I_CNB, I_WOUT, I_WPOOL, I_PSCALE, I_WG, I_WU, I_WD, N_IN };
constexpr size_t O_Y = 0;
constexpr size_t O_CONVP = (size_t)MT * DM;
constexpr size_t O_KP = O_CONVP + 2 * 4 * 30 * 512;
constexpr size_t O_VP = O_KP + 2 * 4 * 128 * 128;
constexpr size_t O_POOLP = O_VP + 2 * 4 * 128 * 128;
constexpr size_t O_CONVS = O_POOLP + 2 * 4 * 15 * 1024;
constexpr size_t O_KS = O_CONVS + (size_t)2 * 128 * 30 * 512;
constexpr size_t O_VS = O_KS + (size_t)2 * 128 * 128 * 128;
constexpr size_t O_POOLS = O_VS + (size_t)2 * 128 * 128 * 128;
constexpr size_t WS_WIN = 0;
constexpr size_t WS_WOUT = WS_WIN + (size_t)2 * DIN * DM * 2;
constexpr size_t WS_WGU = WS_WOUT + (size_t)2 * DM * DM * 2;
constexpr size_t WS_WDN = WS_WGU + (size_t)4 * 2 * DFF * DM * 2;
constexpr size_t WS_WPL = WS_WDN + (size_t)4 * DM * DFF * 2;
constexpr size_t WS_XB = WS_WPL + (size_t)2 * 4 * 256 * 256 * 2;
constexpr size_t WS_SSQ = WS_XB + (size_t)MT * DM * 2;
constexpr size_t WS_ACT = WS_SSQ + (size_t)9 * MT * 8;
constexpr size_t WS_QKV = WS_ACT;
constexpr size_t WS_GLU = WS_QKV + (size_t)MT * 768 * 2;
constexpr size_t WS_CAT = WS_GLU + (size_t)MT * 512 * 2;
constexpr size_t WS_DG = WS_ACT;
constexpr size_t WS_BAR = WS_ACT + (size_t)MT * DFF * 2;
constexpr size_t WS_PART = WS_BAR + 16384;
constexpr size_t WS_END = WS_PART + (size_t)176 * 65536 * 4;
constexpr int LDS_BYTES = 131072 + 16;
constexpr int N_PHASES = 21;

struct Params { const float* in[N_IN]; float* out; unsigned char* ws; int ph_lo, ph_hi; };

__device__ __forceinline__ unsigned cvt_pk_bf16(float lo, float hi) { unsigned r; asm("v_cvt_pk_bf16_f32 %0, %1, %2" : "=v"(r) : "v"(lo), "v"(hi)); return r; }
__device__ __forceinline__ float bflo(unsigned w) { return __uint_as_float(w << 16); }
__device__ __forceinline__ float bfhi(unsigned w) { return __uint_as_float(w & 0xffff0000u); }
__device__ __forceinline__ float bf2f(bf16_t b) { return __uint_as_float(((unsigned)b) << 16); }
__device__ __forceinline__ float wave_sum(float v) {
#pragma unroll
    for (int o = 32; o >= 1; o >>= 1) v += __shfl_xor(v, o);
    return v;
}
__device__ __forceinline__ float ssq_rs(ssq_t v) { return rsqrtf((float)v * (1.0f / (1048576.0f * 1024.0f)) + RMS_EPS); }
__device__ __forceinline__ ssq_t ssq_fix(float ss) { return (ssq_t)(ss * 1048576.0f); }
__device__ __forceinline__ void ssq_add(ssq_t* p, float ss) { (void)__hip_atomic_fetch_add(p, ssq_fix(ss), __ATOMIC_RELAXED, __HIP_MEMORY_SCOPE_AGENT); }
__device__ __forceinline__ float fast_sigmoid(float x) { return __builtin_amdgcn_rcpf(1.0f + __expf(-x)); }
__device__ __forceinline__ f32x2 pk_exp2(f32x2 v) { f32x2 r; r.x = __builtin_amdgcn_exp2f(v.x); r.y = __builtin_amdgcn_exp2f(v.y); return r; }
__device__ __forceinline__ f32x2 pk_rcp(f32x2 v) { f32x2 r; r.x = __builtin_amdgcn_rcpf(v.x); r.y = __builtin_amdgcn_rcpf(v.y); return r; }
__device__ __forceinline__ f32x2 pk_sig(f32x2 g, float k2) { return pk_rcp(pk_exp2(g * k2) + 1.0f); }

namespace pg8 {
constexpr int BM = 256, BK = 64, HALF = 128, HTB = HALF * BK * 2, STAGE_BYTES = 8 * HTB, NXCD = 8, WGM = 8;
__host__ __device__ __forceinline__ int lds_byte(int r, int c) { const int st = (r >> 4) * 2 + (c >> 5), rr = r & 15, cc = c & 31, ob = rr * 64 + cc * 2; return st * 1024 + (ob ^ (((ob >> 9) & 1) << 5)); }
__host__ __device__ __forceinline__ void stage_rc(int b, int& R, int& C) { const int st = b / 1024, sb = b % 1024, swz = sb ^ (((sb >> 9) & 1) << 5); R = (st >> 1) * 16 + swz / 64; C = (st & 1) * 32 + (swz % 64) / 2; }
__host__ __device__ __forceinline__ int perm32(int rho) { const int n = rho >> 4, i = rho & 15; return 8 * (i >> 2) + 4 * n + (i & 3); }
struct Unit { int pm, pn, k0, nt, part; };
struct Gemm { const bf16_t* A; const bf16_t* Bt; int M, N, K; };
struct StaticOrder {
    static constexpr bool SPLIT = false, ABLK = false;
    int nM, nN, nwg, G, c, ntk;
    __device__ void init(int M, int N, int K, int G_, int c_) { nM = M / BM; nN = N / BM; nwg = nM * nN; G = G_; c = c_; ntk = K / BK; }
    __device__ void tile(int L, Unit& u) const {
        int wgid = L; { const int q = nwg / NXCD, r = nwg % NXCD, xcd = wgid % NXCD, off = wgid / NXCD; wgid = (xcd < r ? xcd * (q + 1) : r * (q + 1) + (xcd - r) * q) + off; }
        const int nig = WGM * nN, gid = wgid / nig, fm = gid * WGM, gsz = (nM - fm) < WGM ? (nM - fm) : WGM;
        u.pm = fm + ((wgid % nig) % gsz); u.pn = (wgid % nig) / gsz;
    }
    __device__ bool next(int i, Unit& u) const {
        const long L = (long)i * G + c; if (L >= nwg) return false;
        tile((int)L, u); u.k0 = 0; u.nt = ntk; u.part = -1; return true;
    }
};
template <bool ABLK_> struct SplitOrder : StaticOrder {
    static constexpr bool SPLIT = true, ABLK = ABLK_;
    int KS, ntp;
    __device__ void init2(int M, int N, int K, int G_, int c_, int KS_) { init(M, N, K, G_, c_); KS = KS_; ntp = ntk / KS_; }
    __device__ bool next(int i, Unit& u) const {
        const int np = (nwg - G) * KS;
        int j = i;
        if (c < np) { if (i == 0) { tile(G + c / KS, u); u.k0 = (c % KS) * ntp; u.nt = ntp; u.part = c; return true; } j = i - 1; }
        if (j > 0) return false;
        tile(c, u); u.k0 = 0; u.nt = ntk; u.part = -1; return true;
    }
};
struct PoolOrder {
    static constexpr bool SPLIT = false, ABLK = false;
    int G, c;
    __device__ bool next(int i, Unit& u) const { const int L = i * G + c; if (L >= 4 * NTM) return false; u.pm = L; u.pn = L / NTM; u.k0 = 0; u.nt = 4; u.part = -1; return true; }
};

template <class Epi, class Sched>
__device__ __forceinline__ void gemm_phase(LAS unsigned char* lds, const Gemm g, const Sched& S, const Epi& E) {
    int tid = threadIdx.x; asm volatile("" : "+v"(tid));
    const int wid = __builtin_amdgcn_readfirstlane(tid >> 6), lane = tid & 63, wr = wid >> 2, wc = wid & 3, fr = lane & 15, fq = lane >> 4;
    int K = g.K; asm volatile("" : "+s"(K));
    unsigned voffA[2], voffB[2];
#pragma unroll
    for (int i = 0; i < 2; ++i) { int R, C; stage_rc(tid * 16 + i * 8192, R, C); const int Rb = (R & ~31) + perm32(R & 31);
        voffA[i] = Sched::ABLK ? (unsigned)(R * 64 + C) * 2u : (unsigned)(R * K + C) * 2u; voffB[i] = (unsigned)(Rb * K + C) * 2u; }
    const size_t kstep = (size_t)(BK * 2);
    const size_t hstep = (size_t)HALF * K * 2;
    const size_t tstep = 2 * hstep;
    const size_t kstepA = Sched::ABLK ? (size_t)32768 : kstep, hstepA = Sched::ABLK ? (size_t)16384 : hstep;
    const unsigned ldsw = (unsigned)wid * 1024u;
    const int aoff = lds_byte(wr * 64 + fr, fq * 8), boff = lds_byte(wc * 32 + fr, fq * 8);
#define PG8_SA(b, h) (((b) * 2 + (h)) * HTB)
#define PG8_SB(b, h) ((4 + (b) * 2 + (h)) * HTB)
#define PG8_STAGE(bufoff, gbase, voff) do { _Pragma("unroll") for (int _i = 0; _i < 2; ++_i) \
        __builtin_amdgcn_global_load_lds((const unsigned*)((const char*)(gbase) + (voff)[_i]), (LAS unsigned*)(lds + (bufoff) + ldsw + _i * 8192), 16, 0, 0); } while (0)
#define PG8_LDA(dst, b, h) do { _Pragma("unroll") for (int m = 0; m < 4; ++m) _Pragma("unroll") for (int k = 0; k < 2; ++k) dst[m][k] = *(const LAS bf16x8*)(lds + PG8_SA(b, h) + aoff + m * 2048 + k * 1024); } while (0)
#define PG8_LDB(dst, b, h) do { _Pragma("unroll") for (int n = 0; n < 2; ++n) _Pragma("unroll") for (int k = 0; k < 2; ++k) dst[n][k] = *(const LAS bf16x8*)(lds + PG8_SB(b, h) + boff + n * 2048 + k * 1024); } while (0)
#define PG8_MMA(ai, bj, At, Bt) do { __builtin_amdgcn_s_setprio(1); _Pragma("unroll") for (int m = 0; m < 4; ++m) _Pragma("unroll") for (int n = 0; n < 2; ++n) _Pragma("unroll") for (int k = 0; k < 2; ++k) \
        acc[ai][bj][m][n] = __builtin_amdgcn_mfma_f32_16x16x32_bf16(Bt[n][k], At[m][k], acc[ai][bj][m][n], 0, 0, 0); __builtin_amdgcn_s_setprio(0); } while (0)
#define PG8_WAIT_V(n) asm volatile("s_waitcnt vmcnt(" #n ")" ::: "memory")
#define PG8_WAIT_L(n) asm volatile("s_waitcnt lgkmcnt(" #n ")" ::: "memory")
#define PG8_BAR __builtin_amdgcn_s_barrier()
#define PG8_SCHED __builtin_amdgcn_sched_barrier(0)
    Unit cur, nxt; int ui = 0;
    if (!S.next(0, cur)) return;
    f32x4 acc[2][2][4][2];
    E.init(acc, cur, wr, wc, fr, fq);
    bf16x8 At[4][2], B0[2][2], B1[2][2];
    const char* cA = (const char*)g.A + (size_t)cur.pm * tstep; const char* cB = (const char*)g.Bt + (size_t)cur.pn * tstep;
    if constexpr (Sched::SPLIT) { cA += (size_t)cur.k0 * kstepA; cB += (size_t)cur.k0 * kstep; }
    const int ntc = K / BK;
    PG8_STAGE(PG8_SB(0, 0), cB, voffB); PG8_STAGE(PG8_SA(0, 0), cA, voffA); PG8_STAGE(PG8_SB(0, 1), cB + hstep, voffB); PG8_STAGE(PG8_SA(0, 1), cA + hstepA, voffA);
    if (wr == 1) PG8_BAR;
    PG8_WAIT_V(4); PG8_BAR;
    PG8_STAGE(PG8_SB(1, 0), cB + kstep, voffB); PG8_STAGE(PG8_SA(1, 0), cA + kstepA, voffA); PG8_STAGE(PG8_SB(1, 1), cB + hstep + kstep, voffB);
    PG8_WAIT_V(6); PG8_BAR;
    for (;;) {
        const bool has_next = S.next(ui + 1, nxt);
        const char* nA = has_next ? (const char*)g.A + (size_t)nxt.pm * tstep : cA; const char* nB = has_next ? (const char*)g.Bt + (size_t)nxt.pn * tstep : cB;
        if constexpr (Sched::SPLIT) { if (has_next) { nA += (size_t)nxt.k0 * kstepA; nB += (size_t)nxt.k0 * kstep; } }
        const int nt = Sched::SPLIT ? cur.nt : ntc;
        for (int t = 0; t < nt; t += 2) {
            const bool last = (t == nt - 2);
            const char* a1 = cA + (size_t)(t + 1) * kstepA;
            const char* a2 = last ? nA : cA + (size_t)(t + 2) * kstepA; const char* b2 = last ? nB : cB + (size_t)(t + 2) * kstep;
            const char* a3 = a2 + kstepA; const char* b3 = b2 + kstep;
            PG8_LDB(B0, 0, 0); PG8_SCHED; PG8_LDA(At, 0, 0); PG8_STAGE(PG8_SA(1, 1), a1 + hstepA, voffA);
            PG8_WAIT_L(8); PG8_BAR; PG8_WAIT_L(0); PG8_MMA(0, 0, At, B0); PG8_BAR; PG8_SCHED;
            PG8_LDB(B1, 0, 1); PG8_STAGE(PG8_SB(0, 0), b2, voffB);
            PG8_BAR; PG8_WAIT_L(0); PG8_MMA(0, 1, At, B1); PG8_BAR;
            PG8_LDA(At, 0, 1); PG8_STAGE(PG8_SA(0, 0), a2, voffA);
            PG8_BAR; PG8_WAIT_L(0); PG8_MMA(1, 0, At, B0); PG8_BAR; PG8_SCHED;
            PG8_STAGE(PG8_SB(0, 1), b2 + hstep, voffB);
            PG8_WAIT_V(6); PG8_BAR; PG8_MMA(1, 1, At, B1); PG8_BAR;
            PG8_LDB(B0, 1, 0); PG8_SCHED; PG8_LDA(At, 1, 0); PG8_STAGE(PG8_SA(0, 1), a2 + hstepA, voffA);
            PG8_WAIT_L(8); PG8_BAR; PG8_WAIT_L(0); PG8_MMA(0, 0, At, B0); PG8_BAR; PG8_SCHED;
            PG8_LDB(B1, 1, 1); PG8_STAGE(PG8_SB(1, 0), b3, voffB);
            PG8_BAR; PG8_WAIT_L(0); PG8_MMA(0, 1, At, B1); PG8_BAR;
            PG8_LDA(At, 1, 1); PG8_STAGE(PG8_SA(1, 0), a3, voffA);
            PG8_BAR; PG8_WAIT_L(0); PG8_MMA(1, 0, At, B0); PG8_BAR; PG8_SCHED;
            PG8_STAGE(PG8_SB(1, 1), b3 + hstep, voffB);
            PG8_WAIT_V(6); PG8_BAR; PG8_MMA(1, 1, At, B1); PG8_BAR;
        }
        E(acc, cur, wr, wc, fr, fq);
        if (!has_next) break;
        E.init(acc, nxt, wr, wc, fr, fq);
        cur = nxt; cA = nA; cB = nB; ++ui;
    }
    PG8_WAIT_V(0);
    if (wr == 0) PG8_BAR;
    PG8_BAR;
#undef PG8_SA
#undef PG8_SB
#undef PG8_STAGE
#undef PG8_LDA
#undef PG8_LDB
#undef PG8_MMA
#undef PG8_WAIT_V
#undef PG8_WAIT_L
#undef PG8_BAR
#undef PG8_SCHED
}
}

__device__ __forceinline__ void acc_zero(f32x4 (&acc)[2][2][4][2]) {
#pragma unroll
    for (int a = 0; a < 2; ++a)
#pragma unroll
        for (int b = 0; b < 2; ++b)
#pragma unroll
            for (int m = 0; m < 4; ++m)
#pragma unroll
                for (int n = 0; n < 2; ++n) acc[a][b][m][n] = (f32x4){0.f, 0.f, 0.f, 0.f};
}
struct EpiIn {
    const ssq_t* ssq; bf16_t* glu; bf16_t* qkv;
    __device__ __forceinline__ void init(f32x4 (&acc)[2][2][4][2], const pg8::Unit&, int, int, int, int) const { acc_zero(acc); }
    __device__ __forceinline__ void operator()(const f32x4 (&acc)[2][2][4][2], const pg8::Unit& u, int wr, int wc, int fr, int fq) const {
        const int row0 = u.pm * 256 + wr * 64 + fr;
        if (u.pn < 4) {
            const int col0 = u.pn * 128 + wc * 32 + 8 * fq;
#pragma unroll
            for (int ai = 0; ai < 2; ++ai)
#pragma unroll
                for (int m = 0; m < 4; ++m) {
                    const int r = row0 + ai * 128 + m * 16;
                    const float rs = ssq_rs(ssq[r]);
                    const float k2 = rs * -1.4426950408889634f;
                    f32x2 o[4];
#pragma unroll
                    for (int n = 0; n < 2; ++n)
#pragma unroll
                        for (int h = 0; h < 2; ++h) {
                            const f32x2 a = (f32x2){acc[ai][0][m][n][2 * h], acc[ai][0][m][n][2 * h + 1]}, gt = (f32x2){acc[ai][1][m][n][2 * h], acc[ai][1][m][n][2 * h + 1]};
                            o[n * 2 + h] = (a * rs) * pk_sig(gt, k2);
                        }
                    u32x4 w; w.x = cvt_pk_bf16(o[0].x, o[0].y); w.y = cvt_pk_bf16(o[1].x, o[1].y); w.z = cvt_pk_bf16(o[2].x, o[2].y); w.w = cvt_pk_bf16(o[3].x, o[3].y);
                    *(u32x4*)(glu + (size_t)r * 512 + col0) = w;
                }
        } else {
            const int col0 = (u.pn - 4) * 256 + wc * 32 + 8 * fq;
#pragma unroll
            for (int ai = 0; ai < 2; ++ai)
#pragma unroll
                for (int m = 0; m < 4; ++m) {
                    const int r = row0 + ai * 128 + m * 16;
                    const float rs = ssq_rs(ssq[r]);
#pragma unroll
                    for (int bj = 0; bj < 2; ++bj) {
                        const f32x4 v0 = acc[ai][bj][m][0] * rs, v1 = acc[ai][bj][m][1] * rs;
                        u32x4 w; w.x = cvt_pk_bf16(v0[0], v0[1]); w.y = cvt_pk_bf16(v0[2], v0[3]); w.z = cvt_pk_bf16(v1[0], v1[1]); w.w = cvt_pk_bf16(v1[2], v1[3]);
                        *(u32x4*)(qkv + (size_t)r * 768 + col0 + bj * 128) = w;
                    }
                }
        }
    }
};
struct EpiGU {
    const ssq_t* ssq; bf16_t* act;
    __device__ __forceinline__ void init(f32x4 (&acc)[2][2][4][2], const pg8::Unit&, int, int, int, int) const { acc_zero(acc); }
    __device__ __forceinline__ void operator()(const f32x4 (&acc)[2][2][4][2], const pg8::Unit& u, int wr, int wc, int fr, int fq) const {
        const int row0 = u.pm * 256 + wr * 64 + fr, col0 = u.pn * 128 + wc * 32 + 8 * fq;
#pragma unroll
        for (int ai = 0; ai < 2; ++ai)
#pragma unroll
            for (int m = 0; m < 4; ++m) {
                const int r = row0 + ai * 128 + m * 16;
                const float rs = ssq_rs(ssq[r]);
                const float k2 = rs * -1.4426950408889634f, rs2 = rs * rs;
                f32x2 o[4];
#pragma unroll
                for (int n = 0; n < 2; ++n)
#pragma unroll
                    for (int h = 0; h < 2; ++h) {
                        const f32x2 gt = (f32x2){acc[ai][0][m][n][2 * h], acc[ai][0][m][n][2 * h + 1]}, up = (f32x2){acc[ai][1][m][n][2 * h], acc[ai][1][m][n][2 * h + 1]};
                        o[n * 2 + h] = (gt * up) * rs2 * pk_sig(gt, k2);
                    }
                u32x4 w; w.x = cvt_pk_bf16(o[0].x, o[0].y); w.y = cvt_pk_bf16(o[1].x, o[1].y); w.z = cvt_pk_bf16(o[2].x, o[2].y); w.w = cvt_pk_bf16(o[3].x, o[3].y);
                *(u32x4*)(act + (size_t)(r >> 8) * (256 * DFF) + (size_t)(col0 >> 6) * (256 * 64) + (size_t)(r & 255) * 64 + (col0 & 63)) = w;
            }
    }
};
__device__ __forceinline__ void bf8_to_f32(u32x4 w, f32x4& lo, f32x4& hi) { lo = (f32x4){bflo(w.x), bfhi(w.x), bflo(w.y), bfhi(w.y)}; hi = (f32x4){bflo(w.z), bfhi(w.z), bflo(w.w), bfhi(w.w)}; }
template <bool POOL> struct EpiRes {
    float* Y; bf16_t* XB; ssq_t* ssq; const float* cscale; float* part;
    __device__ __forceinline__ void init(f32x4 (&acc)[2][2][4][2], const pg8::Unit& u, int wr, int wc, int fr, int fq) const {
        if (!POOL && u.part >= 0) { acc_zero(acc); return; }
        const int pmr = POOL ? (u.pm % NTM) : u.pm, ct = POOL ? (u.pm / NTM) : u.pn;
        const bf16_t* xq = XB + (size_t)(pmr * 256 + wr * 64 + fr) * DM + ct * 256 + wc * 32 + 8 * fq;
#pragma unroll
        for (int ai = 0; ai < 2; ++ai)
#pragma unroll
            for (int bj = 0; bj < 2; ++bj)
#pragma unroll
                for (int m = 0; m < 4; ++m) bf8_to_f32(*(const u32x4*)(xq + (size_t)(ai * 128 + m * 16) * DM + bj * 128), acc[ai][bj][m][0], acc[ai][bj][m][1]);
        if (POOL) {
            const float* cq = cscale + ct * 256 + wc * 32 + 8 * fq;
#pragma unroll
            for (int bj = 0; bj < 2; ++bj)
#pragma unroll
                for (int n = 0; n < 2; ++n) {
                    const f32x4 cv = *(const f32x4*)(cq + bj * 128 + 4 * n);
                    const f32x4 ic = (f32x4){__builtin_amdgcn_rcpf(cv[0]), __builtin_amdgcn_rcpf(cv[1]), __builtin_amdgcn_rcpf(cv[2]), __builtin_amdgcn_rcpf(cv[3])};
#pragma unroll
                    for (int ai = 0; ai < 2; ++ai)
#pragma unroll
                        for (int m = 0; m < 4; ++m) acc[ai][bj][m][n] = acc[ai][bj][m][n] * ic;
                }
        }
    }
    __device__ __forceinline__ void operator()(const f32x4 (&acc)[2][2][4][2], const pg8::Unit& u, int wr, int wc, int fr, int fq) const {
        if (!POOL && u.part >= 0) {
            float* pp = part + (size_t)u.part * 65536 + (size_t)(((wr * 4 + wc) * 64) + fq * 16 + fr) * 4;
#pragma unroll
            for (int ai = 0; ai < 2; ++ai)
#pragma unroll
                for (int m = 0; m < 4; ++m)
#pragma unroll
                    for (int bj = 0; bj < 2; ++bj)
#pragma unroll
                        for (int n = 0; n < 2; ++n) *(f32x4*)(pp + (size_t)((((ai * 4 + m) * 2 + bj) * 2 + n) * 2048)) = acc[ai][bj][m][n];
            return;
        }
        const int pmr = POOL ? (u.pm % NTM) : u.pm, ct = POOL ? (u.pm / NTM) : u.pn;
        const int row0 = pmr * 256 + wr * 64 + fr, col0 = ct * 256 + wc * 32 + 8 * fq;
#pragma unroll
        for (int ai = 0; ai < 2; ++ai)
#pragma unroll
            for (int m = 0; m < 4; ++m) {
                const int r = row0 + ai * 128 + m * 16;
                bf16_t* bp = XB + (size_t)r * DM + col0;
                float ss = 0.f;
#pragma unroll
                for (int bj = 0; bj < 2; ++bj) {
                    f32x4 v0 = acc[ai][bj][m][0], v1 = acc[ai][bj][m][1];
                    if (POOL) { v0 = v0 * *(const f32x4*)(cscale + col0 + bj * 128); v1 = v1 * *(const f32x4*)(cscale + col0 + bj * 128 + 4); }
                    if (Y) { float* yp = Y + (size_t)r * DM + col0 + bj * 128; *(f32x4*)yp = v0; *(f32x4*)(yp + 4) = v1; }
                    u32x4 w; w.x = cvt_pk_bf16(v0[0], v0[1]); w.y = cvt_pk_bf16(v0[2], v0[3]); w.z = cvt_pk_bf16(v1[0], v1[1]); w.w = cvt_pk_bf16(v1[2], v1[3]);
                    *(u32x4*)(bp + bj * 128) = w;
                    ss += (v0[0] * v0[0] + v0[1] * v0[1]) + (v0[2] * v0[2] + v0[3] * v0[3]) + (v1[0] * v1[0] + v1[1] * v1[1]) + (v1[2] * v1[2] + v1[3] * v1[3]);
                }
                ss += __shfl_xor(ss, 16); ss += __shfl_xor(ss, 32);
                if (fq == 0) ssq_add(ssq + r, ss);
            }
    }
};

struct WTile { const float* src0; const float* src1; const float* gain; bf16_t* dst; int ld, K, k0, n0m, mode; };
__device__ __forceinline__ void wt_decode(const Params& p, int t, WTile& w) {
    int kt; w.gain = nullptr;
    if (t < 224) { const int i = t / 112, r = t % 112; w.n0m = (r / 16) * 256; kt = r % 16; w.K = 1024; w.ld = DIN; w.mode = (w.n0m < 1024) ? 1 : 0;
        w.src0 = p.in[I_WIN] + (size_t)i * DM * DIN; w.src1 = w.src0; w.gain = p.in[I_NMIX] + (2 * i) * DM; w.dst = (bf16_t*)(p.ws + WS_WIN) + (size_t)i * DIN * DM; }
    else if (t < 352) { t -= 224; const int i = t / 64, r = t % 64; w.n0m = (r / 16) * 256; kt = r % 16; w.K = 1024; w.ld = DM; w.mode = 0;
        w.src0 = p.in[I_WOUT] + (size_t)i * DM * DM; w.src1 = w.src0; w.dst = (bf16_t*)(p.ws + WS_WOUT) + (size_t)i * DM * DM; }
    else if (t < 1760) { t -= 352; const int l = t / 352, r = t % 352; w.n0m = (r / 16) * 256; kt = r % 16; w.K = 1024; w.ld = DFF; w.mode = 2;
        w.src0 = p.in[I_WG] + (size_t)l * DM * DFF; w.src1 = p.in[I_WU] + (size_t)l * DM * DFF; w.gain = p.in[I_NFFN] + l * DM; w.dst = (bf16_t*)(p.ws + WS_WGU) + (size_t)l * 2 * DFF * DM; }
    else if (t < 2464) { t -= 1760; const int l = t / 176, r = t % 176; w.n0m = (r / 44) * 256; kt = r % 44; w.K = DFF; w.ld = DM; w.mode = 0;
        w.src0 = p.in[I_WD] + (size_t)l * DFF * DM; w.src1 = w.src0; w.dst = (bf16_t*)(p.ws + WS_WDN) + (size_t)l * DM * DFF; }
    else { t -= 2464; const int ig = t / 4; w.n0m = 0; kt = t % 4; w.K = 256; w.ld = 256; w.mode = 0;
        w.src0 = p.in[I_WPOOL] + (size_t)ig * 65536; w.src1 = w.src0; w.dst = (bf16_t*)(p.ws + WS_WPL) + (size_t)ig * 65536; }
    w.k0 = kt * 64;
}
__device__ __forceinline__ void wt_load(const WTile& w, int tid, f32x4 (&v)[4][2], float& gs0, float& gs1) {
    const int row = tid >> 4, col4 = (tid & 15) * 4;
    gs0 = w.gain ? w.gain[w.k0 + row] : 1.0f; gs1 = w.gain ? w.gain[w.k0 + row + 32] : 1.0f;
#pragma unroll
    for (int q = 0; q < 4; ++q) {
        const int n0 = w.n0m + 64 * q; int c0 = n0; const float* src = w.src0;
        if (w.mode == 1) { const int pn = n0 / 256, bj = (n0 / 128) & 1, cc = n0 % 128; c0 = bj * 512 + 128 * pn + cc; }
        else if (w.mode == 2) { const int pn = n0 / 256, bj = (n0 / 128) & 1, cc = n0 % 128; c0 = 128 * pn + cc; src = bj ? w.src1 : w.src0; }
        const float* sp = src + (size_t)(w.k0 + row) * w.ld + c0 + col4;
        v[q][0] = *(const f32x4*)sp; v[q][1] = *(const f32x4*)(sp + (size_t)32 * w.ld);
    }
}
__device__ __forceinline__ void prep_phase(const Params& p, LAS unsigned char* lds) {
    int tid = threadIdx.x; asm volatile("" : "+v"(tid));
    const int G = gridDim.x, bid = blockIdx.x, wave = tid >> 6, lane = tid & 63;
    bf16_t* XB = (bf16_t*)(p.ws + WS_XB); ssq_t* SSQ = (ssq_t*)(p.ws + WS_SSQ);
    for (int r0 = bid * 8 + wave; r0 < MT; r0 += G * 16) {
        const int r1 = r0 + G * 8; const bool h1 = r1 < MT; const int r1c = h1 ? r1 : r0;
        const float* s0 = r0 < MP ? p.in[I_XP] + (size_t)r0 * DM : p.in[I_XS] + (size_t)(r0 - MP) * DM;
        const float* s1 = r1c < MP ? p.in[I_XP] + (size_t)r1c * DM : p.in[I_XS] + (size_t)(r1c - MP) * DM;
        f32x4 va[4], vb[4];
#pragma unroll
        for (int q = 0; q < 4; ++q) { va[q] = *(const f32x4*)(s0 + q * 256 + lane * 4); vb[q] = *(const f32x4*)(s1 + q * 256 + lane * 4); }
        float ssa = 0.f, ssb = 0.f;
#pragma unroll
        for (int q = 0; q < 4; ++q) {
            u32x2 w; w.x = cvt_pk_bf16(va[q][0], va[q][1]); w.y = cvt_pk_bf16(va[q][2], va[q][3]);
            *(u32x2*)(XB + (size_t)r0 * DM + q * 256 + lane * 4) = w;
            ssa += (va[q][0] * va[q][0] + va[q][1] * va[q][1]) + (va[q][2] * va[q][2] + va[q][3] * va[q][3]);
            if (h1) {
                u32x2 w2; w2.x = cvt_pk_bf16(vb[q][0], vb[q][1]); w2.y = cvt_pk_bf16(vb[q][2], vb[q][3]);
                *(u32x2*)(XB + (size_t)r1 * DM + q * 256 + lane * 4) = w2;
            }
            ssb += (vb[q][0] * vb[q][0] + vb[q][1] * vb[q][1]) + (vb[q][2] * vb[q][2] + vb[q][3] * vb[q][3]);
        }
        ssa = wave_sum(ssa); ssb = wave_sum(ssb);
        if (lane == 0) { SSQ[r0] = ssq_fix(ssa); if (h1) SSQ[r1] = ssq_fix(ssb); }
    }
    for (int idx = bid * 512 + tid; idx < 8 * MT; idx += G * 512) SSQ[MT + idx] = 0ull;
    LAS float* tile = (LAS float*)lds;
    WTile cur, nxt; f32x4 v[4][2]; float gs0 = 1.f, gs1 = 1.f;
    int t0 = bid;
    if (t0 < 2496) { wt_decode(p, t0, cur); wt_load(cur, tid, v, gs0, gs1); }
    for (; t0 < 2496; t0 += G) {
        __syncthreads();
        {
            const int row = tid >> 4, col4 = (tid & 15) * 4;
#pragma unroll
            for (int q = 0; q < 4; ++q)
#pragma unroll
                for (int h = 0; h < 2; ++h) { LAS float* tp = tile + q * 4160 + (row + 32 * h) * 65 + col4; const float gs = h ? gs1 : gs0;
                    tp[0] = v[q][h][0] * gs; tp[1] = v[q][h][1] * gs; tp[2] = v[q][h][2] * gs; tp[3] = v[q][h][3] * gs; }
        }
        __syncthreads();
        const bool hn = (t0 + G) < 2496;
        if (hn) { wt_decode(p, t0 + G, nxt); wt_load(nxt, tid, v, gs0, gs1); }
        {
            const int n = tid >> 3, kk = (tid & 7) * 8;
#pragma unroll
            for (int q = 0; q < 4; ++q) {
                float e[8];
#pragma unroll
                for (int j = 0; j < 8; ++j) e[j] = tile[q * 4160 + (kk + j) * 65 + n];
                u32x4 w; w.x = cvt_pk_bf16(e[0], e[1]); w.y = cvt_pk_bf16(e[2], e[3]); w.z = cvt_pk_bf16(e[4], e[5]); w.w = cvt_pk_bf16(e[6], e[7]);
                *(u32x4*)(cur.dst + (size_t)(cur.n0m + 64 * q + n) * cur.K + cur.k0 + kk) = w;
            }
        }
        if (hn) cur = nxt;
    }
    __syncthreads();
}

__device__ __forceinline__ f32x4 ld_bf4(const bf16_t* p) { const u32x2 w = *(const u32x2*)p; return (f32x4){bflo(w.x), bfhi(w.x), bflo(w.y), bfhi(w.y)}; }
template <int W>
__device__ __forceinline__ void pool_prompt_strip(const bf16_t* X, const ssq_t* ssq, int row0, int t0, int c, f32x4 gm, bf16_t* dgp, float* outp_seq) {
    constexpr int TT = 16, NR = TT + W - 1;
    f32x4 xr[NR];
    if (t0 >= W - 1) {
        const bf16_t* xp = X + (size_t)(row0 - (W - 1)) * DM + c; asm volatile("" : "+v"(xp));
        const ssq_t* sp = ssq + (row0 - (W - 1)); asm volatile("" : "+v"(sp));
#pragma unroll
        for (int j = 0; j < NR; ++j) { const float rs = ssq_rs(sp[j]); xr[j] = ld_bf4(xp + (size_t)j * DM) * rs * gm; }
    } else {
        int vz; asm volatile("v_mov_b32 %0, 0" : "=v"(vz));
        const bf16_t* xp = X + (size_t)(row0 - t0) * DM + c; const ssq_t* sp = ssq + (row0 - t0);
#pragma unroll
        for (int j = 0; j < NR; ++j) { const int tj = t0 - (W - 1) + j + vz, tc = tj < 0 ? 0 : tj; const float rs = ssq_rs(sp[tc]);
            const f32x4 v = ld_bf4(xp + (size_t)tc * DM) * rs * gm; xr[j] = tj < 0 ? (f32x4){0.f, 0.f, 0.f, 0.f} : v; }
    }
    f32x4 S = (f32x4){0.f, 0.f, 0.f, 0.f};
#pragma unroll
    for (int j = 0; j < W - 1; ++j) S += xr[j];
#pragma unroll
    for (int tt = 0; tt < TT; ++tt) {
        S += xr[tt + W - 1]; if (tt > 0) S -= xr[tt - 1];
        const int t = t0 + tt, cnt = (t + 1 < W) ? (t + 1) : W;
        const f32x4 cur = xr[tt + W - 1], d = S * __builtin_amdgcn_rcpf((float)cnt) - cur;
        u32x2 wv; wv.x = cvt_pk_bf16(d[0], d[1]); wv.y = cvt_pk_bf16(d[2], d[3]);
        *(u32x2*)(dgp + (size_t)tt * 256) = wv;
        if (t >= 4081) *(f32x4*)(outp_seq + (size_t)(t - 4081) * DM) = cur;
    }
}
template <int W>
__device__ __forceinline__ void pool_sample_strip(const bf16_t* X, const ssq_t* ssq, int row0, int c, f32x4 gm, const float* state_seq, bf16_t* dgp, float* outs_seq) {
    constexpr int TT = 8, NR = TT + W - 1;
    f32x4 xr[NR];
    { const float* stp = state_seq + (size_t)(15 - (W - 1)) * DM; asm volatile("" : "+v"(stp));
#pragma unroll
      for (int j = 0; j < W - 1; ++j) xr[j] = *(const f32x4*)(stp + (size_t)j * DM); }
    { const bf16_t* xp = X + (size_t)row0 * DM + c; asm volatile("" : "+v"(xp));
      const ssq_t* sp = ssq + row0;
#pragma unroll
      for (int j = 0; j < TT; ++j) { const float rs = ssq_rs(sp[j]); xr[W - 1 + j] = ld_bf4(xp + (size_t)j * DM) * rs * gm; } }
    f32x4 S = (f32x4){0.f, 0.f, 0.f, 0.f};
#pragma unroll
    for (int j = 0; j < W - 1; ++j) S += xr[j];
#pragma unroll
    for (int tt = 0; tt < TT; ++tt) {
        S += xr[tt + W - 1]; if (tt > 0) S -= xr[tt - 1];
        const f32x4 cur = xr[tt + W - 1], d = S * (1.0f / (float)W) - cur;
        u32x2 wv; wv.x = cvt_pk_bf16(d[0], d[1]); wv.y = cvt_pk_bf16(d[2], d[3]);
        *(u32x2*)(dgp + (size_t)tt * 256) = wv;
        *(f32x4*)(outs_seq + (size_t)(7 + tt) * DM) = cur;
    }
}
__device__ __forceinline__ void pool1_phase(const Params& p, int l, const ssq_t* ssq) {
    int tid = threadIdx.x; asm volatile("" : "+v"(tid));
    const int G = gridDim.x, bid = blockIdx.x, i = l >> 1;
    const bf16_t* X = (const bf16_t*)(p.ws + WS_XB); bf16_t* DG = (bf16_t*)(p.ws + WS_DG);
    const int cq = tid & 255, c = cq * 4, half = tid >> 8, g = __builtin_amdgcn_readfirstlane(cq >> 6);
    const f32x4 gm = *(const f32x4*)(p.in[I_NMIX] + l * DM + c);
    const float* spool = p.in[I_SPOOL] + (size_t)i * 128 * 15 * DM;
    float* outp = p.out + O_POOLP + (size_t)i * 4 * 15 * DM; float* outs = p.out + O_POOLS + (size_t)i * 128 * 15 * DM;
    for (int u = bid; u < MP / 64 + 64; u += G) {
        if (u < MP / 64) {
#pragma unroll 1
            for (int k = 0; k < 2; ++k) {
                const int row0 = u * 64 + k * 32 + half * 16, t0 = row0 & 4095, b = row0 >> 12;
                bf16_t* dgp = DG + ((size_t)g * MT + row0) * 256 + (c - 256 * g); float* op = outp + (size_t)b * 15 * DM + c;
                if (g == 0) pool_prompt_strip<2>(X, ssq, row0, t0, c, gm, dgp, op);
                else if (g == 1) pool_prompt_strip<4>(X, ssq, row0, t0, c, gm, dgp, op);
                else if (g == 2) pool_prompt_strip<8>(X, ssq, row0, t0, c, gm, dgp, op);
                else pool_prompt_strip<16>(X, ssq, row0, t0, c, gm, dgp, op);
            }
        } else {
            const int s0 = (u - MP / 64) * 2;
            {
                const int s = s0 + half, row0 = MP + s * 8;
                bf16_t* dgp = DG + ((size_t)g * MT + row0) * 256 + (c - 256 * g); float* op = outs + (size_t)s * 15 * DM + c; const float* st = spool + (size_t)s * 15 * DM + c;
                if (g == 0) pool_sample_strip<2>(X, ssq, row0, c, gm, st, dgp, op);
                else if (g == 1) pool_sample_strip<4>(X, ssq, row0, c, gm, st, dgp, op);
                else if (g == 2) pool_sample_strip<8>(X, ssq, row0, c, gm, st, dgp, op);
                else pool_sample_strip<16>(X, ssq, row0, c, gm, st, dgp, op);
            }
            for (int idx = tid; idx < 2 * 7 * 256; idx += 512) { const int c4 = (idx & 255) * 4, rr = (idx >> 8) % 7, sl = idx / (7 * 256);
                *(f32x4*)(outs + ((size_t)(s0 + sl) * 15 + rr) * DM + c4) = *(const f32x4*)(spool + ((size_t)(s0 + sl) * 15 + 8 + rr) * DM + c4); }
        }
    }
}

constexpr int KS_STRIDE = 72, VT_STRIDE = 264;

__device__ __forceinline__ void attn_item(const LAS bf16_t* Ks, const LAS bf16_t* Vt, int tile0, int r0, bool first, bool qvalid,
                                          const bf16_t* qptr, const float* qn, float slope, float sink, bf16_t* optr, int fr, int fq) {
    u32x4 raw0 = (u32x4){0u, 0u, 0u, 0u}, raw1 = raw0;
    if (qvalid) { raw0 = *(const u32x4*)(qptr); raw1 = *(const u32x4*)(qptr + 32); }
    float qf[16];
#pragma unroll
    for (int j = 0; j < 4; ++j) { qf[2 * j] = bflo(raw0[j]); qf[2 * j + 1] = bfhi(raw0[j]); qf[8 + 2 * j] = bflo(raw1[j]); qf[8 + 2 * j + 1] = bfhi(raw1[j]); }
    float ss = 0.f;
#pragma unroll
    for (int j = 0; j < 16; ++j) ss += qf[j] * qf[j];
    ss += __shfl_xor(ss, 16); ss += __shfl_xor(ss, 32);
    const float rq = rsqrtf(ss * (1.0f / 64.0f) + RMS_EPS) * 0.125f;
    bf16x8 q0, q1;
    {
        const f32x4 n0 = *(const f32x4*)(qn + fq * 8), n1 = *(const f32x4*)(qn + fq * 8 + 4), n2 = *(const f32x4*)(qn + 32 + fq * 8), n3 = *(const f32x4*)(qn + 32 + fq * 8 + 4);
        u32x4 a, b;
        a.x = cvt_pk_bf16(qf[0] * rq * n0[0], qf[1] * rq * n0[1]); a.y = cvt_pk_bf16(qf[2] * rq * n0[2], qf[3] * rq * n0[3]);
        a.z = cvt_pk_bf16(qf[4] * rq * n1[0], qf[5] * rq * n1[1]); a.w = cvt_pk_bf16(qf[6] * rq * n1[2], qf[7] * rq * n1[3]);
        b.x = cvt_pk_bf16(qf[8] * rq * n2[0], qf[9] * rq * n2[1]); b.y = cvt_pk_bf16(qf[10] * rq * n2[2], qf[11] * rq * n2[3]);
        b.z = cvt_pk_bf16(qf[12] * rq * n3[0], qf[13] * rq * n3[1]); b.w = cvt_pk_bf16(qf[14] * rq * n3[2], qf[15] * rq * n3[3]);
        q0 = __builtin_bit_cast(bf16x8, a); q1 = __builtin_bit_cast(bf16x8, b);
    }
    f32x4 s[9];
#pragma unroll
    for (int T = 0; T < 9; ++T) {
        const LAS bf16_t* kp = Ks + ((tile0 + T) * 16 + fr) * KS_STRIDE + fq * 8;
        const bf16x8 a0 = *(const LAS bf16x8*)(kp), a1 = *(const LAS bf16x8*)(kp + 32);
        f32x4 z = (f32x4){0.f, 0.f, 0.f, 0.f};
        z = __builtin_amdgcn_mfma_f32_16x16x32_bf16(a0, q0, z, 0, 0, 0);
        s[T] = __builtin_amdgcn_mfma_f32_16x16x32_bf16(a1, q1, z, 0, 0, 0);
    }
    __builtin_amdgcn_sched_barrier(0);
    int qi = r0 + fr; asm volatile("" : "+v"(qi));
    const int lim = first ? qi + 1 : 128;
    float mx = sink;
#pragma unroll
    for (int T = 0; T < 9; ++T)
#pragma unroll
        for (int j = 0; j < 4; ++j) {
            const int jk = (tile0 + T) * 16 + 4 * fq + j, dist = 128 + qi - jk;
            const bool valid = (unsigned)dist < (unsigned)lim;
            const float v = valid ? (s[T][j] - slope * (float)dist) : -1e30f;
            s[T][j] = v; mx = fmaxf(mx, v);
        }
    mx = fmaxf(mx, __shfl_xor(mx, 16)); mx = fmaxf(mx, __shfl_xor(mx, 32));
    float sum = 0.f;
#pragma unroll
    for (int T = 0; T < 9; ++T)
#pragma unroll
        for (int j = 0; j < 4; ++j) { const float e = __expf(s[T][j] - mx); s[T][j] = e; sum += e; }
    sum += __shfl_xor(sum, 16); sum += __shfl_xor(sum, 32);
    sum += __expf(sink - mx);
    const float inv = 1.0f / sum;
    __builtin_amdgcn_sched_barrier(0);
    f32x4 o[4];
#pragma unroll
    for (int dt = 0; dt < 4; ++dt) o[dt] = (f32x4){0.f, 0.f, 0.f, 0.f};
#pragma unroll
    for (int pp = 0; pp < 5; ++pp) {
        const int T0 = 2 * pp, T1 = (pp < 4) ? 2 * pp + 1 : 8;
        u32x4 pw;
        pw.x = cvt_pk_bf16(s[T0][0] * inv, s[T0][1] * inv); pw.y = cvt_pk_bf16(s[T0][2] * inv, s[T0][3] * inv);
        if (pp < 4) { pw.z = cvt_pk_bf16(s[T1][0] * inv, s[T1][1] * inv); pw.w = cvt_pk_bf16(s[T1][2] * inv, s[T1][3] * inv); } else { pw.z = 0u; pw.w = 0u; }
        const bf16x8 pf = __builtin_bit_cast(bf16x8, pw);
#pragma unroll
        for (int dt = 0; dt < 4; ++dt) {
            const LAS bf16_t* vp = Vt + (dt * 16 + fr) * VT_STRIDE + 4 * fq;
            const u32x2 v0 = *(const LAS u32x2*)(vp + (tile0 + T0) * 16), v1 = *(const LAS u32x2*)(vp + (tile0 + T1) * 16);
            u32x4 vw; vw.x = v0.x; vw.y = v0.y; vw.z = v1.x; vw.w = v1.y;
            o[dt] = __builtin_amdgcn_mfma_f32_16x16x32_bf16(__builtin_bit_cast(bf16x8, vw), pf, o[dt], 0, 0, 0);
        }
    }
    if (qvalid) {
#pragma unroll
        for (int dt = 0; dt < 4; ++dt) { u32x2 w; w.x = cvt_pk_bf16(o[dt][0], o[dt][1]); w.y = cvt_pk_bf16(o[dt][2], o[dt][3]); *(u32x2*)(optr + dt * 16) = w; }
    }
}

__device__ __forceinline__ void mixer_phase(const Params& p, int l, LAS unsigned char* lds) {
    const int G = gridDim.x, bid = blockIdx.x, i = l >> 1;
    const bf16_t* QKV = (const bf16_t*)(p.ws + WS_QKV); const bf16_t* GLU = (const bf16_t*)(p.ws + WS_GLU); bf16_t* CAT = (bf16_t*)(p.ws + WS_CAT);
    const float* qn = p.in[I_QN] + i * 64; const float* kn = p.in[I_KN] + i * 64; const float* sinks = p.in[I_SINK] + i * 8;
    constexpr int N_PA = 256, N_CV = 640, N_SA = 128;
#define MIX_PRE int tid = threadIdx.x; asm volatile("" : "+v"(tid)); const int wave = tid >> 6, lane = tid & 63, fr = lane & 15, fq = lane >> 4; (void)wave; (void)fr; (void)fq;
    for (int u = bid; u < N_PA; u += G) {
        MIX_PRE
        {
#ifndef X_NOPA
            const int kh = u & 1, blk = (u >> 1) & 31, b = u >> 6;
            const int rowQ0 = b * 4096 + blk * 128, rowK0 = rowQ0 - 128;
            LAS bf16_t* Ks = (LAS bf16_t*)lds; LAS bf16_t* Vt = (LAS bf16_t*)(lds + 256 * KS_STRIDE * 2);
            const int chunk = tid & 7;
            const f32x4 kn0 = *(const f32x4*)(kn + chunk * 8), kn1 = *(const f32x4*)(kn + chunk * 8 + 4);
#pragma unroll 1
            for (int ps = 0; ps < 4; ++ps) {
                const int key = (tid >> 3) + 64 * ps;
                u32x4 kr = (u32x4){0u, 0u, 0u, 0u}, vr = kr;
                const bool have = (blk > 0) || (key >= 128);
                if (have) { const bf16_t* rp = QKV + (size_t)(rowK0 + key) * 768 + 512 + kh * 64 + chunk * 8; kr = *(const u32x4*)rp; vr = *(const u32x4*)(rp + 128); }
                float kf[8], vf[8];
#pragma unroll
                for (int j = 0; j < 4; ++j) { kf[2 * j] = bflo(kr[j]); kf[2 * j + 1] = bfhi(kr[j]); vf[2 * j] = bflo(vr[j]); vf[2 * j + 1] = bfhi(vr[j]); }
                float ss = 0.f;
#pragma unroll
                for (int j = 0; j < 8; ++j) ss += kf[j] * kf[j];
                ss += __shfl_xor(ss, 1); ss += __shfl_xor(ss, 2); ss += __shfl_xor(ss, 4);
                const float rk = rsqrtf(ss * (1.0f / 64.0f) + RMS_EPS);
#pragma unroll
                for (int j = 0; j < 4; ++j) { kf[j] *= rk * kn0[j]; kf[4 + j] *= rk * kn1[j]; }
                u32x4 kw; kw.x = cvt_pk_bf16(kf[0], kf[1]); kw.y = cvt_pk_bf16(kf[2], kf[3]); kw.z = cvt_pk_bf16(kf[4], kf[5]); kw.w = cvt_pk_bf16(kf[6], kf[7]);
                *(LAS u32x4*)(Ks + key * KS_STRIDE + chunk * 8) = kw;
#pragma unroll
                for (int j = 0; j < 4; ++j) { Vt[(chunk * 8 + 2 * j) * VT_STRIDE + key] = (bf16_t)(vr[j] & 0xffffu); Vt[(chunk * 8 + 2 * j + 1) * VT_STRIDE + key] = (bf16_t)(vr[j] >> 16); }
                if (blk == 31 && key >= 128) {
                    float* ko = p.out + O_KP + ((((size_t)i * 4 + b) * 128 + (key - 128)) * 2 + kh) * 64 + chunk * 8;
                    float* vo = p.out + O_VP + ((((size_t)i * 4 + b) * 128 + (key - 128)) * 2 + kh) * 64 + chunk * 8;
                    *(f32x4*)ko = (f32x4){kf[0], kf[1], kf[2], kf[3]}; *(f32x4*)(ko + 4) = (f32x4){kf[4], kf[5], kf[6], kf[7]};
                    *(f32x4*)vo = (f32x4){vf[0], vf[1], vf[2], vf[3]}; *(f32x4*)(vo + 4) = (f32x4){vf[4], vf[5], vf[6], vf[7]};
                }
            }
            __syncthreads();
            const int r0 = wave * 16;
#pragma unroll 1
            for (int g = 0; g < 4; ++g) {
                const int h = kh * 4 + g;
                const float slope = exp2f(-(float)(h + 1)), sink = sinks[h];
                const size_t row = (size_t)(rowQ0 + r0 + fr);
                attn_item(Ks, Vt, wave, r0, blk == 0, true, QKV + row * 768 + h * 64 + fq * 8, qn, slope, sink, CAT + row * DM + 512 + h * 64 + 4 * fq, fr, fq);
            }
            __syncthreads();
#endif
        }
    }
#ifndef X_NOCV
    f32x2 wdw[31]; f32x2 bias;
    { int t0 = threadIdx.x; asm volatile("" : "+v"(t0)); const int c0 = (t0 & 255) * 2;
      const float* wp = p.in[I_WDW] + (size_t)i * 31 * 512 + c0; asm volatile("" : "+v"(wp));
#pragma unroll
      for (int j = 0; j < 31; ++j) { wdw[j] = *(const f32x2*)wp; wp += 512; asm volatile("" : "+v"(wp)); }
      bias = *(const f32x2*)(p.in[I_BDW] + i * 512 + c0); }
    for (int cu = bid; cu < N_CV; cu += G) {
        MIX_PRE
        {
            const int c2 = tid & 255, half = tid >> 8, c = c2 * 2; const bool prm = cu < 512;
            LAS float* ybuf = (LAS float*)lds;
            if (prm && ((cu & 127) * 32 + half * 16) >= 30) {
                const int b = cu >> 7, tb0 = (cu & 127) * 32 + half * 16;
                unsigned raw[46];
                { const bf16_t* gp = GLU + ((size_t)b * 4096 + tb0 - 30) * 512 + c; asm volatile("" : "+v"(gp));
#pragma unroll
                  for (int j = 0; j < 46; ++j) { raw[j] = *(const unsigned*)gp; gp += 512; asm volatile("" : "+v"(gp)); } }
                if (tb0 >= 4064) {
                    float* oc = p.out + O_CONVP + (((size_t)i * 4 + b) * 30) * 512 + c; asm volatile("" : "+v"(oc));
#pragma unroll
                    for (int j = 0; j < 16; ++j) { const int t = tb0 + j; if (t >= 4066) *(f32x2*)(oc + (size_t)(t - 4066) * 512) = (f32x2){bflo(raw[30 + j]), bfhi(raw[30 + j])}; }
                }
#pragma unroll
                for (int q = 0; q < 2; ++q) {
                    f32x2 win[38];
#pragma unroll
                    for (int j = 0; j < 38; ++j) win[j] = (f32x2){bflo(raw[q * 8 + j]), bfhi(raw[q * 8 + j])};
#pragma unroll
                    for (int t = 0; t < 8; ++t) {
                        f32x2 y = bias;
#pragma unroll
                        for (int j = 0; j < 31; ++j) y += wdw[j] * win[t + j];
                        *(LAS f32x2*)(ybuf + (half * 16 + q * 8 + t) * 512 + c) = y;
                    }
                    __builtin_amdgcn_sched_barrier(0);
                }
            } else if (prm) {
#pragma unroll 1
                for (int q = 0; q < 2; ++q) {
                    const int b = cu >> 7, tl = half * 16 + q * 8, tb = (cu & 127) * 32 + tl;
                    f32x2 win[38];
                    {
                        int vz; asm volatile("v_mov_b32 %0, 0" : "=v"(vz));
                        const bf16_t* gp = GLU + (size_t)b * 4096 * 512 + c; asm volatile("" : "+v"(gp));
#pragma unroll
                        for (int j = 0; j < 38; ++j) { const int tj = tb - 30 + j + vz; const unsigned w = *(const unsigned*)gp; if (tj >= 0) gp += 512; asm volatile("" : "+v"(gp));
                            win[j] = tj < 0 ? (f32x2){0.f, 0.f} : (f32x2){bflo(w), bfhi(w)}; }
                    }
#pragma unroll
                    for (int t = 0; t < 8; ++t) {
                        f32x2 y = bias;
#pragma unroll
                        for (int j = 0; j < 31; ++j) y += wdw[j] * win[t + j];
                        *(LAS f32x2*)(ybuf + (tl + t) * 512 + c) = y;
                    }
                }
            } else {
                const int sq = cu - 512;
                f32x2 win[34];
                const float* cc = p.in[I_CCONV] + (((size_t)i * 128 + sq) * 30 + half * 4) * 512 + c; asm volatile("" : "+v"(cc));
                const bf16_t* gs = GLU + ((size_t)MP + sq * 8) * 512 + c; asm volatile("" : "+v"(gs));
                float* oc = p.out + O_CONVS + (((size_t)i * 128 + sq) * 30 + half * 15) * 512 + c; asm volatile("" : "+v"(oc));
                if (half == 0) {
#pragma unroll
                    for (int j = 0; j < 30; ++j) { win[j] = *(const f32x2*)cc; cc += 512; asm volatile("" : "+v"(cc)); }
#pragma unroll
                    for (int j = 0; j < 4; ++j) { const unsigned w = *(const unsigned*)gs; gs += 512; asm volatile("" : "+v"(gs)); win[30 + j] = (f32x2){bflo(w), bfhi(w)}; }
#pragma unroll
                    for (int j = 0; j < 15; ++j) { *(f32x2*)oc = win[8 + j]; oc += 512; asm volatile("" : "+v"(oc)); }
                } else {
#pragma unroll
                    for (int j = 0; j < 26; ++j) { win[j] = *(const f32x2*)cc; cc += 512; asm volatile("" : "+v"(cc)); }
#pragma unroll
                    for (int j = 0; j < 8; ++j) { const unsigned w = *(const unsigned*)gs; gs += 512; asm volatile("" : "+v"(gs)); win[26 + j] = (f32x2){bflo(w), bfhi(w)}; }
#pragma unroll
                    for (int j = 0; j < 15; ++j) { *(f32x2*)oc = win[19 + j]; oc += 512; asm volatile("" : "+v"(oc)); }
                }
#pragma unroll
                for (int t = 0; t < 4; ++t) {
                    f32x2 y = bias;
#pragma unroll
                    for (int j = 0; j < 31; ++j) y += wdw[j] * win[t + j];
                    *(LAS f32x2*)(ybuf + (half * 4 + t) * 512 + c) = y;
                }
            }
            __syncthreads();
            {
                const float* gp = p.in[I_CNG] + i * 512 + lane * 8; const float* bp = p.in[I_CNB] + i * 512 + lane * 8;
                const f32x4 g0 = *(const f32x4*)gp, g1 = *(const f32x4*)(gp + 4), b0 = *(const f32x4*)bp, b1 = *(const f32x4*)(bp + 4);
#pragma unroll 1
                for (int q = 0; q < (prm ? 4 : 1); ++q) {
                    const int tk = prm ? wave * 4 + q : wave; const size_t row = prm ? (size_t)cu * 32 + tk : (size_t)MP + (size_t)(cu - 512) * 8 + tk;
                    const f32x4 v0 = *(const LAS f32x4*)(ybuf + tk * 512 + lane * 8), v1 = *(const LAS f32x4*)(ybuf + tk * 512 + lane * 8 + 4);
                    const float mean = wave_sum((v0[0] + v0[1]) + (v0[2] + v0[3]) + (v1[0] + v1[1]) + (v1[2] + v1[3])) * (1.0f / 512.0f);
                    const f32x4 d0 = v0 - mean, d1 = v1 - mean;
                    const float var = wave_sum((d0[0] * d0[0] + d0[1] * d0[1]) + (d0[2] * d0[2] + d0[3] * d0[3]) + (d1[0] * d1[0] + d1[1] * d1[1]) + (d1[2] * d1[2] + d1[3] * d1[3])) * (1.0f / 512.0f);
                    const float rs = rsqrtf(var + LN_EPS);
                    f32x4 o0 = d0 * rs * g0 + b0, o1 = d1 * rs * g1 + b1;
#pragma unroll
                    for (int j = 0; j < 4; ++j) { o0[j] = o0[j] * fast_sigmoid(o0[j]); o1[j] = o1[j] * fast_sigmoid(o1[j]); }
                    u32x4 w; w.x = cvt_pk_bf16(o0[0], o0[1]); w.y = cvt_pk_bf16(o0[2], o0[3]); w.z = cvt_pk_bf16(o1[0], o1[1]); w.w = cvt_pk_bf16(o1[2], o1[3]);
                    *(u32x4*)(CAT + row * DM + lane * 8) = w;
                }
            }
            __syncthreads();
        }
    }
#endif
    for (int s = bid - 128; s < N_SA; s += G) {
        if (s < 0) continue;
        MIX_PRE
        {
#ifndef X_NOSA
            LAS bf16_t* Ks = (LAS bf16_t*)lds; LAS bf16_t* Vt = (LAS bf16_t*)(lds + 2 * 144 * KS_STRIDE * 2);
            const int chunk = tid & 7;
            const f32x4 kn0 = *(const f32x4*)(kn + chunk * 8), kn1 = *(const f32x4*)(kn + chunk * 8 + 4);
#pragma unroll 1
            for (int it = tid; it < 2 * 144 * 8; it += 512) {
                const int kk = it >> 3, kh = kk / 144, key = kk % 144;
                float kf[8], vf[8];
#pragma unroll
                for (int j = 0; j < 8; ++j) { kf[j] = 0.f; vf[j] = 0.f; }
                const bool isnew = (key >= 128) && (key < 136);
                if (key < 128) {
                    const size_t off = ((((size_t)i * 128 + s) * 128 + key) * 2 + kh) * 64 + chunk * 8;
                    const f32x4 a0 = *(const f32x4*)(p.in[I_CK] + off), a1 = *(const f32x4*)(p.in[I_CK] + off + 4), c0 = *(const f32x4*)(p.in[I_CV] + off), c1 = *(const f32x4*)(p.in[I_CV] + off + 4);
#pragma unroll
                    for (int j = 0; j < 4; ++j) { kf[j] = a0[j]; kf[4 + j] = a1[j]; vf[j] = c0[j]; vf[4 + j] = c1[j]; }
                } else if (isnew) {
                    const bf16_t* rp = QKV + ((size_t)MP + s * 8 + (key - 128)) * 768 + 512 + kh * 64 + chunk * 8;
                    const u32x4 kr = *(const u32x4*)rp, vr = *(const u32x4*)(rp + 128);
#pragma unroll
                    for (int j = 0; j < 4; ++j) { kf[2 * j] = bflo(kr[j]); kf[2 * j + 1] = bfhi(kr[j]); vf[2 * j] = bflo(vr[j]); vf[2 * j + 1] = bfhi(vr[j]); }
                }
                float ss = 0.f;
#pragma unroll
                for (int j = 0; j < 8; ++j) ss += kf[j] * kf[j];
                ss += __shfl_xor(ss, 1); ss += __shfl_xor(ss, 2); ss += __shfl_xor(ss, 4);
                const float rk = rsqrtf(ss * (1.0f / 64.0f) + RMS_EPS);
                if (isnew) {
#pragma unroll
                    for (int j = 0; j < 4; ++j) { kf[j] *= rk * kn0[j]; kf[4 + j] *= rk * kn1[j]; }
                }
                u32x4 kw; kw.x = cvt_pk_bf16(kf[0], kf[1]); kw.y = cvt_pk_bf16(kf[2], kf[3]); kw.z = cvt_pk_bf16(kf[4], kf[5]); kw.w = cvt_pk_bf16(kf[6], kf[7]);
                *(LAS u32x4*)(Ks + (kh * 144 + key) * KS_STRIDE + chunk * 8) = kw;
                u32x4 vw; vw.x = cvt_pk_bf16(vf[0], vf[1]); vw.y = cvt_pk_bf16(vf[2], vf[3]); vw.z = cvt_pk_bf16(vf[4], vf[5]); vw.w = cvt_pk_bf16(vf[6], vf[7]);
#pragma unroll
                for (int j = 0; j < 4; ++j) { Vt[(kh * 64 + chunk * 8 + 2 * j) * VT_STRIDE + key] = (bf16_t)(vw[j] & 0xffffu); Vt[(kh * 64 + chunk * 8 + 2 * j + 1) * VT_STRIDE + key] = (bf16_t)(vw[j] >> 16); }
                if (key >= 8 && key < 136) {
                    const size_t oo = ((((size_t)i * 128 + s) * 128 + (key - 8)) * 2 + kh) * 64 + chunk * 8;
                    float* ko = p.out + O_KS + oo; float* vo = p.out + O_VS + oo;
                    *(f32x4*)ko = (f32x4){kf[0], kf[1], kf[2], kf[3]}; *(f32x4*)(ko + 4) = (f32x4){kf[4], kf[5], kf[6], kf[7]};
                    *(f32x4*)vo = (f32x4){vf[0], vf[1], vf[2], vf[3]}; *(f32x4*)(vo + 4) = (f32x4){vf[4], vf[5], vf[6], vf[7]};
                }
            }
            __syncthreads();
            {
                const int kh = wave >> 2, g = wave & 3, h = kh * 4 + g;
                const float slope = exp2f(-(float)(h + 1)), sink = sinks[h];
                const size_t row = (size_t)MP + s * 8 + (fr & 7);
                attn_item(Ks + kh * 144 * KS_STRIDE, Vt + kh * 64 * VT_STRIDE, 0, 0, false, fr < 8, QKV + row * 768 + h * 64 + fq * 8, qn, slope, sink, CAT + row * DM + 512 + h * 64 + 4 * fq, fr, fq);
            }
            __syncthreads();
#endif
        }
    }
}


__device__ __forceinline__ void splitk_reduce(float* Y, bf16_t* XB, ssq_t* ssq, const float* part, const pg8::StaticOrder& S, int KS) {
    int tid = threadIdx.x; asm volatile("" : "+v"(tid));
    const int wid = tid >> 6, lane = tid & 63, wr = wid >> 2, wc = wid & 3, fr = lane & 15, fq = lane >> 4;
    for (int task = blockIdx.x; task < 256; task += gridDim.x) {
        const int e = task >> 4, ai = (task >> 3) & 1, m = (task >> 1) & 3, bj = task & 1;
        pg8::Unit u; S.tile(256 + e, u);
        const float* pp = part + (size_t)(e * KS) * 65536 + (size_t)((((ai * 4 + m) * 2 + bj) * 2) * 2048) + (size_t)tid * 4;
        f32x4 a0 = (f32x4){0.f, 0.f, 0.f, 0.f}, a1 = a0;
        for (int k = 0; k < KS; ++k) { a0 += *(const f32x4*)(pp + (size_t)k * 65536); a1 += *(const f32x4*)(pp + (size_t)k * 65536 + 2048); }
        const int r = u.pm * 256 + ai * 128 + wr * 64 + m * 16 + fr, col = u.pn * 256 + bj * 128 + wc * 32 + 8 * fq;
        bf16_t* bp = XB + (size_t)r * DM + col;
        f32x4 x0, x1; bf8_to_f32(*(const u32x4*)bp, x0, x1);
        const f32x4 v0 = x0 + a0, v1 = x1 + a1;
        if (Y) { float* yp = Y + (size_t)r * DM + col; *(f32x4*)yp = v0; *(f32x4*)(yp + 4) = v1; }
        u32x4 w; w.x = cvt_pk_bf16(v0[0], v0[1]); w.y = cvt_pk_bf16(v0[2], v0[3]); w.z = cvt_pk_bf16(v1[0], v1[1]); w.w = cvt_pk_bf16(v1[2], v1[3]);
        *(u32x4*)bp = w;
        float ss = (v0[0] * v0[0] + v0[1] * v0[1]) + (v0[2] * v0[2] + v0[3] * v0[3]) + (v1[0] * v1[0] + v1[1] * v1[1]) + (v1[2] * v1[2] + v1[3] * v1[3]);
        ss += __shfl_xor(ss, 16); ss += __shfl_xor(ss, 32);
        if (fq == 0) ssq_add(ssq + r, ss);
    }
}

#define XB_TMO      128
#define XB_XCNT(j)  (256  + 64 * (j))
#define XB_XSUB(j)  (1280 + 64 * (j))
#define XB_XGEN(j)  (2304 + 64 * (j))
#define XB_TOP      3328
#define XB_TOPGEN   3392
#define XCD_BAR_WORDS 3456
#define XB_SPIN_CAP (1u << 22)
__device__ __forceinline__ unsigned xb_ld(unsigned* p)              { return __hip_atomic_load(p, __ATOMIC_RELAXED, __HIP_MEMORY_SCOPE_AGENT); }
__device__ __forceinline__ unsigned xb_add(unsigned* p, unsigned v) { return __hip_atomic_fetch_add(p, v, __ATOMIC_RELAXED, __HIP_MEMORY_SCOPE_AGENT); }
__device__ __forceinline__ unsigned xb_xcc_id() { return (unsigned)__builtin_amdgcn_s_getreg((3 << 11) | 20) & 0xFu; }
#define XB_SPIN(cond, bar) do { unsigned _sp = 0; while (cond) { __builtin_amdgcn_s_sleep(1); \
    if ((++_sp & 255u) == 0u) { if (xb_ld(&(bar)[XB_TMO])) break; if (_sp > XB_SPIN_CAP) { atomicAdd(&(bar)[XB_TMO], 1u); break; } } } } while (0)
struct XcdBarrier { unsigned* bar; unsigned x; volatile LAS unsigned* st; };
__device__ __forceinline__ XcdBarrier xcd_barrier_post(unsigned* bar, volatile LAS unsigned* st) {
    XcdBarrier b; b.bar = bar; b.x = xb_xcc_id(); b.st = st;
    if (threadIdx.x == 0) st[2] = xb_add(&bar[XB_XCNT(b.x)], 1u);
    return b;
}
__device__ __forceinline__ void xcd_barrier_complete(unsigned* bar, unsigned x, unsigned& nloc, unsigned& nx) {
    const unsigned G = gridDim.x * gridDim.y * gridDim.z;
    unsigned sum, cnt, mine, sp = 0u;
    for (;;) {
        sum = 0u; cnt = 0u; mine = 0u;
#pragma unroll
        for (unsigned j = 0; j < 16; ++j) { const unsigned c = xb_ld(&bar[XB_XCNT(j)]); sum += c; cnt += (c > 0u) ? 1u : 0u; mine = (j == x) ? c : mine; }
        if (sum == G) break;
        __builtin_amdgcn_s_sleep(1);
        if ((++sp & 255u) == 0u) { if (xb_ld(&bar[XB_TMO])) break; if (sp > XB_SPIN_CAP) { atomicAdd(&bar[XB_TMO], 1u); break; } }
    }
    nloc = mine > 0u ? mine : 1u; nx = cnt > 0u ? cnt : 1u;
}
__device__ __forceinline__ void xcd_barrier(const XcdBarrier& b) {
    asm volatile("s_waitcnt vmcnt(0)" ::: "memory");
    __syncthreads();
    if (threadIdx.x == 0) {
        unsigned* bar = b.bar;
        __builtin_amdgcn_s_waitcnt(0);
        unsigned nloc = b.st[0], nx = b.st[1];
        if (nloc == 0u) { xcd_barrier_complete(bar, b.x, nloc, nx); b.st[0] = nloc; b.st[1] = nx; }
        const unsigned old = xb_add(&bar[XB_XSUB(b.x)], 1u);
        const unsigned gen = old / nloc;
        if (old + 1u == (gen + 1u) * nloc) {
            __builtin_amdgcn_fence(__ATOMIC_RELEASE, "agent");
            asm volatile("s_waitcnt vmcnt(0)" ::: "memory");
            const unsigned og = xb_add(&bar[XB_TOP], 1u);
            const unsigned tg = og / nx;
            if (og + 1u == (tg + 1u) * nx) xb_add(&bar[XB_TOPGEN], 1u);
            else XB_SPIN(xb_ld(&bar[XB_TOPGEN]) == tg, bar);
            __builtin_amdgcn_fence(__ATOMIC_ACQUIRE, "agent");
            xb_add(&bar[XB_XGEN(b.x)], 1u);
            asm volatile("s_waitcnt vmcnt(0)" ::: "memory");
        } else {
            XB_SPIN(xb_ld(&bar[XB_XGEN(b.x)]) == gen, bar);
            __builtin_amdgcn_fence(__ATOMIC_ACQUIRE, "agent");
            asm volatile("s_waitcnt vmcnt(0)" ::: "memory");
        }
    }
    __syncthreads();
}

__global__ void __launch_bounds__(512, 2) fwd_megakernel(Params p) {
    extern __shared__ __attribute__((aligned(16))) unsigned char lds_raw[];
    LAS unsigned char* lds = (LAS unsigned char*)lds_raw;
    cg::grid_group grid = cg::this_grid();
    const int G = gridDim.x, bid = blockIdx.x;
    bf16_t* XB = (bf16_t*)(p.ws + WS_XB); ssq_t* SSQ = (ssq_t*)(p.ws + WS_SSQ); float* PART = (float*)(p.ws + WS_PART);
#define IN(k) (p.ph_lo <= (k) && (k) < p.ph_hi)
#define SYNC(k) do { if (p.ph_hi > (k) + 1) xcd_barrier(bar); } while (0)
    unsigned* barw = (unsigned*)(p.ws + WS_BAR);
    volatile LAS unsigned* bst = (volatile LAS unsigned*)(lds + 131072);
    if (threadIdx.x < 4) bst[threadIdx.x] = 0u;
    __syncthreads();
    XcdBarrier bar = xcd_barrier_post(barw, bst);
#ifndef X_NOPREP
    if (IN(0)) prep_phase(p, lds);
    if (p.ph_lo < 0) grid.sync();
    xcd_barrier(bar);
    for (int rep = 0; rep < DUP_SYNC; ++rep) xcd_barrier(bar);
    int vbid = bid;
    { bool okc = (G == 256);
#pragma unroll
      for (int j = 0; j < 16; ++j) { const unsigned cj = xb_ld(&barw[XB_XCNT(j)]); okc = okc && (cj == (j < 8 ? 32u : 0u)); }
      if (okc) vbid = (int)(bar.x + 8u * bst[2]); }
#endif
#pragma unroll 1
    for (int l = 0; l < 4; ++l) {
        const int pb = 1 + 5 * l, i = l >> 1;
        ssq_t* ssq_in = SSQ + (size_t)(2 * l) * MT;
        ssq_t* ssq_mid = SSQ + (size_t)(2 * l + 1) * MT;
        ssq_t* ssq_out = SSQ + (size_t)(2 * l + 2) * MT;
        if ((l & 1) == 0) {
            if (IN(pb) && X_GIN) {
                pg8::Gemm g{XB, (const bf16_t*)(p.ws + WS_WIN) + (size_t)i * DIN * DM, MT, DIN, DM}; pg8::StaticOrder S; S.init(MT, DIN, DM, G, vbid);
                EpiIn E{ssq_in, (bf16_t*)(p.ws + WS_GLU), (bf16_t*)(p.ws + WS_QKV)};
                for (int rep = 0; rep <= DUP_IN; ++rep) { pg8::gemm_phase(lds, g, S, E); SYNC(pb); }
            }
#ifndef X_NOMIX
            if (IN(pb + 1)) { for (int rep = 0; rep <= DUP_MIX; ++rep) { mixer_phase(p, l, lds); SYNC(pb + 1); } }
#endif
            if (IN(pb + 2) && X_GOUT) {
                pg8::Gemm g{(const bf16_t*)(p.ws + WS_CAT), (const bf16_t*)(p.ws + WS_WOUT) + (size_t)i * DM * DM, MT, DM, DM}; pg8::SplitOrder<false> S; S.init2(MT, DM, DM, G, vbid, 4);
                EpiRes<false> E{nullptr, XB, ssq_mid, nullptr, PART};
                pg8::gemm_phase(lds, g, S, E);
                xcd_barrier(bar);
                splitk_reduce(nullptr, XB, ssq_mid, PART, S, 4);
                SYNC(pb + 2);
            }
        } else {
#ifndef X_NOPOOL1
            if (IN(pb)) { for (int rep = 0; rep <= DUP_POOL1; ++rep) { pool1_phase(p, l, ssq_in); SYNC(pb); } }
#endif
            if (IN(pb + 1) && X_GPOOL) {
                pg8::Gemm g{(const bf16_t*)(p.ws + WS_DG), (const bf16_t*)(p.ws + WS_WPL) + (size_t)i * 4 * 65536, 4 * MT, 256, 256}; pg8::PoolOrder S{G, vbid};
                EpiRes<true> E{nullptr, XB, ssq_mid, p.in[I_PSCALE] + i * DM, PART};
                pg8::gemm_phase(lds, g, S, E);
                SYNC(pb + 2);
            }
        }
        if (IN(pb + 3) && X_GGU) {
            pg8::Gemm g{XB, (const bf16_t*)(p.ws + WS_WGU) + (size_t)l * 2 * DFF * DM, MT, 2 * DFF, DM}; pg8::StaticOrder S; S.init(MT, 2 * DFF, DM, G, vbid);
            EpiGU E{ssq_mid, (bf16_t*)(p.ws + WS_ACT)};
            for (int rep = 0; rep <= DUP_GU; ++rep) { pg8::gemm_phase(lds, g, S, E); SYNC(pb + 3); }
        }
        if (IN(pb + 4) && X_GDN) {
            pg8::Gemm g{(const bf16_t*)(p.ws + WS_ACT), (const bf16_t*)(p.ws + WS_WDN) + (size_t)l * DM * DFF, MT, DM, DFF}; pg8::SplitOrder<true> S; S.init2(MT, DM, DFF, G, vbid, 11);
            float* Yout = (l == 3) ? p.out : nullptr;
            EpiRes<false> E{Yout, XB, ssq_out, nullptr, PART};
            pg8::gemm_phase(lds, g, S, E);
            xcd_barrier(bar);
            splitk_reduce(Yout, XB, ssq_out, PART, S, 11);
            SYNC(pb + 4);
        }
    }
#undef IN
#undef SYNC
}

extern "C" void kernel_launch(void* const* d_in, const int* in_sizes, int n_in, void* d_out, int out_size, void* d_ws, size_t ws_size, hipStream_t stream) {
    static int grid_blocks = 0;
    if (grid_blocks == 0) {
        if (n_in != N_IN || ws_size < WS_END) { fprintf(stderr, "kernel_launch: unexpected n_in %d or ws_size %zu (< %zu)\n", n_in, ws_size, (size_t)WS_END); grid_blocks = -1; return; }
        int dev = 0, cus = 0, per_cu = 0;
        hipGetDevice(&dev);
        hipDeviceGetAttribute(&cus, hipDeviceAttributeMultiprocessorCount, dev);
        hipFuncSetAttribute((const void*)fwd_megakernel, hipFuncAttributeMaxDynamicSharedMemorySize, LDS_BYTES);
        hipOccupancyMaxActiveBlocksPerMultiprocessor(&per_cu, (const void*)fwd_megakernel, 512, LDS_BYTES);
        if (per_cu < 1) { fprintf(stderr, "kernel_launch: occupancy query reports %d blocks per CU\n", per_cu); per_cu = 1; }
        grid_blocks = cus * 1;
    }
    if (grid_blocks < 0) return;
    Params p{};
    for (int k = 0; k < N_IN; ++k) p.in[k] = (const float*)d_in[k];
    p.out = (float*)d_out; p.ws = (unsigned char*)d_ws; p.ph_lo = 0; p.ph_hi = N_PHASES;
    void* args[] = {&p};
    if (hipMemsetAsync((unsigned char*)d_ws + WS_BAR, 0, 16384, stream) != hipSuccess) { fprintf(stderr, "kernel_launch: memset of the barrier words failed\n"); return; }
    hipError_t e = hipLaunchCooperativeKernel((const void*)fwd_megakernel, dim3(grid_blocks), dim3(512), args, LDS_BYTES, stream);
    if (e != hipSuccess) fprintf(stderr, "cooperative launch failed: %s (grid %d)\n", hipGetErrorString(e), grid_blocks);
}
```

```cpp
#include <hip/hip_runtime.h>
#include <hip/hip_cooperative_groups.h>
#include <cstdio>
namespace cg = cooperative_groups;

#define LAS __attribute__((address_space(3)))
#ifndef DUP_PREP
#define DUP_PREP 0
#define DUP_IN 0
#define DUP_MIX 0
#define DUP_POOL1 0
#define DUP_GU 0
#define DUP_SYNC 0
#define DUP_DN 0
#endif
#ifndef X_GIN
#define X_GIN 1
#define X_GOUT 1
#define X_GPOOL 1
#define X_GGU 1
#define X_GDN 1
#endif
typedef unsigned short bf16_t;
typedef short bf16x8 __attribute__((ext_vector_type(8)));
typedef float f32x4 __attribute__((ext_vector_type(4)));
typedef unsigned u32x4 __attribute__((ext_vector_type(4)));
typedef unsigned u32x2 __attribute__((ext_vector_type(2)));
typedef float f32x2 __attribute__((ext_vector_type(2)));
typedef unsigned long long ssq_t;

constexpr int DM = 1024, MP = 16384, MS = 1024, MT = 17408, NTM = 68, DFF = 2816, DIN = 1792;
constexpr float RMS_EPS = 1e-6f, LN_EPS = 1e-5f;
enum { I_XP = 0, I_XS, I_CCONV, I_CK, I_CV, I_SPOOL, I_NMIX, I_NFFN, I_WIN, I_QN, I_KN, I_SINK, I_WDW, I_BDW, I_CNG, I_CNB, I_WOUT, I_WPOOL, I_PSCALE, I_WG, I_WU, I_WD, N_IN };
constexpr size_t O_Y = 0;
constexpr size_t O_CONVP = (size_t)MT * DM;
constexpr size_t O_KP = O_CONVP + 2 * 4 * 30 * 512;
constexpr size_t O_VP = O_KP + 2 * 4 * 128 * 128;
constexpr size_t O_POOLP = O_VP + 2 * 4 * 128 * 128;
constexpr size_t O_CONVS = O_POOLP + 2 * 4 * 15 * 1024;
constexpr size_t O_KS = O_CONVS + (size_t)2 * 128 * 30 * 512;
constexpr size_t O_VS = O_KS + (size_t)2 * 128 * 128 * 128;
constexpr size_t O_POOLS = O_VS + (size_t)2 * 128 * 128 * 128;
constexpr size_t WS_WIN = 0;
constexpr size_t WS_WOUT = WS_WIN + (size_t)2 * DIN * DM * 2;
constexpr size_t WS_WGU = WS_WOUT + (size_t)2 * DM * DM * 2;
constexpr size_t WS_WDN = WS_WGU + (size_t)4 * 2 * DFF * DM * 2;
constexpr size_t WS_WPL = WS_WDN + (size_t)4 * DM * DFF * 2;
constexpr size_t WS_XB = WS_WPL + (size_t)2 * 4 * 256 * 256 * 2;
constexpr size_t WS_SSQ = WS_XB + (size_t)MT * DM * 2;
constexpr size_t WS_ACT = WS_SSQ + (size_t)9 * MT * 8;
constexpr size_t WS_QKV = WS_ACT;
constexpr size_t WS_GLU = WS_QKV + (size_t)MT * 768 * 2;
constexpr size_t WS_CAT = WS_GLU + (size_t)MT * 512 * 2;
constexpr size_t WS_DG = WS_ACT;
constexpr size_t WS_BAR = WS_ACT + (size_t)MT * DFF * 2;
constexpr size_t WS_PART = WS_BAR + 16384;
constexpr size_t WS_END = WS_PART + (size_t)176 * 65536 * 4;
constexpr int LDS_BYTES = 131072 + 16;
constexpr int N_PHASES = 21;

struct Params { const float* in[N_IN]; float* out; unsigned char* ws; int ph_lo, ph_hi; };

__device__ __forceinline__ unsigned cvt_pk_bf16(float lo, float hi) { unsigned r; asm("v_cvt_pk_bf16_f32 %0, %1, %2" : "=v"(r) : "v"(lo), "v"(hi)); return r; }
__device__ __forceinline__ float bflo(unsigned w) { return __uint_as_float(w << 16); }
__device__ __forceinline__ float bfhi(unsigned w) { return __uint_as_float(w & 0xffff0000u); }
__device__ __forceinline__ float bf2f(bf16_t b) { return __uint_as_float(((unsigned)b) << 16); }
__device__ __forceinline__ float wave_sum(float v) {
#pragma unroll
    for (int o = 32; o >= 1; o >>= 1) v += __shfl_xor(v, o);
    return v;
}
__device__ __forceinline__ float ssq_rs(ssq_t v) { return rsqrtf((float)v * (1.0f / (1048576.0f * 1024.0f)) + RMS_EPS); }
__device__ __forceinline__ ssq_t ssq_fix(float ss) { return (ssq_t)(ss * 1048576.0f); }
__device__ __forceinline__ void ssq_add(ssq_t* p, float ss) { (void)__hip_atomic_fetch_add(p, ssq_fix(ss), __ATOMIC_RELAXED, __HIP_MEMORY_SCOPE_AGENT); }
__device__ __forceinline__ float fast_sigmoid(float x) { return __builtin_amdgcn_rcpf(1.0f + __expf(-x)); }
__device__ __forceinline__ f32x2 pk_exp2(f32x2 v) { f32x2 r; r.x = __builtin_amdgcn_exp2f(v.x); r.y = __builtin_amdgcn_exp2f(v.y); return r; }
__device__ __forceinline__ f32x2 pk_rcp(f32x2 v) { f32x2 r; r.x = __builtin_amdgcn_rcpf(v.x); r.y = __builtin_amdgcn_rcpf(v.y); return r; }
__device__ __forceinline__ f32x2 pk_sig(f32x2 g, float k2) { return pk_rcp(pk_exp2(g * k2) + 1.0f); }

namespace pg8 {
constexpr int BM = 256, BK = 64, HALF = 128, HTB = HALF * BK * 2, STAGE_BYTES = 8 * HTB, NXCD = 8, WGM = 8;
__host__ __device__ __forceinline__ int lds_byte(int r, int c) { const int st = (r >> 4) * 2 + (c >> 5), rr = r & 15, cc = c & 31, ob = rr * 64 + cc * 2; return st * 1024 + (ob ^ (((ob >> 9) & 1) << 5)); }
__host__ __device__ __forceinline__ void stage_rc(int b, int& R, int& C) { const int st = b / 1024, sb = b % 1024, swz = sb ^ (((sb >> 9) & 1) << 5); R = (st >> 1) * 16 + swz / 64; C = (st & 1) * 32 + (swz % 64) / 2; }
__host__ __device__ __forceinline__ int perm32(int rho) { const int n = rho >> 4, i = rho & 15; return 8 * (i >> 2) + 4 * n + (i & 3); }
struct Unit { int pm, pn, k0, nt, part; };
struct Gemm { const bf16_t* A; const bf16_t* Bt; int M, N, K; };
struct StaticOrder {
    static constexpr bool SPLIT = false, ABLK = false;
    int nM, nN, nwg, G, c, ntk;
    __device__ void init(int M, int N, int K, int G_, int c_) { nM = M / BM; nN = N / BM; nwg = nM * nN; G = G_; c = c_; ntk = K / BK; }
    __device__ void tile(int L, Unit& u) const {
        int wgid = L; { const int q = nwg / NXCD, r = nwg % NXCD, xcd = wgid % NXCD, off = wgid / NXCD; wgid = (xcd < r ? xcd * (q + 1) : r * (q + 1) + (xcd - r) * q) + off; }
        const int nig = WGM * nN, gid = wgid / nig, fm = gid * WGM, gsz = (nM - fm) < WGM ? (nM - fm) : WGM;
        u.pm = fm + ((wgid % nig) % gsz); u.pn = (wgid % nig) / gsz;
    }
    __device__ bool next(int i, Unit& u) const {
        const long L = (long)i * G + c; if (L >= nwg) return false;
        tile((int)L, u); u.k0 = 0; u.nt = ntk; u.part = -1; return true;
    }
};
template <bool ABLK_> struct SplitOrder : StaticOrder {
    static constexpr bool SPLIT = true, ABLK = ABLK_;
    int KS, ntp;
    __device__ void init2(int M, int N, int K, int G_, int c_, int KS_) { init(M, N, K, G_, c_); KS = KS_; ntp = ntk / KS_; }
    __device__ bool next(int i, Unit& u) const {
        const int np = (nwg - G) * KS;
        int j = i;
        if (c < np) { if (i == 0) { tile(G + c / KS, u); u.k0 = (c % KS) * ntp; u.nt = ntp; u.part = c; return true; } j = i - 1; }
        if (j > 0) return false;
        tile(c, u); u.k0 = 0; u.nt = ntk; u.part = -1; return true;
    }
};
struct PoolOrder {
    static constexpr bool SPLIT = false, ABLK = false;
    int G, c;
    __device__ bool next(int i, Unit& u) const { const int L = i * G + c; if (L >= 4 * NTM) return false; u.pm = L; u.pn = L / NTM; u.k0 = 0; u.nt = 4; u.part = -1; return true; }
};

template <class Epi, class Sched>
__device__ __forceinline__ void gemm_phase(LAS unsigned char* lds, const Gemm g, const Sched& S, const Epi& E) {
    int tid = threadIdx.x; asm volatile("" : "+v"(tid));
    const int wid = __builtin_amdgcn_readfirstlane(tid >> 6), lane = tid & 63, wr = wid >> 2, wc = wid & 3, fr = lane & 15, fq = lane >> 4;
    int K = g.K; asm volatile("" : "+s"(K));
    unsigned voffA[2], voffB[2];
#pragma unroll
    for (int i = 0; i < 2; ++i) { int R, C; stage_rc(tid * 16 + i * 8192, R, C); const int Rb = (R & ~31) + perm32(R & 31);
        voffA[i] = Sched::ABLK ? (unsigned)(R * 64 + C) * 2u : (unsigned)(R * K + C) * 2u; voffB[i] = (unsigned)(Rb * K + C) * 2u; }
    const size_t kstep = (size_t)(BK * 2);
    const size_t hstep = (size_t)HALF * K * 2;
    const size_t tstep = 2 * hstep;
    const size_t kstepA = Sched::ABLK ? (size_t)32768 : kstep, hstepA = Sched::ABLK ? (size_t)16384 : hstep;
    const unsigned ldsw = (unsigned)wid * 1024u;
    const int aoff = lds_byte(wr * 64 + fr, fq * 8), boff = lds_byte(wc * 32 + fr, fq * 8);
#define PG8_SA(b, h) (((b) * 2 + (h)) * HTB)
#define PG8_SB(b, h) ((4 + (b) * 2 + (h)) * HTB)
#define PG8_STAGE(bufoff, gbase, voff) do { _Pragma("unroll") for (int _i = 0; _i < 2; ++_i) \
        __builtin_amdgcn_global_load_lds((const unsigned*)((const char*)(gbase) + (voff)[_i]), (LAS unsigned*)(lds + (bufoff) + ldsw + _i * 8192), 16, 0, 0); } while (0)
#define PG8_LDA(dst, b, h) do { _Pragma("unroll") for (int m = 0; m < 4; ++m) _Pragma("unroll") for (int k = 0; k < 2; ++k) dst[m][k] = *(const LAS bf16x8*)(lds + PG8_SA(b, h) + aoff + m * 2048 + k * 1024); } while (0)
#define PG8_LDB(dst, b, h) do { _Pragma("unroll") for (int n = 0; n < 2; ++n) _Pragma("unroll") for (int k = 0; k < 2; ++k) dst[n][k] = *(const LAS bf16x8*)(lds + PG8_SB(b, h) + boff + n * 2048 + k * 1024); } while (0)
#define PG8_MMA(ai, bj, At, Bt) do { __builtin_amdgcn_s_setprio(1); _Pragma("unroll") for (int m = 0; m < 4; ++m) _Pragma("unroll") for (int n = 0; n < 2; ++n) _Pragma("unroll") for (int k = 0; k < 2; ++k) \
        acc[ai][bj][m][n] = __builtin_amdgcn_mfma_f32_16x16x32_bf16(Bt[n][k], At[m][k], acc[ai][bj][m][n], 0, 0, 0); __builtin_amdgcn_s_setprio(0); } while (0)
#define PG8_WAIT_V(n) asm volatile("s_waitcnt vmcnt(" #n ")" ::: "memory")
#define PG8_WAIT_L(n) asm volatile("s_waitcnt lgkmcnt(" #n ")" ::: "memory")
#define PG8_BAR __builtin_amdgcn_s_barrier()
#define PG8_SCHED __builtin_amdgcn_sched_barrier(0)
    Unit cur, nxt; int ui = 0;
    if (!S.next(0, cur)) return;
    f32x4 acc[2][2][4][2];
    E.init(acc, cur, wr, wc, fr, fq);
    bf16x8 At[4][2], B0[2][2], B1[2][2];
    const char* cA = (const char*)g.A + (size_t)cur.pm * tstep; const char* cB = (const char*)g.Bt + (size_t)cur.pn * tstep;
    if constexpr (Sched::SPLIT) { cA += (size_t)cur.k0 * kstepA; cB += (size_t)cur.k0 * kstep; }
    const int ntc = K / BK;
    PG8_STAGE(PG8_SB(0, 0), cB, voffB); PG8_STAGE(PG8_SA(0, 0), cA, voffA); PG8_STAGE(PG8_SB(0, 1), cB + hstep, voffB); PG8_STAGE(PG8_SA(0, 1), cA + hstepA, voffA);
    if (wr == 1) PG8_BAR;
    PG8_WAIT_V(4); PG8_BAR;
    PG8_STAGE(PG8_SB(1, 0), cB + kstep, voffB); PG8_STAGE(PG8_SA(1, 0), cA + kstepA, voffA); PG8_STAGE(PG8_SB(1, 1), cB + hstep + kstep, voffB);
    PG8_WAIT_V(6); PG8_BAR;
    for (;;) {
        const bool has_next = S.next(ui + 1, nxt);
        const char* nA = has_next ? (const char*)g.A + (size_t)nxt.pm * tstep : cA; const char* nB = has_next ? (const char*)g.Bt + (size_t)nxt.pn * tstep : cB;
        if constexpr (Sched::SPLIT) { if (has_next) { nA += (size_t)nxt.k0 * kstepA; nB += (size_t)nxt.k0 * kstep; } }
        const int nt = Sched::SPLIT ? cur.nt : ntc;
        for (int t = 0; t < nt; t += 2) {
            const bool last = (t == nt - 2);
            const char* a1 = cA + (size_t)(t + 1) * kstepA;
            const char* a2 = last ? nA : cA + (size_t)(t + 2) * kstepA; const char* b2 = last ? nB : cB + (size_t)(t + 2) * kstep;
            const char* a3 = a2 + kstepA; const char* b3 = b2 + kstep;
            PG8_LDB(B0, 0, 0); PG8_SCHED; PG8_LDA(At, 0, 0); PG8_STAGE(PG8_SA(1, 1), a1 + hstepA, voffA);
            PG8_WAIT_L(8); PG8_BAR; PG8_WAIT_L(0); PG8_MMA(0, 0, At, B0); PG8_BAR; PG8_SCHED;
            PG8_LDB(B1, 0, 1); PG8_STAGE(PG8_SB(0, 0), b2, voffB);
            PG8_BAR; PG8_WAIT_L(0); PG8_MMA(0, 1, At, B1); PG8_BAR;
            PG8_LDA(At, 0, 1); PG8_STAGE(PG8_SA(0, 0), a2, voffA);
            PG8_BAR; PG8_WAIT_L(0); PG8_MMA(1, 0, At, B0); PG8_BAR; PG8_SCHED;
            PG8_STAGE(PG8_SB(0, 1), b2 + hstep, voffB);
            PG8_WAIT_V(6); PG8_BAR; PG8_MMA(1, 1, At, B1); PG8_BAR;
            PG8_LDB(B0, 1, 0); PG8_SCHED; PG8_LDA(At, 1, 0); PG8_STAGE(PG8_SA(0, 1), a2 + hstepA, voffA);
            PG8_WAIT_L(8); PG8_BAR; PG8_WAIT_L(0); PG8_MMA(0, 0, At, B0); PG8_BAR; PG8_SCHED;
            PG8_LDB(B1, 1, 1); PG8_STAGE(PG8_SB(1, 0), b3, voffB);
            PG8_BAR; PG8_WAIT_L(0); PG8_MMA(0, 1, At, B1); PG8_BAR;
            PG8_LDA(At, 1, 1); PG8_STAGE(PG8_SA(1, 0), a3, voffA);
            PG8_BAR; PG8_WAIT_L(0); PG8_MMA(1, 0, At, B0); PG8_BAR; PG8_SCHED;
            PG8_STAGE(PG8_SB(1, 1), b3 + hstep, voffB);
            PG8_WAIT_V(6); PG8_BAR; PG8_MMA(1, 1, At, B1); PG8_BAR;
        }
        E(acc, cur, wr, wc, fr, fq);
        if (!has_next) break;
        E.init(acc, nxt, wr, wc, fr, fq);
        cur = nxt; cA = nA; cB = nB; ++ui;
    }
    PG8_WAIT_V(0);
    if (wr == 0) PG8_BAR;
    PG8_BAR;
#undef PG8_SA
#undef PG8_SB
#undef PG8_STAGE
#undef PG8_LDA
#undef PG8_LDB
#undef PG8_MMA
#undef PG8_WAIT_V
#undef PG8_WAIT_L
#undef PG8_BAR
#undef PG8_SCHED
}
}

__device__ __forceinline__ void acc_zero(f32x4 (&acc)[2][2][4][2]) {
#pragma unroll
    for (int a = 0; a < 2; ++a)
#pragma unroll
        for (int b = 0; b < 2; ++b)
#pragma unroll
            for (int m = 0; m < 4; ++m)
#pragma unroll
                for (int n = 0; n < 2; ++n) acc[a][b][m][n] = (f32x4){0.f, 0.f, 0.f, 0.f};
}
struct EpiIn {
    const ssq_t* ssq; bf16_t* glu; bf16_t* qkv;
    __device__ __forceinline__ void init(f32x4 (&acc)[2][2][4][2], const pg8::Unit&, int, int, int, int) const { acc_zero(acc); }
    __device__ __forceinline__ void operator()(const f32x4 (&acc)[2][2][4][2], const pg8::Unit& u, int wr, int wc, int fr, int fq) const {
        const int row0 = u.pm * 256 + wr * 64 + fr;
        if (u.pn < 4) {
            const int col0 = u.pn * 128 + wc * 32 + 8 * fq;
#pragma unroll
            for (int ai = 0; ai < 2; ++ai)
#pragma unroll
                for (int m = 0; m < 4; ++m) {
                    const int r = row0 + ai * 128 + m * 16;
                    const float rs = ssq_rs(ssq[r]);
                    const float k2 = rs * -1.4426950408889634f;
                    f32x2 o[4];
#pragma unroll
                    for (int n = 0; n < 2; ++n)
#pragma unroll
                        for (int h = 0; h < 2; ++h) {
                            const f32x2 a = (f32x2){acc[ai][0][m][n][2 * h], acc[ai][0][m][n][2 * h + 1]}, gt = (f32x2){acc[ai][1][m][n][2 * h], acc[ai][1][m][n][2 * h + 1]};
                            o[n * 2 + h] = (a * rs) * pk_sig(gt, k2);
                        }
                    u32x4 w; w.x = cvt_pk_bf16(o[0].x, o[0].y); w.y = cvt_pk_bf16(o[1].x, o[1].y); w.z = cvt_pk_bf16(o[2].x, o[2].y); w.w = cvt_pk_bf16(o[3].x, o[3].y);
                    *(u32x4*)(glu + (size_t)r * 512 + col0) = w;
                }
        } else {
            const int col0 = (u.pn - 4) * 256 + wc * 32 + 8 * fq;
#pragma unroll
            for (int ai = 0; ai < 2; ++ai)
#pragma unroll
                for (int m = 0; m < 4; ++m) {
                    const int r = row0 + ai * 128 + m * 16;
                    const float rs = ssq_rs(ssq[r]);
#pragma unroll
                    for (int bj = 0; bj < 2; ++bj) {
                        const f32x4 v0 = acc[ai][bj][m][0] * rs, v1 = acc[ai][bj][m][1] * rs;
                        u32x4 w; w.x = cvt_pk_bf16(v0[0], v0[1]); w.y = cvt_pk_bf16(v0[2], v0[3]); w.z = cvt_pk_bf16(v1[0], v1[1]); w.w = cvt_pk_bf16(v1[2], v1[3]);
                        *(u32x4*)(qkv + (size_t)r * 768 + col0 + bj * 128) = w;
                    }
                }
        }
    }
};
struct EpiGU {
    const ssq_t* ssq; bf16_t* act;
    __device__ __forceinline__ void init(f32x4 (&acc)[2][2][4][2], const pg8::Unit&, int, int, int, int) const { acc_zero(acc); }
    __device__ __forceinline__ void operator()(const f32x4 (&acc)[2][2][4][2], const pg8::Unit& u, int wr, int wc, int fr, int fq) const {
        const int row0 = u.pm * 256 + wr * 64 + fr, col0 = u.pn * 128 + wc * 32 + 8 * fq;
#pragma unroll
        for (int ai = 0; ai < 2; ++ai)
#pragma unroll
            for (int m = 0; m < 4; ++m) {
                const int r = row0 + ai * 128 + m * 16;
                const float rs = ssq_rs(ssq[r]);
                const float k2 = rs * -1.4426950408889634f, rs2 = rs * rs;
                f32x2 o[4];
#pragma unroll
                for (int n = 0; n < 2; ++n)
#pragma unroll
                    for (int h = 0; h < 2; ++h) {
                        const f32x2 gt = (f32x2){acc[ai][0][m][n][2 * h], acc[ai][0][m][n][2 * h + 1]}, up = (f32x2){acc[ai][1][m][n][2 * h], acc[ai][1][m][n][2 * h + 1]};
                        o[n * 2 + h] = (gt * up) * rs2 * pk_sig(gt, k2);
                    }
                u32x4 w; w.x = cvt_pk_bf16(o[0].x, o[0].y); w.y = cvt_pk_bf16(o[1].x, o[1].y); w.z = cvt_pk_bf16(o[2].x, o[2].y); w.w = cvt_pk_bf16(o[3].x, o[3].y);
                *(u32x4*)(act + (size_t)(r >> 8) * (256 * DFF) + (size_t)(col0 >> 6) * (256 * 64) + (size_t)(r & 255) * 64 + (col0 & 63)) = w;
            }
    }
};
__device__ __forceinline__ void bf8_to_f32(u32x4 w, f32x4& lo, f32x4& hi) { lo = (f32x4){bflo(w.x), bfhi(w.x), bflo(w.y), bfhi(w.y)}; hi = (f32x4){bflo(w.z), bfhi(w.z), bflo(w.w), bfhi(w.w)}; }
template <bool POOL> struct EpiRes {
    float* Y; bf16_t* XB; ssq_t* ssq; const float* cscale; float* part;
    __device__ __forceinline__ void init(f32x4 (&acc)[2][2][4][2], const pg8::Unit& u, int wr, int wc, int fr, int fq) const {
        if (!POOL && u.part >= 0) { acc_zero(acc); return; }
        const int pmr = POOL ? (u.pm % NTM) : u.pm, ct = POOL ? (u.pm / NTM) : u.pn;
        const bf16_t* xq = XB + (size_t)(pmr * 256 + wr * 64 + fr) * DM + ct * 256 + wc * 32 + 8 * fq;
#pragma unroll
        for (int ai = 0; ai < 2; ++ai)
#pragma unroll
            for (int bj = 0; bj < 2; ++bj)
#pragma unroll
                for (int m = 0; m < 4; ++m) bf8_to_f32(*(const u32x4*)(xq + (size_t)(ai * 128 + m * 16) * DM + bj * 128), acc[ai][bj][m][0], acc[ai][bj][m][1]);
        if (POOL) {
            const float* cq = cscale + ct * 256 + wc * 32 + 8 * fq;
#pragma unroll
            for (int bj = 0; bj < 2; ++bj)
#pragma unroll
                for (int n = 0; n < 2; ++n) {
                    const f32x4 cv = *(const f32x4*)(cq + bj * 128 + 4 * n);
                    const f32x4 ic = (f32x4){__builtin_amdgcn_rcpf(cv[0]), __builtin_amdgcn_rcpf(cv[1]), __builtin_amdgcn_rcpf(cv[2]), __builtin_amdgcn_rcpf(cv[3])};
#pragma unroll
                    for (int ai = 0; ai < 2; ++ai)
#pragma unroll
                        for (int m = 0; m < 4; ++m) acc[ai][bj][m][n] = acc[ai][bj][m][n] * ic;
                }
        }
    }
    __device__ __forceinline__ void operator()(const f32x4 (&acc)[2][2][4][2], const pg8::Unit& u, int wr, int wc, int fr, int fq) const {
        if (!POOL && u.part >= 0) {
            float* pp = part + (size_t)u.part * 65536 + (size_t)(((wr * 4 + wc) * 64) + fq * 16 + fr) * 4;
#pragma unroll
            for (int ai = 0; ai < 2; ++ai)
#pragma unroll
                for (int m = 0; m < 4; ++m)
#pragma unroll
                    for (int bj = 0; bj < 2; ++bj)
#pragma unroll
                        for (int n = 0; n < 2; ++n) *(f32x4*)(pp + (size_t)((((ai * 4 + m) * 2 + bj) * 2 + n) * 2048)) = acc[ai][bj][m][n];
            return;
        }
        const int pmr = POOL ? (u.pm % NTM) : u.pm, ct = POOL ? (u.pm / NTM) : u.pn;
        const int row0 = pmr * 256 + wr * 64 + fr, col0 = ct * 256 + wc * 32 + 8 * fq;
#pragma unroll
        for (int ai = 0; ai < 2; ++ai)
#pragma unroll
            for (int m = 0; m < 4; ++m) {
                const int r = row0 + ai * 128 + m * 16;
                bf16_t* bp = XB + (size_t)r * DM + col0;
                float ss = 0.f;
#pragma unroll
                for (int bj = 0; bj < 2; ++bj) {
                    f32x4 v0 = acc[ai][bj][m][0], v1 = acc[ai][bj][m][1];
                    if (POOL) { v0 = v0 * *(const f32x4*)(cscale + col0 + bj * 128); v1 = v1 * *(const f32x4*)(cscale + col0 + bj * 128 + 4); }
                    if (Y) { float* yp = Y + (size_t)r * DM + col0 + bj * 128; *(f32x4*)yp = v0; *(f32x4*)(yp + 4) = v1; continue; }
                    u32x4 w; w.x = cvt_pk_bf16(v0[0], v0[1]); w.y = cvt_pk_bf16(v0[2], v0[3]); w.z = cvt_pk_bf16(v1[0], v1[1]); w.w = cvt_pk_bf16(v1[2], v1[3]);
                    *(u32x4*)(bp + bj * 128) = w;
                    ss += (v0[0] * v0[0] + v0[1] * v0[1]) + (v0[2] * v0[2] + v0[3] * v0[3]) + (v1[0] * v1[0] + v1[1] * v1[1]) + (v1[2] * v1[2] + v1[3] * v1[3]);
                }
                if (Y) continue;
                ss += __shfl_xor(ss, 16); ss += __shfl_xor(ss, 32);
                if (fq == 0) ssq_add(ssq + r, ss);
            }
    }
};

struct WTile { const float* src0; const float* src1; const float* gain; bf16_t* dst; int ld, K, k0, n0m, mode; };
__device__ __forceinline__ void wt_decode(const Params& p, int t, WTile& w) {
    int kt; w.gain = nullptr;
    if (t < 224) { const int i = t / 112, r = t % 112; w.n0m = (r / 16) * 256; kt = r % 16; w.K = 1024; w.ld = DIN; w.mode = (w.n0m < 1024) ? 1 : 0;
        w.src0 = p.in[I_WIN] + (size_t)i * DM * DIN; w.src1 = w.src0; w.gain = p.in[I_NMIX] + (2 * i) * DM; w.dst = (bf16_t*)(p.ws + WS_WIN) + (size_t)i * DIN * DM; }
    else if (t < 352) { t -= 224; const int i = t / 64, r = t % 64; w.n0m = (r / 16) * 256; kt = r % 16; w.K = 1024; w.ld = DM; w.mode = 0;
        w.src0 = p.in[I_WOUT] + (size_t)i * DM * DM; w.src1 = w.src0; w.dst = (bf16_t*)(p.ws + WS_WOUT) + (size_t)i * DM * DM; }
    else if (t < 1760) { t -= 352; const int l = t / 352, r = t % 352; w.n0m = (r / 16) * 256; kt = r % 16; w.K = 1024; w.ld = DFF; w.mode = 2;
        w.src0 = p.in[I_WG] + (size_t)l * DM * DFF; w.src1 = p.in[I_WU] + (size_t)l * DM * DFF; w.gain = p.in[I_NFFN] + l * DM; w.dst = (bf16_t*)(p.ws + WS_WGU) + (size_t)l * 2 * DFF * DM; }
    else if (t < 2464) { t -= 1760; const int l = t / 176, r = t % 176; w.n0m = (r / 44) * 256; kt = r % 44; w.K = DFF; w.ld = DM; w.mode = 0;
        w.src0 = p.in[I_WD] + (size_t)l * DFF * DM; w.src1 = w.src0; w.dst = (bf16_t*)(p.ws + WS_WDN) + (size_t)l * DM * DFF; }
    else { t -= 2464; const int ig = t / 4; w.n0m = 0; kt = t % 4; w.K = 256; w.ld = 256; w.mode = 0;
        w.src0 = p.in[I_WPOOL] + (size_t)ig * 65536; w.src1 = w.src0; w.dst = (bf16_t*)(p.ws + WS_WPL) + (size_t)ig * 65536; }
    w.k0 = kt * 64;
}
__device__ __forceinline__ void wt_load(const WTile& w, int tid, f32x4 (&v)[4][2], float& gs0, float& gs1) {
    const int row = tid >> 4, col4 = (tid & 15) * 4;
    gs0 = w.gain ? w.gain[w.k0 + row] : 1.0f; gs1 = w.gain ? w.gain[w.k0 + row + 32] : 1.0f;
#pragma unroll
    for (int q = 0; q < 4; ++q) {
        const int n0 = w.n0m + 64 * q; int c0 = n0; const float* src = w.src0;
        if (w.mode == 1) { const int pn = n0 / 256, bj = (n0 / 128) & 1, cc = n0 % 128; c0 = bj * 512 + 128 * pn + cc; }
        else if (w.mode == 2) { const int pn = n0 / 256, bj = (n0 / 128) & 1, cc = n0 % 128; c0 = 128 * pn + cc; src = bj ? w.src1 : w.src0; }
        const float* sp = src + (size_t)(w.k0 + row) * w.ld + c0 + col4;
        v[q][0] = *(const f32x4*)sp; v[q][1] = *(const f32x4*)(sp + (size_t)32 * w.ld);
    }
}
__device__ __forceinline__ void prep_phase(const Params& p, LAS unsigned char* lds) {
    int tid = threadIdx.x; asm volatile("" : "+v"(tid));
    const int G = gridDim.x, bid = blockIdx.x, wave = tid >> 6, lane = tid & 63;
    bf16_t* XB = (bf16_t*)(p.ws + WS_XB); ssq_t* SSQ = (ssq_t*)(p.ws + WS_SSQ);
    for (int r0 = bid * 8 + wave; r0 < MT; r0 += G * 16) {
        const int r1 = r0 + G * 8; const bool h1 = r1 < MT; const int r1c = h1 ? r1 : r0;
        const float* s0 = r0 < MP ? p.in[I_XP] + (size_t)r0 * DM : p.in[I_XS] + (size_t)(r0 - MP) * DM;
        const float* s1 = r1c < MP ? p.in[I_XP] + (size_t)r1c * DM : p.in[I_XS] + (size_t)(r1c - MP) * DM;
        f32x4 va[4], vb[4];
#pragma unroll
        for (int q = 0; q < 4; ++q) { va[q] = *(const f32x4*)(s0 + q * 256 + lane * 4); vb[q] = *(const f32x4*)(s1 + q * 256 + lane * 4); }
        float ssa = 0.f, ssb = 0.f;
#pragma unroll
        for (int q = 0; q < 4; ++q) {
            u32x2 w; w.x = cvt_pk_bf16(va[q][0], va[q][1]); w.y = cvt_pk_bf16(va[q][2], va[q][3]);
            *(u32x2*)(XB + (size_t)r0 * DM + q * 256 + lane * 4) = w;
            ssa += (va[q][0] * va[q][0] + va[q][1] * va[q][1]) + (va[q][2] * va[q][2] + va[q][3] * va[q][3]);
            if (h1) {
                u32x2 w2; w2.x = cvt_pk_bf16(vb[q][0], vb[q][1]); w2.y = cvt_pk_bf16(vb[q][2], vb[q][3]);
                *(u32x2*)(XB + (size_t)r1 * DM + q * 256 + lane * 4) = w2;
            }
            ssb += (vb[q][0] * vb[q][0] + vb[q][1] * vb[q][1]) + (vb[q][2] * vb[q][2] + vb[q][3] * vb[q][3]);
        }
        ssa = wave_sum(ssa); ssb = wave_sum(ssb);
        if (lane == 0) { SSQ[r0] = ssq_fix(ssa); if (h1) SSQ[r1] = ssq_fix(ssb); }
    }
    for (int idx = bid * 512 + tid; idx < 8 * MT; idx += G * 512) SSQ[MT + idx] = 0ull;
    LAS float* tile = (LAS float*)lds;
    WTile cur, nxt; f32x4 v[4][2]; float gs0 = 1.f, gs1 = 1.f;
    int t0 = bid;
    if (t0 < 2496) { wt_decode(p, t0, cur); wt_load(cur, tid, v, gs0, gs1); }
    for (; t0 < 2496; t0 += G) {
        __syncthreads();
        {
            const int row = tid >> 4, col4 = (tid & 15) * 4;
#pragma unroll
            for (int q = 0; q < 4; ++q)
#pragma unroll
                for (int h = 0; h < 2; ++h) { LAS float* tp = tile + q * 4160 + (row + 32 * h) * 65 + col4; const float gs = h ? gs1 : gs0;
                    tp[0] = v[q][h][0] * gs; tp[1] = v[q][h][1] * gs; tp[2] = v[q][h][2] * gs; tp[3] = v[q][h][3] * gs; }
        }
        __syncthreads();
        const bool hn = (t0 + G) < 2496;
        if (hn) { wt_decode(p, t0 + G, nxt); wt_load(nxt, tid, v, gs0, gs1); }
        {
            const int n = tid >> 3, kk = (tid & 7) * 8;
#pragma unroll
            for (int q = 0; q < 4; ++q) {
                float e[8];
#pragma unroll
                for (int j = 0; j < 8; ++j) e[j] = tile[q * 4160 + (kk + j) * 65 + n];
                u32x4 w; w.x = cvt_pk_bf16(e[0], e[1]); w.y = cvt_pk_bf16(e[2], e[3]); w.z = cvt_pk_bf16(e[4], e[5]); w.w = cvt_pk_bf16(e[6], e[7]);
                *(u32x4*)(cur.dst + (size_t)(cur.n0m + 64 * q + n) * cur.K + cur.k0 + kk) = w;
            }
        }
        if (hn) cur = nxt;
    }
    __syncthreads();
}

__device__ __forceinline__ f32x4 ld_bf4(const bf16_t* p) { const u32x2 w = *(const u32x2*)p; return (f32x4){bflo(w.x), bfhi(w.x), bflo(w.y), bfhi(w.y)}; }
template <int W>
__device__ __forceinline__ void pool_prompt_strip(const bf16_t* X, const ssq_t* ssq, int row0, int t0, int c, f32x4 gm, bf16_t* dgp, float* outp_seq) {
    constexpr int TT = 16, NR = TT + W - 1;
    f32x4 xr[NR];
    if (t0 >= W - 1) {
        const bf16_t* xp = X + (size_t)(row0 - (W - 1)) * DM + c; asm volatile("" : "+v"(xp));
        const ssq_t* sp = ssq + (row0 - (W - 1)); asm volatile("" : "+v"(sp));
#pragma unroll
        for (int j = 0; j < NR; ++j) { const float rs = ssq_rs(sp[j]); xr[j] = ld_bf4(xp + (size_t)j * DM) * rs * gm; }
    } else {
        int vz; asm volatile("v_mov_b32 %0, 0" : "=v"(vz));
        const bf16_t* xp = X + (size_t)(row0 - t0) * DM + c; const ssq_t* sp = ssq + (row0 - t0);
#pragma unroll
        for (int j = 0; j < NR; ++j) { const int tj = t0 - (W - 1) + j + vz, tc = tj < 0 ? 0 : tj; const float rs = ssq_rs(sp[tc]);
            const f32x4 v = ld_bf4(xp + (size_t)tc * DM) * rs * gm; xr[j] = tj < 0 ? (f32x4){0.f, 0.f, 0.f, 0.f} : v; }
    }
    f32x4 S = (f32x4){0.f, 0.f, 0.f, 0.f};
#pragma unroll
    for (int j = 0; j < W - 1; ++j) S += xr[j];
#pragma unroll
    for (int tt = 0; tt < TT; ++tt) {
        S += xr[tt + W - 1]; if (tt > 0) S -= xr[tt - 1];
        const int t = t0 + tt, cnt = (t + 1 < W) ? (t + 1) : W;
        const f32x4 cur = xr[tt + W - 1], d = S * __builtin_amdgcn_rcpf((float)cnt) - cur;
        u32x2 wv; wv.x = cvt_pk_bf16(d[0], d[1]); wv.y = cvt_pk_bf16(d[2], d[3]);
        *(u32x2*)(dgp + (size_t)tt * 256) = wv;
        if (t >= 4081) *(f32x4*)(outp_seq + (size_t)(t - 4081) * DM) = cur;
    }
}
template <int W>
__device__ __forceinline__ void pool_sample_strip(const bf16_t* X, const ssq_t* ssq, int row0, int c, f32x4 gm, const float* state_seq, bf16_t* dgp, float* outs_seq) {
    constexpr int TT = 8, NR = TT + W - 1;
    f32x4 xr[NR];
    { const float* stp = state_seq + (size_t)(15 - (W - 1)) * DM; asm volatile("" : "+v"(stp));
#pragma unroll
      for (int j = 0; j < W - 1; ++j) xr[j] = *(const f32x4*)(stp + (size_t)j * DM); }
    { const bf16_t* xp = X + (size_t)row0 * DM + c; asm volatile("" : "+v"(xp));
      const ssq_t* sp = ssq + row0;
#pragma unroll
      for (int j = 0; j < TT; ++j) { const float rs = ssq_rs(sp[j]); xr[W - 1 + j] = ld_bf4(xp + (size_t)j * DM) * rs * gm; } }
    f32x4 S = (f32x4){0.f, 0.f, 0.f, 0.f};
#pragma unroll
    for (int j = 0; j < W - 1; ++j) S += xr[j];
#pragma unroll
    for (int tt = 0; tt < TT; ++tt) {
        S += xr[tt + W - 1]; if (tt > 0) S -= xr[tt - 1];
        const f32x4 cur = xr[tt + W - 1], d = S * (1.0f / (float)W) - cur;
        u32x2 wv; wv.x = cvt_pk_bf16(d[0], d[1]); wv.y = cvt_pk_bf16(d[2], d[3]);
        *(u32x2*)(dgp + (size_t)tt * 256) = wv;
        *(f32x4*)(outs_seq + (size_t)(7 + tt) * DM) = cur;
    }
}
__device__ __forceinline__ void pool1_phase(const Params& p, int l, const ssq_t* ssq) {
    int tid = threadIdx.x; asm volatile("" : "+v"(tid));
    const int G = gridDim.x, bid = blockIdx.x, i = l >> 1;
    const bf16_t* X = (const bf16_t*)(p.ws + WS_XB); bf16_t* DG = (bf16_t*)(p.ws + WS_DG);
    const int cq = tid & 255, c = cq * 4, half = tid >> 8, g = __builtin_amdgcn_readfirstlane(cq >> 6);
    const f32x4 gm = *(const f32x4*)(p.in[I_NMIX] + l * DM + c);
    const float* spool = p.in[I_SPOOL] + (size_t)i * 128 * 15 * DM;
    float* outp = p.out + O_POOLP + (size_t)i * 4 * 15 * DM; float* outs = p.out + O_POOLS + (size_t)i * 128 * 15 * DM;
    for (int u = bid; u < MP / 64 + 64; u += G) {
        if (u < MP / 64) {
#pragma unroll 1
            for (int k = 0; k < 2; ++k) {
                const int row0 = u * 64 + k * 32 + half * 16, t0 = row0 & 4095, b = row0 >> 12;
                bf16_t* dgp = DG + ((size_t)g * MT + row0) * 256 + (c - 256 * g); float* op = outp + (size_t)b * 15 * DM + c;
                if (g == 0) pool_prompt_strip<2>(X, ssq, row0, t0, c, gm, dgp, op);
                else if (g == 1) pool_prompt_strip<4>(X, ssq, row0, t0, c, gm, dgp, op);
                else if (g == 2) pool_prompt_strip<8>(X, ssq, row0, t0, c, gm, dgp, op);
                else pool_prompt_strip<16>(X, ssq, row0, t0, c, gm, dgp, op);
            }
        } else {
            const int s0 = (u - MP / 64) * 2;
            {
                const int s = s0 + half, row0 = MP + s * 8;
                bf16_t* dgp = DG + ((size_t)g * MT + row0) * 256 + (c - 256 * g); float* op = outs + (size_t)s * 15 * DM + c; const float* st = spool + (size_t)s * 15 * DM + c;
                if (g == 0) pool_sample_strip<2>(X, ssq, row0, c, gm, st, dgp, op);
                else if (g == 1) pool_sample_strip<4>(X, ssq, row0, c, gm, st, dgp, op);
                else if (g == 2) pool_sample_strip<8>(X, ssq, row0, c, gm, st, dgp, op);
                else pool_sample_strip<16>(X, ssq, row0, c, gm, st, dgp, op);
            }
            for (int idx = tid; idx < 2 * 7 * 256; idx += 512) { const int c4 = (idx & 255) * 4, rr = (idx >> 8) % 7, sl = idx / (7 * 256);
                *(f32x4*)(outs + ((size_t)(s0 + sl) * 15 + rr) * DM + c4) = *(const f32x4*)(spool + ((size_t)(s0 + sl) * 15 + 8 + rr) * DM + c4); }
        }
    }
}

constexpr int KS_STRIDE = 72, VT_STRIDE = 264;

__device__ __forceinline__ void attn_item(const LAS bf16_t* Ks, const LAS bf16_t* Vt, int tile0, int r0, bool first, bool qvalid,
                                          const bf16_t* qptr, const float* qn, float slope, float sink, bf16_t* optr, int fr, int fq) {
    u32x4 raw0 = (u32x4){0u, 0u, 0u, 0u}, raw1 = raw0;
    if (qvalid) { raw0 = *(const u32x4*)(qptr); raw1 = *(const u32x4*)(qptr + 32); }
    float qf[16];
#pragma unroll
    for (int j = 0; j < 4; ++j) { qf[2 * j] = bflo(raw0[j]); qf[2 * j + 1] = bfhi(raw0[j]); qf[8 + 2 * j] = bflo(raw1[j]); qf[8 + 2 * j + 1] = bfhi(raw1[j]); }
    float ss = 0.f;
#pragma unroll
    for (int j = 0; j < 16; ++j) ss += qf[j] * qf[j];
    ss += __shfl_xor(ss, 16); ss += __shfl_xor(ss, 32);
    const float rq = rsqrtf(ss * (1.0f / 64.0f) + RMS_EPS) * 0.125f;
    bf16x8 q0, q1;
    {
        const f32x4 n0 = *(const f32x4*)(qn + fq * 8), n1 = *(const f32x4*)(qn + fq * 8 + 4), n2 = *(const f32x4*)(qn + 32 + fq * 8), n3 = *(const f32x4*)(qn + 32 + fq * 8 + 4);
        u32x4 a, b;
        a.x = cvt_pk_bf16(qf[0] * rq * n0[0], qf[1] * rq * n0[1]); a.y = cvt_pk_bf16(qf[2] * rq * n0[2], qf[3] * rq * n0[3]);
        a.z = cvt_pk_bf16(qf[4] * rq * n1[0], qf[5] * rq * n1[1]); a.w = cvt_pk_bf16(qf[6] * rq * n1[2], qf[7] * rq * n1[3]);
        b.x = cvt_pk_bf16(qf[8] * rq * n2[0], qf[9] * rq * n2[1]); b.y = cvt_pk_bf16(qf[10] * rq * n2[2], qf[11] * rq * n2[3]);
        b.z = cvt_pk_bf16(qf[12] * rq * n3[0], qf[13] * rq * n3[1]); b.w = cvt_pk_bf16(qf[14] * rq * n3[2], qf[15] * rq * n3[3]);
        q0 = __builtin_bit_cast(bf16x8, a); q1 = __builtin_bit_cast(bf16x8, b);
    }
    f32x4 s[9];
#pragma unroll
    for (int T = 0; T < 9; ++T) {
        const LAS bf16_t* kp = Ks + ((tile0 + T) * 16 + fr) * KS_STRIDE + fq * 8;
        const bf16x8 a0 = *(const LAS bf16x8*)(kp), a1 = *(const LAS bf16x8*)(kp + 32);
        f32x4 z = (f32x4){0.f, 0.f, 0.f, 0.f};
        z = __builtin_amdgcn_mfma_f32_16x16x32_bf16(a0, q0, z, 0, 0, 0);
        s[T] = __builtin_amdgcn_mfma_f32_16x16x32_bf16(a1, q1, z, 0, 0, 0);
    }
    __builtin_amdgcn_sched_barrier(0);
    int qi = r0 + fr; asm volatile("" : "+v"(qi));
    const int lim = first ? qi + 1 : 128;
    float mx = sink;
#pragma unroll
    for (int T = 0; T < 9; ++T)
#pragma unroll
        for (int j = 0; j < 4; ++j) {
            const int jk = (tile0 + T) * 16 + 4 * fq + j, dist = 128 + qi - jk;
            const bool valid = (unsigned)dist < (unsigned)lim;
            const float v = valid ? (s[T][j] - slope * (float)dist) : -1e30f;
            s[T][j] = v; mx = fmaxf(mx, v);
        }
    mx = fmaxf(mx, __shfl_xor(mx, 16)); mx = fmaxf(mx, __shfl_xor(mx, 32));
    float sum = 0.f;
#pragma unroll
    for (int T = 0; T < 9; ++T)
#pragma unroll
        for (int j = 0; j < 4; ++j) { const float e = __expf(s[T][j] - mx); s[T][j] = e; sum += e; }
    sum += __shfl_xor(sum, 16); sum += __shfl_xor(sum, 32);
    sum += __expf(sink - mx);
    const float inv = 1.0f / sum;
    __builtin_amdgcn_sched_barrier(0);
    f32x4 o[4];
#pragma unroll
    for (int dt = 0; dt < 4; ++dt) o[dt] = (f32x4){0.f, 0.f, 0.f, 0.f};
#pragma unroll
    for (int pp = 0; pp < 5; ++pp) {
        const int T0 = 2 * pp, T1 = (pp < 4) ? 2 * pp + 1 : 8;
        u32x4 pw;
        pw.x = cvt_pk_bf16(s[T0][0] * inv, s[T0][1] * inv); pw.y = cvt_pk_bf16(s[T0][2] * inv, s[T0][3] * inv);
        if (pp < 4) { pw.z = cvt_pk_bf16(s[T1][0] * inv, s[T1][1] * inv); pw.w = cvt_pk_bf16(s[T1][2] * inv, s[T1][3] * inv); } else { pw.z = 0u; pw.w = 0u; }
        const bf16x8 pf = __builtin_bit_cast(bf16x8, pw);
#pragma unroll
        for (int dt = 0; dt < 4; ++dt) {
            const LAS bf16_t* vp = Vt + (dt * 16 + fr) * VT_STRIDE + 4 * fq;
            const u32x2 v0 = *(const LAS u32x2*)(vp + (tile0 + T0) * 16), v1 = *(const LAS u32x2*)(vp + (tile0 + T1) * 16);
            u32x4 vw; vw.x = v0.x; vw.y = v0.y; vw.z = v1.x; vw.w = v1.y;
            o[dt] = __builtin_amdgcn_mfma_f32_16x16x32_bf16(__builtin_bit_cast(bf16x8, vw), pf, o[dt], 0, 0, 0);
        }
    }
    if (qvalid) {
#pragma unroll
        for (int dt = 0; dt < 4; ++dt) { u32x2 w; w.x = cvt_pk_bf16(o[dt][0], o[dt][1]); w.y = cvt_pk_bf16(o[dt][2], o[dt][3]); *(u32x2*)(optr + dt * 16) = w; }
    }
}

__device__ __forceinline__ void mixer_phase(const Params& p, int l, LAS unsigned char* lds) {
    const int G = gridDim.x, bid = blockIdx.x, i = l >> 1;
    const bf16_t* QKV = (const bf16_t*)(p.ws + WS_QKV); const bf16_t* GLU = (const bf16_t*)(p.ws + WS_GLU); bf16_t* CAT = (bf16_t*)(p.ws + WS_CAT);
    const float* qn = p.in[I_QN] + i * 64; const float* kn = p.in[I_KN] + i * 64; const float* sinks = p.in[I_SINK] + i * 8;
    constexpr int N_PA = 256, N_CV = 640, N_SA = 128;
#define MIX_PRE int tid = threadIdx.x; asm volatile("" : "+v"(tid)); const int wave = tid >> 6, lane = tid & 63, fr = lane & 15, fq = lane >> 4; (void)wave; (void)fr; (void)fq;
    for (int u = bid; u < N_PA; u += G) {
        MIX_PRE
        {
#ifndef X_NOPA
            const int kh = u & 1, blk = (u >> 1) & 31, b = u >> 6;
            const int rowQ0 = b * 4096 + blk * 128, rowK0 = rowQ0 - 128;
            LAS bf16_t* Ks = (LAS bf16_t*)lds; LAS bf16_t* Vt = (LAS bf16_t*)(lds + 256 * KS_STRIDE * 2);
            const int chunk = tid & 7;
            const f32x4 kn0 = *(const f32x4*)(kn + chunk * 8), kn1 = *(const f32x4*)(kn + chunk * 8 + 4);
#pragma unroll 1
            for (int ps = 0; ps < 4; ++ps) {
                const int key = (tid >> 3) + 64 * ps;
                u32x4 kr = (u32x4){0u, 0u, 0u, 0u}, vr = kr;
                const bool have = (blk > 0) || (key >= 128);
                if (have) { const bf16_t* rp = QKV + (size_t)(rowK0 + key) * 768 + 512 + kh * 64 + chunk * 8; kr = *(const u32x4*)rp; vr = *(const u32x4*)(rp + 128); }
                float kf[8], vf[8];
#pragma unroll
                for (int j = 0; j < 4; ++j) { kf[2 * j] = bflo(kr[j]); kf[2 * j + 1] = bfhi(kr[j]); vf[2 * j] = bflo(vr[j]); vf[2 * j + 1] = bfhi(vr[j]); }
                float ss = 0.f;
#pragma unroll
                for (int j = 0; j < 8; ++j) ss += kf[j] * kf[j];
                ss += __shfl_xor(ss, 1); ss += __shfl_xor(ss, 2); ss += __shfl_xor(ss, 4);
                const float rk = rsqrtf(ss * (1.0f / 64.0f) + RMS_EPS);
#pragma unroll
                for (int j = 0; j < 4; ++j) { kf[j] *= rk * kn0[j]; kf[4 + j] *= rk * kn1[j]; }
                u32x4 kw; kw.x = cvt_pk_bf16(kf[0], kf[1]); kw.y = cvt_pk_bf16(kf[2], kf[3]); kw.z = cvt_pk_bf16(kf[4], kf[5]); kw.w = cvt_pk_bf16(kf[6], kf[7]);
                *(LAS u32x4*)(Ks + key * KS_STRIDE + chunk * 8) = kw;
#pragma unroll
                for (int j = 0; j < 4; ++j) { Vt[(chunk * 8 + 2 * j) * VT_STRIDE + key] = (bf16_t)(vr[j] & 0xffffu); Vt[(chunk * 8 + 2 * j + 1) * VT_STRIDE + key] = (bf16_t)(vr[j] >> 16); }
                if (blk == 31 && key >= 128) {
                    float* ko = p.out + O_KP + ((((size_t)i * 4 + b) * 128 + (key - 128)) * 2 + kh) * 64 + chunk * 8;
                    float* vo = p.out + O_VP + ((((size_t)i * 4 + b) * 128 + (key - 128)) * 2 + kh) * 64 + chunk * 8;
                    *(f32x4*)ko = (f32x4){kf[0], kf[1], kf[2], kf[3]}; *(f32x4*)(ko + 4) = (f32x4){kf[4], kf[5], kf[6], kf[7]};
                    *(f32x4*)vo = (f32x4){vf[0], vf[1], vf[2], vf[3]}; *(f32x4*)(vo + 4) = (f32x4){vf[4], vf[5], vf[6], vf[7]};
                }
            }
            __syncthreads();
            const int r0 = wave * 16;
#pragma unroll 1
            for (int g = 0; g < 4; ++g) {
                const int h = kh * 4 + g;
                const float slope = exp2f(-(float)(h + 1)), sink = sinks[h];
                const size_t row = (size_t)(rowQ0 + r0 + fr);
                attn_item(Ks, Vt, wave, r0, blk == 0, true, QKV + row * 768 + h * 64 + fq * 8, qn, slope, sink, CAT + row * DM + 512 + h * 64 + 4 * fq, fr, fq);
            }
            __syncthreads();
#endif
        }
    }
#ifndef X_NOCV
    f32x2 wdw[31]; f32x2 bias;
    { int t0 = threadIdx.x; asm volatile("" : "+v"(t0)); const int c0 = (t0 & 255) * 2;
      const float* wp = p.in[I_WDW] + (size_t)i * 31 * 512 + c0; asm volatile("" : "+v"(wp));
#pragma unroll
      for (int j = 0; j < 31; ++j) { wdw[j] = *(const f32x2*)wp; wp += 512; asm volatile("" : "+v"(wp)); }
      bias = *(const f32x2*)(p.in[I_BDW] + i * 512 + c0); }
    for (int cu = bid; cu < N_CV; cu += G) {
        MIX_PRE
        {
            const int c2 = tid & 255, half = tid >> 8, c = c2 * 2; const bool prm = cu < 512;
            LAS float* ybuf = (LAS float*)lds;
            if (prm && ((cu & 127) * 32 + half * 16) >= 30) {
                const int b = cu >> 7, tb0 = (cu & 127) * 32 + half * 16;
                unsigned raw[46];
                { const bf16_t* gp = GLU + ((size_t)b * 4096 + tb0 - 30) * 512 + c; asm volatile("" : "+v"(gp));
#pragma unroll
                  for (int j = 0; j < 46; ++j) { raw[j] = *(const unsigned*)gp; gp += 512; asm volatile("" : "+v"(gp)); } }
                if (tb0 >= 4064) {
                    float* oc = p.out + O_CONVP + (((size_t)i * 4 + b) * 30) * 512 + c; asm volatile("" : "+v"(oc));
#pragma unroll
                    for (int j = 0; j < 16; ++j) { const int t = tb0 + j; if (t >= 4066) *(f32x2*)(oc + (size_t)(t - 4066) * 512) = (f32x2){bflo(raw[30 + j]), bfhi(raw[30 + j])}; }
                }
#pragma unroll
                for (int q = 0; q < 2; ++q) {
                    f32x2 win[38];
#pragma unroll
                    for (int j = 0; j < 38; ++j) win[j] = (f32x2){bflo(raw[q * 8 + j]), bfhi(raw[q * 8 + j])};
#pragma unroll
                    for (int t = 0; t < 8; ++t) {
                        f32x2 y = bias;
#pragma unroll
                        for (int j = 0; j < 31; ++j) y += wdw[j] * win[t + j];
                        *(LAS f32x2*)(ybuf + (half * 16 + q * 8 + t) * 512 + c) = y;
                    }
                    __builtin_amdgcn_sched_barrier(0);
                }
            } else if (prm) {
#pragma unroll 1
                for (int q = 0; q < 2; ++q) {
                    const int b = cu >> 7, tl = half * 16 + q * 8, tb = (cu & 127) * 32 + tl;
                    f32x2 win[38];
                    {
                        int vz; asm volatile("v_mov_b32 %0, 0" : "=v"(vz));
                        const bf16_t* gp = GLU + (size_t)b * 4096 * 512 + c; asm volatile("" : "+v"(gp));
#pragma unroll
                        for (int j = 0; j < 38; ++j) { const int tj = tb - 30 + j + vz; const unsigned w = *(const unsigned*)gp; if (tj >= 0) gp += 512; asm volatile("" : "+v"(gp));
                            win[j] = tj < 0 ? (f32x2){0.f, 0.f} : (f32x2){bflo(w), bfhi(w)}; }
                    }
#pragma unroll
                    for (int t = 0; t < 8; ++t) {
                        f32x2 y = bias;
#pragma unroll
                        for (int j = 0; j < 31; ++j) y += wdw[j] * win[t + j];
                        *(LAS f32x2*)(ybuf + (tl + t) * 512 + c) = y;
                    }
                }
            } else {
                const int sq = cu - 512;
                f32x2 win[34];
                const float* cc = p.in[I_CCONV] + (((size_t)i * 128 + sq) * 30 + half * 4) * 512 + c; asm volatile("" : "+v"(cc));
                const bf16_t* gs = GLU + ((size_t)MP + sq * 8) * 512 + c; asm volatile("" : "+v"(gs));
                float* oc = p.out + O_CONVS + (((size_t)i * 128 + sq) * 30 + half * 15) * 512 + c; asm volatile("" : "+v"(oc));
                if (half == 0) {
#pragma unroll
                    for (int j = 0; j < 30; ++j) { win[j] = *(const f32x2*)cc; cc += 512; asm volatile("" : "+v"(cc)); }
#pragma unroll
                    for (int j = 0; j < 4; ++j) { const unsigned w = *(const unsigned*)gs; gs += 512; asm volatile("" : "+v"(gs)); win[30 + j] = (f32x2){bflo(w), bfhi(w)}; }
#pragma unroll
                    for (int j = 0; j < 15; ++j) { *(f32x2*)oc = win[8 + j]; oc += 512; asm volatile("" : "+v"(oc)); }
                } else {
#pragma unroll
                    for (int j = 0; j < 26; ++j) { win[j] = *(const f32x2*)cc; cc += 512; asm volatile("" : "+v"(cc)); }
#pragma unroll
                    for (int j = 0; j < 8; ++j) { const unsigned w = *(const unsigned*)gs; gs += 512; asm volatile("" : "+v"(gs)); win[26 + j] = (f32x2){bflo(w), bfhi(w)}; }
#pragma unroll
                    for (int j = 0; j < 15; ++j) { *(f32x2*)oc = win[19 + j]; oc += 512; asm volatile("" : "+v"(oc)); }
                }
#pragma unroll
                for (int t = 0; t < 4; ++t) {
                    f32x2 y = bias;
#pragma unroll
                    for (int j = 0; j < 31; ++j) y += wdw[j] * win[t + j];
                    *(LAS f32x2*)(ybuf + (half * 4 + t) * 512 + c) = y;
                }
            }
            __syncthreads();
            {
                const float* gp = p.in[I_CNG] + i * 512 + lane * 8; const float* bp = p.in[I_CNB] + i * 512 + lane * 8;
                const f32x4 g0 = *(const f32x4*)gp, g1 = *(const f32x4*)(gp + 4), b0 = *(const f32x4*)bp, b1 = *(const f32x4*)(bp + 4);
#pragma unroll 1
                for (int q = 0; q < (prm ? 4 : 1); ++q) {
                    const int tk = prm ? wave * 4 + q : wave; const size_t row = prm ? (size_t)cu * 32 + tk : (size_t)MP + (size_t)(cu - 512) * 8 + tk;
                    const f32x4 v0 = *(const LAS f32x4*)(ybuf + tk * 512 + lane * 8), v1 = *(const LAS f32x4*)(ybuf + tk * 512 + lane * 8 + 4);
                    const float mean = wave_sum((v0[0] + v0[1]) + (v0[2] + v0[3]) + (v1[0] + v1[1]) + (v1[2] + v1[3])) * (1.0f / 512.0f);
                    const f32x4 d0 = v0 - mean, d1 = v1 - mean;
                    const float var = wave_sum((d0[0] * d0[0] + d0[1] * d0[1]) + (d0[2] * d0[2] + d0[3] * d0[3]) + (d1[0] * d1[0] + d1[1] * d1[1]) + (d1[2] * d1[2] + d1[3] * d1[3])) * (1.0f / 512.0f);
                    const float rs = rsqrtf(var + LN_EPS);
                    f32x4 o0 = d0 * rs * g0 + b0, o1 = d1 * rs * g1 + b1;
#pragma unroll
                    for (int j = 0; j < 4; ++j) { o0[j] = o0[j] * fast_sigmoid(o0[j]); o1[j] = o1[j] * fast_sigmoid(o1[j]); }
                    u32x4 w; w.x = cvt_pk_bf16(o0[0], o0[1]); w.y = cvt_pk_bf16(o0[2], o0[3]); w.z = cvt_pk_bf16(o1[0], o1[1]); w.w = cvt_pk_bf16(o1[2], o1[3]);
                    *(u32x4*)(CAT + row * DM + lane * 8) = w;
                }
            }
            __syncthreads();
        }
    }
#endif
    for (int s = bid - 128; s < N_SA; s += G) {
        if (s < 0) continue;
        MIX_PRE
        {
#ifndef X_NOSA
            LAS bf16_t* Ks = (LAS bf16_t*)lds; LAS bf16_t* Vt = (LAS bf16_t*)(lds + 2 * 144 * KS_STRIDE * 2);
            const int chunk = tid & 7;
            const f32x4 kn0 = *(const f32x4*)(kn + chunk * 8), kn1 = *(const f32x4*)(kn + chunk * 8 + 4);
#pragma unroll 1
            for (int it = tid; it < 2 * 144 * 8; it += 512) {
                const int kk = it >> 3, kh = kk / 144, key = kk % 144;
                float kf[8], vf[8];
#pragma unroll
                for (int j = 0; j < 8; ++j) { kf[j] = 0.f; vf[j] = 0.f; }
                const bool isnew = (key >= 128) && (key < 136);
                if (key < 128) {
                    const size_t off = ((((size_t)i * 128 + s) * 128 + key) * 2 + kh) * 64 + chunk * 8;
                    const f32x4 a0 = *(const f32x4*)(p.in[I_CK] + off), a1 = *(const f32x4*)(p.in[I_CK] + off + 4), c0 = *(const f32x4*)(p.in[I_CV] + off), c1 = *(const f32x4*)(p.in[I_CV] + off + 4);
#pragma unroll
                    for (int j = 0; j < 4; ++j) { kf[j] = a0[j]; kf[4 + j] = a1[j]; vf[j] = c0[j]; vf[4 + j] = c1[j]; }
                } else if (isnew) {
                    const bf16_t* rp = QKV + ((size_t)MP + s * 8 + (key - 128)) * 768 + 512 + kh * 64 + chunk * 8;
                    const u32x4 kr = *(const u32x4*)rp, vr = *(const u32x4*)(rp + 128);
#pragma unroll
                    for (int j = 0; j < 4; ++j) { kf[2 * j] = bflo(kr[j]); kf[2 * j + 1] = bfhi(kr[j]); vf[2 * j] = bflo(vr[j]); vf[2 * j + 1] = bfhi(vr[j]); }
                }
                float ss = 0.f;
#pragma unroll
                for (int j = 0; j < 8; ++j) ss += kf[j] * kf[j];
                ss += __shfl_xor(ss, 1); ss += __shfl_xor(ss, 2); ss += __shfl_xor(ss, 4);
                const float rk = rsqrtf(ss * (1.0f / 64.0f) + RMS_EPS);
                if (isnew) {
#pragma unroll
                    for (int j = 0; j < 4; ++j) { kf[j] *= rk * kn0[j]; kf[4 + j] *= rk * kn1[j]; }
                }
                u32x4 kw; kw.x = cvt_pk_bf16(kf[0], kf[1]); kw.y = cvt_pk_bf16(kf[2], kf[3]); kw.z = cvt_pk_bf16(kf[4], kf[5]); kw.w = cvt_pk_bf16(kf[6], kf[7]);
                *(LAS u32x4*)(Ks + (kh * 144 + key) * KS_STRIDE + chunk * 8) = kw;
                u32x4 vw; vw.x = cvt_pk_bf16(vf[0], vf[1]); vw.y = cvt_pk_bf16(vf[2], vf[3]); vw.z = cvt_pk_bf16(vf[4], vf[5]); vw.w = cvt_pk_bf16(vf[6], vf[7]);
#pragma unroll
                for (int j = 0; j < 4; ++j) { Vt[(kh * 64 + chunk * 8 + 2 * j) * VT_STRIDE + key] = (bf16_t)(vw[j] & 0xffffu); Vt[(kh * 64 + chunk * 8 + 2 * j + 1) * VT_STRIDE + key] = (bf16_t)(vw[j] >> 16); }
                if (key >= 8 && key < 136) {
                    const size_t oo = ((((size_t)i * 128 + s) * 128 + (key - 8)) * 2 + kh) * 64 + chunk * 8;
                    float* ko = p.out + O_KS + oo; float* vo = p.out + O_VS + oo;
                    *(f32x4*)ko = (f32x4){kf[0], kf[1], kf[2], kf[3]}; *(f32x4*)(ko + 4) = (f32x4){kf[4], kf[5], kf[6], kf[7]};
                    *(f32x4*)vo = (f32x4){vf[0], vf[1], vf[2], vf[3]}; *(f32x4*)(vo + 4) = (f32x4){vf[4], vf[5], vf[6], vf[7]};
                }
            }
            __syncthreads();
            {
                const int kh = wave >> 2, g = wave & 3, h = kh * 4 + g;
                const float slope = exp2f(-(float)(h + 1)), sink = sinks[h];
                const size_t row = (size_t)MP + s * 8 + (fr & 7);
                attn_item(Ks + kh * 144 * KS_STRIDE, Vt + kh * 64 * VT_STRIDE, 0, 0, false, fr < 8, QKV + row * 768 + h * 64 + fq * 8, qn, slope, sink, CAT + row * DM + 512 + h * 64 + 4 * fq, fr, fq);
            }
            __syncthreads();
#endif
        }
    }
}


__device__ __forceinline__ void splitk_reduce(float* Y, bf16_t* XB, ssq_t* ssq, const float* part, const pg8::StaticOrder& S, int KS) {
    int tid = threadIdx.x; asm volatile("" : "+v"(tid));
    const int wid = tid >> 6, lane = tid & 63, wr = wid >> 2, wc = wid & 3, fr = lane & 15, fq = lane >> 4;
    for (int task = blockIdx.x; task < 256; task += gridDim.x) {
        const int e = task >> 4, ai = (task >> 3) & 1, m = (task >> 1) & 3, bj = task & 1;
        pg8::Unit u; S.tile(256 + e, u);
        const float* pp = part + (size_t)(e * KS) * 65536 + (size_t)((((ai * 4 + m) * 2 + bj) * 2) * 2048) + (size_t)tid * 4;
        f32x4 a0 = (f32x4){0.f, 0.f, 0.f, 0.f}, a1 = a0;
        for (int k = 0; k < KS; ++k) { a0 += *(const f32x4*)(pp + (size_t)k * 65536); a1 += *(const f32x4*)(pp + (size_t)k * 65536 + 2048); }
        const int r = u.pm * 256 + ai * 128 + wr * 64 + m * 16 + fr, col = u.pn * 256 + bj * 128 + wc * 32 + 8 * fq;
        bf16_t* bp = XB + (size_t)r * DM + col;
        f32x4 x0, x1; bf8_to_f32(*(const u32x4*)bp, x0, x1);
        const f32x4 v0 = x0 + a0, v1 = x1 + a1;
        if (Y) { float* yp = Y + (size_t)r * DM + col; *(f32x4*)yp = v0; *(f32x4*)(yp + 4) = v1; continue; }
        u32x4 w; w.x = cvt_pk_bf16(v0[0], v0[1]); w.y = cvt_pk_bf16(v0[2], v0[3]); w.z = cvt_pk_bf16(v1[0], v1[1]); w.w = cvt_pk_bf16(v1[2], v1[3]);
        *(u32x4*)bp = w;
        float ss = (v0[0] * v0[0] + v0[1] * v0[1]) + (v0[2] * v0[2] + v0[3] * v0[3]) + (v1[0] * v1[0] + v1[1] * v1[1]) + (v1[2] * v1[2] + v1[3] * v1[3]);
        ss += __shfl_xor(ss, 16); ss += __shfl_xor(ss, 32);
        if (fq == 0) ssq_add(ssq + r, ss);
    }
}

#define XB_TMO      128
#define XB_XCNT(j)  (256  + 64 * (j))
#define XB_XSUB(j)  (1280 + 64 * (j))
#define XB_XGEN(j)  (2304 + 64 * (j))
#define XB_TOP      3328
#define XB_TOPGEN   3392
#define XCD_BAR_WORDS 3456
#define XB_SPIN_CAP (1u << 22)
__device__ __forceinline__ unsigned xb_ld(unsigned* p)              { return __hip_atomic_load(p, __ATOMIC_RELAXED, __HIP_MEMORY_SCOPE_AGENT); }
__device__ __forceinline__ unsigned xb_add(unsigned* p, unsigned v) { return __hip_atomic_fetch_add(p, v, __ATOMIC_RELAXED, __HIP_MEMORY_SCOPE_AGENT); }
__device__ __forceinline__ unsigned xb_xcc_id() { return (unsigned)__builtin_amdgcn_s_getreg((3 << 11) | 20) & 0xFu; }
#define XB_SPIN(cond, bar) do { unsigned _sp = 0; while (cond) { __builtin_amdgcn_s_sleep(1); \
    if ((++_sp & 255u) == 0u) { if (xb_ld(&(bar)[XB_TMO])) break; if (_sp > XB_SPIN_CAP) { atomicAdd(&(bar)[XB_TMO], 1u); break; } } } } while (0)
struct XcdBarrier { unsigned* bar; unsigned x; volatile LAS unsigned* st; };
__device__ __forceinline__ XcdBarrier xcd_barrier_post(unsigned* bar, volatile LAS unsigned* st) {
    XcdBarrier b; b.bar = bar; b.x = xb_xcc_id(); b.st = st;
    if (threadIdx.x == 0) st[2] = xb_add(&bar[XB_XCNT(b.x)], 1u);
    return b;
}
__device__ __forceinline__ void xcd_barrier_complete(unsigned* bar, unsigned x, unsigned& nloc, unsigned& nx) {
    const unsigned G = gridDim.x * gridDim.y * gridDim.z;
    unsigned sum, cnt, mine, sp = 0u;
    for (;;) {
        sum = 0u; cnt = 0u; mine = 0u;
#pragma unroll
        for (unsigned j = 0; j < 16; ++j) { const unsigned c = xb_ld(&bar[XB_XCNT(j)]); sum += c; cnt += (c > 0u) ? 1u : 0u; mine = (j == x) ? c : mine; }
        if (sum == G) break;
        __builtin_amdgcn_s_sleep(1);
        if ((++sp & 255u) == 0u) { if (xb_ld(&bar[XB_TMO])) break; if (sp > XB_SPIN_CAP) { atomicAdd(&bar[XB_TMO], 1u); break; } }
    }
    nloc = mine > 0u ? mine : 1u; nx = cnt > 0u ? cnt : 1u;
}
__device__ __forceinline__ void xcd_barrier(const XcdBarrier& b) {
    asm volatile("s_waitcnt vmcnt(0)" ::: "memory");
    __syncthreads();
    if (threadIdx.x == 0) {
        unsigned* bar = b.bar;
        __builtin_amdgcn_s_waitcnt(0);
        unsigned nloc = b.st[0], nx = b.st[1];
        if (nloc == 0u) { xcd_barrier_complete(bar, b.x, nloc, nx); b.st[0] = nloc; b.st[1] = nx; }
        const unsigned old = xb_add(&bar[XB_XSUB(b.x)], 1u);
        const unsigned gen = old / nloc;
        if (old + 1u == (gen + 1u) * nloc) {
            __builtin_amdgcn_fence(__ATOMIC_RELEASE, "agent");
            asm volatile("s_waitcnt vmcnt(0)" ::: "memory");
            const unsigned og = xb_add(&bar[XB_TOP], 1u);
            const unsigned tg = og / nx;
            if (og + 1u == (tg + 1u) * nx) xb_add(&bar[XB_TOPGEN], 1u);
            else XB_SPIN(xb_ld(&bar[XB_TOPGEN]) == tg, bar);
            __builtin_amdgcn_fence(__ATOMIC_ACQUIRE, "agent");
            xb_add(&bar[XB_XGEN(b.x)], 1u);
            asm volatile("s_waitcnt vmcnt(0)" ::: "memory");
        } else {
            XB_SPIN(xb_ld(&bar[XB_XGEN(b.x)]) == gen, bar);
            __builtin_amdgcn_fence(__ATOMIC_ACQUIRE, "agent");
            asm volatile("s_waitcnt vmcnt(0)" ::: "memory");
        }
    }
    __syncthreads();
}

__global__ void __launch_bounds__(512, 2) fwd_megakernel(Params p) {
    extern __shared__ __attribute__((aligned(16))) unsigned char lds_raw[];
    LAS unsigned char* lds = (LAS unsigned char*)lds_raw;
    cg::grid_group grid = cg::this_grid();
    const int G = gridDim.x, bid = blockIdx.x;
    bf16_t* XB = (bf16_t*)(p.ws + WS_XB); ssq_t* SSQ = (ssq_t*)(p.ws + WS_SSQ); float* PART = (float*)(p.ws + WS_PART);
#define IN(k) (p.ph_lo <= (k) && (k) < p.ph_hi)
#define SYNC(k) do { if (p.ph_hi > (k) + 1) xcd_barrier(bar); } while (0)
    unsigned* barw = (unsigned*)(p.ws + WS_BAR);
    volatile LAS unsigned* bst = (volatile LAS unsigned*)(lds + 131072);
    if (threadIdx.x < 4) bst[threadIdx.x] = 0u;
    __syncthreads();
    XcdBarrier bar = xcd_barrier_post(barw, bst);
#ifndef X_NOPREP
    if (IN(0)) prep_phase(p, lds);
    if (p.ph_lo < 0) grid.sync();
    xcd_barrier(bar);
    for (int rep = 0; rep < DUP_SYNC; ++rep) xcd_barrier(bar);
    int vbid = bid;
    { bool okc = (G == 256);
#pragma unroll
      for (int j = 0; j < 16; ++j) { const unsigned cj = xb_ld(&barw[XB_XCNT(j)]); okc = okc && (cj == (j < 8 ? 32u : 0u)); }
      if (okc) vbid = (int)(bar.x + 8u * bst[2]); }
#endif
#pragma unroll 1
    for (int l = 0; l < 4; ++l) {
        const int pb = 1 + 5 * l, i = l >> 1;
        ssq_t* ssq_in = SSQ + (size_t)(2 * l) * MT;
        ssq_t* ssq_mid = SSQ + (size_t)(2 * l + 1) * MT;
        ssq_t* ssq_out = SSQ + (size_t)(2 * l + 2) * MT;
        if ((l & 1) == 0) {
            if (IN(pb) && X_GIN) {
                pg8::Gemm g{XB, (const bf16_t*)(p.ws + WS_WIN) + (size_t)i * DIN * DM, MT, DIN, DM}; pg8::StaticOrder S; S.init(MT, DIN, DM, G, vbid);
                EpiIn E{ssq_in, (bf16_t*)(p.ws + WS_GLU), (bf16_t*)(p.ws + WS_QKV)};
                for (int rep = 0; rep <= DUP_IN; ++rep) { pg8::gemm_phase(lds, g, S, E); SYNC(pb); }
            }
#ifndef X_NOMIX
            if (IN(pb + 1)) { for (int rep = 0; rep <= DUP_MIX; ++rep) { mixer_phase(p, l, lds); SYNC(pb + 1); } }
#endif
            if (IN(pb + 2) && X_GOUT) {
                pg8::Gemm g{(const bf16_t*)(p.ws + WS_CAT), (const bf16_t*)(p.ws + WS_WOUT) + (size_t)i * DM * DM, MT, DM, DM}; pg8::SplitOrder<false> S; S.init2(MT, DM, DM, G, vbid, 4);
                EpiRes<false> E{nullptr, XB, ssq_mid, nullptr, PART};
                pg8::gemm_phase(lds, g, S, E);
                xcd_barrier(bar);
                splitk_reduce(nullptr, XB, ssq_mid, PART, S, 4);
                SYNC(pb + 2);
            }
        } else {
#ifndef X_NOPOOL1
            if (IN(pb)) { for (int rep = 0; rep <= DUP_POOL1; ++rep) { pool1_phase(p, l, ssq_in); SYNC(pb); } }
#endif
            if (IN(pb + 1) && X_GPOOL) {
                pg8::Gemm g{(const bf16_t*)(p.ws + WS_DG), (const bf16_t*)(p.ws + WS_WPL) + (size_t)i * 4 * 65536, 4 * MT, 256, 256}; pg8::PoolOrder S{G, vbid};
                EpiRes<true> E{nullptr, XB, ssq_mid, p.in[I_PSCALE] + i * DM, PART};
                pg8::gemm_phase(lds, g, S, E);
                SYNC(pb + 2);
            }
        }
        if (IN(pb + 3) && X_GGU) {
            pg8::Gemm g{XB, (const bf16_t*)(p.ws + WS_WGU) + (size_t)l * 2 * DFF * DM, MT, 2 * DFF, DM}; pg8::StaticOrder S; S.init(MT, 2 * DFF, DM, G, vbid);
            EpiGU E{ssq_mid, (bf16_t*)(p.ws + WS_ACT)};
            for (int rep = 0; rep <= DUP_GU; ++rep) { pg8::gemm_phase(lds, g, S, E); SYNC(pb + 3); }
        }
        if (IN(pb + 4) && X_GDN) {
            pg8::Gemm g{(const bf16_t*)(p.ws + WS_ACT), (const bf16_t*)(p.ws + WS_WDN) + (size_t)l * DM * DFF, MT, DM, DFF}; pg8::SplitOrder<true> S; S.init2(MT, DM, DFF, G, vbid, 11);
            float* Yout = (l == 3) ? p.out : nullptr;
            EpiRes<false> E{Yout, XB, ssq_out, nullptr, PART};
            pg8::gemm_phase(lds, g, S, E);
            xcd_barrier(bar);
            splitk_reduce(Yout, XB, ssq_out, PART, S, 11);
            SYNC(pb + 4);
        }
    }
#undef IN
#undef SYNC
}

extern "C" void kernel_launch(void* const* d_in, const int* in_sizes, int n_in, void* d_out, int out_size, void* d_ws, size_t ws_size, hipStream_t stream) {
    static int grid_blocks = 0;
    if (grid_blocks == 0) {
        if (n_in != N_IN || ws_size < WS_END) { fprintf(stderr, "kernel_launch: unexpected n_in %d or ws_size %zu (< %zu)\n", n_in, ws_size, (size_t)WS_END); grid_blocks = -1; return; }
        int dev = 0, cus = 0, per_cu = 0;
        hipGetDevice(&dev);
        hipDeviceGetAttribute(&cus, hipDeviceAttributeMultiprocessorCount, dev);
        hipFuncSetAttribute((const void*)fwd_megakernel, hipFuncAttributeMaxDynamicSharedMemorySize, LDS_BYTES);
        hipOccupancyMaxActiveBlocksPerMultiprocessor(&per_cu, (const void*)fwd_megakernel, 512, LDS_BYTES);
        if (per_cu < 1) { fprintf(stderr, "kernel_launch: occupancy query reports %d blocks per CU\n", per_cu); per_cu = 1; }
        grid_blocks = cus * 1;
    }
    if (grid_blocks < 0) return;
    Params p{};
    for (int k = 0; k < N_IN; ++k) p.in[k] = (const float*)d_in[k];
    p.out = (float*)d_out; p.ws = (unsigned char*)d_ws; p.ph_lo = 0; p.ph_hi = N_PHASES;
    void* args[] = {&p};
    if (hipMemsetAsync((unsigned char*)d_ws + WS_BAR, 0, 16384, stream) != hipSuccess) { fprintf(stderr, "kernel_launch: memset of the barrier words failed\n"); return; }
    hipError_t e = hipLaunchCooperativeKernel((const void*)fwd_megakernel, dim3(grid_blocks), dim3(512), args, LDS_BYTES, stream);
    if (e != hipSuccess) fprintf(stderr, "cooperative launch failed: %s (grid %d)\n", hipGetErrorString(e), grid_blocks);
}
```

```cpp
#include <hip/hip_runtime.h>
#include <hip/hip_cooperative_groups.h>
#include <cstdio>
namespace cg = cooperative_groups;

#define LAS __attribute__((address_space(3)))
#ifndef DUP_PREP
#define DUP_PREP 0
#define DUP_IN 0
#define DUP_MIX 0
#define DUP_POOL1 0
#define DUP_GU 0
#define DUP_SYNC 0
#define DUP_DN 0
#endif
#ifndef X_GIN
#define X_GIN 1
#define X_GOUT 1
#define X_GPOOL 1
#define X_GGU 1
#define X_GDN 1
#endif
typedef unsigned short bf16_t;
typedef short bf16x8 __attribute__((ext_vector_type(8)));
typedef float f32x4 __attribute__((ext_vector_type(4)));
typedef unsigned u32x4 __attribute__((ext_vector_type(4)));
typedef unsigned u32x2 __attribute__((ext_vector_type(2)));
typedef float f32x2 __attribute__((ext_vector_type(2)));
typedef unsigned long long ssq_t;

constexpr int DM = 1024, MP = 16384, MS = 1024, MT = 17408, NTM = 68, DFF = 2816, DIN = 1792;
constexpr float RMS_EPS = 1e-6f, LN_EPS = 1e-5f;
enum { I_XP = 0, I_XS, I_CCONV, I_CK, I_CV, I_SPOOL, I_NMIX, I_NFFN, I_WIN, I_QN, I_KN, I_SINK, I_WDW, I_BDW, I_CNG, I_CNB, I_WOUT, I_WPOOL, I_PSCALE, I_WG, I_WU, I_WD, N_IN };
constexpr size_t O_Y = 0;
constexpr size_t O_CONVP = (size_t)MT * DM;
constexpr size_t O_KP = O_CONVP + 2 * 4 * 30 * 512;
constexpr size_t O_VP = O_KP + 2 * 4 * 128 * 128;
constexpr size_t O_POOLP = O_VP + 2 * 4 * 128 * 128;
constexpr size_t O_CONVS = O_POOLP + 2 * 4 * 15 * 1024;
constexpr size_t O_KS = O_CONVS + (size_t)2 * 128 * 30 * 512;
constexpr size_t O_VS = O_KS + (size_t)2 * 128 * 128 * 128;
constexpr size_t O_POOLS = O_VS + (size_t)2 * 128 * 128 * 128;
constexpr size_t WS_WIN = 0;
constexpr size_t WS_WOUT = WS_WIN + (size_t)2 * DIN * DM * 2;
constexpr size_t WS_WGU = WS_WOUT + (size_t)2 * DM * DM * 2;
constexpr size_t WS_WDN = WS_WGU + (size_t)4 * 2 * DFF * DM * 2;
constexpr size_t WS_WPL = WS_WDN + (size_t)4 * DM * DFF * 2;
constexpr size_t WS_XB = WS_WPL + (size_t)2 * 4 * 256 * 256 * 2;
constexpr size_t WS_SSQ = WS_XB + (size_t)MT * DM * 2;
constexpr size_t WS_ACT = WS_SSQ + (size_t)9 * MT * 8;
constexpr size_t WS_QKV = WS_ACT;
constexpr size_t WS_GLU = WS_QKV + (size_t)MT * 768 * 2;
constexpr size_t WS_CAT = WS_GLU + (size_t)MT * 512 * 2;
constexpr size_t WS_DG = WS_ACT;
constexpr size_t WS_BAR = WS_ACT + (size_t)MT * DFF * 2;
constexpr size_t WS_PART = WS_BAR + 16384;
constexpr size_t WS_END = WS_PART + (size_t)176 * 65536 * 4;
constexpr int LDS_BYTES = 131072 + 16;
constexpr int N_PHASES = 21;

struct Params { const float* in[N_IN]; float* out; unsigned char* ws; int ph_lo, ph_hi; };

__device__ __forceinline__ unsigned cvt_pk_bf16(float lo, float hi) { unsigned r; asm("v_cvt_pk_bf16_f32 %0, %1, %2" : "=v"(r) : "v"(lo), "v"(hi)); return r; }
__device__ __forceinline__ float bflo(unsigned w) { return __uint_as_float(w << 16); }
__device__ __forceinline__ float bfhi(unsigned w) { return __uint_as_float(w & 0xffff0000u); }
__device__ __forceinline__ float bf2f(bf16_t b) { return __uint_as_float(((unsigned)b) << 16); }
__device__ __forceinline__ float wave_sum(float v) {
#pragma unroll
    for (int o = 32; o >= 1; o >>= 1) v += __shfl_xor(v, o);
    return v;
}
__device__ __forceinline__ float ssq_rs(ssq_t v) { return rsqrtf((float)v * (1.0f / (1048576.0f * 1024.0f)) + RMS_EPS); }
__device__ __forceinline__ ssq_t ssq_fix(float ss) { return (ssq_t)(ss * 1048576.0f); }
__device__ __forceinline__ void ssq_add(ssq_t* p, float ss) { (void)__hip_atomic_fetch_add(p, ssq_fix(ss), __ATOMIC_RELAXED, __HIP_MEMORY_SCOPE_AGENT); }
__device__ __forceinline__ float fast_sigmoid(float x) { return __builtin_amdgcn_rcpf(1.0f + __expf(-x)); }
__device__ __forceinline__ f32x2 pk_exp2(f32x2 v) { f32x2 r; r.x = __builtin_amdgcn_exp2f(v.x); r.y = __builtin_amdgcn_exp2f(v.y); return r; }
__device__ __forceinline__ f32x2 pk_rcp(f32x2 v) { f32x2 r; r.x = __builtin_amdgcn_rcpf(v.x); r.y = __builtin_amdgcn_rcpf(v.y); return r; }
__device__ __forceinline__ f32x2 pk_sig(f32x2 g, float k2) { return pk_rcp(pk_exp2(g * k2) + 1.0f); }

namespace pg8 {
constexpr int BM = 256, BK = 64, HALF = 128, HTB = HALF * BK * 2, STAGE_BYTES = 8 * HTB, NXCD = 8, WGM = 8;
__host__ __device__ __forceinline__ int lds_byte(int r, int c) { const int st = (r >> 4) * 2 + (c >> 5), rr = r & 15, cc = c & 31, ob = rr * 64 + cc * 2; return st * 1024 + (ob ^ (((ob >> 9) & 1) << 5)); }
__host__ __device__ __forceinline__ void stage_rc(int b, int& R, int& C) { const int st = b / 1024, sb = b % 1024, swz = sb ^ (((sb >> 9) & 1) << 5); R = (st >> 1) * 16 + swz / 64; C = (st & 1) * 32 + (swz % 64) / 2; }
__host__ __device__ __forceinline__ int perm32(int rho) { const int n = rho >> 4, i = rho & 15; return 8 * (i >> 2) + 4 * n + (i & 3); }
struct Unit { int pm, pn, k0, nt, part; };
struct Gemm { const bf16_t* A; const bf16_t* Bt; int M, N, K; };
struct StaticOrder {
    static constexpr bool SPLIT = false, ABLK = false;
    int nM, nN, nwg, G, c, ntk;
    __device__ void init(int M, int N, int K, int G_, int c_) { nM = M / BM; nN = N / BM; nwg = nM * nN; G = G_; c = c_; ntk = K / BK; }
    __device__ void tile(int L, Unit& u) const {
        int wgid = L; { const int q = nwg / NXCD, r = nwg % NXCD, xcd = wgid % NXCD, off = wgid / NXCD; wgid = (xcd < r ? xcd * (q + 1) : r * (q + 1) + (xcd - r) * q) + off; }
        const int nig = WGM * nN, gid = wgid / nig, fm = gid * WGM, gsz = (nM - fm) < WGM ? (nM - fm) : WGM;
        u.pm = fm + ((wgid % nig) % gsz); u.pn = (wgid % nig) / gsz;
    }
    __device__ bool next(int i, Unit& u) const {
        const long L = (long)i * G + c; if (L >= nwg) return false;
        tile((int)L, u); u.k0 = 0; u.nt = ntk; u.part = -1; return true;
    }
};
template <bool ABLK_> struct SplitOrder : StaticOrder {
    static constexpr bool SPLIT = true, ABLK = ABLK_;
    int KS, ntp;
    __device__ void init2(int M, int N, int K, int G_, int c_, int KS_) { init(M, N, K, G_, c_); KS = KS_; ntp = ntk / KS_; }
    __device__ bool next(int i, Unit& u) const {
        const int np = (nwg - G) * KS;
        int j = i;
        if (c < np) { if (i == 0) { tile(G + c / KS, u); u.k0 = (c % KS) * ntp; u.nt = ntp; u.part = c; return true; } j = i - 1; }
        if (j > 0) return false;
        tile(c, u); u.k0 = 0; u.nt = ntk; u.part = -1; return true;
    }
};
struct PoolOrder {
    static constexpr bool SPLIT = false, ABLK = false;
    int G, c;
    __device__ bool next(int i, Unit& u) const { const int L = i * G + c; if (L >= 4 * NTM) return false; u.pm = L; u.pn = L / NTM; u.k0 = 0; u.nt = 4; u.part = -1; return true; }
};

template <class Epi, class Sched>
__device__ __forceinline__ void gemm_phase(LAS unsigned char* lds, const Gemm g, const Sched& S, const Epi& E) {
    int tid = threadIdx.x; asm volatile("" : "+v"(tid));
    const int wid = __builtin_amdgcn_readfirstlane(tid >> 6), lane = tid & 63, wr = wid >> 2, wc = wid & 3, fr = lane & 15, fq = lane >> 4;
    int K = g.K; asm volatile("" : "+s"(K));
    unsigned voffA[2], voffB[2];
#pragma unroll
    for (int i = 0; i < 2; ++i) { int R, C; stage_rc(tid * 16 + i * 8192, R, C); const int Rb = (R & ~31) + perm32(R & 31);
        voffA[i] = Sched::ABLK ? (unsigned)(R * 64 + C) * 2u : (unsigned)(R * K + C) * 2u; voffB[i] = (unsigned)(Rb * K + C) * 2u; }
    const size_t kstep = (size_t)(BK * 2);
    const size_t hstep = (size_t)HALF * K * 2;
    const size_t tstep = 2 * hstep;
    const size_t kstepA = Sched::ABLK ? (size_t)32768 : kstep, hstepA = Sched::ABLK ? (size_t)16384 : hstep;
    const unsigned ldsw = (unsigned)wid * 1024u;
    const int aoff = lds_byte(wr * 64 + fr, fq * 8), boff = lds_byte(wc * 32 + fr, fq * 8);
#define PG8_SA(b, h) (((b) * 2 + (h)) * HTB)
#define PG8_SB(b, h) ((4 + (b) * 2 + (h)) * HTB)
#define PG8_STAGE(bufoff, gbase, voff) do { _Pragma("unroll") for (int _i = 0; _i < 2; ++_i) \
        __builtin_amdgcn_global_load_lds((const unsigned*)((const char*)(gbase) + (voff)[_i]), (LAS unsigned*)(lds + (bufoff) + ldsw + _i * 8192), 16, 0, 0); } while (0)
#define PG8_LDA(dst, b, h) do { _Pragma("unroll") for (int m = 0; m < 4; ++m) _Pragma("unroll") for (int k = 0; k < 2; ++k) dst[m][k] = *(const LAS bf16x8*)(lds + PG8_SA(b, h) + aoff + m * 2048 + k * 1024); } while (0)
#define PG8_LDB(dst, b, h) do { _Pragma("unroll") for (int n = 0; n < 2; ++n) _Pragma("unroll") for (int k = 0; k < 2; ++k) dst[n][k] = *(const LAS bf16x8*)(lds + PG8_SB(b, h) + boff + n * 2048 + k * 1024); } while (0)
#define PG8_MMA(ai, bj, At, Bt) do { __builtin_amdgcn_s_setprio(1); _Pragma("unroll") for (int m = 0; m < 4; ++m) _Pragma("unroll") for (int n = 0; n < 2; ++n) _Pragma("unroll") for (int k = 0; k < 2; ++k) \
        acc[ai][bj][m][n] = __builtin_amdgcn_mfma_f32_16x16x32_bf16(Bt[n][k], At[m][k], acc[ai][bj][m][n], 0, 0, 0); __builtin_amdgcn_s_setprio(0); } while (0)
#define PG8_WAIT_V(n) asm volatile("s_waitcnt vmcnt(" #n ")" ::: "memory")
#define PG8_WAIT_L(n) asm volatile("s_waitcnt lgkmcnt(" #n ")" ::: "memory")
#define PG8_BAR __builtin_amdgcn_s_barrier()
#define PG8_SCHED __builtin_amdgcn_sched_barrier(0)
    Unit cur, nxt; int ui = 0;
    if (!S.next(0, cur)) return;
    f32x4 acc[2][2][4][2];
    E.init(acc, cur, wr, wc, fr, fq);
    bf16x8 At[4][2], B0[2][2], B1[2][2];
    const char* cA = (const char*)g.A + (size_t)cur.pm * tstep; const char* cB = (const char*)g.Bt + (size_t)cur.pn * tstep;
    if constexpr (Sched::SPLIT) { cA += (size_t)cur.k0 * kstepA; cB += (size_t)cur.k0 * kstep; }
    const int ntc = K / BK;
    PG8_STAGE(PG8_SB(0, 0), cB, voffB); PG8_STAGE(PG8_SA(0, 0), cA, voffA); PG8_STAGE(PG8_SB(0, 1), cB + hstep, voffB); PG8_STAGE(PG8_SA(0, 1), cA + hstepA, voffA);
    if (wr == 1) PG8_BAR;
    PG8_WAIT_V(4); PG8_BAR;
    PG8_STAGE(PG8_SB(1, 0), cB + kstep, voffB); PG8_STAGE(PG8_SA(1, 0), cA + kstepA, voffA); PG8_STAGE(PG8_SB(1, 1), cB + hstep + kstep, voffB);
    PG8_WAIT_V(6); PG8_BAR;
    for (;;) {
        const bool has_next = S.next(ui + 1, nxt);
        const char* nA = has_next ? (const char*)g.A + (size_t)nxt.pm * tstep : cA; const char* nB = has_next ? (const char*)g.Bt + (size_t)nxt.pn * tstep : cB;
        if constexpr (Sched::SPLIT) { if (has_next) { nA += (size_t)nxt.k0 * kstepA; nB += (size_t)nxt.k0 * kstep; } }
        const int nt = Sched::SPLIT ? cur.nt : ntc;
        for (int t = 0; t < nt; t += 2) {
            const bool last = (t == nt - 2);
            const char* a1 = cA + (size_t)(t + 1) * kstepA;
            const char* a2 = last ? nA : cA + (size_t)(t + 2) * kstepA; const char* b2 = last ? nB : cB + (size_t)(t + 2) * kstep;
            const char* a3 = a2 + kstepA; const char* b3 = b2 + kstep;
            PG8_LDB(B0, 0, 0); PG8_SCHED; PG8_LDA(At, 0, 0); PG8_STAGE(PG8_SA(1, 1), a1 + hstepA, voffA);
            PG8_WAIT_L(8); PG8_BAR; PG8_WAIT_L(0); PG8_MMA(0, 0, At, B0); PG8_BAR; PG8_SCHED;
            PG8_LDB(B1, 0, 1); PG8_STAGE(PG8_SB(0, 0), b2, voffB);
            PG8_BAR; PG8_WAIT_L(0); PG8_MMA(0, 1, At, B1); PG8_BAR;
            PG8_LDA(At, 0, 1); PG8_STAGE(PG8_SA(0, 0), a2, voffA);
            PG8_BAR; PG8_WAIT_L(0); PG8_MMA(1, 0, At, B0); PG8_BAR; PG8_SCHED;
            PG8_STAGE(PG8_SB(0, 1), b2 + hstep, voffB);
            PG8_WAIT_V(6); PG8_BAR; PG8_MMA(1, 1, At, B1); PG8_BAR;
            PG8_LDB(B0, 1, 0); PG8_SCHED; PG8_LDA(At, 1, 0); PG8_STAGE(PG8_SA(0, 1), a2 + hstepA, voffA);
            PG8_WAIT_L(8); PG8_BAR; PG8_WAIT_L(0); PG8_MMA(0, 0, At, B0); PG8_BAR; PG8_SCHED;
            PG8_LDB(B1, 1, 1); PG8_STAGE(PG8_SB(1, 0), b3, voffB);
            PG8_BAR; PG8_WAIT_L(0); PG8_MMA(0, 1, At, B1); PG8_BAR;
            PG8_LDA(At, 1, 1); PG8_STAGE(PG8_SA(1, 0), a3, voffA);
            PG8_BAR; PG8_WAIT_L(0); PG8_MMA(1, 0, At, B0); PG8_BAR; PG8_SCHED;
            PG8_STAGE(PG8_SB(1, 1), b3 + hstep, voffB);
            PG8_WAIT_V(6); PG8_BAR; PG8_MMA(1, 1, At, B1); PG8_BAR;
        }
        E(acc, cur, wr, wc, fr, fq);
        if (!has_next) break;
        E.init(acc, nxt, wr, wc, fr, fq);
        cur = nxt; cA = nA; cB = nB; ++ui;
    }
    PG8_WAIT_V(0);
    if (wr == 0) PG8_BAR;
    PG8_BAR;
#undef PG8_SA
#undef PG8_SB
#undef PG8_STAGE
#undef PG8_LDA
#undef PG8_LDB
#undef PG8_MMA
#undef PG8_WAIT_V
#undef PG8_WAIT_L
#undef PG8_BAR
#undef PG8_SCHED
}
}

__device__ __forceinline__ void acc_zero(f32x4 (&acc)[2][2][4][2]) {
#pragma unroll
    for (int a = 0; a < 2; ++a)
#pragma unroll
        for (int b = 0; b < 2; ++b)
#pragma unroll
            for (int m = 0; m < 4; ++m)
#pragma unroll
                for (int n = 0; n < 2; ++n) acc[a][b][m][n] = (f32x4){0.f, 0.f, 0.f, 0.f};
}
struct EpiIn {
    const ssq_t* ssq; bf16_t* glu; bf16_t* qkv;
    __device__ __forceinline__ void init(f32x4 (&acc)[2][2][4][2], const pg8::Unit&, int, int, int, int) const { acc_zero(acc); }
    __device__ __forceinline__ void operator()(const f32x4 (&acc)[2][2][4][2], const pg8::Unit& u, int wr, int wc, int fr, int fq) const {
        const int row0 = u.pm * 256 + wr * 64 + fr;
        if (u.pn < 4) {
            const int col0 = u.pn * 128 + wc * 32 + 8 * fq;
#pragma unroll
            for (int ai = 0; ai < 2; ++ai)
#pragma unroll
                for (int m = 0; m < 4; ++m) {
                    const int r = row0 + ai * 128 + m * 16;
                    const float rs = ssq_rs(ssq[r]);
                    const float k2 = rs * -1.4426950408889634f;
                    f32x2 o[4];
#pragma unroll
                    for (int n = 0; n < 2; ++n)
#pragma unroll
                        for (int h = 0; h < 2; ++h) {
                            const f32x2 a = (f32x2){acc[ai][0][m][n][2 * h], acc[ai][0][m][n][2 * h + 1]}, gt = (f32x2){acc[ai][1][m][n][2 * h], acc[ai][1][m][n][2 * h + 1]};
                            o[n * 2 + h] = (a * rs) * pk_sig(gt, k2);
                        }
                    u32x4 w; w.x = cvt_pk_bf16(o[0].x, o[0].y); w.y = cvt_pk_bf16(o[1].x, o[1].y); w.z = cvt_pk_bf16(o[2].x, o[2].y); w.w = cvt_pk_bf16(o[3].x, o[3].y);
                    *(u32x4*)(glu + (size_t)r * 512 + col0) = w;
                }
        } else {
            const int col0 = (u.pn - 4) * 256 + wc * 32 + 8 * fq;
#pragma unroll
            for (int ai = 0; ai < 2; ++ai)
#pragma unroll
                for (int m = 0; m < 4; ++m) {
                    const int r = row0 + ai * 128 + m * 16;
                    const float rs = ssq_rs(ssq[r]);
#pragma unroll
                    for (int bj = 0; bj < 2; ++bj) {
                        const f32x4 v0 = acc[ai][bj][m][0] * rs, v1 = acc[ai][bj][m][1] * rs;
                        u32x4 w; w.x = cvt_pk_bf16(v0[0], v0[1]); w.y = cvt_pk_bf16(v0[2], v0[3]); w.z = cvt_pk_bf16(v1[0], v1[1]); w.w = cvt_pk_bf16(v1[2], v1[3]);
                        *(u32x4*)(qkv + (size_t)r * 768 + col0 + bj * 128) = w;
                    }
                }
        }
    }
};
struct EpiGU {
    const ssq_t* ssq; bf16_t* act;
    __device__ __forceinline__ void init(f32x4 (&acc)[2][2][4][2], const pg8::Unit&, int, int, int, int) const { acc_zero(acc); }
    __device__ __forceinline__ void operator()(const f32x4 (&acc)[2][2][4][2], const pg8::Unit& u, int wr, int wc, int fr, int fq) const {
        const int row0 = u.pm * 256 + wr * 64 + fr, col0 = u.pn * 128 + wc * 32 + 8 * fq;
#pragma unroll
        for (int ai = 0; ai < 2; ++ai)
#pragma unroll
            for (int m = 0; m < 4; ++m) {
                const int r = row0 + ai * 128 + m * 16;
                const float rs = ssq_rs(ssq[r]);
                const float k2 = rs * -1.4426950408889634f, rs2 = rs * rs;
                f32x2 o[4];
#pragma unroll
                for (int n = 0; n < 2; ++n)
#pragma unroll
                    for (int h = 0; h < 2; ++h) {
                        const f32x2 gt = (f32x2){acc[ai][0][m][n][2 * h], acc[ai][0][m][n][2 * h + 1]}, up = (f32x2){acc[ai][1][m][n][2 * h], acc[ai][1][m][n][2 * h + 1]};
                        o[n * 2 + h] = (gt * up) * rs2 * pk_sig(gt, k2);
                    }
                u32x4 w; w.x = cvt_pk_bf16(o[0].x, o[0].y); w.y = cvt_pk_bf16(o[1].x, o[1].y); w.z = cvt_pk_bf16(o[2].x, o[2].y); w.w = cvt_pk_bf16(o[3].x, o[3].y);
                *(u32x4*)(act + (size_t)(r >> 8) * (256 * DFF) + (size_t)(col0 >> 6) * (256 * 64) + (size_t)(r & 255) * 64 + (col0 & 63)) = w;
            }
    }
};
__device__ __forceinline__ void bf8_to_f32(u32x4 w, f32x4& lo, f32x4& hi) { lo = (f32x4){bflo(w.x), bfhi(w.x), bflo(w.y), bfhi(w.y)}; hi = (f32x4){bflo(w.z), bfhi(w.z), bflo(w.w), bfhi(w.w)}; }
template <bool POOL> struct EpiRes {
    float* Y; bf16_t* XB; ssq_t* ssq; const float* cscale; float* part;
    __device__ __forceinline__ void init(f32x4 (&acc)[2][2][4][2], const pg8::Unit& u, int wr, int wc, int fr, int fq) const {
        if (!POOL && u.part >= 0) { acc_zero(acc); return; }
        const int pmr = POOL ? (u.pm % NTM) : u.pm, ct = POOL ? (u.pm / NTM) : u.pn;
        const bf16_t* xq = XB + (size_t)(pmr * 256 + wr * 64 + fr) * DM + ct * 256 + wc * 32 + 8 * fq;
#pragma unroll
        for (int ai = 0; ai < 2; ++ai)
#pragma unroll
            for (int bj = 0; bj < 2; ++bj)
#pragma unroll
                for (int m = 0; m < 4; ++m) bf8_to_f32(*(const u32x4*)(xq + (size_t)(ai * 128 + m * 16) * DM + bj * 128), acc[ai][bj][m][0], acc[ai][bj][m][1]);
        if (POOL) {
            const float* cq = cscale + ct * 256 + wc * 32 + 8 * fq;
#pragma unroll
            for (int bj = 0; bj < 2; ++bj)
#pragma unroll
                for (int n = 0; n < 2; ++n) {
                    const f32x4 cv = *(const f32x4*)(cq + bj * 128 + 4 * n);
                    const f32x4 ic = (f32x4){__builtin_amdgcn_rcpf(cv[0]), __builtin_amdgcn_rcpf(cv[1]), __builtin_amdgcn_rcpf(cv[2]), __builtin_amdgcn_rcpf(cv[3])};
#pragma unroll
                    for (int ai = 0; ai < 2; ++ai)
#pragma unroll
                        for (int m = 0; m < 4; ++m) acc[ai][bj][m][n] = acc[ai][bj][m][n] * ic;
                }
        }
    }
    __device__ __forceinline__ void operator()(const f32x4 (&acc)[2][2][4][2], const pg8::Unit& u, int wr, int wc, int fr, int fq) const {
        if (!POOL && u.part >= 0) {
            float* pp = part + (size_t)u.part * 65536 + (size_t)(((wr * 4 + wc) * 64) + fq * 16 + fr) * 4;
#pragma unroll
            for (int ai = 0; ai < 2; ++ai)
#pragma unroll
                for (int m = 0; m < 4; ++m)
#pragma unroll
                    for (int bj = 0; bj < 2; ++bj)
#pragma unroll
                        for (int n = 0; n < 2; ++n) *(f32x4*)(pp + (size_t)((((ai * 4 + m) * 2 + bj) * 2 + n) * 2048)) = acc[ai][bj][m][n];
            return;
        }
        const int pmr = POOL ? (u.pm % NTM) : u.pm, ct = POOL ? (u.pm / NTM) : u.pn;
        const int row0 = pmr * 256 + wr * 64 + fr, col0 = ct * 256 + wc * 32 + 8 * fq;
#pragma unroll
        for (int ai = 0; ai < 2; ++ai)
#pragma unroll
            for (int m = 0; m < 4; ++m) {
                const int r = row0 + ai * 128 + m * 16;
                bf16_t* bp = XB + (size_t)r * DM + col0;
                float ss = 0.f;
#pragma unroll
                for (int bj = 0; bj < 2; ++bj) {
                    f32x4 v0 = acc[ai][bj][m][0], v1 = acc[ai][bj][m][1];
                    if (POOL) { v0 = v0 * *(const f32x4*)(cscale + col0 + bj * 128); v1 = v1 * *(const f32x4*)(cscale + col0 + bj * 128 + 4); }
                    if (Y) { float* yp = Y + (size_t)r * DM + col0 + bj * 128; *(f32x4*)yp = v0; *(f32x4*)(yp + 4) = v1; continue; }
                    u32x4 w; w.x = cvt_pk_bf16(v0[0], v0[1]); w.y = cvt_pk_bf16(v0[2], v0[3]); w.z = cvt_pk_bf16(v1[0], v1[1]); w.w = cvt_pk_bf16(v1[2], v1[3]);
                    *(u32x4*)(bp + bj * 128) = w;
                    ss += (v0[0] * v0[0] + v0[1] * v0[1]) + (v0[2] * v0[2] + v0[3] * v0[3]) + (v1[0] * v1[0] + v1[1] * v1[1]) + (v1[2] * v1[2] + v1[3] * v1[3]);
                }
                if (Y) continue;
                ss += __shfl_xor(ss, 16); ss += __shfl_xor(ss, 32);
                if (fq == 0) ssq_add(ssq + r, ss);
            }
    }
};

struct WTile { const float* src0; const float* src1; const float* gain; bf16_t* dst; int ld, K, k0, n0m, mode; };
__device__ __forceinline__ void wt_decode(const Params& p, int t, WTile& w) {
    int kt; w.gain = nullptr;
    if (t < 224) { const int i = t / 112, r = t % 112; w.n0m = (r / 16) * 256; kt = r % 16; w.K = 1024; w.ld = DIN; w.mode = (w.n0m < 1024) ? 1 : 0;
        w.src0 = p.in[I_WIN] + (size_t)i * DM * DIN; w.src1 = w.src0; w.gain = p.in[I_NMIX] + (2 * i) * DM; w.dst = (bf16_t*)(p.ws + WS_WIN) + (size_t)i * DIN * DM; }
    else if (t < 352) { t -= 224; const int i = t / 64, r = t % 64; w.n0m = (r / 16) * 256; kt = r % 16; w.K = 1024; w.ld = DM; w.mode = 0;
        w.src0 = p.in[I_WOUT] + (size_t)i * DM * DM; w.src1 = w.src0; w.dst = (bf16_t*)(p.ws + WS_WOUT) + (size_t)i * DM * DM; }
    else if (t < 1760) { t -= 352; const int l = t / 352, r = t % 352; w.n0m = (r / 16) * 256; kt = r % 16; w.K = 1024; w.ld = DFF; w.mode = 2;
        w.src0 = p.in[I_WG] + (size_t)l * DM * DFF; w.src1 = p.in[I_WU] + (size_t)l * DM * DFF; w.gain = p.in[I_NFFN] + l * DM; w.dst = (bf16_t*)(p.ws + WS_WGU) + (size_t)l * 2 * DFF * DM; }
    else if (t < 2464) { t -= 1760; const int l = t / 176, r = t % 176; w.n0m = (r / 44) * 256; kt = r % 44; w.K = DFF; w.ld = DM; w.mode = 0;
        w.src0 = p.in[I_WD] + (size_t)l * DFF * DM; w.src1 = w.src0; w.dst = (bf16_t*)(p.ws + WS_WDN) + (size_t)l * DM * DFF; }
    else { t -= 2464; const int ig = t / 4; w.n0m = 0; kt = t % 4; w.K = 256; w.ld = 256; w.mode = 0;
        w.src0 = p.in[I_WPOOL] + (size_t)ig * 65536; w.src1 = w.src0; w.dst = (bf16_t*)(p.ws + WS_WPL) + (size_t)ig * 65536; }
    w.k0 = kt * 64;
}
__device__ __forceinline__ void wt_load(const WTile& w, int tid, f32x4 (&v)[4][2], float& gs0, float& gs1) {
    const int row = tid >> 4, col4 = (tid & 15) * 4;
    gs0 = w.gain ? w.gain[w.k0 + row] : 1.0f; gs1 = w.gain ? w.gain[w.k0 + row + 32] : 1.0f;
#pragma unroll
    for (int q = 0; q < 4; ++q) {
        const int n0 = w.n0m + 64 * q; int c0 = n0; const float* src = w.src0;
        if (w.mode == 1) { const int pn = n0 / 256, bj = (n0 / 128) & 1, cc = n0 % 128; c0 = bj * 512 + 128 * pn + cc; }
        else if (w.mode == 2) { const int pn = n0 / 256, bj = (n0 / 128) & 1, cc = n0 % 128; c0 = 128 * pn + cc; src = bj ? w.src1 : w.src0; }
        const float* sp = src + (size_t)(w.k0 + row) * w.ld + c0 + col4;
        v[q][0] = __builtin_nontemporal_load((const f32x4*)sp); v[q][1] = __builtin_nontemporal_load((const f32x4*)(sp + (size_t)32 * w.ld));
    }
}
__device__ __forceinline__ void prep_phase(const Params& p, LAS unsigned char* lds) {
    int tid = threadIdx.x; asm volatile("" : "+v"(tid));
    const int G = gridDim.x, bid = blockIdx.x, wave = tid >> 6, lane = tid & 63;
    bf16_t* XB = (bf16_t*)(p.ws + WS_XB); ssq_t* SSQ = (ssq_t*)(p.ws + WS_SSQ);
    for (int r0 = bid * 8 + wave; r0 < MT; r0 += G * 16) {
        const int r1 = r0 + G * 8; const bool h1 = r1 < MT; const int r1c = h1 ? r1 : r0;
        const float* s0 = r0 < MP ? p.in[I_XP] + (size_t)r0 * DM : p.in[I_XS] + (size_t)(r0 - MP) * DM;
        const float* s1 = r1c < MP ? p.in[I_XP] + (size_t)r1c * DM : p.in[I_XS] + (size_t)(r1c - MP) * DM;
        f32x4 va[4], vb[4];
#pragma unroll
        for (int q = 0; q < 4; ++q) { va[q] = __builtin_nontemporal_load((const f32x4*)(s0 + q * 256 + lane * 4)); vb[q] = __builtin_nontemporal_load((const f32x4*)(s1 + q * 256 + lane * 4)); }
        float ssa = 0.f, ssb = 0.f;
#pragma unroll
        for (int q = 0; q < 4; ++q) {
            u32x2 w; w.x = cvt_pk_bf16(va[q][0], va[q][1]); w.y = cvt_pk_bf16(va[q][2], va[q][3]);
            *(u32x2*)(XB + (size_t)r0 * DM + q * 256 + lane * 4) = w;
            ssa += (va[q][0] * va[q][0] + va[q][1] * va[q][1]) + (va[q][2] * va[q][2] + va[q][3] * va[q][3]);
            if (h1) {
                u32x2 w2; w2.x = cvt_pk_bf16(vb[q][0], vb[q][1]); w2.y = cvt_pk_bf16(vb[q][2], vb[q][3]);
                *(u32x2*)(XB + (size_t)r1 * DM + q * 256 + lane * 4) = w2;
            }
            ssb += (vb[q][0] * vb[q][0] + vb[q][1] * vb[q][1]) + (vb[q][2] * vb[q][2] + vb[q][3] * vb[q][3]);
        }
        ssa = wave_sum(ssa); ssb = wave_sum(ssb);
        if (lane == 0) { SSQ[r0] = ssq_fix(ssa); if (h1) SSQ[r1] = ssq_fix(ssb); }
    }
    for (int idx = bid * 512 + tid; idx < 8 * MT; idx += G * 512) SSQ[MT + idx] = 0ull;
    LAS float* tile = (LAS float*)lds;
    WTile cur, nxt; f32x4 v[4][2]; float gs0 = 1.f, gs1 = 1.f;
    int t0 = bid;
    if (t0 < 2496) { wt_decode(p, t0, cur); wt_load(cur, tid, v, gs0, gs1); }
    for (; t0 < 2496; t0 += G) {
        __syncthreads();
        {
            const int row = tid >> 4, col4 = (tid & 15) * 4;
#pragma unroll
            for (int q = 0; q < 4; ++q)
#pragma unroll
                for (int h = 0; h < 2; ++h) { LAS float* tp = tile + q * 4160 + (row + 32 * h) * 65 + col4; const float gs = h ? gs1 : gs0;
                    tp[0] = v[q][h][0] * gs; tp[1] = v[q][h][1] * gs; tp[2] = v[q][h][2] * gs; tp[3] = v[q][h][3] * gs; }
        }
        __syncthreads();
        const bool hn = (t0 + G) < 2496;
        if (hn) { wt_decode(p, t0 + G, nxt); wt_load(nxt, tid, v, gs0, gs1); }
        {
            const int n = tid >> 3, kk = (tid & 7) * 8;
#pragma unroll
            for (int q = 0; q < 4; ++q) {
                float e[8];
#pragma unroll
                for (int j = 0; j < 8; ++j) e[j] = tile[q * 4160 + (kk + j) * 65 + n];
                u32x4 w; w.x = cvt_pk_bf16(e[0], e[1]); w.y = cvt_pk_bf16(e[2], e[3]); w.z = cvt_pk_bf16(e[4], e[5]); w.w = cvt_pk_bf16(e[6], e[7]);
                *(u32x4*)(cur.dst + (size_t)(cur.n0m + 64 * q + n) * cur.K + cur.k0 + kk) = w;
            }
        }
        if (hn) cur = nxt;
    }
    __syncthreads();
}

__device__ __forceinline__ f32x4 ld_bf4(const bf16_t* p) { const u32x2 w = *(const u32x2*)p; return (f32x4){bflo(w.x), bfhi(w.x), bflo(w.y), bfhi(w.y)}; }
template <int W>
__device__ __forceinline__ void pool_prompt_strip(const bf16_t* X, const ssq_t* ssq, int row0, int t0, int c, f32x4 gm, bf16_t* dgp, float* outp_seq) {
    constexpr int TT = 16, NR = TT + W - 1;
    f32x4 xr[NR];
    if (t0 >= W - 1) {
        const bf16_t* xp = X + (size_t)(row0 - (W - 1)) * DM + c; asm volatile("" : "+v"(xp));
        const ssq_t* sp = ssq + (row0 - (W - 1)); asm volatile("" : "+v"(sp));
#pragma unroll
        for (int j = 0; j < NR; ++j) { const float rs = ssq_rs(sp[j]); xr[j] = ld_bf4(xp + (size_t)j * DM) * rs * gm; }
    } else {
        int vz; asm volatile("v_mov_b32 %0, 0" : "=v"(vz));
        const bf16_t* xp = X + (size_t)(row0 - t0) * DM + c; const ssq_t* sp = ssq + (row0 - t0);
#pragma unroll
        for (int j = 0; j < NR; ++j) { const int tj = t0 - (W - 1) + j + vz, tc = tj < 0 ? 0 : tj; const float rs = ssq_rs(sp[tc]);
            const f32x4 v = ld_bf4(xp + (size_t)tc * DM) * rs * gm; xr[j] = tj < 0 ? (f32x4){0.f, 0.f, 0.f, 0.f} : v; }
    }
    f32x4 S = (f32x4){0.f, 0.f, 0.f, 0.f};
#pragma unroll
    for (int j = 0; j < W - 1; ++j) S += xr[j];
#pragma unroll
    for (int tt = 0; tt < TT; ++tt) {
        S += xr[tt + W - 1]; if (tt > 0) S -= xr[tt - 1];
        const int t = t0 + tt, cnt = (t + 1 < W) ? (t + 1) : W;
        const f32x4 cur = xr[tt + W - 1], d = S * __builtin_amdgcn_rcpf((float)cnt) - cur;
        u32x2 wv; wv.x = cvt_pk_bf16(d[0], d[1]); wv.y = cvt_pk_bf16(d[2], d[3]);
        *(u32x2*)(dgp + (size_t)tt * 256) = wv;
        if (t >= 4081) *(f32x4*)(outp_seq + (size_t)(t - 4081) * DM) = cur;
    }
}
template <int W>
__device__ __forceinline__ void pool_sample_strip(const bf16_t* X, const ssq_t* ssq, int row0, int c, f32x4 gm, const float* state_seq, bf16_t* dgp, float* outs_seq) {
    constexpr int TT = 8, NR = TT + W - 1;
    f32x4 xr[NR];
    { const float* stp = state_seq + (size_t)(15 - (W - 1)) * DM; asm volatile("" : "+v"(stp));
#pragma unroll
      for (int j = 0; j < W - 1; ++j) xr[j] = *(const f32x4*)(stp + (size_t)j * DM); }
    { const bf16_t* xp = X + (size_t)row0 * DM + c; asm volatile("" : "+v"(xp));
      const ssq_t* sp = ssq + row0;
#pragma unroll
      for (int j = 0; j < TT; ++j) { const float rs = ssq_rs(sp[j]); xr[W - 1 + j] = ld_bf4(xp + (size_t)j * DM) * rs * gm; } }
    f32x4 S = (f32x4){0.f, 0.f, 0.f, 0.f};
#pragma unroll
    for (int j = 0; j < W - 1; ++j) S += xr[j];
#pragma unroll
    for (int tt = 0; tt < TT; ++tt) {
        S += xr[tt + W - 1]; if (tt > 0) S -= xr[tt - 1];
        const f32x4 cur = xr[tt + W - 1], d = S * (1.0f / (float)W) - cur;
        u32x2 wv; wv.x = cvt_pk_bf16(d[0], d[1]); wv.y = cvt_pk_bf16(d[2], d[3]);
        *(u32x2*)(dgp + (size_t)tt * 256) = wv;
        *(f32x4*)(outs_seq + (size_t)(7 + tt) * DM) = cur;
    }
}
__device__ __forceinline__ void pool1_phase(const Params& p, int l, const ssq_t* ssq) {
    int tid = threadIdx.x; asm volatile("" : "+v"(tid));
    const int G = gridDim.x, bid = blockIdx.x, i = l >> 1;
    const bf16_t* X = (const bf16_t*)(p.ws + WS_XB); bf16_t* DG = (bf16_t*)(p.ws + WS_DG);
    const int cq = tid & 255, c = cq * 4, half = tid >> 8, g = __builtin_amdgcn_readfirstlane(cq >> 6);
    const f32x4 gm = *(const f32x4*)(p.in[I_NMIX] + l * DM + c);
    const float* spool = p.in[I_SPOOL] + (size_t)i * 128 * 15 * DM;
    float* outp = p.out + O_POOLP + (size_t)i * 4 * 15 * DM; float* outs = p.out + O_POOLS + (size_t)i * 128 * 15 * DM;
    for (int u = bid; u < MP / 64 + 64; u += G) {
        if (u < MP / 64) {
#pragma unroll 1
            for (int k = 0; k < 2; ++k) {
                const int row0 = u * 64 + k * 32 + half * 16, t0 = row0 & 4095, b = row0 >> 12;
                bf16_t* dgp = DG + ((size_t)g * MT + row0) * 256 + (c - 256 * g); float* op = outp + (size_t)b * 15 * DM + c;
                if (g == 0) pool_prompt_strip<2>(X, ssq, row0, t0, c, gm, dgp, op);
                else if (g == 1) pool_prompt_strip<4>(X, ssq, row0, t0, c, gm, dgp, op);
                else if (g == 2) pool_prompt_strip<8>(X, ssq, row0, t0, c, gm, dgp, op);
                else pool_prompt_strip<16>(X, ssq, row0, t0, c, gm, dgp, op);
            }
        } else {
            const int s0 = (u - MP / 64) * 2;
            {
                const int s = s0 + half, row0 = MP + s * 8;
                bf16_t* dgp = DG + ((size_t)g * MT + row0) * 256 + (c - 256 * g); float* op = outs + (size_t)s * 15 * DM + c; const float* st = spool + (size_t)s * 15 * DM + c;
                if (g == 0) pool_sample_strip<2>(X, ssq, row0, c, gm, st, dgp, op);
                else if (g == 1) pool_sample_strip<4>(X, ssq, row0, c, gm, st, dgp, op);
                else if (g == 2) pool_sample_strip<8>(X, ssq, row0, c, gm, st, dgp, op);
                else pool_sample_strip<16>(X, ssq, row0, c, gm, st, dgp, op);
            }
            for (int idx = tid; idx < 2 * 7 * 256; idx += 512) { const int c4 = (idx & 255) * 4, rr = (idx >> 8) % 7, sl = idx / (7 * 256);
                *(f32x4*)(outs + ((size_t)(s0 + sl) * 15 + rr) * DM + c4) = *(const f32x4*)(spool + ((size_t)(s0 + sl) * 15 + 8 + rr) * DM + c4); }
        }
    }
}

constexpr int KS_STRIDE = 72, VT_STRIDE = 264;

__device__ __forceinline__ void attn_item(const LAS bf16_t* Ks, const LAS bf16_t* Vt, int tile0, int r0, bool first, bool qvalid,
                                          const bf16_t* qptr, const float* qn, float slope, float sink, bf16_t* optr, int fr, int fq) {
    u32x4 raw0 = (u32x4){0u, 0u, 0u, 0u}, raw1 = raw0;
    if (qvalid) { raw0 = *(const u32x4*)(qptr); raw1 = *(const u32x4*)(qptr + 32); }
    float qf[16];
#pragma unroll
    for (int j = 0; j < 4; ++j) { qf[2 * j] = bflo(raw0[j]); qf[2 * j + 1] = bfhi(raw0[j]); qf[8 + 2 * j] = bflo(raw1[j]); qf[8 + 2 * j + 1] = bfhi(raw1[j]); }
    float ss = 0.f;
#pragma unroll
    for (int j = 0; j < 16; ++j) ss += qf[j] * qf[j];
    ss += __shfl_xor(ss, 16); ss += __shfl_xor(ss, 32);
    const float rq = rsqrtf(ss * (1.0f / 64.0f) + RMS_EPS) * 0.125f;
    bf16x8 q0, q1;
    {
        const f32x4 n0 = *(const f32x4*)(qn + fq * 8), n1 = *(const f32x4*)(qn + fq * 8 + 4), n2 = *(const f32x4*)(qn + 32 + fq * 8), n3 = *(const f32x4*)(qn + 32 + fq * 8 + 4);
        u32x4 a, b;
        a.x = cvt_pk_bf16(qf[0] * rq * n0[0], qf[1] * rq * n0[1]); a.y = cvt_pk_bf16(qf[2] * rq * n0[2], qf[3] * rq * n0[3]);
        a.z = cvt_pk_bf16(qf[4] * rq * n1[0], qf[5] * rq * n1[1]); a.w = cvt_pk_bf16(qf[6] * rq * n1[2], qf[7] * rq * n1[3]);
        b.x = cvt_pk_bf16(qf[8] * rq * n2[0], qf[9] * rq * n2[1]); b.y = cvt_pk_bf16(qf[10] * rq * n2[2], qf[11] * rq * n2[3]);
        b.z = cvt_pk_bf16(qf[12] * rq * n3[0], qf[13] * rq * n3[1]); b.w = cvt_pk_bf16(qf[14] * rq * n3[2], qf[15] * rq * n3[3]);
        q0 = __builtin_bit_cast(bf16x8, a); q1 = __builtin_bit_cast(bf16x8, b);
    }
    f32x4 s[9];
#pragma unroll
    for (int T = 0; T < 9; ++T) {
        const LAS bf16_t* kp = Ks + ((tile0 + T) * 16 + fr) * KS_STRIDE + fq * 8;
        const bf16x8 a0 = *(const LAS bf16x8*)(kp), a1 = *(const LAS bf16x8*)(kp + 32);
        f32x4 z = (f32x4){0.f, 0.f, 0.f, 0.f};
        z = __builtin_amdgcn_mfma_f32_16x16x32_bf16(a0, q0, z, 0, 0, 0);
        s[T] = __builtin_amdgcn_mfma_f32_16x16x32_bf16(a1, q1, z, 0, 0, 0);
    }
    __builtin_amdgcn_sched_barrier(0);
    int qi = r0 + fr; asm volatile("" : "+v"(qi));
    const int lim = first ? qi + 1 : 128;
    float mx = sink;
#pragma unroll
    for (int T = 0; T < 9; ++T)
#pragma unroll
        for (int j = 0; j < 4; ++j) {
            const int jk = (tile0 + T) * 16 + 4 * fq + j, dist = 128 + qi - jk;
            const bool valid = (unsigned)dist < (unsigned)lim;
            const float v = valid ? (s[T][j] - slope * (float)dist) : -1e30f;
            s[T][j] = v; mx = fmaxf(mx, v);
        }
    mx = fmaxf(mx, __shfl_xor(mx, 16)); mx = fmaxf(mx, __shfl_xor(mx, 32));
    float sum = 0.f;
#pragma unroll
    for (int T = 0; T < 9; ++T)
#pragma unroll
        for (int j = 0; j < 4; ++j) { const float e = __expf(s[T][j] - mx); s[T][j] = e; sum += e; }
    sum += __shfl_xor(sum, 16); sum += __shfl_xor(sum, 32);
    sum += __expf(sink - mx);
    const float inv = 1.0f / sum;
    __builtin_amdgcn_sched_barrier(0);
    f32x4 o[4];
#pragma unroll
    for (int dt = 0; dt < 4; ++dt) o[dt] = (f32x4){0.f, 0.f, 0.f, 0.f};
#pragma unroll
    for (int pp = 0; pp < 5; ++pp) {
        const int T0 = 2 * pp, T1 = (pp < 4) ? 2 * pp + 1 : 8;
        u32x4 pw;
        pw.x = cvt_pk_bf16(s[T0][0] * inv, s[T0][1] * inv); pw.y = cvt_pk_bf16(s[T0][2] * inv, s[T0][3] * inv);
        if (pp < 4) { pw.z = cvt_pk_bf16(s[T1][0] * inv, s[T1][1] * inv); pw.w = cvt_pk_bf16(s[T1][2] * inv, s[T1][3] * inv); } else { pw.z = 0u; pw.w = 0u; }
        const bf16x8 pf = __builtin_bit_cast(bf16x8, pw);
#pragma unroll
        for (int dt = 0; dt < 4; ++dt) {
            const LAS bf16_t* vp = Vt + (dt * 16 + fr) * VT_STRIDE + 4 * fq;
            const u32x2 v0 = *(const LAS u32x2*)(vp + (tile0 + T0) * 16), v1 = *(const LAS u32x2*)(vp + (tile0 + T1) * 16);
            u32x4 vw; vw.x = v0.x; vw.y = v0.y; vw.z = v1.x; vw.w = v1.y;
            o[dt] = __builtin_amdgcn_mfma_f32_16x16x32_bf16(__builtin_bit_cast(bf16x8, vw), pf, o[dt], 0, 0, 0);
        }
    }
    if (qvalid) {
#pragma unroll
        for (int dt = 0; dt < 4; ++dt) { u32x2 w; w.x = cvt_pk_bf16(o[dt][0], o[dt][1]); w.y = cvt_pk_bf16(o[dt][2], o[dt][3]); *(u32x2*)(optr + dt * 16) = w; }
    }
}

__device__ __forceinline__ void mixer_phase(const Params& p, int l, LAS unsigned char* lds) {
    const int G = gridDim.x, bid = blockIdx.x, i = l >> 1;
    const bf16_t* QKV = (const bf16_t*)(p.ws + WS_QKV); const bf16_t* GLU = (const bf16_t*)(p.ws + WS_GLU); bf16_t* CAT = (bf16_t*)(p.ws + WS_CAT);
    const float* qn = p.in[I_QN] + i * 64; const float* kn = p.in[I_KN] + i * 64; const float* sinks = p.in[I_SINK] + i * 8;
    constexpr int N_PA = 256, N_CV = 640, N_SA = 128;
#define MIX_PRE int tid = threadIdx.x; asm volatile("" : "+v"(tid)); const int wave = tid >> 6, lane = tid & 63, fr = lane & 15, fq = lane >> 4; (void)wave; (void)fr; (void)fq;
    for (int u = bid; u < N_PA; u += G) {
        MIX_PRE
        {
#ifndef X_NOPA
            const int kh = u & 1, blk = (u >> 1) & 31, b = u >> 6;
            const int rowQ0 = b * 4096 + blk * 128, rowK0 = rowQ0 - 128;
            LAS bf16_t* Ks = (LAS bf16_t*)lds; LAS bf16_t* Vt = (LAS bf16_t*)(lds + 256 * KS_STRIDE * 2);
            const int chunk = tid & 7;
            const f32x4 kn0 = *(const f32x4*)(kn + chunk * 8), kn1 = *(const f32x4*)(kn + chunk * 8 + 4);
#pragma unroll 1
            for (int ps = 0; ps < 4; ++ps) {
                const int key = (tid >> 3) + 64 * ps;
                u32x4 kr = (u32x4){0u, 0u, 0u, 0u}, vr = kr;
                const bool have = (blk > 0) || (key >= 128);
                if (have) { const bf16_t* rp = QKV + (size_t)(rowK0 + key) * 768 + 512 + kh * 64 + chunk * 8; kr = *(const u32x4*)rp; vr = *(const u32x4*)(rp + 128); }
                float kf[8], vf[8];
#pragma unroll
                for (int j = 0; j < 4; ++j) { kf[2 * j] = bflo(kr[j]); kf[2 * j + 1] = bfhi(kr[j]); vf[2 * j] = bflo(vr[j]); vf[2 * j + 1] = bfhi(vr[j]); }
                float ss = 0.f;
#pragma unroll
                for (int j = 0; j < 8; ++j) ss += kf[j] * kf[j];
                ss += __shfl_xor(ss, 1); ss += __shfl_xor(ss, 2); ss += __shfl_xor(ss, 4);
                const float rk = rsqrtf(ss * (1.0f / 64.0f) + RMS_EPS);
#pragma unroll
                for (int j = 0; j < 4; ++j) { kf[j] *= rk * kn0[j]; kf[4 + j] *= rk * kn1[j]; }
                u32x4 kw; kw.x = cvt_pk_bf16(kf[0], kf[1]); kw.y = cvt_pk_bf16(kf[2], kf[3]); kw.z = cvt_pk_bf16(kf[4], kf[5]); kw.w = cvt_pk_bf16(kf[6], kf[7]);
                *(LAS u32x4*)(Ks + key * KS_STRIDE + chunk * 8) = kw;
#pragma unroll
                for (int j = 0; j < 4; ++j) { Vt[(chunk * 8 + 2 * j) * VT_STRIDE + key] = (bf16_t)(vr[j] & 0xffffu); Vt[(chunk * 8 + 2 * j + 1) * VT_STRIDE + key] = (bf16_t)(vr[j] >> 16); }
                if (blk == 31 && key >= 128) {
                    float* ko = p.out + O_KP + ((((size_t)i * 4 + b) * 128 + (key - 128)) * 2 + kh) * 64 + chunk * 8;
                    float* vo = p.out + O_VP + ((((size_t)i * 4 + b) * 128 + (key - 128)) * 2 + kh) * 64 + chunk * 8;
                    *(f32x4*)ko = (f32x4){kf[0], kf[1], kf[2], kf[3]}; *(f32x4*)(ko + 4) = (f32x4){kf[4], kf[5], kf[6], kf[7]};
                    *(f32x4*)vo = (f32x4){vf[0], vf[1], vf[2], vf[3]}; *(f32x4*)(vo + 4) = (f32x4){vf[4], vf[5], vf[6], vf[7]};
                }
            }
            __syncthreads();
            const int r0 = wave * 16;
#pragma unroll 1
            for (int g = 0; g < 4; ++g) {
                const int h = kh * 4 + g;
                const float slope = exp2f(-(float)(h + 1)), sink = sinks[h];
                const size_t row = (size_t)(rowQ0 + r0 + fr);
                attn_item(Ks, Vt, wave, r0, blk == 0, true, QKV + row * 768 + h * 64 + fq * 8, qn, slope, sink, CAT + row * DM + 512 + h * 64 + 4 * fq, fr, fq);
            }
            __syncthreads();
#endif
        }
    }
#ifndef X_NOCV
    f32x2 wdw[31]; f32x2 bias;
    { int t0 = threadIdx.x; asm volatile("" : "+v"(t0)); const int c0 = (t0 & 255) * 2;
      const float* wp = p.in[I_WDW] + (size_t)i * 31 * 512 + c0; asm volatile("" : "+v"(wp));
#pragma unroll
      for (int j = 0; j < 31; ++j) { wdw[j] = *(const f32x2*)wp; wp += 512; asm volatile("" : "+v"(wp)); }
      bias = *(const f32x2*)(p.in[I_BDW] + i * 512 + c0); }
    for (int cu = bid; cu < N_CV; cu += G) {
        MIX_PRE
        {
            const int c2 = tid & 255, half = tid >> 8, c = c2 * 2; const bool prm = cu < 512;
            LAS float* ybuf = (LAS float*)lds;
            if (prm && ((cu & 127) * 32 + half * 16) >= 30) {
                const int b = cu >> 7, tb0 = (cu & 127) * 32 + half * 16;
                unsigned raw[46];
                { const bf16_t* gp = GLU + ((size_t)b * 4096 + tb0 - 30) * 512 + c; asm volatile("" : "+v"(gp));
#pragma unroll
                  for (int j = 0; j < 46; ++j) { raw[j] = *(const unsigned*)gp; gp += 512; asm volatile("" : "+v"(gp)); } }
                if (tb0 >= 4064) {
                    float* oc = p.out + O_CONVP + (((size_t)i * 4 + b) * 30) * 512 + c; asm volatile("" : "+v"(oc));
#pragma unroll
                    for (int j = 0; j < 16; ++j) { const int t = tb0 + j; if (t >= 4066) *(f32x2*)(oc + (size_t)(t - 4066) * 512) = (f32x2){bflo(raw[30 + j]), bfhi(raw[30 + j])}; }
                }
#pragma unroll
                for (int q = 0; q < 2; ++q) {
                    f32x2 win[38];
#pragma unroll
                    for (int j = 0; j < 38; ++j) win[j] = (f32x2){bflo(raw[q * 8 + j]), bfhi(raw[q * 8 + j])};
#pragma unroll
                    for (int t = 0; t < 8; ++t) {
                        f32x2 y = bias;
#pragma unroll
                        for (int j = 0; j < 31; ++j) y += wdw[j] * win[t + j];
                        *(LAS f32x2*)(ybuf + (half * 16 + q * 8 + t) * 512 + c) = y;
                    }
                    __builtin_amdgcn_sched_barrier(0);
                }
            } else if (prm) {
#pragma unroll 1
                for (int q = 0; q < 2; ++q) {
                    const int b = cu >> 7, tl = half * 16 + q * 8, tb = (cu & 127) * 32 + tl;
                    f32x2 win[38];
                    {
                        int vz; asm volatile("v_mov_b32 %0, 0" : "=v"(vz));
                        const bf16_t* gp = GLU + (size_t)b * 4096 * 512 + c; asm volatile("" : "+v"(gp));
#pragma unroll
                        for (int j = 0; j < 38; ++j) { const int tj = tb - 30 + j + vz; const unsigned w = *(const unsigned*)gp; if (tj >= 0) gp += 512; asm volatile("" : "+v"(gp));
                            win[j] = tj < 0 ? (f32x2){0.f, 0.f} : (f32x2){bflo(w), bfhi(w)}; }
                    }
#pragma unroll
                    for (int t = 0; t < 8; ++t) {
                        f32x2 y = bias;
#pragma unroll
                        for (int j = 0; j < 31; ++j) y += wdw[j] * win[t + j];
                        *(LAS f32x2*)(ybuf + (tl + t) * 512 + c) = y;
                    }
                }
            } else {
                const int sq = cu - 512;
                f32x2 win[34];
                const float* cc = p.in[I_CCONV] + (((size_t)i * 128 + sq) * 30 + half * 4) * 512 + c; asm volatile("" : "+v"(cc));
                const bf16_t* gs = GLU + ((size_t)MP + sq * 8) * 512 + c; asm volatile("" : "+v"(gs));
                float* oc = p.out + O_CONVS + (((size_t)i * 128 + sq) * 30 + half * 15) * 512 + c; asm volatile("" : "+v"(oc));
                if (half == 0) {
#pragma unroll
                    for (int j = 0; j < 30; ++j) { win[j] = *(const f32x2*)cc; cc += 512; asm volatile("" : "+v"(cc)); }
#pragma unroll
                    for (int j = 0; j < 4; ++j) { const unsigned w = *(const unsigned*)gs; gs += 512; asm volatile("" : "+v"(gs)); win[30 + j] = (f32x2){bflo(w), bfhi(w)}; }
#pragma unroll
                    for (int j = 0; j < 15; ++j) { *(f32x2*)oc = win[8 + j]; oc += 512; asm volatile("" : "+v"(oc)); }
                } else {
#pragma unroll
                    for (int j = 0; j < 26; ++j) { win[j] = *(const f32x2*)cc; cc += 512; asm volatile("" : "+v"(cc)); }
#pragma unroll
                    for (int j = 0; j < 8; ++j) { const unsigned w = *(const unsigned*)gs; gs += 512; asm volatile("" : "+v"(gs)); win[26 + j] = (f32x2){bflo(w), bfhi(w)}; }
#pragma unroll
                    for (int j = 0; j < 15; ++j) { *(f32x2*)oc = win[19 + j]; oc += 512; asm volatile("" : "+v"(oc)); }
                }
#pragma unroll
                for (int t = 0; t < 4; ++t) {
                    f32x2 y = bias;
#pragma unroll
                    for (int j = 0; j < 31; ++j) y += wdw[j] * win[t + j];
                    *(LAS f32x2*)(ybuf + (half * 4 + t) * 512 + c) = y;
                }
            }
            __syncthreads();
            {
                const float* gp = p.in[I_CNG] + i * 512 + lane * 8; const float* bp = p.in[I_CNB] + i * 512 + lane * 8;
                const f32x4 g0 = *(const f32x4*)gp, g1 = *(const f32x4*)(gp + 4), b0 = *(const f32x4*)bp, b1 = *(const f32x4*)(bp + 4);
#pragma unroll 1
                for (int q = 0; q < (prm ? 4 : 1); ++q) {
                    const int tk = prm ? wave * 4 + q : wave; const size_t row = prm ? (size_t)cu * 32 + tk : (size_t)MP + (size_t)(cu - 512) * 8 + tk;
                    const f32x4 v0 = *(const LAS f32x4*)(ybuf + tk * 512 + lane * 8), v1 = *(const LAS f32x4*)(ybuf + tk * 512 + lane * 8 + 4);
                    const float mean = wave_sum((v0[0] + v0[1]) + (v0[2] + v0[3]) + (v1[0] + v1[1]) + (v1[2] + v1[3])) * (1.0f / 512.0f);
                    const f32x4 d0 = v0 - mean, d1 = v1 - mean;
                    const float var = wave_sum((d0[0] * d0[0] + d0[1] * d0[1]) + (d0[2] * d0[2] + d0[3] * d0[3]) + (d1[0] * d1[0] + d1[1] * d1[1]) + (d1[2] * d1[2] + d1[3] * d1[3])) * (1.0f / 512.0f);
                    const float rs = rsqrtf(var + LN_EPS);
                    f32x4 o0 = d0 * rs * g0 + b0, o1 = d1 * rs * g1 + b1;
#pragma unroll
                    for (int j = 0; j < 4; ++j) { o0[j] = o0[j] * fast_sigmoid(o0[j]); o1[j] = o1[j] * fast_sigmoid(o1[j]); }
                    u32x4 w; w.x = cvt_pk_bf16(o0[0], o0[1]); w.y = cvt_pk_bf16(o0[2], o0[3]); w.z = cvt_pk_bf16(o1[0], o1[1]); w.w = cvt_pk_bf16(o1[2], o1[3]);
                    *(u32x4*)(CAT + row * DM + lane * 8) = w;
                }
            }
            __syncthreads();
        }
    }
#endif
    for (int s = bid - 128; s < N_SA; s += G) {
        if (s < 0) continue;
        MIX_PRE
        {
#ifndef X_NOSA
            LAS bf16_t* Ks = (LAS bf16_t*)lds; LAS bf16_t* Vt = (LAS bf16_t*)(lds + 2 * 144 * KS_STRIDE * 2);
            const int chunk = tid & 7;
            const f32x4 kn0 = *(const f32x4*)(kn + chunk * 8), kn1 = *(const f32x4*)(kn + chunk * 8 + 4);
#pragma unroll 1
            for (int it = tid; it < 2 * 144 * 8; it += 512) {
                const int kk = it >> 3, kh = kk / 144, key = kk % 144;
                float kf[8], vf[8];
#pragma unroll
                for (int j = 0; j < 8; ++j) { kf[j] = 0.f; vf[j] = 0.f; }
                const bool isnew = (key >= 128) && (key < 136);
                if (key < 128) {
                    const size_t off = ((((size_t)i * 128 + s) * 128 + key) * 2 + kh) * 64 + chunk * 8;
                    const f32x4 a0 = *(const f32x4*)(p.in[I_CK] + off), a1 = *(const f32x4*)(p.in[I_CK] + off + 4), c0 = *(const f32x4*)(p.in[I_CV] + off), c1 = *(const f32x4*)(p.in[I_CV] + off + 4);
#pragma unroll
                    for (int j = 0; j < 4; ++j) { kf[j] = a0[j]; kf[4 + j] = a1[j]; vf[j] = c0[j]; vf[4 + j] = c1[j]; }
                } else if (isnew) {
                    const bf16_t* rp = QKV + ((size_t)MP + s * 8 + (key - 128)) * 768 + 512 + kh * 64 + chunk * 8;
                    const u32x4 kr = *(const u32x4*)rp, vr = *(const u32x4*)(rp + 128);
#pragma unroll
                    for (int j = 0; j < 4; ++j) { kf[2 * j] = bflo(kr[j]); kf[2 * j + 1] = bfhi(kr[j]); vf[2 * j] = bflo(vr[j]); vf[2 * j + 1] = bfhi(vr[j]); }
                }
                float ss = 0.f;
#pragma unroll
                for (int j = 0; j < 8; ++j) ss += kf[j] * kf[j];
                ss += __shfl_xor(ss, 1); ss += __shfl_xor(ss, 2); ss += __shfl_xor(ss, 4);
                const float rk = rsqrtf(ss * (1.0f / 64.0f) + RMS_EPS);
                if (isnew) {
#pragma unroll
                    for (int j = 0; j < 4; ++j) { kf[j] *= rk * kn0[j]; kf[4 + j] *= rk * kn1[j]; }
                }
                u32x4 kw; kw.x = cvt_pk_bf16(kf[0], kf[1]); kw.y = cvt_pk_bf16(kf[2], kf[3]); kw.z = cvt_pk_bf16(kf[4], kf[5]); kw.w = cvt_pk_bf16(kf[6], kf[7]);
                *(LAS u32x4*)(Ks + (kh * 144 + key) * KS_STRIDE + chunk * 8) = kw;
                u32x4 vw; vw.x = cvt_pk_bf16(vf[0], vf[1]); vw.y = cvt_pk_bf16(vf[2], vf[3]); vw.z = cvt_pk_bf16(vf[4], vf[5]); vw.w = cvt_pk_bf16(vf[6], vf[7]);
#pragma unroll
                for (int j = 0; j < 4; ++j) { Vt[(kh * 64 + chunk * 8 + 2 * j) * VT_STRIDE + key] = (bf16_t)(vw[j] & 0xffffu); Vt[(kh * 64 + chunk * 8 + 2 * j + 1) * VT_STRIDE + key] = (bf16_t)(vw[j] >> 16); }
                if (key >= 8 && key < 136) {
                    const size_t oo = ((((size_t)i * 128 + s) * 128 + (key - 8)) * 2 + kh) * 64 + chunk * 8;
                    float* ko = p.out + O_KS + oo; float* vo = p.out + O_VS + oo;
                    *(f32x4*)ko = (f32x4){kf[0], kf[1], kf[2], kf[3]}; *(f32x4*)(ko + 4) = (f32x4){kf[4], kf[5], kf[6], kf[7]};
                    *(f32x4*)vo = (f32x4){vf[0], vf[1], vf[2], vf[3]}; *(f32x4*)(vo + 4) = (f32x4){vf[4], vf[5], vf[6], vf[7]};
                }
            }
            __syncthreads();
            {
                const int kh = wave >> 2, g = wave & 3, h = kh * 4 + g;
                const float slope = exp2f(-(float)(h + 1)), sink = sinks[h];
                const size_t row = (size_t)MP + s * 8 + (fr & 7);
                attn_item(Ks + kh * 144 * KS_STRIDE, Vt + kh * 64 * VT_STRIDE, 0, 0, false, fr < 8, QKV + row * 768 + h * 64 + fq * 8, qn, slope, sink, CAT + row * DM + 512 + h * 64 + 4 * fq, fr, fq);
            }
            __syncthreads();
#endif
        }
    }
}


__device__ __forceinline__ void splitk_reduce(float* Y, bf16_t* XB, ssq_t* ssq, const float* part, const pg8::StaticOrder& S, int KS) {
    int tid = threadIdx.x; asm volatile("" : "+v"(tid));
    const int wid = tid >> 6, lane = tid & 63, wr = wid >> 2, wc = wid & 3, fr = lane & 15, fq = lane >> 4;
    for (int task = blockIdx.x; task < 256; task += gridDim.x) {
        const int e = task >> 4, ai = (task >> 3) & 1, m = (task >> 1) & 3, bj = task & 1;
        pg8::Unit u; S.tile(256 + e, u);
        const float* pp = part + (size_t)(e * KS) * 65536 + (size_t)((((ai * 4 + m) * 2 + bj) * 2) * 2048) + (size_t)tid * 4;
        f32x4 a0 = (f32x4){0.f, 0.f, 0.f, 0.f}, a1 = a0;
        for (int k = 0; k < KS; ++k) { a0 += *(const f32x4*)(pp + (size_t)k * 65536); a1 += *(const f32x4*)(pp + (size_t)k * 65536 + 2048); }
        const int r = u.pm * 256 + ai * 128 + wr * 64 + m * 16 + fr, col = u.pn * 256 + bj * 128 + wc * 32 + 8 * fq;
        bf16_t* bp = XB + (size_t)r * DM + col;
        f32x4 x0, x1; bf8_to_f32(*(const u32x4*)bp, x0, x1);
        const f32x4 v0 = x0 + a0, v1 = x1 + a1;
        if (Y) { float* yp = Y + (size_t)r * DM + col; *(f32x4*)yp = v0; *(f32x4*)(yp + 4) = v1; continue; }
        u32x4 w; w.x = cvt_pk_bf16(v0[0], v0[1]); w.y = cvt_pk_bf16(v0[2], v0[3]); w.z = cvt_pk_bf16(v1[0], v1[1]); w.w = cvt_pk_bf16(v1[2], v1[3]);
        *(u32x4*)bp = w;
        float ss = (v0[0] * v0[0] + v0[1] * v0[1]) + (v0[2] * v0[2] + v0[3] * v0[3]) + (v1[0] * v1[0] + v1[1] * v1[1]) + (v1[2] * v1[2] + v1[3] * v1[3]);
        ss += __shfl_xor(ss, 16); ss += __shfl_xor(ss, 32);
        if (fq == 0) ssq_add(ssq + r, ss);
    }
}

#define XB_TMO      128
#define XB_XCNT(j)  (256  + 64 * (j))
#define XB_XSUB(j)  (1280 + 64 * (j))
#define XB_XGEN(j)  (2304 + 64 * (j))
#define XB_TOP      3328
#define XB_TOPGEN   3392
#define XCD_BAR_WORDS 3456
#define XB_SPIN_CAP (1u << 22)
__device__ __forceinline__ unsigned xb_ld(unsigned* p)              { return __hip_atomic_load(p, __ATOMIC_RELAXED, __HIP_MEMORY_SCOPE_AGENT); }
__device__ __forceinline__ unsigned xb_add(unsigned* p, unsigned v) { return __hip_atomic_fetch_add(p, v, __ATOMIC_RELAXED, __HIP_MEMORY_SCOPE_AGENT); }
__device__ __forceinline__ unsigned xb_xcc_id() { return (unsigned)__builtin_amdgcn_s_getreg((3 << 11) | 20) & 0xFu; }
#define XB_SPIN(cond, bar) do { unsigned _sp = 0; while (cond) { __builtin_amdgcn_s_sleep(1); \
    if ((++_sp & 255u) == 0u) { if (xb_ld(&(bar)[XB_TMO])) break; if (_sp > XB_SPIN_CAP) { atomicAdd(&(bar)[XB_TMO], 1u); break; } } } } while (0)
struct XcdBarrier { unsigned* bar; unsigned x; volatile LAS unsigned* st; };
__device__ __forceinline__ XcdBarrier xcd_barrier_post(unsigned* bar, volatile LAS unsigned* st) {
    XcdBarrier b; b.bar = bar; b.x = xb_xcc_id(); b.st = st;
    if (threadIdx.x == 0) st[2] = xb_add(&bar[XB_XCNT(b.x)], 1u);
    return b;
}
__device__ __forceinline__ void xcd_barrier_complete(unsigned* bar, unsigned x, unsigned& nloc, unsigned& nx) {
    const unsigned G = gridDim.x * gridDim.y * gridDim.z;
    unsigned sum, cnt, mine, sp = 0u;
    for (;;) {
        sum = 0u; cnt = 0u; mine = 0u;
#pragma unroll
        for (unsigned j = 0; j < 16; ++j) { const unsigned c = xb_ld(&bar[XB_XCNT(j)]); sum += c; cnt += (c > 0u) ? 1u : 0u; mine = (j == x) ? c : mine; }
        if (sum == G) break;
        __builtin_amdgcn_s_sleep(1);
        if ((++sp & 255u) == 0u) { if (xb_ld(&bar[XB_TMO])) break; if (sp > XB_SPIN_CAP) { atomicAdd(&bar[XB_TMO], 1u); break; } }
    }
    nloc = mine > 0u ? mine : 1u; nx = cnt > 0u ? cnt : 1u;
}
__device__ __forceinline__ void xcd_barrier(const XcdBarrier& b) {
    asm volatile("s_waitcnt vmcnt(0)" ::: "memory");
    __syncthreads();
    if (threadIdx.x == 0) {
        unsigned* bar = b.bar;
        __builtin_amdgcn_s_waitcnt(0);
        unsigned nloc = b.st[0], nx = b.st[1];
        if (nloc == 0u) { xcd_barrier_complete(bar, b.x, nloc, nx); b.st[0] = nloc; b.st[1] = nx; }
        const unsigned old = xb_add(&bar[XB_XSUB(b.x)], 1u);
        const unsigned gen = old / nloc;
        if (old + 1u == (gen + 1u) * nloc) {
            __builtin_amdgcn_fence(__ATOMIC_RELEASE, "agent");
            asm volatile("s_waitcnt vmcnt(0)" ::: "memory");
            const unsigned og = xb_add(&bar[XB_TOP], 1u);
            const unsigned tg = og / nx;
            if (og + 1u == (tg + 1u) * nx) xb_add(&bar[XB_TOPGEN], 1u);
            else XB_SPIN(xb_ld(&bar[XB_TOPGEN]) == tg, bar);
            __builtin_amdgcn_fence(__ATOMIC_ACQUIRE, "agent");
            xb_add(&bar[XB_XGEN(b.x)], 1u);
            asm volatile("s_waitcnt vmcnt(0)" ::: "memory");
        } else {
            XB_SPIN(xb_ld(&bar[XB_XGEN(b.x)]) == gen, bar);
            __builtin_amdgcn_fence(__ATOMIC_ACQUIRE, "agent");
            asm volatile("s_waitcnt vmcnt(0)" ::: "memory");
        }
    }
    __syncthreads();
}

__global__ void __launch_bounds__(512, 2) fwd_megakernel(Params p) {
    extern __shared__ __attribute__((aligned(16))) unsigned char lds_raw[];
    LAS unsigned char* lds = (LAS unsigned char*)lds_raw;
    cg::grid_group grid = cg::this_grid();
    const int G = gridDim.x, bid = blockIdx.x;
    bf16_t* XB = (bf16_t*)(p.ws + WS_XB); ssq_t* SSQ = (ssq_t*)(p.ws + WS_SSQ); float* PART = (float*)(p.ws + WS_PART);
#define IN(k) (p.ph_lo <= (k) && (k) < p.ph_hi)
#define SYNC(k) do { if (p.ph_hi > (k) + 1) xcd_barrier(bar); } while (0)
    unsigned* barw = (unsigned*)(p.ws + WS_BAR);
    volatile LAS unsigned* bst = (volatile LAS unsigned*)(lds + 131072);
    if (threadIdx.x < 4) bst[threadIdx.x] = 0u;
    __syncthreads();
    XcdBarrier bar = xcd_barrier_post(barw, bst);
#ifndef X_NOPREP
    if (IN(0)) prep_phase(p, lds);
    if (p.ph_lo < 0) grid.sync();
    xcd_barrier(bar);
    for (int rep = 0; rep < DUP_SYNC; ++rep) xcd_barrier(bar);
    int vbid = bid;
    { bool okc = (G == 256);
#pragma unroll
      for (int j = 0; j < 16; ++j) { const unsigned cj = xb_ld(&barw[XB_XCNT(j)]); okc = okc && (cj == (j < 8 ? 32u : 0u)); }
      if (okc) vbid = (int)(bar.x + 8u * bst[2]); }
#endif
#pragma unroll 1
    for (int l = 0; l < 4; ++l) {
        const int pb = 1 + 5 * l, i = l >> 1;
        ssq_t* ssq_in = SSQ + (size_t)(2 * l) * MT;
        ssq_t* ssq_mid = SSQ + (size_t)(2 * l + 1) * MT;
        ssq_t* ssq_out = SSQ + (size_t)(2 * l + 2) * MT;
        if ((l & 1) == 0) {
            if (IN(pb) && X_GIN) {
                pg8::Gemm g{XB, (const bf16_t*)(p.ws + WS_WIN) + (size_t)i * DIN * DM, MT, DIN, DM}; pg8::StaticOrder S; S.init(MT, DIN, DM, G, vbid);
                EpiIn E{ssq_in, (bf16_t*)(p.ws + WS_GLU), (bf16_t*)(p.ws + WS_QKV)};
                for (int rep = 0; rep <= DUP_IN; ++rep) { pg8::gemm_phase(lds, g, S, E); SYNC(pb); }
            }
#ifndef X_NOMIX
            if (IN(pb + 1)) { for (int rep = 0; rep <= DUP_MIX; ++rep) { mixer_phase(p, l, lds); SYNC(pb + 1); } }
#endif
            if (IN(pb + 2) && X_GOUT) {
                pg8::Gemm g{(const bf16_t*)(p.ws + WS_CAT), (const bf16_t*)(p.ws + WS_WOUT) + (size_t)i * DM * DM, MT, DM, DM}; pg8::SplitOrder<false> S; S.init2(MT, DM, DM, G, vbid, 4);
                EpiRes<false> E{nullptr, XB, ssq_mid, nullptr, PART};
                pg8::gemm_phase(lds, g, S, E);
                xcd_barrier(bar);
                splitk_reduce(nullptr, XB, ssq_mid, PART, S, 4);
                SYNC(pb + 2);
            }
        } else {
#ifndef X_NOPOOL1
            if (IN(pb)) { for (int rep = 0; rep <= DUP_POOL1; ++rep) { pool1_phase(p, l, ssq_in); SYNC(pb); } }
#endif
            if (IN(pb + 1) && X_GPOOL) {
                pg8::Gemm g{(const bf16_t*)(p.ws + WS_DG), (const bf16_t*)(p.ws + WS_WPL) + (size_t)i * 4 * 65536, 4 * MT, 256, 256}; pg8::PoolOrder S{G, vbid};
                EpiRes<true> E{nullptr, XB, ssq_mid, p.in[I_PSCALE] + i * DM, PART};
                pg8::gemm_phase(lds, g, S, E);
                SYNC(pb + 2);
            }
        }
        if (IN(pb + 3) && X_GGU) {
            pg8::Gemm g{XB, (const bf16_t*)(p.ws + WS_WGU) + (size_t)l * 2 * DFF * DM, MT, 2 * DFF, DM}; pg8::StaticOrder S; S.init(MT, 2 * DFF, DM, G, vbid);
            EpiGU E{ssq_mid, (bf16_t*)(p.ws + WS_ACT)};
            for (int rep = 0; rep <= DUP_GU; ++rep) { pg8::gemm_phase(lds, g, S, E); SYNC(pb + 3); }
        }
        if (IN(pb + 4) && X_GDN) {
            pg8::Gemm g{(const bf16_t*)(p.ws + WS_ACT), (const bf16_t*)(p.ws + WS_WDN) + (size_t)l * DM * DFF, MT, DM, DFF}; pg8::SplitOrder<true> S; S.init2(MT, DM, DFF, G, vbid, 11);
            float* Yout = (l == 3) ? p.out : nullptr;
            EpiRes<false> E{Yout, XB, ssq_out, nullptr, PART};
            pg8::gemm_phase(lds, g, S, E);
            xcd_barrier(bar);
            splitk_reduce(Yout, XB, ssq_out, PART, S, 11);
            SYNC(pb + 4);
        }
    }
#undef IN
#undef SYNC
}

extern "C" void kernel_launch(void* const* d_in, const int* in_sizes, int n_in, void* d_out, int out_size, void* d_ws, size_t ws_size, hipStream_t stream) {
    static int grid_blocks = 0;
    if (grid_blocks == 0) {
        if (n_in != N_IN || ws_size < WS_END) { fprintf(stderr, "kernel_launch: unexpected n_in %d or ws_size %zu (< %zu)\n", n_in, ws_size, (size_t)WS_END); grid_blocks = -1; return; }
        int dev = 0, cus = 0, per_cu = 0;
        hipGetDevice(&dev);
        hipDeviceGetAttribute(&cus, hipDeviceAttributeMultiprocessorCount, dev);
        hipFuncSetAttribute((const void*)fwd_megakernel, hipFuncAttributeMaxDynamicSharedMemorySize, LDS_BYTES);
        hipOccupancyMaxActiveBlocksPerMultiprocessor(&per_cu, (const void*)fwd_megakernel, 512, LDS_BYTES);
        if (per_cu < 1) { fprintf(stderr, "kernel_launch: occupancy query reports %d blocks per CU\n", per_cu); per_cu = 1; }
        grid_blocks = cus * 1;
    }
    if (grid_blocks < 0) return;
    Params p{};
    for (int k = 0; k < N_IN; ++k) p.in[k] = (const float*)d_in[k];
    p.out = (float*)d_out; p.ws = (unsigned char*)d_ws; p.ph_lo = 0; p.ph_hi = N_PHASES;
    void* args[] = {&p};
    if (hipMemsetAsync((unsigned char*)d_ws + WS_BAR, 0, 16384, stream) != hipSuccess) { fprintf(stderr, "kernel_launch: memset of the barrier words failed\n"); return; }
    hipError_t e = hipLaunchCooperativeKernel((const void*)fwd_megakernel, dim3(grid_blocks), dim3(512), args, LDS_BYTES, stream);
    if (e != hipSuccess) fprintf(stderr, "cooperative launch failed: %s (grid %d)\n", hipGetErrorString(e), grid_blocks);
}
```

```cpp
#include <hip/hip_runtime.h>
#include <hip/hip_cooperative_groups.h>
#include <cstdio>
namespace cg = cooperative_groups;

#define LAS __attribute__((address_space(3)))
#ifndef DUP_PREP
#define DUP_PREP 0
#define DUP_IN 0
#define DUP_MIX 0
#define DUP_POOL1 0
#define DUP_GU 0
#define DUP_SYNC 0
#define DUP_DN 0
#endif
#ifndef X_GIN
#define X_GIN 1
#define X_GOUT 1
#define X_GPOOL 1
#define X_GGU 1
#define X_GDN 1
#endif
typedef unsigned short bf16_t;
typedef short bf16x8 __attribute__((ext_vector_type(8)));
typedef float f32x4 __attribute__((ext_vector_type(4)));
typedef unsigned u32x4 __attribute__((ext_vector_type(4)));
typedef unsigned u32x2 __attribute__((ext_vector_type(2)));
typedef float f32x2 __attribute__((ext_vector_type(2)));
typedef unsigned long long ssq_t;

constexpr int DM = 1024, MP = 16384, MS = 1024, MT = 17408, NTM = 68, DFF = 2816, DIN = 1792;
constexpr float RMS_EPS = 1e-6f, LN_EPS = 1e-5f;
enum { I_XP = 0, I_XS, I_CCONV, I_CK, I_CV, I_SPOOL, I_NMIX, I_NFFN, I_WIN, I_QN, I_KN, I_SINK, I_WDW, I_BDW, I_CNG, I_CNB, I_WOUT, I_WPOOL, I_PSCALE, I_WG, I_WU, I_WD, N_IN };
constexpr size_t O_Y = 0;
constexpr size_t O_CONVP = (size_t)MT * DM;
constexpr size_t O_KP = O_CONVP + 2 * 4 * 30 * 512;
constexpr size_t O_VP = O_KP + 2 * 4 * 128 * 128;
constexpr size_t O_POOLP = O_VP + 2 * 4 * 128 * 128;
constexpr size_t O_CONVS = O_POOLP + 2 * 4 * 15 * 1024;
constexpr size_t O_KS = O_CONVS + (size_t)2 * 128 * 30 * 512;
constexpr size_t O_VS = O_KS + (size_t)2 * 128 * 128 * 128;
constexpr size_t O_POOLS = O_VS + (size_t)2 * 128 * 128 * 128;
constexpr size_t WS_WIN = 0;
constexpr size_t WS_WOUT = WS_WIN + (size_t)2 * DIN * DM * 2;
constexpr size_t WS_WGU = WS_WOUT + (size_t)2 * DM * DM * 2;
constexpr size_t WS_WDN = WS_WGU + (size_t)4 * 2 * DFF * DM * 2;
constexpr size_t WS_WPL = WS_WDN + (size_t)4 * DM * DFF * 2;
constexpr size_t WS_XB = WS_WPL + (size_t)2 * 4 * 256 * 256 * 2;
constexpr size_t WS_SSQ = WS_XB + (size_t)MT * DM * 2;
constexpr size_t WS_ACT = WS_SSQ + (size_t)9 * MT * 8;
constexpr size_t WS_QKV = WS_ACT;
constexpr size_t WS_GLU = WS_QKV + (size_t)MT * 768 * 2;
constexpr size_t WS_CAT = WS_GLU + (size_t)MT * 512 * 2;
constexpr size_t WS_DG = WS_ACT;
constexpr size_t WS_BAR = WS_ACT + (size_t)MT * DFF * 2;
constexpr size_t WS_PART = WS_BAR + 16384;
constexpr size_t WS_END = WS_PART + (size_t)176 * 65536 * 4;
constexpr int LDS_BYTES = 131072 + 16;
constexpr int N_PHASES = 21;

struct Params { const float* in[N_IN]; float* out; unsigned char* ws; int ph_lo, ph_hi; };

__device__ __forceinline__ unsigned cvt_pk_bf16(float lo, float hi) { unsigned r; asm("v_cvt_pk_bf16_f32 %0, %1, %2" : "=v"(r) : "v"(lo), "v"(hi)); return r; }
__device__ __forceinline__ float bflo(unsigned w) { return __uint_as_float(w << 16); }
__device__ __forceinline__ float bfhi(unsigned w) { return __uint_as_float(w & 0xffff0000u); }
__device__ __forceinline__ float bf2f(bf16_t b) { return __uint_as_float(((unsigned)b) << 16); }
__device__ __forceinline__ float wave_sum(float v) {
#pragma unroll
    for (int o = 32; o >= 1; o >>= 1) v += __shfl_xor(v, o);
    return v;
}
__device__ __forceinline__ float ssq_rs(ssq_t v) { return rsqrtf((float)v * (1.0f / (1048576.0f * 1024.0f)) + RMS_EPS); }
__device__ __forceinline__ ssq_t ssq_fix(float ss) { return (ssq_t)(ss * 1048576.0f); }
__device__ __forceinline__ void ssq_add(ssq_t* p, float ss) { (void)__hip_atomic_fetch_add(p, ssq_fix(ss), __ATOMIC_RELAXED, __HIP_MEMORY_SCOPE_AGENT); }
__device__ __forceinline__ float fast_sigmoid(float x) { return __builtin_amdgcn_rcpf(1.0f + __expf(-x)); }
__device__ __forceinline__ f32x2 pk_exp2(f32x2 v) { f32x2 r; r.x = __builtin_amdgcn_exp2f(v.x); r.y = __builtin_amdgcn_exp2f(v.y); return r; }
__device__ __forceinline__ f32x2 pk_rcp(f32x2 v) { f32x2 r; r.x = __builtin_amdgcn_rcpf(v.x); r.y = __builtin_amdgcn_rcpf(v.y); return r; }
__device__ __forceinline__ f32x2 pk_sig(f32x2 g, float k2) { return pk_rcp(pk_exp2(g * k2) + 1.0f); }

namespace pg8 {
constexpr int BM = 256, BK = 64, HALF = 128, HTB = HALF * BK * 2, STAGE_BYTES = 8 * HTB, NXCD = 8, WGM = 8;
__host__ __device__ __forceinline__ int lds_byte(int r, int c) { const int st = (r >> 4) * 2 + (c >> 5), rr = r & 15, cc = c & 31, ob = rr * 64 + cc * 2; return st * 1024 + (ob ^ (((ob >> 9) & 1) << 5)); }
__host__ __device__ __forceinline__ void stage_rc(int b, int& R, int& C) { const int st = b / 1024, sb = b % 1024, swz = sb ^ (((sb >> 9) & 1) << 5); R = (st >> 1) * 16 + swz / 64; C = (st & 1) * 32 + (swz % 64) / 2; }
__host__ __device__ __forceinline__ int perm32(int rho) { const int n = rho >> 4, i = rho & 15; return 8 * (i >> 2) + 4 * n + (i & 3); }
struct Unit { int pm, pn, k0, nt, part; };
struct Gemm { const bf16_t* A; const bf16_t* Bt; int M, N, K; };
struct StaticOrder {
    static constexpr bool SPLIT = false, ABLK = false;
    int nM, nN, nwg, G, c, ntk;
    __device__ void init(int M, int N, int K, int G_, int c_) { nM = M / BM; nN = N / BM; nwg = nM * nN; G = G_; c = c_; ntk = K / BK; }
    __device__ void tile(int L, Unit& u) const {
        int wgid = L; { const int q = nwg / NXCD, r = nwg % NXCD, xcd = wgid % NXCD, off = wgid / NXCD; wgid = (xcd < r ? xcd * (q + 1) : r * (q + 1) + (xcd - r) * q) + off; }
        const int nig = WGM * nN, gid = wgid / nig, fm = gid * WGM, gsz = (nM - fm) < WGM ? (nM - fm) : WGM;
        u.pm = fm + ((wgid % nig) % gsz); u.pn = (wgid % nig) / gsz;
    }
    __device__ bool next(int i, Unit& u) const {
        const long L = (long)i * G + c; if (L >= nwg) return false;
        tile((int)L, u); u.k0 = 0; u.nt = ntk; u.part = -1; return true;
    }
};
template <bool ABLK_> struct SplitOrder : StaticOrder {
    static constexpr bool SPLIT = true, ABLK = ABLK_;
    int KS, ntp;
    __device__ void init2(int M, int N, int K, int G_, int c_, int KS_) { init(M, N, K, G_, c_); KS = KS_; ntp = ntk / KS_; }
    __device__ bool next(int i, Unit& u) const {
        const int np = (nwg - G) * KS;
        int j = i;
        if (c < np) { if (i == 0) { tile(G + c / KS, u); u.k0 = (c % KS) * ntp; u.nt = ntp; u.part = c; return true; } j = i - 1; }
        if (j > 0) return false;
        tile(c, u); u.k0 = 0; u.nt = ntk; u.part = -1; return true;
    }
};
struct PoolOrder {
    static constexpr bool SPLIT = false, ABLK = false;
    int G, c;
    __device__ bool next(int i, Unit& u) const { const int L = i * G + c; if (L >= 4 * NTM) return false; u.pm = L; u.pn = L / NTM; u.k0 = 0; u.nt = 4; u.part = -1; return true; }
};

template <class Epi, class Sched>
__device__ __forceinline__ void gemm_phase(LAS unsigned char* lds, const Gemm g, const Sched& S, const Epi& E) {
    int tid = threadIdx.x; asm volatile("" : "+v"(tid));
    const int wid = __builtin_amdgcn_readfirstlane(tid >> 6), lane = tid & 63, wr = wid >> 2, wc = wid & 3, fr = lane & 15, fq = lane >> 4;
    int K = g.K; asm volatile("" : "+s"(K));
    unsigned voffA[2], voffB[2];
#pragma unroll
    for (int i = 0; i < 2; ++i) { int R, C; stage_rc(tid * 16 + i * 8192, R, C); const int Rb = (R & ~31) + perm32(R & 31);
        voffA[i] = Sched::ABLK ? (unsigned)(R * 64 + C) * 2u : (unsigned)(R * K + C) * 2u; voffB[i] = (unsigned)(Rb * K + C) * 2u; }
    const size_t kstep = (size_t)(BK * 2);
    const size_t hstep = (size_t)HALF * K * 2;
    const size_t tstep = 2 * hstep;
    const size_t kstepA = Sched::ABLK ? (size_t)32768 : kstep, hstepA = Sched::ABLK ? (size_t)16384 : hstep;
    const unsigned ldsw = (unsigned)wid * 1024u;
    const int aoff = lds_byte(wr * 64 + fr, fq * 8), boff = lds_byte(wc * 32 + fr, fq * 8);
#define PG8_SA(b, h) (((b) * 2 + (h)) * HTB)
#define PG8_SB(b, h) ((4 + (b) * 2 + (h)) * HTB)
#define PG8_STAGE(bufoff, gbase, voff) do { _Pragma("unroll") for (int _i = 0; _i < 2; ++_i) \
        __builtin_amdgcn_global_load_lds((const unsigned*)((const char*)(gbase) + (voff)[_i]), (LAS unsigned*)(lds + (bufoff) + ldsw + _i * 8192), 16, 0, 0); } while (0)
#define PG8_LDA(dst, b, h) do { _Pragma("unroll") for (int m = 0; m < 4; ++m) _Pragma("unroll") for (int k = 0; k < 2; ++k) dst[m][k] = *(const LAS bf16x8*)(lds + PG8_SA(b, h) + aoff + m * 2048 + k * 1024); } while (0)
#define PG8_LDB(dst, b, h) do { _Pragma("unroll") for (int n = 0; n < 2; ++n) _Pragma("unroll") for (int k = 0; k < 2; ++k) dst[n][k] = *(const LAS bf16x8*)(lds + PG8_SB(b, h) + boff + n * 2048 + k * 1024); } while (0)
#define PG8_MMA(ai, bj, At, Bt) do { __builtin_amdgcn_s_setprio(1); _Pragma("unroll") for (int m = 0; m < 4; ++m) _Pragma("unroll") for (int n = 0; n < 2; ++n) _Pragma("unroll") for (int k = 0; k < 2; ++k) \
        acc[ai][bj][m][n] = __builtin_amdgcn_mfma_f32_16x16x32_bf16(Bt[n][k], At[m][k], acc[ai][bj][m][n], 0, 0, 0); __builtin_amdgcn_s_setprio(0); } while (0)
#define PG8_WAIT_V(n) asm volatile("s_waitcnt vmcnt(" #n ")" ::: "memory")
#define PG8_WAIT_L(n) asm volatile("s_waitcnt lgkmcnt(" #n ")" ::: "memory")
#define PG8_BAR __builtin_amdgcn_s_barrier()
#define PG8_SCHED __builtin_amdgcn_sched_barrier(0)
    Unit cur, nxt; int ui = 0;
    if (!S.next(0, cur)) return;
    f32x4 acc[2][2][4][2];
    E.init(acc, cur, wr, wc, fr, fq);
    bf16x8 At[4][2], B0[2][2], B1[2][2];
    const char* cA = (const char*)g.A + (size_t)cur.pm * tstep; const char* cB = (const char*)g.Bt + (size_t)cur.pn * tstep;
    if constexpr (Sched::SPLIT) { cA += (size_t)cur.k0 * kstepA; cB += (size_t)cur.k0 * kstep; }
    const int ntc = K / BK;
    PG8_STAGE(PG8_SB(0, 0), cB, voffB); PG8_STAGE(PG8_SA(0, 0), cA, voffA); PG8_STAGE(PG8_SB(0, 1), cB + hstep, voffB); PG8_STAGE(PG8_SA(0, 1), cA + hstepA, voffA);
    if (wr == 1) PG8_BAR;
    PG8_WAIT_V(4); PG8_BAR;
    PG8_STAGE(PG8_SB(1, 0), cB + kstep, voffB); PG8_STAGE(PG8_SA(1, 0), cA + kstepA, voffA); PG8_STAGE(PG8_SB(1, 1), cB + hstep + kstep, voffB);
    PG8_WAIT_V(6); PG8_BAR;
    for (;;) {
        const bool has_next = S.next(ui + 1, nxt);
        const char* nA = has_next ? (const char*)g.A + (size_t)nxt.pm * tstep : cA; const char* nB = has_next ? (const char*)g.Bt + (size_t)nxt.pn * tstep : cB;
        if constexpr (Sched::SPLIT) { if (has_next) { nA += (size_t)nxt.k0 * kstepA; nB += (size_t)nxt.k0 * kstep; } }
        const int nt = Sched::SPLIT ? cur.nt : ntc;
        for (int t = 0; t < nt; t += 2) {
            const bool last = (t == nt - 2);
            const char* a1 = cA + (size_t)(t + 1) * kstepA;
            const char* a2 = last ? nA : cA + (size_t)(t + 2) * kstepA; const char* b2 = last ? nB : cB + (size_t)(t + 2) * kstep;
            const char* a3 = a2 + kstepA; const char* b3 = b2 + kstep;
            PG8_LDB(B0, 0, 0); PG8_SCHED; PG8_LDA(At, 0, 0); PG8_STAGE(PG8_SA(1, 1), a1 + hstepA, voffA);
            PG8_WAIT_L(8); PG8_BAR; PG8_WAIT_L(0); PG8_MMA(0, 0, At, B0); PG8_BAR; PG8_SCHED;
            PG8_LDB(B1, 0, 1); PG8_STAGE(PG8_SB(0, 0), b2, voffB);
            PG8_BAR; PG8_WAIT_L(0); PG8_MMA(0, 1, At, B1); PG8_BAR;
            PG8_LDA(At, 0, 1); PG8_STAGE(PG8_SA(0, 0), a2, voffA);
            PG8_BAR; PG8_WAIT_L(0); PG8_MMA(1, 0, At, B0); PG8_BAR; PG8_SCHED;
            PG8_STAGE(PG8_SB(0, 1), b2 + hstep, voffB);
            PG8_WAIT_V(6); PG8_BAR; PG8_MMA(1, 1, At, B1); PG8_BAR;
            PG8_LDB(B0, 1, 0); PG8_SCHED; PG8_LDA(At, 1, 0); PG8_STAGE(PG8_SA(0, 1), a2 + hstepA, voffA);
            PG8_WAIT_L(8); PG8_BAR; PG8_WAIT_L(0); PG8_MMA(0, 0, At, B0); PG8_BAR; PG8_SCHED;
            PG8_LDB(B1, 1, 1); PG8_STAGE(PG8_SB(1, 0), b3, voffB);
            PG8_BAR; PG8_WAIT_L(0); PG8_MMA(0, 1, At, B1); PG8_BAR;
            PG8_LDA(At, 1, 1); PG8_STAGE(PG8_SA(1, 0), a3, voffA);
            PG8_BAR; PG8_WAIT_L(0); PG8_MMA(1, 0, At, B0); PG8_BAR; PG8_SCHED;
            PG8_STAGE(PG8_SB(1, 1), b3 + hstep, voffB);
            PG8_WAIT_V(6); PG8_BAR; PG8_MMA(1, 1, At, B1); PG8_BAR;
        }
        E(acc, cur, wr, wc, fr, fq);
        if (!has_next) break;
        E.init(acc, nxt, wr, wc, fr, fq);
        cur = nxt; cA = nA; cB = nB; ++ui;
    }
    PG8_WAIT_V(0);
    if (wr == 0) PG8_BAR;
    PG8_BAR;
#undef PG8_SA
#undef PG8_SB
#undef PG8_STAGE
#undef PG8_LDA
#undef PG8_LDB
#undef PG8_MMA
#undef PG8_WAIT_V
#undef PG8_WAIT_L
#undef PG8_BAR
#undef PG8_SCHED
}
}

__device__ __forceinline__ void acc_zero(f32x4 (&acc)[2][2][4][2]) {
#pragma unroll
    for (int a = 0; a < 2; ++a)
#pragma unroll
        for (int b = 0; b < 2; ++b)
#pragma unroll
            for (int m = 0; m < 4; ++m)
#pragma unroll
                for (int n = 0; n < 2; ++n) acc[a][b][m][n] = (f32x4){0.f, 0.f, 0.f, 0.f};
}
struct EpiIn {
    const ssq_t* ssq; bf16_t* glu; bf16_t* qkv;
    __device__ __forceinline__ void init(f32x4 (&acc)[2][2][4][2], const pg8::Unit&, int, int, int, int) const { acc_zero(acc); }
    __device__ __forceinline__ void operator()(const f32x4 (&acc)[2][2][4][2], const pg8::Unit& u, int wr, int wc, int fr, int fq) const {
        const int row0 = u.pm * 256 + wr * 64 + fr;
        if (u.pn < 4) {
            const int col0 = u.pn * 128 + wc * 32 + 8 * fq;
#pragma unroll
            for (int ai = 0; ai < 2; ++ai)
#pragma unroll
                for (int m = 0; m < 4; ++m) {
                    const int r = row0 + ai * 128 + m * 16;
                    const float rs = ssq_rs(ssq[r]);
                    const float k2 = rs * -1.4426950408889634f;
                    f32x2 o[4];
#pragma unroll
                    for (int n = 0; n < 2; ++n)
#pragma unroll
                        for (int h = 0; h < 2; ++h) {
                            const f32x2 a = (f32x2){acc[ai][0][m][n][2 * h], acc[ai][0][m][n][2 * h + 1]}, gt = (f32x2){acc[ai][1][m][n][2 * h], acc[ai][1][m][n][2 * h + 1]};
                            o[n * 2 + h] = (a * rs) * pk_sig(gt, k2);
                        }
                    u32x4 w; w.x = cvt_pk_bf16(o[0].x, o[0].y); w.y = cvt_pk_bf16(o[1].x, o[1].y); w.z = cvt_pk_bf16(o[2].x, o[2].y); w.w = cvt_pk_bf16(o[3].x, o[3].y);
                    *(u32x4*)(glu + (size_t)r * 512 + col0) = w;
                }
        } else {
            const int col0 = (u.pn - 4) * 256 + wc * 32 + 8 * fq;
#pragma unroll
            for (int ai = 0; ai < 2; ++ai)
#pragma unroll
                for (int m = 0; m < 4; ++m) {
                    const int r = row0 + ai * 128 + m * 16;
                    const float rs = ssq_rs(ssq[r]);
#pragma unroll
                    for (int bj = 0; bj < 2; ++bj) {
                        const f32x4 v0 = acc[ai][bj][m][0] * rs, v1 = acc[ai][bj][m][1] * rs;
                        u32x4 w; w.x = cvt_pk_bf16(v0[0], v0[1]); w.y = cvt_pk_bf16(v0[2], v0[3]); w.z = cvt_pk_bf16(v1[0], v1[1]); w.w = cvt_pk_bf16(v1[2], v1[3]);
                        *(u32x4*)(qkv + (size_t)r * 768 + col0 + bj * 128) = w;
                    }
                }
        }
    }
};
struct EpiGU {
    const ssq_t* ssq; bf16_t* act;
    __device__ __forceinline__ void init(f32x4 (&acc)[2][2][4][2], const pg8::Unit&, int, int, int, int) const { acc_zero(acc); }
    __device__ __forceinline__ void operator()(const f32x4 (&acc)[2][2][4][2], const pg8::Unit& u, int wr, int wc, int fr, int fq) const {
        const int row0 = u.pm * 256 + wr * 64 + fr, col0 = u.pn * 128 + wc * 32 + 8 * fq;
#pragma unroll
        for (int ai = 0; ai < 2; ++ai)
#pragma unroll
            for (int m = 0; m < 4; ++m) {
                const int r = row0 + ai * 128 + m * 16;
                const float rs = ssq_rs(ssq[r]);
                const float k2 = rs * -1.4426950408889634f, rs2 = rs * rs;
                f32x2 o[4];
#pragma unroll
                for (int n = 0; n < 2; ++n)
#pragma unroll
                    for (int h = 0; h < 2; ++h) {
                        const f32x2 gt = (f32x2){acc[ai][0][m][n][2 * h], acc[ai][0][m][n][2 * h + 1]}, up = (f32x2){acc[ai][1][m][n][2 * h], acc[ai][1][m][n][2 * h + 1]};
                        o[n * 2 + h] = (gt * up) * rs2 * pk_sig(gt, k2);
                    }
                u32x4 w; w.x = cvt_pk_bf16(o[0].x, o[0].y); w.y = cvt_pk_bf16(o[1].x, o[1].y); w.z = cvt_pk_bf16(o[2].x, o[2].y); w.w = cvt_pk_bf16(o[3].x, o[3].y);
                *(u32x4*)(act + (size_t)(r >> 8) * (256 * DFF) + (size_t)(col0 >> 6) * (256 * 64) + (size_t)(r & 255) * 64 + (col0 & 63)) = w;
            }
    }
};
__device__ __forceinline__ void bf8_to_f32(u32x4 w, f32x4& lo, f32x4& hi) { lo = (f32x4){bflo(w.x), bfhi(w.x), bflo(w.y), bfhi(w.y)}; hi = (f32x4){bflo(w.z), bfhi(w.z), bflo(w.w), bfhi(w.w)}; }
template <bool POOL> struct EpiRes {
    float* Y; bf16_t* XB; ssq_t* ssq; const float* cscale; float* part;
    __device__ __forceinline__ void init(f32x4 (&acc)[2][2][4][2], const pg8::Unit& u, int wr, int wc, int fr, int fq) const {
        if (!POOL && u.part >= 0) { acc_zero(acc); return; }
        const int pmr = POOL ? (u.pm % NTM) : u.pm, ct = POOL ? (u.pm / NTM) : u.pn;
        const bf16_t* xq = XB + (size_t)(pmr * 256 + wr * 64 + fr) * DM + ct * 256 + wc * 32 + 8 * fq;
#pragma unroll
        for (int ai = 0; ai < 2; ++ai)
#pragma unroll
            for (int bj = 0; bj < 2; ++bj)
#pragma unroll
                for (int m = 0; m < 4; ++m) bf8_to_f32(*(const u32x4*)(xq + (size_t)(ai * 128 + m * 16) * DM + bj * 128), acc[ai][bj][m][0], acc[ai][bj][m][1]);
        if (POOL) {
            const float* cq = cscale + ct * 256 + wc * 32 + 8 * fq;
#pragma unroll
            for (int bj = 0; bj < 2; ++bj)
#pragma unroll
                for (int n = 0; n < 2; ++n) {
                    const f32x4 cv = *(const f32x4*)(cq + bj * 128 + 4 * n);
                    const f32x4 ic = (f32x4){__builtin_amdgcn_rcpf(cv[0]), __builtin_amdgcn_rcpf(cv[1]), __builtin_amdgcn_rcpf(cv[2]), __builtin_amdgcn_rcpf(cv[3])};
#pragma unroll
                    for (int ai = 0; ai < 2; ++ai)
#pragma unroll
                        for (int m = 0; m < 4; ++m) acc[ai][bj][m][n] = acc[ai][bj][m][n] * ic;
                }
        }
    }
    __device__ __forceinline__ void operator()(const f32x4 (&acc)[2][2][4][2], const pg8::Unit& u, int wr, int wc, int fr, int fq) const {
        if (!POOL && u.part >= 0) {
            float* pp = part + (size_t)u.part * 65536 + (size_t)(((wr * 4 + wc) * 64) + fq * 16 + fr) * 4;
#pragma unroll
            for (int ai = 0; ai < 2; ++ai)
#pragma unroll
                for (int m = 0; m < 4; ++m)
#pragma unroll
                    for (int bj = 0; bj < 2; ++bj)
#pragma unroll
                        for (int n = 0; n < 2; ++n) *(f32x4*)(pp + (size_t)((((ai * 4 + m) * 2 + bj) * 2 + n) * 2048)) = acc[ai][bj][m][n];
            return;
        }
        const int pmr = POOL ? (u.pm % NTM) : u.pm, ct = POOL ? (u.pm / NTM) : u.pn;
        const int row0 = pmr * 256 + wr * 64 + fr, col0 = ct * 256 + wc * 32 + 8 * fq;
#pragma unroll
        for (int ai = 0; ai < 2; ++ai)
#pragma unroll
            for (int m = 0; m < 4; ++m) {
                const int r = row0 + ai * 128 + m * 16;
                bf16_t* bp = XB + (size_t)r * DM + col0;
                float ss = 0.f;
#pragma unroll
                for (int bj = 0; bj < 2; ++bj) {
                    f32x4 v0 = acc[ai][bj][m][0], v1 = acc[ai][bj][m][1];
                    if (POOL) { v0 = v0 * *(const f32x4*)(cscale + col0 + bj * 128); v1 = v1 * *(const f32x4*)(cscale + col0 + bj * 128 + 4); }
                    if (Y) { float* yp = Y + (size_t)r * DM + col0 + bj * 128; *(f32x4*)yp = v0; *(f32x4*)(yp + 4) = v1; continue; }
                    u32x4 w; w.x = cvt_pk_bf16(v0[0], v0[1]); w.y = cvt_pk_bf16(v0[2], v0[3]); w.z = cvt_pk_bf16(v1[0], v1[1]); w.w = cvt_pk_bf16(v1[2], v1[3]);
                    *(u32x4*)(bp + bj * 128) = w;
                    ss += (v0[0] * v0[0] + v0[1] * v0[1]) + (v0[2] * v0[2] + v0[3] * v0[3]) + (v1[0] * v1[0] + v1[1] * v1[1]) + (v1[2] * v1[2] + v1[3] * v1[3]);
                }
                if (Y) continue;
                ss += __shfl_xor(ss, 16); ss += __shfl_xor(ss, 32);
                if (fq == 0) ssq_add(ssq + r, ss);
            }
    }
};

struct WTile { const float* src0; const float* src1; const float* gain; bf16_t* dst; int ld, K, k0, n0m, mode; };
__device__ __forceinline__ void wt_decode(const Params& p, int t, WTile& w) {
    int kt; w.gain = nullptr;
    if (t < 224) { const int i = t / 112, r = t % 112; w.n0m = (r / 16) * 256; kt = r % 16; w.K = 1024; w.ld = DIN; w.mode = (w.n0m < 1024) ? 1 : 0;
        w.src0 = p.in[I_WIN] + (size_t)i * DM * DIN; w.src1 = w.src0; w.gain = p.in[I_NMIX] + (2 * i) * DM; w.dst = (bf16_t*)(p.ws + WS_WIN) + (size_t)i * DIN * DM; }
    else if (t < 352) { t -= 224; const int i = t / 64, r = t % 64; w.n0m = (r / 16) * 256; kt = r % 16; w.K = 1024; w.ld = DM; w.mode = 0;
        w.src0 = p.in[I_WOUT] + (size_t)i * DM * DM; w.src1 = w.src0; w.dst = (bf16_t*)(p.ws + WS_WOUT) + (size_t)i * DM * DM; }
    else if (t < 1760) { t -= 352; const int l = t / 352, r = t % 352; w.n0m = (r / 16) * 256; kt = r % 16; w.K = 1024; w.ld = DFF; w.mode = 2;
        w.src0 = p.in[I_WG] + (size_t)l * DM * DFF; w.src1 = p.in[I_WU] + (size_t)l * DM * DFF; w.gain = p.in[I_NFFN] + l * DM; w.dst = (bf16_t*)(p.ws + WS_WGU) + (size_t)l * 2 * DFF * DM; }
    else if (t < 2464) { t -= 1760; const int l = t / 176, r = t % 176; w.n0m = (r / 44) * 256; kt = r % 44; w.K = DFF; w.ld = DM; w.mode = 0;
        w.src0 = p.in[I_WD] + (size_t)l * DFF * DM; w.src1 = w.src0; w.dst = (bf16_t*)(p.ws + WS_WDN) + (size_t)l * DM * DFF; }
    else { t -= 2464; const int ig = t / 4; w.n0m = 0; kt = t % 4; w.K = 256; w.ld = 256; w.mode = 0;
        w.src0 = p.in[I_WPOOL] + (size_t)ig * 65536; w.src1 = w.src0; w.dst = (bf16_t*)(p.ws + WS_WPL) + (size_t)ig * 65536; }
    w.k0 = kt * 64;
}
__device__ __forceinline__ void wt_load(const WTile& w, int tid, f32x4 (&v)[4][2], float& gs0, float& gs1) {
    const int row = tid >> 4, col4 = (tid & 15) * 4;
    gs0 = w.gain ? w.gain[w.k0 + row] : 1.0f; gs1 = w.gain ? w.gain[w.k0 + row + 32] : 1.0f;
#pragma unroll
    for (int q = 0; q < 4; ++q) {
        const int n0 = w.n0m + 64 * q; int c0 = n0; const float* src = w.src0;
        if (w.mode == 1) { const int pn = n0 / 256, bj = (n0 / 128) & 1, cc = n0 % 128; c0 = bj * 512 + 128 * pn + cc; }
        else if (w.mode == 2) { const int pn = n0 / 256, bj = (n0 / 128) & 1, cc = n0 % 128; c0 = 128 * pn + cc; src = bj ? w.src1 : w.src0; }
        const float* sp = src + (size_t)(w.k0 + row) * w.ld + c0 + col4;
        v[q][0] = __builtin_nontemporal_load((const f32x4*)sp); v[q][1] = __builtin_nontemporal_load((const f32x4*)(sp + (size_t)32 * w.ld));
    }
}
__device__ __forceinline__ void prep_phase(const Params& p, LAS unsigned char* lds) {
    int tid = threadIdx.x; asm volatile("" : "+v"(tid));
    const int G = gridDim.x, bid = blockIdx.x, wave = tid >> 6, lane = tid & 63;
    bf16_t* XB = (bf16_t*)(p.ws + WS_XB); ssq_t* SSQ = (ssq_t*)(p.ws + WS_SSQ);
    for (int r0 = bid * 8 + wave; r0 < MT; r0 += G * 16) {
        const int r1 = r0 + G * 8; const bool h1 = r1 < MT; const int r1c = h1 ? r1 : r0;
        const float* s0 = r0 < MP ? p.in[I_XP] + (size_t)r0 * DM : p.in[I_XS] + (size_t)(r0 - MP) * DM;
        const float* s1 = r1c < MP ? p.in[I_XP] + (size_t)r1c * DM : p.in[I_XS] + (size_t)(r1c - MP) * DM;
        f32x4 va[4], vb[4];
#pragma unroll
        for (int q = 0; q < 4; ++q) { va[q] = __builtin_nontemporal_load((const f32x4*)(s0 + q * 256 + lane * 4)); vb[q] = __builtin_nontemporal_load((const f32x4*)(s1 + q * 256 + lane * 4)); }
        float ssa = 0.f, ssb = 0.f;
#pragma unroll
        for (int q = 0; q < 4; ++q) {
            u32x2 w; w.x = cvt_pk_bf16(va[q][0], va[q][1]); w.y = cvt_pk_bf16(va[q][2], va[q][3]);
            *(u32x2*)(XB + (size_t)r0 * DM + q * 256 + lane * 4) = w;
            ssa += (va[q][0] * va[q][0] + va[q][1] * va[q][1]) + (va[q][2] * va[q][2] + va[q][3] * va[q][3]);
            if (h1) {
                u32x2 w2; w2.x = cvt_pk_bf16(vb[q][0], vb[q][1]); w2.y = cvt_pk_bf16(vb[q][2], vb[q][3]);
                *(u32x2*)(XB + (size_t)r1 * DM + q * 256 + lane * 4) = w2;
            }
            ssb += (vb[q][0] * vb[q][0] + vb[q][1] * vb[q][1]) + (vb[q][2] * vb[q][2] + vb[q][3] * vb[q][3]);
        }
        ssa = wave_sum(ssa); ssb = wave_sum(ssb);
        if (lane == 0) { SSQ[r0] = ssq_fix(ssa); if (h1) SSQ[r1] = ssq_fix(ssb); }
    }
    for (int idx = bid * 512 + tid; idx < 8 * MT; idx += G * 512) SSQ[MT + idx] = 0ull;
    LAS float* tile = (LAS float*)lds;
    WTile cur, nxt; f32x4 v[4][2]; float gs0 = 1.f, gs1 = 1.f;
    int t0 = bid;
    if (t0 < 2496) { wt_decode(p, t0, cur); wt_load(cur, tid, v, gs0, gs1); }
    for (; t0 < 2496; t0 += G) {
        __syncthreads();
        {
            const int row = tid >> 4, col4 = (tid & 15) * 4;
#pragma unroll
            for (int q = 0; q < 4; ++q)
#pragma unroll
                for (int h = 0; h < 2; ++h) { LAS float* tp = tile + q * 4160 + (row + 32 * h) * 65 + col4; const float gs = h ? gs1 : gs0;
                    tp[0] = v[q][h][0] * gs; tp[1] = v[q][h][1] * gs; tp[2] = v[q][h][2] * gs; tp[3] = v[q][h][3] * gs; }
        }
        __syncthreads();
        const bool hn = (t0 + G) < 2496;
        if (hn) { wt_decode(p, t0 + G, nxt); wt_load(nxt, tid, v, gs0, gs1); }
        {
            const int n = tid >> 3, kk = (tid & 7) * 8;
#pragma unroll
            for (int q = 0; q < 4; ++q) {
                float e[8];
#pragma unroll
                for (int j = 0; j < 8; ++j) e[j] = tile[q * 4160 + (kk + j) * 65 + n];
                u32x4 w; w.x = cvt_pk_bf16(e[0], e[1]); w.y = cvt_pk_bf16(e[2], e[3]); w.z = cvt_pk_bf16(e[4], e[5]); w.w = cvt_pk_bf16(e[6], e[7]);
                *(u32x4*)(cur.dst + (size_t)(cur.n0m + 64 * q + n) * cur.K + cur.k0 + kk) = w;
            }
        }
        if (hn) cur = nxt;
    }
    __syncthreads();
}

__device__ __forceinline__ f32x4 ld_bf4(const bf16_t* p) { const u32x2 w = *(const u32x2*)p; return (f32x4){bflo(w.x), bfhi(w.x), bflo(w.y), bfhi(w.y)}; }
template <int W>
__device__ __forceinline__ void pool_prompt_strip(const bf16_t* X, const ssq_t* ssq, int row0, int t0, int c, f32x4 gm, bf16_t* dgp, float* outp_seq) {
    constexpr int TT = 16, NR = TT + W - 1;
    f32x4 xr[NR];
    if (t0 >= W - 1) {
        const bf16_t* xp = X + (size_t)(row0 - (W - 1)) * DM + c; asm volatile("" : "+v"(xp));
        const ssq_t* sp = ssq + (row0 - (W - 1)); asm volatile("" : "+v"(sp));
#pragma unroll
        for (int j = 0; j < NR; ++j) { const float rs = ssq_rs(sp[j]); xr[j] = ld_bf4(xp + (size_t)j * DM) * rs * gm; }
    } else {
        int vz; asm volatile("v_mov_b32 %0, 0" : "=v"(vz));
        const bf16_t* xp = X + (size_t)(row0 - t0) * DM + c; const ssq_t* sp = ssq + (row0 - t0);
#pragma unroll
        for (int j = 0; j < NR; ++j) { const int tj = t0 - (W - 1) + j + vz, tc = tj < 0 ? 0 : tj; const float rs = ssq_rs(sp[tc]);
            const f32x4 v = ld_bf4(xp + (size_t)tc * DM) * rs * gm; xr[j] = tj < 0 ? (f32x4){0.f, 0.f, 0.f, 0.f} : v; }
    }
    f32x4 S = (f32x4){0.f, 0.f, 0.f, 0.f};
#pragma unroll
    for (int j = 0; j < W - 1; ++j) S += xr[j];
#pragma unroll
    for (int tt = 0; tt < TT; ++tt) {
        S += xr[tt + W - 1]; if (tt > 0) S -= xr[tt - 1];
        const int t = t0 + tt, cnt = (t + 1 < W) ? (t + 1) : W;
        const f32x4 cur = xr[tt + W - 1], d = S * __builtin_amdgcn_rcpf((float)cnt) - cur;
        u32x2 wv; wv.x = cvt_pk_bf16(d[0], d[1]); wv.y = cvt_pk_bf16(d[2], d[3]);
        *(u32x2*)(dgp + (size_t)tt * 256) = wv;
        if (t >= 4081) *(f32x4*)(outp_seq + (size_t)(t - 4081) * DM) = cur;
    }
}
template <int W>
__device__ __forceinline__ void pool_sample_strip(const bf16_t* X, const ssq_t* ssq, int row0, int c, f32x4 gm, const float* state_seq, bf16_t* dgp, float* outs_seq) {
    constexpr int TT = 8, NR = TT + W - 1;
    f32x4 xr[NR];
    { const float* stp = state_seq + (size_t)(15 - (W - 1)) * DM; asm volatile("" : "+v"(stp));
#pragma unroll
      for (int j = 0; j < W - 1; ++j) xr[j] = *(const f32x4*)(stp + (size_t)j * DM); }
    { const bf16_t* xp = X + (size_t)row0 * DM + c; asm volatile("" : "+v"(xp));
      const ssq_t* sp = ssq + row0;
#pragma unroll
      for (int j = 0; j < TT; ++j) { const float rs = ssq_rs(sp[j]); xr[W - 1 + j] = ld_bf4(xp + (size_t)j * DM) * rs * gm; } }
    f32x4 S = (f32x4){0.f, 0.f, 0.f, 0.f};
#pragma unroll
    for (int j = 0; j < W - 1; ++j) S += xr[j];
#pragma unroll
    for (int tt = 0; tt < TT; ++tt) {
        S += xr[tt + W - 1]; if (tt > 0) S -= xr[tt - 1];
        const f32x4 cur = xr[tt + W - 1], d = S * (1.0f / (float)W) - cur;
        u32x2 wv; wv.x = cvt_pk_bf16(d[0], d[1]); wv.y = cvt_pk_bf16(d[2], d[3]);
        *(u32x2*)(dgp + (size_t)tt * 256) = wv;
        *(f32x4*)(outs_seq + (size_t)(7 + tt) * DM) = cur;
    }
}
__device__ __forceinline__ void pool1_phase(const Params& p, int l, const ssq_t* ssq, int bid) {
    int tid = threadIdx.x; asm volatile("" : "+v"(tid));
    const int G = gridDim.x, i = l >> 1;
    const bf16_t* X = (const bf16_t*)(p.ws + WS_XB); bf16_t* DG = (bf16_t*)(p.ws + WS_DG);
    const int cq = tid & 255, c = cq * 4, half = tid >> 8, g = __builtin_amdgcn_readfirstlane(cq >> 6);
    const f32x4 gm = *(const f32x4*)(p.in[I_NMIX] + l * DM + c);
    const float* spool = p.in[I_SPOOL] + (size_t)i * 128 * 15 * DM;
    float* outp = p.out + O_POOLP + (size_t)i * 4 * 15 * DM; float* outs = p.out + O_POOLS + (size_t)i * 128 * 15 * DM;
    for (int u = bid; u < MP / 64 + 64; u += G) {
        if (u < MP / 64) {
#pragma unroll 1
            for (int k = 0; k < 2; ++k) {
                const int row0 = u * 64 + k * 32 + half * 16, t0 = row0 & 4095, b = row0 >> 12;
                bf16_t* dgp = DG + ((size_t)g * MT + row0) * 256 + (c - 256 * g); float* op = outp + (size_t)b * 15 * DM + c;
                if (g == 0) pool_prompt_strip<2>(X, ssq, row0, t0, c, gm, dgp, op);
                else if (g == 1) pool_prompt_strip<4>(X, ssq, row0, t0, c, gm, dgp, op);
                else if (g == 2) pool_prompt_strip<8>(X, ssq, row0, t0, c, gm, dgp, op);
                else pool_prompt_strip<16>(X, ssq, row0, t0, c, gm, dgp, op);
            }
        } else {
            const int s0 = (u - MP / 64) * 2;
            {
                const int s = s0 + half, row0 = MP + s * 8;
                bf16_t* dgp = DG + ((size_t)g * MT + row0) * 256 + (c - 256 * g); float* op = outs + (size_t)s * 15 * DM + c; const float* st = spool + (size_t)s * 15 * DM + c;
                if (g == 0) pool_sample_strip<2>(X, ssq, row0, c, gm, st, dgp, op);
                else if (g == 1) pool_sample_strip<4>(X, ssq, row0, c, gm, st, dgp, op);
                else if (g == 2) pool_sample_strip<8>(X, ssq, row0, c, gm, st, dgp, op);
                else pool_sample_strip<16>(X, ssq, row0, c, gm, st, dgp, op);
            }
            for (int idx = tid; idx < 2 * 7 * 256; idx += 512) { const int c4 = (idx & 255) * 4, rr = (idx >> 8) % 7, sl = idx / (7 * 256);
                *(f32x4*)(outs + ((size_t)(s0 + sl) * 15 + rr) * DM + c4) = *(const f32x4*)(spool + ((size_t)(s0 + sl) * 15 + 8 + rr) * DM + c4); }
        }
    }
}

constexpr int KS_STRIDE = 72, VT_STRIDE = 264;

__device__ __forceinline__ void attn_item(const LAS bf16_t* Ks, const LAS bf16_t* Vt, int tile0, int r0, bool first, bool qvalid,
                                          const bf16_t* qptr, const float* qn, float slope, float sink, bf16_t* optr, int fr, int fq) {
    u32x4 raw0 = (u32x4){0u, 0u, 0u, 0u}, raw1 = raw0;
    if (qvalid) { raw0 = *(const u32x4*)(qptr); raw1 = *(const u32x4*)(qptr + 32); }
    float qf[16];
#pragma unroll
    for (int j = 0; j < 4; ++j) { qf[2 * j] = bflo(raw0[j]); qf[2 * j + 1] = bfhi(raw0[j]); qf[8 + 2 * j] = bflo(raw1[j]); qf[8 + 2 * j + 1] = bfhi(raw1[j]); }
    float ss = 0.f;
#pragma unroll
    for (int j = 0; j < 16; ++j) ss += qf[j] * qf[j];
    ss += __shfl_xor(ss, 16); ss += __shfl_xor(ss, 32);
    const float rq = rsqrtf(ss * (1.0f / 64.0f) + RMS_EPS) * 0.125f;
    bf16x8 q0, q1;
    {
        const f32x4 n0 = *(const f32x4*)(qn + fq * 8), n1 = *(const f32x4*)(qn + fq * 8 + 4), n2 = *(const f32x4*)(qn + 32 + fq * 8), n3 = *(const f32x4*)(qn + 32 + fq * 8 + 4);
        u32x4 a, b;
        a.x = cvt_pk_bf16(qf[0] * rq * n0[0], qf[1] * rq * n0[1]); a.y = cvt_pk_bf16(qf[2] * rq * n0[2], qf[3] * rq * n0[3]);
        a.z = cvt_pk_bf16(qf[4] * rq * n1[0], qf[5] * rq * n1[1]); a.w = cvt_pk_bf16(qf[6] * rq * n1[2], qf[7] * rq * n1[3]);
        b.x = cvt_pk_bf16(qf[8] * rq * n2[0], qf[9] * rq * n2[1]); b.y = cvt_pk_bf16(qf[10] * rq * n2[2], qf[11] * rq * n2[3]);
        b.z = cvt_pk_bf16(qf[12] * rq * n3[0], qf[13] * rq * n3[1]); b.w = cvt_pk_bf16(qf[14] * rq * n3[2], qf[15] * rq * n3[3]);
        q0 = __builtin_bit_cast(bf16x8, a); q1 = __builtin_bit_cast(bf16x8, b);
    }
    f32x4 s[9];
#pragma unroll
    for (int T = 0; T < 9; ++T) {
        const LAS bf16_t* kp = Ks + ((tile0 + T) * 16 + fr) * KS_STRIDE + fq * 8;
        const bf16x8 a0 = *(const LAS bf16x8*)(kp), a1 = *(const LAS bf16x8*)(kp + 32);
        f32x4 z = (f32x4){0.f, 0.f, 0.f, 0.f};
        z = __builtin_amdgcn_mfma_f32_16x16x32_bf16(a0, q0, z, 0, 0, 0);
        s[T] = __builtin_amdgcn_mfma_f32_16x16x32_bf16(a1, q1, z, 0, 0, 0);
    }
    __builtin_amdgcn_sched_barrier(0);
    int qi = r0 + fr; asm volatile("" : "+v"(qi));
    const int lim = first ? qi + 1 : 128;
    float mx = sink;
#pragma unroll
    for (int T = 0; T < 9; ++T)
#pragma unroll
        for (int j = 0; j < 4; ++j) {
            const int jk = (tile0 + T) * 16 + 4 * fq + j, dist = 128 + qi - jk;
            const bool valid = (unsigned)dist < (unsigned)lim;
            const float v = valid ? (s[T][j] - slope * (float)dist) : -1e30f;
            s[T][j] = v; mx = fmaxf(mx, v);
        }
    mx = fmaxf(mx, __shfl_xor(mx, 16)); mx = fmaxf(mx, __shfl_xor(mx, 32));
    float sum = 0.f;
#pragma unroll
    for (int T = 0; T < 9; ++T)
#pragma unroll
        for (int j = 0; j < 4; ++j) { const float e = __expf(s[T][j] - mx); s[T][j] = e; sum += e; }
    sum += __shfl_xor(sum, 16); sum += __shfl_xor(sum, 32);
    sum += __expf(sink - mx);
    const float inv = 1.0f / sum;
    __builtin_amdgcn_sched_barrier(0);
    f32x4 o[4];
#pragma unroll
    for (int dt = 0; dt < 4; ++dt) o[dt] = (f32x4){0.f, 0.f, 0.f, 0.f};
#pragma unroll
    for (int pp = 0; pp < 5; ++pp) {
        const int T0 = 2 * pp, T1 = (pp < 4) ? 2 * pp + 1 : 8;
        u32x4 pw;
        pw.x = cvt_pk_bf16(s[T0][0] * inv, s[T0][1] * inv); pw.y = cvt_pk_bf16(s[T0][2] * inv, s[T0][3] * inv);
        if (pp < 4) { pw.z = cvt_pk_bf16(s[T1][0] * inv, s[T1][1] * inv); pw.w = cvt_pk_bf16(s[T1][2] * inv, s[T1][3] * inv); } else { pw.z = 0u; pw.w = 0u; }
        const bf16x8 pf = __builtin_bit_cast(bf16x8, pw);
#pragma unroll
        for (int dt = 0; dt < 4; ++dt) {
            const LAS bf16_t* vp = Vt + (dt * 16 + fr) * VT_STRIDE + 4 * fq;
            const u32x2 v0 = *(const LAS u32x2*)(vp + (tile0 + T0) * 16), v1 = *(const LAS u32x2*)(vp + (tile0 + T1) * 16);
            u32x4 vw; vw.x = v0.x; vw.y = v0.y; vw.z = v1.x; vw.w = v1.y;
            o[dt] = __builtin_amdgcn_mfma_f32_16x16x32_bf16(__builtin_bit_cast(bf16x8, vw), pf, o[dt], 0, 0, 0);
        }
    }
    if (qvalid) {
#pragma unroll
        for (int dt = 0; dt < 4; ++dt) { u32x2 w; w.x = cvt_pk_bf16(o[dt][0], o[dt][1]); w.y = cvt_pk_bf16(o[dt][2], o[dt][3]); *(u32x2*)(optr + dt * 16) = w; }
    }
}

__device__ __forceinline__ void mixer_phase(const Params& p, int l, LAS unsigned char* lds, int bid) {
    const int G = gridDim.x, i = l >> 1;
    const bf16_t* QKV = (const bf16_t*)(p.ws + WS_QKV); const bf16_t* GLU = (const bf16_t*)(p.ws + WS_GLU); bf16_t* CAT = (bf16_t*)(p.ws + WS_CAT);
    const float* qn = p.in[I_QN] + i * 64; const float* kn = p.in[I_KN] + i * 64; const float* sinks = p.in[I_SINK] + i * 8;
    constexpr int N_PA = 256, N_CV = 640, N_SA = 128;
#define MIX_PRE int tid = threadIdx.x; asm volatile("" : "+v"(tid)); const int wave = tid >> 6, lane = tid & 63, fr = lane & 15, fq = lane >> 4; (void)wave; (void)fr; (void)fq;
    for (int u = bid; u < N_PA; u += G) {
        MIX_PRE
        {
#ifndef X_NOPA
            const int kh = u & 1, blk = (u >> 1) & 31, b = u >> 6;
            const int rowQ0 = b * 4096 + blk * 128, rowK0 = rowQ0 - 128;
            LAS bf16_t* Ks = (LAS bf16_t*)lds; LAS bf16_t* Vt = (LAS bf16_t*)(lds + 256 * KS_STRIDE * 2);
            const int chunk = tid & 7;
            const f32x4 kn0 = *(const f32x4*)(kn + chunk * 8), kn1 = *(const f32x4*)(kn + chunk * 8 + 4);
#pragma unroll 1
            for (int ps = 0; ps < 4; ++ps) {
                const int key = (tid >> 3) + 64 * ps;
                u32x4 kr = (u32x4){0u, 0u, 0u, 0u}, vr = kr;
                const bool have = (blk > 0) || (key >= 128);
                if (have) { const bf16_t* rp = QKV + (size_t)(rowK0 + key) * 768 + 512 + kh * 64 + chunk * 8; kr = *(const u32x4*)rp; vr = *(const u32x4*)(rp + 128); }
                float kf[8], vf[8];
#pragma unroll
                for (int j = 0; j < 4; ++j) { kf[2 * j] = bflo(kr[j]); kf[2 * j + 1] = bfhi(kr[j]); vf[2 * j] = bflo(vr[j]); vf[2 * j + 1] = bfhi(vr[j]); }
                float ss = 0.f;
#pragma unroll
                for (int j = 0; j < 8; ++j) ss += kf[j] * kf[j];
                ss += __shfl_xor(ss, 1); ss += __shfl_xor(ss, 2); ss += __shfl_xor(ss, 4);
                const float rk = rsqrtf(ss * (1.0f / 64.0f) + RMS_EPS);
#pragma unroll
                for (int j = 0; j < 4; ++j) { kf[j] *= rk * kn0[j]; kf[4 + j] *= rk * kn1[j]; }
                u32x4 kw; kw.x = cvt_pk_bf16(kf[0], kf[1]); kw.y = cvt_pk_bf16(kf[2], kf[3]); kw.z = cvt_pk_bf16(kf[4], kf[5]); kw.w = cvt_pk_bf16(kf[6], kf[7]);
                *(LAS u32x4*)(Ks + key * KS_STRIDE + chunk * 8) = kw;
#pragma unroll
                for (int j = 0; j < 4; ++j) { Vt[(chunk * 8 + 2 * j) * VT_STRIDE + key] = (bf16_t)(vr[j] & 0xffffu); Vt[(chunk * 8 + 2 * j + 1) * VT_STRIDE + key] = (bf16_t)(vr[j] >> 16); }
                if (blk == 31 && key >= 128) {
                    float* ko = p.out + O_KP + ((((size_t)i * 4 + b) * 128 + (key - 128)) * 2 + kh) * 64 + chunk * 8;
                    float* vo = p.out + O_VP + ((((size_t)i * 4 + b) * 128 + (key - 128)) * 2 + kh) * 64 + chunk * 8;
                    *(f32x4*)ko = (f32x4){kf[0], kf[1], kf[2], kf[3]}; *(f32x4*)(ko + 4) = (f32x4){kf[4], kf[5], kf[6], kf[7]};
                    *(f32x4*)vo = (f32x4){vf[0], vf[1], vf[2], vf[3]}; *(f32x4*)(vo + 4) = (f32x4){vf[4], vf[5], vf[6], vf[7]};
                }
            }
            __syncthreads();
            const int r0 = wave * 16;
#pragma unroll 1
            for (int g = 0; g < 4; ++g) {
                const int h = kh * 4 + g;
                const float slope = exp2f(-(float)(h + 1)), sink = sinks[h];
                const size_t row = (size_t)(rowQ0 + r0 + fr);
                attn_item(Ks, Vt, wave, r0, blk == 0, true, QKV + row * 768 + h * 64 + fq * 8, qn, slope, sink, CAT + row * DM + 512 + h * 64 + 4 * fq, fr, fq);
            }
            __syncthreads();
#endif
        }
    }
#ifndef X_NOCV
    f32x2 wdw[31]; f32x2 bias;
    { int t0 = threadIdx.x; asm volatile("" : "+v"(t0)); const int c0 = (t0 & 255) * 2;
      const float* wp = p.in[I_WDW] + (size_t)i * 31 * 512 + c0; asm volatile("" : "+v"(wp));
#pragma unroll
      for (int j = 0; j < 31; ++j) { wdw[j] = *(const f32x2*)wp; wp += 512; asm volatile("" : "+v"(wp)); }
      bias = *(const f32x2*)(p.in[I_BDW] + i * 512 + c0); }
    for (int cu = bid; cu < N_CV; cu += G) {
        MIX_PRE
        {
            const int c2 = tid & 255, half = tid >> 8, c = c2 * 2; const bool prm = cu < 512;
            LAS float* ybuf = (LAS float*)lds;
            if (prm && ((cu & 127) * 32 + half * 16) >= 30) {
                const int b = cu >> 7, tb0 = (cu & 127) * 32 + half * 16;
                unsigned raw[46];
                { const bf16_t* gp = GLU + ((size_t)b * 4096 + tb0 - 30) * 512 + c; asm volatile("" : "+v"(gp));
#pragma unroll
                  for (int j = 0; j < 46; ++j) { raw[j] = *(const unsigned*)gp; gp += 512; asm volatile("" : "+v"(gp)); } }
                if (tb0 >= 4064) {
                    float* oc = p.out + O_CONVP + (((size_t)i * 4 + b) * 30) * 512 + c; asm volatile("" : "+v"(oc));
#pragma unroll
                    for (int j = 0; j < 16; ++j) { const int t = tb0 + j; if (t >= 4066) *(f32x2*)(oc + (size_t)(t - 4066) * 512) = (f32x2){bflo(raw[30 + j]), bfhi(raw[30 + j])}; }
                }
#pragma unroll
                for (int q = 0; q < 2; ++q) {
                    f32x2 win[38];
#pragma unroll
                    for (int j = 0; j < 38; ++j) win[j] = (f32x2){bflo(raw[q * 8 + j]), bfhi(raw[q * 8 + j])};
#pragma unroll
                    for (int t = 0; t < 8; ++t) {
                        f32x2 y = bias;
#pragma unroll
                        for (int j = 0; j < 31; ++j) y += wdw[j] * win[t + j];
                        *(LAS f32x2*)(ybuf + (half * 16 + q * 8 + t) * 512 + c) = y;
                    }
                    __builtin_amdgcn_sched_barrier(0);
                }
            } else if (prm) {
#pragma unroll 1
                for (int q = 0; q < 2; ++q) {
                    const int b = cu >> 7, tl = half * 16 + q * 8, tb = (cu & 127) * 32 + tl;
                    f32x2 win[38];
                    {
                        int vz; asm volatile("v_mov_b32 %0, 0" : "=v"(vz));
                        const bf16_t* gp = GLU + (size_t)b * 4096 * 512 + c; asm volatile("" : "+v"(gp));
#pragma unroll
                        for (int j = 0; j < 38; ++j) { const int tj = tb - 30 + j + vz; const unsigned w = *(const unsigned*)gp; if (tj >= 0) gp += 512; asm volatile("" : "+v"(gp));
                            win[j] = tj < 0 ? (f32x2){0.f, 0.f} : (f32x2){bflo(w), bfhi(w)}; }
                    }
#pragma unroll
                    for (int t = 0; t < 8; ++t) {
                        f32x2 y = bias;
#pragma unroll
                        for (int j = 0; j < 31; ++j) y += wdw[j] * win[t + j];
                        *(LAS f32x2*)(ybuf + (tl + t) * 512 + c) = y;
                    }
                }
            } else {
                const int sq = cu - 512;
                f32x2 win[34];
                const float* cc = p.in[I_CCONV] + (((size_t)i * 128 + sq) * 30 + half * 4) * 512 + c; asm volatile("" : "+v"(cc));
                const bf16_t* gs = GLU + ((size_t)MP + sq * 8) * 512 + c; asm volatile("" : "+v"(gs));
                float* oc = p.out + O_CONVS + (((size_t)i * 128 + sq) * 30 + half * 15) * 512 + c; asm volatile("" : "+v"(oc));
                if (half == 0) {
#pragma unroll
                    for (int j = 0; j < 30; ++j) { win[j] = *(const f32x2*)cc; cc += 512; asm volatile("" : "+v"(cc)); }
#pragma unroll
                    for (int j = 0; j < 4; ++j) { const unsigned w = *(const unsigned*)gs; gs += 512; asm volatile("" : "+v"(gs)); win[30 + j] = (f32x2){bflo(w), bfhi(w)}; }
#pragma unroll
                    for (int j = 0; j < 15; ++j) { *(f32x2*)oc = win[8 + j]; oc += 512; asm volatile("" : "+v"(oc)); }
                } else {
#pragma unroll
                    for (int j = 0; j < 26; ++j) { win[j] = *(const f32x2*)cc; cc += 512; asm volatile("" : "+v"(cc)); }
#pragma unroll
                    for (int j = 0; j < 8; ++j) { const unsigned w = *(const unsigned*)gs; gs += 512; asm volatile("" : "+v"(gs)); win[26 + j] = (f32x2){bflo(w), bfhi(w)}; }
#pragma unroll
                    for (int j = 0; j < 15; ++j) { *(f32x2*)oc = win[19 + j]; oc += 512; asm volatile("" : "+v"(oc)); }
                }
#pragma unroll
                for (int t = 0; t < 4; ++t) {
                    f32x2 y = bias;
#pragma unroll
                    for (int j = 0; j < 31; ++j) y += wdw[j] * win[t + j];
                    *(LAS f32x2*)(ybuf + (half * 4 + t) * 512 + c) = y;
                }
            }
            __syncthreads();
            {
                const float* gp = p.in[I_CNG] + i * 512 + lane * 8; const float* bp = p.in[I_CNB] + i * 512 + lane * 8;
                const f32x4 g0 = *(const f32x4*)gp, g1 = *(const f32x4*)(gp + 4), b0 = *(const f32x4*)bp, b1 = *(const f32x4*)(bp + 4);
#pragma unroll 1
                for (int q = 0; q < (prm ? 4 : 1); ++q) {
                    const int tk = prm ? wave * 4 + q : wave; const size_t row = prm ? (size_t)cu * 32 + tk : (size_t)MP + (size_t)(cu - 512) * 8 + tk;
                    const f32x4 v0 = *(const LAS f32x4*)(ybuf + tk * 512 + lane * 8), v1 = *(const LAS f32x4*)(ybuf + tk * 512 + lane * 8 + 4);
                    const float mean = wave_sum((v0[0] + v0[1]) + (v0[2] + v0[3]) + (v1[0] + v1[1]) + (v1[2] + v1[3])) * (1.0f / 512.0f);
                    const f32x4 d0 = v0 - mean, d1 = v1 - mean;
                    const float var = wave_sum((d0[0] * d0[0] + d0[1] * d0[1]) + (d0[2] * d0[2] + d0[3] * d0[3]) + (d1[0] * d1[0] + d1[1] * d1[1]) + (d1[2] * d1[2] + d1[3] * d1[3])) * (1.0f / 512.0f);
                    const float rs = rsqrtf(var + LN_EPS);
                    f32x4 o0 = d0 * rs * g0 + b0, o1 = d1 * rs * g1 + b1;
#pragma unroll
                    for (int j = 0; j < 4; ++j) { o0[j] = o0[j] * fast_sigmoid(o0[j]); o1[j] = o1[j] * fast_sigmoid(o1[j]); }
                    u32x4 w; w.x = cvt_pk_bf16(o0[0], o0[1]); w.y = cvt_pk_bf16(o0[2], o0[3]); w.z = cvt_pk_bf16(o1[0], o1[1]); w.w = cvt_pk_bf16(o1[2], o1[3]);
                    *(u32x4*)(CAT + row * DM + lane * 8) = w;
                }
            }
            __syncthreads();
        }
    }
#endif
    for (int s = bid - 128; s < N_SA; s += G) {
        if (s < 0) continue;
        MIX_PRE
        {
#ifndef X_NOSA
            LAS bf16_t* Ks = (LAS bf16_t*)lds; LAS bf16_t* Vt = (LAS bf16_t*)(lds + 2 * 144 * KS_STRIDE * 2);
            const int chunk = tid & 7;
            const f32x4 kn0 = *(const f32x4*)(kn + chunk * 8), kn1 = *(const f32x4*)(kn + chunk * 8 + 4);
#pragma unroll 1
            for (int it = tid; it < 2 * 144 * 8; it += 512) {
                const int kk = it >> 3, kh = kk / 144, key = kk % 144;
                float kf[8], vf[8];
#pragma unroll
                for (int j = 0; j < 8; ++j) { kf[j] = 0.f; vf[j] = 0.f; }
                const bool isnew = (key >= 128) && (key < 136);
                if (key < 128) {
                    const size_t off = ((((size_t)i * 128 + s) * 128 + key) * 2 + kh) * 64 + chunk * 8;
                    const f32x4 a0 = *(const f32x4*)(p.in[I_CK] + off), a1 = *(const f32x4*)(p.in[I_CK] + off + 4), c0 = *(const f32x4*)(p.in[I_CV] + off), c1 = *(const f32x4*)(p.in[I_CV] + off + 4);
#pragma unroll
                    for (int j = 0; j < 4; ++j) { kf[j] = a0[j]; kf[4 + j] = a1[j]; vf[j] = c0[j]; vf[4 + j] = c1[j]; }
                } else if (isnew) {
                    const bf16_t* rp = QKV + ((size_t)MP + s * 8 + (key - 128)) * 768 + 512 + kh * 64 + chunk * 8;
                    const u32x4 kr = *(const u32x4*)rp, vr = *(const u32x4*)(rp + 128);
#pragma unroll
                    for (int j = 0; j < 4; ++j) { kf[2 * j] = bflo(kr[j]); kf[2 * j + 1] = bfhi(kr[j]); vf[2 * j] = bflo(vr[j]); vf[2 * j + 1] = bfhi(vr[j]); }
                }
                float ss = 0.f;
#pragma unroll
                for (int j = 0; j < 8; ++j) ss += kf[j] * kf[j];
                ss += __shfl_xor(ss, 1); ss += __shfl_xor(ss, 2); ss += __shfl_xor(ss, 4);
                const float rk = rsqrtf(ss * (1.0f / 64.0f) + RMS_EPS);
                if (isnew) {
#pragma unroll
                    for (int j = 0; j < 4; ++j) { kf[j] *= rk * kn0[j]; kf[4 + j] *= rk * kn1[j]; }
                }
                u32x4 kw; kw.x = cvt_pk_bf16(kf[0], kf[1]); kw.y = cvt_pk_bf16(kf[2], kf[3]); kw.z = cvt_pk_bf16(kf[4], kf[5]); kw.w = cvt_pk_bf16(kf[6], kf[7]);
                *(LAS u32x4*)(Ks + (kh * 144 + key) * KS_STRIDE + chunk * 8) = kw;
                u32x4 vw; vw.x = cvt_pk_bf16(vf[0], vf[1]); vw.y = cvt_pk_bf16(vf[2], vf[3]); vw.z = cvt_pk_bf16(vf[4], vf[5]); vw.w = cvt_pk_bf16(vf[6], vf[7]);
#pragma unroll
                for (int j = 0; j < 4; ++j) { Vt[(kh * 64 + chunk * 8 + 2 * j) * VT_STRIDE + key] = (bf16_t)(vw[j] & 0xffffu); Vt[(kh * 64 + chunk * 8 + 2 * j + 1) * VT_STRIDE + key] = (bf16_t)(vw[j] >> 16); }
                if (key >= 8 && key < 136) {
                    const size_t oo = ((((size_t)i * 128 + s) * 128 + (key - 8)) * 2 + kh) * 64 + chunk * 8;
                    float* ko = p.out + O_KS + oo; float* vo = p.out + O_VS + oo;
                    *(f32x4*)ko = (f32x4){kf[0], kf[1], kf[2], kf[3]}; *(f32x4*)(ko + 4) = (f32x4){kf[4], kf[5], kf[6], kf[7]};
                    *(f32x4*)vo = (f32x4){vf[0], vf[1], vf[2], vf[3]}; *(f32x4*)(vo + 4) = (f32x4){vf[4], vf[5], vf[6], vf[7]};
                }
            }
            __syncthreads();
            {
                const int kh = wave >> 2, g = wave & 3, h = kh * 4 + g;
                const float slope = exp2f(-(float)(h + 1)), sink = sinks[h];
                const size_t row = (size_t)MP + s * 8 + (fr & 7);
                attn_item(Ks + kh * 144 * KS_STRIDE, Vt + kh * 64 * VT_STRIDE, 0, 0, false, fr < 8, QKV + row * 768 + h * 64 + fq * 8, qn, slope, sink, CAT + row * DM + 512 + h * 64 + 4 * fq, fr, fq);
            }
            __syncthreads();
#endif
        }
    }
}


__device__ __forceinline__ void splitk_reduce(float* Y, bf16_t* XB, ssq_t* ssq, const float* part, const pg8::StaticOrder& S, int KS) {
    int tid = threadIdx.x; asm volatile("" : "+v"(tid));
    const int wid = tid >> 6, lane = tid & 63, wr = wid >> 2, wc = wid & 3, fr = lane & 15, fq = lane >> 4;
    for (int task = blockIdx.x; task < 256; task += gridDim.x) {
        const int e = task >> 4, ai = (task >> 3) & 1, m = (task >> 1) & 3, bj = task & 1;
        pg8::Unit u; S.tile(256 + e, u);
        const float* pp = part + (size_t)(e * KS) * 65536 + (size_t)((((ai * 4 + m) * 2 + bj) * 2) * 2048) + (size_t)tid * 4;
        f32x4 a0 = (f32x4){0.f, 0.f, 0.f, 0.f}, a1 = a0;
        for (int k = 0; k < KS; ++k) { a0 += *(const f32x4*)(pp + (size_t)k * 65536); a1 += *(const f32x4*)(pp + (size_t)k * 65536 + 2048); }
        const int r = u.pm * 256 + ai * 128 + wr * 64 + m * 16 + fr, col = u.pn * 256 + bj * 128 + wc * 32 + 8 * fq;
        bf16_t* bp = XB + (size_t)r * DM + col;
        f32x4 x0, x1; bf8_to_f32(*(const u32x4*)bp, x0, x1);
        const f32x4 v0 = x0 + a0, v1 = x1 + a1;
        if (Y) { float* yp = Y + (size_t)r * DM + col; *(f32x4*)yp = v0; *(f32x4*)(yp + 4) = v1; continue; }
        u32x4 w; w.x = cvt_pk_bf16(v0[0], v0[1]); w.y = cvt_pk_bf16(v0[2], v0[3]); w.z = cvt_pk_bf16(v1[0], v1[1]); w.w = cvt_pk_bf16(v1[2], v1[3]);
        *(u32x4*)bp = w;
        float ss = (v0[0] * v0[0] + v0[1] * v0[1]) + (v0[2] * v0[2] + v0[3] * v0[3]) + (v1[0] * v1[0] + v1[1] * v1[1]) + (v1[2] * v1[2] + v1[3] * v1[3]);
        ss += __shfl_xor(ss, 16); ss += __shfl_xor(ss, 32);
        if (fq == 0) ssq_add(ssq + r, ss);
    }
}

#define XB_TMO      128
#define XB_XCNT(j)  (256  + 64 * (j))
#define XB_XSUB(j)  (1280 + 64 * (j))
#define XB_XGEN(j)  (2304 + 64 * (j))
#define XB_TOP      3328
#define XB_TOPGEN   3392
#define XCD_BAR_WORDS 3456
#define XB_SPIN_CAP (1u << 22)
__device__ __forceinline__ unsigned xb_ld(unsigned* p)              { return __hip_atomic_load(p, __ATOMIC_RELAXED, __HIP_MEMORY_SCOPE_AGENT); }
__device__ __forceinline__ unsigned xb_add(unsigned* p, unsigned v) { return __hip_atomic_fetch_add(p, v, __ATOMIC_RELAXED, __HIP_MEMORY_SCOPE_AGENT); }
__device__ __forceinline__ unsigned xb_xcc_id() { return (unsigned)__builtin_amdgcn_s_getreg((3 << 11) | 20) & 0xFu; }
#define XB_SPIN(cond, bar) do { unsigned _sp = 0; while (cond) { __builtin_amdgcn_s_sleep(1); \
    if ((++_sp & 255u) == 0u) { if (xb_ld(&(bar)[XB_TMO])) break; if (_sp > XB_SPIN_CAP) { atomicAdd(&(bar)[XB_TMO], 1u); break; } } } } while (0)
struct XcdBarrier { unsigned* bar; unsigned x; volatile LAS unsigned* st; };
__device__ __forceinline__ XcdBarrier xcd_barrier_post(unsigned* bar, volatile LAS unsigned* st) {
    XcdBarrier b; b.bar = bar; b.x = xb_xcc_id(); b.st = st;
    if (threadIdx.x == 0) st[2] = xb_add(&bar[XB_XCNT(b.x)], 1u);
    return b;
}
__device__ __forceinline__ void xcd_barrier_complete(unsigned* bar, unsigned x, unsigned& nloc, unsigned& nx) {
    const unsigned G = gridDim.x * gridDim.y * gridDim.z;
    unsigned sum, cnt, mine, sp = 0u;
    for (;;) {
        sum = 0u; cnt = 0u; mine = 0u;
#pragma unroll
        for (unsigned j = 0; j < 16; ++j) { const unsigned c = xb_ld(&bar[XB_XCNT(j)]); sum += c; cnt += (c > 0u) ? 1u : 0u; mine = (j == x) ? c : mine; }
        if (sum == G) break;
        __builtin_amdgcn_s_sleep(1);
        if ((++sp & 255u) == 0u) { if (xb_ld(&bar[XB_TMO])) break; if (sp > XB_SPIN_CAP) { atomicAdd(&bar[XB_TMO], 1u); break; } }
    }
    nloc = mine > 0u ? mine : 1u; nx = cnt > 0u ? cnt : 1u;
}
__device__ __forceinline__ void xcd_barrier(const XcdBarrier& b) {
    asm volatile("s_waitcnt vmcnt(0)" ::: "memory");
    __syncthreads();
    if (threadIdx.x == 0) {
        unsigned* bar = b.bar;
        __builtin_amdgcn_s_waitcnt(0);
        unsigned nloc = b.st[0], nx = b.st[1];
        if (nloc == 0u) { xcd_barrier_complete(bar, b.x, nloc, nx); b.st[0] = nloc; b.st[1] = nx; }
        const unsigned old = xb_add(&bar[XB_XSUB(b.x)], 1u);
        const unsigned gen = old / nloc;
        if (old + 1u == (gen + 1u) * nloc) {
            __builtin_amdgcn_fence(__ATOMIC_RELEASE, "agent");
            asm volatile("s_waitcnt vmcnt(0)" ::: "memory");
            const unsigned og = xb_add(&bar[XB_TOP], 1u);
            const unsigned tg = og / nx;
            if (og + 1u == (tg + 1u) * nx) xb_add(&bar[XB_TOPGEN], 1u);
            else XB_SPIN(xb_ld(&bar[XB_TOPGEN]) == tg, bar);
            __builtin_amdgcn_fence(__ATOMIC_ACQUIRE, "agent");
            xb_add(&bar[XB_XGEN(b.x)], 1u);
            asm volatile("s_waitcnt vmcnt(0)" ::: "memory");
        } else {
            XB_SPIN(xb_ld(&bar[XB_XGEN(b.x)]) == gen, bar);
            __builtin_amdgcn_fence(__ATOMIC_ACQUIRE, "agent");
            asm volatile("s_waitcnt vmcnt(0)" ::: "memory");
        }
    }
    __syncthreads();
}

__global__ void __launch_bounds__(512, 2) fwd_megakernel(Params p) {
    extern __shared__ __attribute__((aligned(16))) unsigned char lds_raw[];
    LAS unsigned char* lds = (LAS unsigned char*)lds_raw;
    cg::grid_group grid = cg::this_grid();
    const int G = gridDim.x, bid = blockIdx.x;
    bf16_t* XB = (bf16_t*)(p.ws + WS_XB); ssq_t* SSQ = (ssq_t*)(p.ws + WS_SSQ); float* PART = (float*)(p.ws + WS_PART);
#define IN(k) (p.ph_lo <= (k) && (k) < p.ph_hi)
#define SYNC(k) do { if (p.ph_hi > (k) + 1) xcd_barrier(bar); } while (0)
    unsigned* barw = (unsigned*)(p.ws + WS_BAR);
    volatile LAS unsigned* bst = (volatile LAS unsigned*)(lds + 131072);
    if (threadIdx.x < 4) bst[threadIdx.x] = 0u;
    __syncthreads();
    XcdBarrier bar = xcd_barrier_post(barw, bst);
#ifndef X_NOPREP
    if (IN(0)) prep_phase(p, lds);
    if (p.ph_lo < 0) grid.sync();
    xcd_barrier(bar);
    for (int rep = 0; rep < DUP_SYNC; ++rep) xcd_barrier(bar);
    int vbid = bid, cbid = bid;
    { bool okc = (G == 256);
#pragma unroll
      for (int j = 0; j < 16; ++j) { const unsigned cj = xb_ld(&barw[XB_XCNT(j)]); okc = okc && (cj == (j < 8 ? 32u : 0u)); }
      if (okc) { vbid = (int)(bar.x + 8u * bst[2]); cbid = (int)(bar.x * 32u + bst[2]); } }
#endif
#pragma unroll 1
    for (int l = 0; l < 4; ++l) {
        const int pb = 1 + 5 * l, i = l >> 1;
        ssq_t* ssq_in = SSQ + (size_t)(2 * l) * MT;
        ssq_t* ssq_mid = SSQ + (size_t)(2 * l + 1) * MT;
        ssq_t* ssq_out = SSQ + (size_t)(2 * l + 2) * MT;
        if ((l & 1) == 0) {
            if (IN(pb) && X_GIN) {
                pg8::Gemm g{XB, (const bf16_t*)(p.ws + WS_WIN) + (size_t)i * DIN * DM, MT, DIN, DM}; pg8::StaticOrder S; S.init(MT, DIN, DM, G, vbid);
                EpiIn E{ssq_in, (bf16_t*)(p.ws + WS_GLU), (bf16_t*)(p.ws + WS_QKV)};
                for (int rep = 0; rep <= DUP_IN; ++rep) { pg8::gemm_phase(lds, g, S, E); SYNC(pb); }
            }
#ifndef X_NOMIX
            if (IN(pb + 1)) { for (int rep = 0; rep <= DUP_MIX; ++rep) { mixer_phase(p, l, lds, cbid); SYNC(pb + 1); } }
#endif
            if (IN(pb + 2) && X_GOUT) {
                pg8::Gemm g{(const bf16_t*)(p.ws + WS_CAT), (const bf16_t*)(p.ws + WS_WOUT) + (size_t)i * DM * DM, MT, DM, DM}; pg8::SplitOrder<false> S; S.init2(MT, DM, DM, G, vbid, 4);
                EpiRes<false> E{nullptr, XB, ssq_mid, nullptr, PART};
                pg8::gemm_phase(lds, g, S, E);
                xcd_barrier(bar);
                splitk_reduce(nullptr, XB, ssq_mid, PART, S, 4);
                SYNC(pb + 2);
            }
        } else {
#ifndef X_NOPOOL1
            if (IN(pb)) { for (int rep = 0; rep <= DUP_POOL1; ++rep) { pool1_phase(p, l, ssq_in, cbid); SYNC(pb); } }
#endif
            if (IN(pb + 1) && X_GPOOL) {
                pg8::Gemm g{(const bf16_t*)(p.ws + WS_DG), (const bf16_t*)(p.ws + WS_WPL) + (size_t)i * 4 * 65536, 4 * MT, 256, 256}; pg8::PoolOrder S{G, vbid};
                EpiRes<true> E{nullptr, XB, ssq_mid, p.in[I_PSCALE] + i * DM, PART};
                pg8::gemm_phase(lds, g, S, E);
                SYNC(pb + 2);
            }
        }
        if (IN(pb + 3) && X_GGU) {
            pg8::Gemm g{XB, (const bf16_t*)(p.ws + WS_WGU) + (size_t)l * 2 * DFF * DM, MT, 2 * DFF, DM}; pg8::StaticOrder S; S.init(MT, 2 * DFF, DM, G, vbid);
            EpiGU E{ssq_mid, (bf16_t*)(p.ws + WS_ACT)};
            for (int rep = 0; rep <= DUP_GU; ++rep) { pg8::gemm_phase(lds, g, S, E); SYNC(pb + 3); }
        }
        if (IN(pb + 4) && X_GDN) {
            pg8::Gemm g{(const bf16_t*)(p.ws + WS_ACT), (const bf16_t*)(p.ws + WS_WDN) + (size_t)l * DM * DFF, MT, DM, DFF}; pg8::SplitOrder<true> S; S.init2(MT, DM, DFF, G, vbid, 11);
            float* Yout = (l == 3) ? p.out : nullptr;
            EpiRes<false> E{Yout, XB, ssq_out, nullptr, PART};
            pg8::gemm_phase(lds, g, S, E);
            xcd_barrier(bar);
            splitk_reduce(Yout, XB, ssq_out, PART, S, 11);
            SYNC(pb + 4);
        }
    }
#undef IN
#undef SYNC
}

extern "C" void kernel_launch(void* const* d_in, const int* in_sizes, int n_in, void* d_out, int out_size, void* d_ws, size_t ws_size, hipStream_t stream) {
    static int grid_blocks = 0;
    if (grid_blocks == 0) {
        if (n_in != N_IN || ws_size < WS_END) { fprintf(stderr, "kernel_launch: unexpected n_in %d or ws_size %zu (< %zu)\n", n_in, ws_size, (size_t)WS_END); grid_blocks = -1; return; }
        int dev = 0, cus = 0, per_cu = 0;
        hipGetDevice(&dev);
        hipDeviceGetAttribute(&cus, hipDeviceAttributeMultiprocessorCount, dev);
        hipFuncSetAttribute((const void*)fwd_megakernel, hipFuncAttributeMaxDynamicSharedMemorySize, LDS_BYTES);
        hipOccupancyMaxActiveBlocksPerMultiprocessor(&per_cu, (const void*)fwd_megakernel, 512, LDS_BYTES);
        if (per_cu < 1) { fprintf(stderr, "kernel_launch: occupancy query reports %d blocks per CU\n", per_cu); per_cu = 1; }
        grid_blocks = cus * 1;
    }
    if (grid_blocks < 0) return;
    Params p{};
    for (int k = 0; k < N_IN; ++k) p.in[k] = (const float*)d_in[k];
    p.out = (float*)d_out; p.ws = (unsigned char*)d_ws; p.ph_lo = 0; p.ph_hi = N_PHASES;
    void* args[] = {&p};
    if (hipMemsetAsync((unsigned char*)d_ws + WS_BAR, 0, 16384, stream) != hipSuccess) { fprintf(stderr, "kernel_launch: memset of the barrier words failed\n"); return; }
    hipError_t e = hipLaunchCooperativeKernel((const void*)fwd_megakernel, dim3(grid_blocks), dim3(512), args, LDS_BYTES, stream);
    if (e != hipSuccess) fprintf(stderr, "cooperative launch failed: %s (grid %d)\n", hipGetErrorString(e), grid_blocks);
}
```

```cpp
#include <hip/hip_runtime.h>
#include <hip/hip_cooperative_groups.h>
#include <cstdio>
namespace cg = cooperative_groups;

#define LAS __attribute__((address_space(3)))
#ifndef DUP_PREP
#define DUP_PREP 0
#define DUP_IN 0
#define DUP_MIX 0
#define DUP_POOL1 0
#define DUP_GU 0
#define DUP_SYNC 0
#define DUP_DN 0
#endif
#ifndef X_GIN
#define X_GIN 1
#define X_GOUT 1
#define X_GPOOL 1
#define X_GGU 1
#define X_GDN 1
#endif
typedef unsigned short bf16_t;
typedef short bf16x8 __attribute__((ext_vector_type(8)));
typedef float f32x4 __attribute__((ext_vector_type(4)));
typedef unsigned u32x4 __attribute__((ext_vector_type(4)));
typedef unsigned u32x2 __attribute__((ext_vector_type(2)));
typedef float f32x2 __attribute__((ext_vector_type(2)));
typedef unsigned long long ssq_t;

constexpr int DM = 1024, MP = 16384, MS = 1024, MT = 17408, NTM = 68, DFF = 2816, DIN = 1792;
constexpr float RMS_EPS = 1e-6f, LN_EPS = 1e-5f;
enum { I_XP = 0, I_XS, I_CCONV, I_CK, I_CV, I_SPOOL, I_NMIX, I_NFFN, I_WIN, I_QN, I_KN, I_SINK, I_WDW, I_BDW, I_CNG, I_CNB, I_WOUT, I_WPOOL, I_PSCALE, I_WG, I_WU, I_WD, N_IN };
constexpr size_t O_Y = 0;
constexpr size_t O_CONVP = (size_t)MT * DM;
constexpr size_t O_KP = O_CONVP + 2 * 4 * 30 * 512;
constexpr size_t O_VP = O_KP + 2 * 4 * 128 * 128;
constexpr size_t O_POOLP = O_VP + 2 * 4 * 128 * 128;
constexpr size_t O_CONVS = O_POOLP + 2 * 4 * 15 * 1024;
constexpr size_t O_KS = O_CONVS + (size_t)2 * 128 * 30 * 512;
constexpr size_t O_VS = O_KS + (size_t)2 * 128 * 128 * 128;
constexpr size_t O_POOLS = O_VS + (size_t)2 * 128 * 128 * 128;
constexpr size_t WS_WIN = 0;
constexpr size_t WS_WOUT = WS_WIN + (size_t)2 * DIN * DM * 2;
constexpr size_t WS_WGU = WS_WOUT + (size_t)2 * DM * DM * 2;
constexpr size_t WS_WDN = WS_WGU + (size_t)4 * 2 * DFF * DM * 2;
constexpr size_t WS_WPL = WS_WDN + (size_t)4 * DM * DFF * 2;
constexpr size_t WS_XB = WS_WPL + (size_t)2 * 4 * 256 * 256 * 2;
constexpr size_t WS_SSQ = WS_XB + (size_t)MT * DM * 2;
constexpr size_t WS_ACT = WS_SSQ + (size_t)9 * MT * 8;
constexpr size_t WS_QKV = WS_ACT;
constexpr size_t WS_GLU = WS_QKV + (size_t)MT * 768 * 2;
constexpr size_t WS_CAT = WS_GLU + (size_t)MT * 512 * 2;
constexpr size_t WS_DG = WS_ACT;
constexpr size_t WS_BAR = WS_ACT + (size_t)MT * DFF * 2;
constexpr size_t WS_PART = WS_BAR + 16384;
constexpr size_t WS_END = WS_PART + (size_t)176 * 65536 * 4;
constexpr int LDS_BYTES = 131072 + 16;
constexpr int N_PHASES = 21;

struct Params { const float* in[N_IN]; float* out; unsigned char* ws; int ph_lo, ph_hi; };

__device__ __forceinline__ unsigned cvt_pk_bf16(float lo, float hi) { unsigned r; asm("v_cvt_pk_bf16_f32 %0, %1, %2" : "=v"(r) : "v"(lo), "v"(hi)); return r; }
__device__ __forceinline__ float bflo(unsigned w) { return __uint_as_float(w << 16); }
__device__ __forceinline__ float bfhi(unsigned w) { return __uint_as_float(w & 0xffff0000u); }
__device__ __forceinline__ float bf2f(bf16_t b) { return __uint_as_float(((unsigned)b) << 16); }
__device__ __forceinline__ float wave_sum(float v) {
#pragma unroll
    for (int o = 32; o >= 1; o >>= 1) v += __shfl_xor(v, o);
    return v;
}
__device__ __forceinline__ float ssq_rs(ssq_t v) { return rsqrtf((float)v * (1.0f / (1048576.0f * 1024.0f)) + RMS_EPS); }
__device__ __forceinline__ ssq_t ssq_fix(float ss) { return (ssq_t)(ss * 1048576.0f); }
__device__ __forceinline__ void ssq_add(ssq_t* p, float ss) { (void)__hip_atomic_fetch_add(p, ssq_fix(ss), __ATOMIC_RELAXED, __HIP_MEMORY_SCOPE_AGENT); }
__device__ __forceinline__ float fast_sigmoid(float x) { return __builtin_amdgcn_rcpf(1.0f + __expf(-x)); }
__device__ __forceinline__ f32x2 pk_exp2(f32x2 v) { f32x2 r; r.x = __builtin_amdgcn_exp2f(v.x); r.y = __builtin_amdgcn_exp2f(v.y); return r; }
__device__ __forceinline__ f32x2 pk_rcp(f32x2 v) { f32x2 r; r.x = __builtin_amdgcn_rcpf(v.x); r.y = __builtin_amdgcn_rcpf(v.y); return r; }
__device__ __forceinline__ f32x2 pk_sig(f32x2 g, float k2) { return pk_rcp(pk_exp2(g * k2) + 1.0f); }

namespace pg8 {
constexpr int BM = 256, BK = 64, HALF = 128, HTB = HALF * BK * 2, STAGE_BYTES = 8 * HTB, NXCD = 8, WGM = 8;
__host__ __device__ __forceinline__ int lds_byte(int r, int c) { const int st = (r >> 4) * 2 + (c >> 5), rr = r & 15, cc = c & 31, ob = rr * 64 + cc * 2; return st * 1024 + (ob ^ (((ob >> 9) & 1) << 5)); }
__host__ __device__ __forceinline__ void stage_rc(int b, int& R, int& C) { const int st = b / 1024, sb = b % 1024, swz = sb ^ (((sb >> 9) & 1) << 5); R = (st >> 1) * 16 + swz / 64; C = (st & 1) * 32 + (swz % 64) / 2; }
__host__ __device__ __forceinline__ int perm32(int rho) { const int n = rho >> 4, i = rho & 15; return 8 * (i >> 2) + 4 * n + (i & 3); }
struct Unit { int pm, pn, k0, nt, part; };
struct Gemm { const bf16_t* A; const bf16_t* Bt; int M, N, K; };
struct StaticOrder {
    static constexpr bool SPLIT = false, ABLK = false;
    int nM, nN, nwg, G, c, ntk;
    __device__ void init(int M, int N, int K, int G_, int c_) { nM = M / BM; nN = N / BM; nwg = nM * nN; G = G_; c = c_; ntk = K / BK; }
    __device__ void tile(int L, Unit& u) const {
        int wgid = L; { const int q = nwg / NXCD, r = nwg % NXCD, xcd = wgid % NXCD, off = wgid / NXCD; wgid = (xcd < r ? xcd * (q + 1) : r * (q + 1) + (xcd - r) * q) + off; }
        const int nig = WGM * nN, gid = wgid / nig, fm = gid * WGM, gsz = (nM - fm) < WGM ? (nM - fm) : WGM;
        u.pm = fm + ((wgid % nig) % gsz); u.pn = (wgid % nig) / gsz;
    }
    __device__ bool next(int i, Unit& u) const {
        const long L = (long)i * G + c; if (L >= nwg) return false;
        tile((int)L, u); u.k0 = 0; u.nt = ntk; u.part = -1; return true;
    }
};
template <bool ABLK_> struct SplitOrder : StaticOrder {
    static constexpr bool SPLIT = true, ABLK = ABLK_;
    int KS, ntp;
    __device__ void init2(int M, int N, int K, int G_, int c_, int KS_) { init(M, N, K, G_, c_); KS = KS_; ntp = ntk / KS_; }
    __device__ bool next(int i, Unit& u) const {
        const int np = (nwg - G) * KS;
        int j = i;
        if (c < np) { if (i == 0) { tile(G + c / KS, u); u.k0 = (c % KS) * ntp; u.nt = ntp; u.part = c; return true; } j = i - 1; }
        if (j > 0) return false;
        tile(c, u); u.k0 = 0; u.nt = ntk; u.part = -1; return true;
    }
};
struct PoolOrder {
    static constexpr bool SPLIT = false, ABLK = false;
    int G, c;
    __device__ bool next(int i, Unit& u) const { const int L = i * G + c; if (L >= 4 * NTM) return false; u.pm = L; u.pn = L / NTM; u.k0 = 0; u.nt = 4; u.part = -1; return true; }
};

template <class Epi, class Sched>
__device__ __forceinline__ void gemm_phase(LAS unsigned char* lds, const Gemm g, const Sched& S, const Epi& E) {
    int tid = threadIdx.x; asm volatile("" : "+v"(tid));
    const int wid = __builtin_amdgcn_readfirstlane(tid >> 6), lane = tid & 63, wr = wid >> 2, wc = wid & 3, fr = lane & 15, fq = lane >> 4;
    int K = g.K; asm volatile("" : "+s"(K));
    unsigned voffA[2], voffB[2];
#pragma unroll
    for (int i = 0; i < 2; ++i) { int R, C; stage_rc(tid * 16 + i * 8192, R, C); const int Rb = (R & ~31) + perm32(R & 31);
        voffA[i] = Sched::ABLK ? (unsigned)(R * 64 + C) * 2u : (unsigned)(R * K + C) * 2u; voffB[i] = (unsigned)(Rb * K + C) * 2u; }
    const size_t kstep = (size_t)(BK * 2);
    const size_t hstep = (size_t)HALF * K * 2;
    const size_t tstep = 2 * hstep;
    const size_t kstepA = Sched::ABLK ? (size_t)32768 : kstep, hstepA = Sched::ABLK ? (size_t)16384 : hstep;
    const unsigned ldsw = (unsigned)wid * 1024u;
    const int aoff = lds_byte(wr * 64 + fr, fq * 8), boff = lds_byte(wc * 32 + fr, fq * 8);
#define PG8_SA(b, h) (((b) * 2 + (h)) * HTB)
#define PG8_SB(b, h) ((4 + (b) * 2 + (h)) * HTB)
#define PG8_STAGE(bufoff, gbase, voff) do { _Pragma("unroll") for (int _i = 0; _i < 2; ++_i) \
        __builtin_amdgcn_global_load_lds((const unsigned*)((const char*)(gbase) + (voff)[_i]), (LAS unsigned*)(lds + (bufoff) + ldsw + _i * 8192), 16, 0, 0); } while (0)
#define PG8_LDA(dst, b, h) do { _Pragma("unroll") for (int m = 0; m < 4; ++m) _Pragma("unroll") for (int k = 0; k < 2; ++k) dst[m][k] = *(const LAS bf16x8*)(lds + PG8_SA(b, h) + aoff + m * 2048 + k * 1024); } while (0)
#define PG8_LDB(dst, b, h) do { _Pragma("unroll") for (int n = 0; n < 2; ++n) _Pragma("unroll") for (int k = 0; k < 2; ++k) dst[n][k] = *(const LAS bf16x8*)(lds + PG8_SB(b, h) + boff + n * 2048 + k * 1024); } while (0)
#define PG8_MMA(ai, bj, At, Bt) do { __builtin_amdgcn_s_setprio(1); _Pragma("unroll") for (int m = 0; m < 4; ++m) _Pragma("unroll") for (int n = 0; n < 2; ++n) _Pragma("unroll") for (int k = 0; k < 2; ++k) \
        acc[ai][bj][m][n] = __builtin_amdgcn_mfma_f32_16x16x32_bf16(Bt[n][k], At[m][k], acc[ai][bj][m][n], 0, 0, 0); __builtin_amdgcn_s_setprio(0); } while (0)
#define PG8_WAIT_V(n) asm volatile("s_waitcnt vmcnt(" #n ")" ::: "memory")
#define PG8_WAIT_L(n) asm volatile("s_waitcnt lgkmcnt(" #n ")" ::: "memory")
#define PG8_BAR __builtin_amdgcn_s_barrier()
#define PG8_SCHED __builtin_amdgcn_sched_barrier(0)
    Unit cur, nxt; int ui = 0;
    if (!S.next(0, cur)) return;
    f32x4 acc[2][2][4][2];
    E.init(acc, cur, wr, wc, fr, fq);
    bf16x8 At[4][2], B0[2][2], B1[2][2];
    const char* cA = (const char*)g.A + (size_t)cur.pm * tstep; const char* cB = (const char*)g.Bt + (size_t)cur.pn * tstep;
    if constexpr (Sched::SPLIT) { cA += (size_t)cur.k0 * kstepA; cB += (size_t)cur.k0 * kstep; }
    const int ntc = K / BK;
    PG8_STAGE(PG8_SB(0, 0), cB, voffB); PG8_STAGE(PG8_SA(0, 0), cA, voffA); PG8_STAGE(PG8_SB(0, 1), cB + hstep, voffB); PG8_STAGE(PG8_SA(0, 1), cA + hstepA, voffA);
    if (wr == 1) PG8_BAR;
    PG8_WAIT_V(4); PG8_BAR;
    PG8_STAGE(PG8_SB(1, 0), cB + kstep, voffB); PG8_STAGE(PG8_SA(1, 0), cA + kstepA, voffA); PG8_STAGE(PG8_SB(1, 1), cB + hstep + kstep, voffB);
    PG8_WAIT_V(6); PG8_BAR;
    for (;;) {
        const bool has_next = S.next(ui + 1, nxt);
        const char* nA = has_next ? (const char*)g.A + (size_t)nxt.pm * tstep : cA; const char* nB = has_next ? (const char*)g.Bt + (size_t)nxt.pn * tstep : cB;
        if constexpr (Sched::SPLIT) { if (has_next) { nA += (size_t)nxt.k0 * kstepA; nB += (size_t)nxt.k0 * kstep; } }
        const int nt = Sched::SPLIT ? cur.nt : ntc;
        for (int t = 0; t < nt; t += 2) {
            const bool last = (t == nt - 2);
            const char* a1 = cA + (size_t)(t + 1) * kstepA;
            const char* a2 = last ? nA : cA + (size_t)(t + 2) * kstepA; const char* b2 = last ? nB : cB + (size_t)(t + 2) * kstep;
            const char* a3 = a2 + kstepA; const char* b3 = b2 + kstep;
            PG8_LDB(B0, 0, 0); PG8_SCHED; PG8_LDA(At, 0, 0); PG8_STAGE(PG8_SA(1, 1), a1 + hstepA, voffA);
            PG8_WAIT_L(8); PG8_BAR; PG8_WAIT_L(0); PG8_MMA(0, 0, At, B0); PG8_BAR; PG8_SCHED;
            PG8_LDB(B1, 0, 1); PG8_STAGE(PG8_SB(0, 0), b2, voffB);
            PG8_BAR; PG8_WAIT_L(0); PG8_MMA(0, 1, At, B1); PG8_BAR;
            PG8_LDA(At, 0, 1); PG8_STAGE(PG8_SA(0, 0), a2, voffA);
            PG8_BAR; PG8_WAIT_L(0); PG8_MMA(1, 0, At, B0); PG8_BAR; PG8_SCHED;
            PG8_STAGE(PG8_SB(0, 1), b2 + hstep, voffB);
            PG8_WAIT_V(6); PG8_BAR; PG8_MMA(1, 1, At, B1); PG8_BAR;
            PG8_LDB(B0, 1, 0); PG8_SCHED; PG8_LDA(At, 1, 0); PG8_STAGE(PG8_SA(0, 1), a2 + hstepA, voffA);
            PG8_WAIT_L(8); PG8_BAR; PG8_WAIT_L(0); PG8_MMA(0, 0, At, B0); PG8_BAR; PG8_SCHED;
            PG8_LDB(B1, 1, 1); PG8_STAGE(PG8_SB(1, 0), b3, voffB);
            PG8_BAR; PG8_WAIT_L(0); PG8_MMA(0, 1, At, B1); PG8_BAR;
            PG8_LDA(At, 1, 1); PG8_STAGE(PG8_SA(1, 0), a3, voffA);
            PG8_BAR; PG8_WAIT_L(0); PG8_MMA(1, 0, At, B0); PG8_BAR; PG8_SCHED;
            PG8_STAGE(PG8_SB(1, 1), b3 + hstep, voffB);
            PG8_WAIT_V(6); PG8_BAR; PG8_MMA(1, 1, At, B1); PG8_BAR;
        }
        E(acc, cur, wr, wc, fr, fq);
        if (!has_next) break;
        E.init(acc, nxt, wr, wc, fr, fq);
        cur = nxt; cA = nA; cB = nB; ++ui;
    }
    PG8_WAIT_V(0);
    if (wr == 0) PG8_BAR;
    PG8_BAR;
#undef PG8_SA
#undef PG8_SB
#undef PG8_STAGE
#undef PG8_LDA
#undef PG8_LDB
#undef PG8_MMA
#undef PG8_WAIT_V
#undef PG8_WAIT_L
#undef PG8_BAR
#undef PG8_SCHED
}
}

__device__ __forceinline__ void acc_zero(f32x4 (&acc)[2][2][4][2]) {
#pragma unroll
    for (int a = 0; a < 2; ++a)
#pragma unroll
        for (int b = 0; b < 2; ++b)
#pragma unroll
            for (int m = 0; m < 4; ++m)
#pragma unroll
                for (int n = 0; n < 2; ++n) acc[a][b][m][n] = (f32x4){0.f, 0.f, 0.f, 0.f};
}
struct EpiIn {
    const ssq_t* ssq; bf16_t* glu; bf16_t* qkv;
    __device__ __forceinline__ void init(f32x4 (&acc)[2][2][4][2], const pg8::Unit&, int, int, int, int) const { acc_zero(acc); }
    __device__ __forceinline__ void operator()(const f32x4 (&acc)[2][2][4][2], const pg8::Unit& u, int wr, int wc, int fr, int fq) const {
        const int row0 = u.pm * 256 + wr * 64 + fr;
        if (u.pn < 4) {
            const int col0 = u.pn * 128 + wc * 32 + 8 * fq;
#pragma unroll
            for (int ai = 0; ai < 2; ++ai)
#pragma unroll
                for (int m = 0; m < 4; ++m) {
                    const int r = row0 + ai * 128 + m * 16;
                    const float rs = ssq_rs(ssq[r]);
                    const float k2 = rs * -1.4426950408889634f;
                    f32x2 o[4];
#pragma unroll
                    for (int n = 0; n < 2; ++n)
#pragma unroll
                        for (int h = 0; h < 2; ++h) {
                            const f32x2 a = (f32x2){acc[ai][0][m][n][2 * h], acc[ai][0][m][n][2 * h + 1]}, gt = (f32x2){acc[ai][1][m][n][2 * h], acc[ai][1][m][n][2 * h + 1]};
                            o[n * 2 + h] = (a * rs) * pk_sig(gt, k2);
                        }
                    u32x4 w; w.x = cvt_pk_bf16(o[0].x, o[0].y); w.y = cvt_pk_bf16(o[1].x, o[1].y); w.z = cvt_pk_bf16(o[2].x, o[2].y); w.w = cvt_pk_bf16(o[3].x, o[3].y);
                    *(u32x4*)(glu + (size_t)r * 512 + col0) = w;
                }
        } else {
            const int col0 = (u.pn - 4) * 256 + wc * 32 + 8 * fq;
#pragma unroll
            for (int ai = 0; ai < 2; ++ai)
#pragma unroll
                for (int m = 0; m < 4; ++m) {
                    const int r = row0 + ai * 128 + m * 16;
                    const float rs = ssq_rs(ssq[r]);
#pragma unroll
                    for (int bj = 0; bj < 2; ++bj) {
                        const f32x4 v0 = acc[ai][bj][m][0] * rs, v1 = acc[ai][bj][m][1] * rs;
                        u32x4 w; w.x = cvt_pk_bf16(v0[0], v0[1]); w.y = cvt_pk_bf16(v0[2], v0[3]); w.z = cvt_pk_bf16(v1[0], v1[1]); w.w = cvt_pk_bf16(v1[2], v1[3]);
                        *(u32x4*)(qkv + (size_t)r * 768 + col0 + bj * 128) = w;
                    }
                }
        }
    }
};
struct EpiGU {
    const ssq_t* ssq; bf16_t* act;
    __device__ __forceinline__ void init(f32x4 (&acc)[2][2][4][2], const pg8::Unit&, int, int, int, int) const { acc_zero(acc); }
    __device__ __forceinline__ void operator()(const f32x4 (&acc)[2][2][4][2], const pg8::Unit& u, int wr, int wc, int fr, int fq) const {
        const int row0 = u.pm * 256 + wr * 64 + fr, col0 = u.pn * 128 + wc * 32 + 8 * fq;
#pragma unroll
        for (int ai = 0; ai < 2; ++ai)
#pragma unroll
            for (int m = 0; m < 4; ++m) {
                const int r = row0 + ai * 128 + m * 16;
                const float rs = ssq_rs(ssq[r]);
                const float k2 = rs * -1.4426950408889634f, rs2 = rs * rs;
                f32x2 o[4];
#pragma unroll
                for (int n = 0; n < 2; ++n)
#pragma unroll
                    for (int h = 0; h < 2; ++h) {
                        const f32x2 gt = (f32x2){acc[ai][0][m][n][2 * h], acc[ai][0][m][n][2 * h + 1]}, up = (f32x2){acc[ai][1][m][n][2 * h], acc[ai][1][m][n][2 * h + 1]};
                        o[n * 2 + h] = (gt * up) * rs2 * pk_sig(gt, k2);
                    }
                u32x4 w; w.x = cvt_pk_bf16(o[0].x, o[0].y); w.y = cvt_pk_bf16(o[1].x, o[1].y); w.z = cvt_pk_bf16(o[2].x, o[2].y); w.w = cvt_pk_bf16(o[3].x, o[3].y);
                *(u32x4*)(act + (size_t)(r >> 8) * (256 * DFF) + (size_t)(col0 >> 6) * (256 * 64) + (size_t)(r & 255) * 64 + (col0 & 63)) = w;
            }
    }
};
__device__ __forceinline__ void bf8_to_f32(u32x4 w, f32x4& lo, f32x4& hi) { lo = (f32x4){bflo(w.x), bfhi(w.x), bflo(w.y), bfhi(w.y)}; hi = (f32x4){bflo(w.z), bfhi(w.z), bflo(w.w), bfhi(w.w)}; }
template <bool POOL> struct EpiRes {
    float* Y; bf16_t* XB; ssq_t* ssq; const float* cscale; float* part;
    __device__ __forceinline__ void init(f32x4 (&acc)[2][2][4][2], const pg8::Unit& u, int wr, int wc, int fr, int fq) const {
        if (!POOL && u.part >= 0) { acc_zero(acc); return; }
        const int pmr = POOL ? (u.pm % NTM) : u.pm, ct = POOL ? (u.pm / NTM) : u.pn;
        const bf16_t* xq = XB + (size_t)(pmr * 256 + wr * 64 + fr) * DM + ct * 256 + wc * 32 + 8 * fq;
#pragma unroll
        for (int ai = 0; ai < 2; ++ai)
#pragma unroll
            for (int bj = 0; bj < 2; ++bj)
#pragma unroll
                for (int m = 0; m < 4; ++m) bf8_to_f32(*(const u32x4*)(xq + (size_t)(ai * 128 + m * 16) * DM + bj * 128), acc[ai][bj][m][0], acc[ai][bj][m][1]);
        if (POOL) {
            const float* cq = cscale + ct * 256 + wc * 32 + 8 * fq;
#pragma unroll
            for (int bj = 0; bj < 2; ++bj)
#pragma unroll
                for (int n = 0; n < 2; ++n) {
                    const f32x4 cv = *(const f32x4*)(cq + bj * 128 + 4 * n);
                    const f32x4 ic = (f32x4){__builtin_amdgcn_rcpf(cv[0]), __builtin_amdgcn_rcpf(cv[1]), __builtin_amdgcn_rcpf(cv[2]), __builtin_amdgcn_rcpf(cv[3])};
#pragma unroll
                    for (int ai = 0; ai < 2; ++ai)
#pragma unroll
                        for (int m = 0; m < 4; ++m) acc[ai][bj][m][n] = acc[ai][bj][m][n] * ic;
                }
        }
    }
    __device__ __forceinline__ void operator()(const f32x4 (&acc)[2][2][4][2], const pg8::Unit& u, int wr, int wc, int fr, int fq) const {
        if (!POOL && u.part >= 0) {
            float* pp = part + (size_t)u.part * 65536 + (size_t)(((wr * 4 + wc) * 64) + fq * 16 + fr) * 4;
#pragma unroll
            for (int ai = 0; ai < 2; ++ai)
#pragma unroll
                for (int m = 0; m < 4; ++m)
#pragma unroll
                    for (int bj = 0; bj < 2; ++bj)
#pragma unroll
                        for (int n = 0; n < 2; ++n) *(f32x4*)(pp + (size_t)((((ai * 4 + m) * 2 + bj) * 2 + n) * 2048)) = acc[ai][bj][m][n];
            return;
        }
        const int pmr = POOL ? (u.pm % NTM) : u.pm, ct = POOL ? (u.pm / NTM) : u.pn;
        const int row0 = pmr * 256 + wr * 64 + fr, col0 = ct * 256 + wc * 32 + 8 * fq;
#pragma unroll
        for (int ai = 0; ai < 2; ++ai)
#pragma unroll
            for (int m = 0; m < 4; ++m) {
                const int r = row0 + ai * 128 + m * 16;
                bf16_t* bp = XB + (size_t)r * DM + col0;
                float ss = 0.f;
#pragma unroll
                for (int bj = 0; bj < 2; ++bj) {
                    f32x4 v0 = acc[ai][bj][m][0], v1 = acc[ai][bj][m][1];
                    if (POOL) { v0 = v0 * *(const f32x4*)(cscale + col0 + bj * 128); v1 = v1 * *(const f32x4*)(cscale + col0 + bj * 128 + 4); }
                    if (Y) { float* yp = Y + (size_t)r * DM + col0 + bj * 128; *(f32x4*)yp = v0; *(f32x4*)(yp + 4) = v1; continue; }
                    u32x4 w; w.x = cvt_pk_bf16(v0[0], v0[1]); w.y = cvt_pk_bf16(v0[2], v0[3]); w.z = cvt_pk_bf16(v1[0], v1[1]); w.w = cvt_pk_bf16(v1[2], v1[3]);
                    *(u32x4*)(bp + bj * 128) = w;
                    ss += (v0[0] * v0[0] + v0[1] * v0[1]) + (v0[2] * v0[2] + v0[3] * v0[3]) + (v1[0] * v1[0] + v1[1] * v1[1]) + (v1[2] * v1[2] + v1[3] * v1[3]);
                }
                if (Y) continue;
                ss += __shfl_xor(ss, 16); ss += __shfl_xor(ss, 32);
                if (fq == 0) ssq_add(ssq + r, ss);
            }
    }
};

struct WTile { const float* src0; const float* src1; const float* gain; bf16_t* dst; int ld, K, k0, n0m, mode; };
__device__ __forceinline__ void wt_decode(const Params& p, int t, WTile& w) {
    int kt; w.gain = nullptr;
    if (t < 224) { const int i = t / 112, r = t % 112; w.n0m = (r / 16) * 256; kt = r % 16; w.K = 1024; w.ld = DIN; w.mode = (w.n0m < 1024) ? 1 : 0;
        w.src0 = p.in[I_WIN] + (size_t)i * DM * DIN; w.src1 = w.src0; w.gain = p.in[I_NMIX] + (2 * i) * DM; w.dst = (bf16_t*)(p.ws + WS_WIN) + (size_t)i * DIN * DM; }
    else if (t < 352) { t -= 224; const int i = t / 64, r = t % 64; w.n0m = (r / 16) * 256; kt = r % 16; w.K = 1024; w.ld = DM; w.mode = 0;
        w.src0 = p.in[I_WOUT] + (size_t)i * DM * DM; w.src1 = w.src0; w.dst = (bf16_t*)(p.ws + WS_WOUT) + (size_t)i * DM * DM; }
    else if (t < 1760) { t -= 352; const int l = t / 352, r = t % 352; w.n0m = (r / 16) * 256; kt = r % 16; w.K = 1024; w.ld = DFF; w.mode = 2;
        w.src0 = p.in[I_WG] + (size_t)l * DM * DFF; w.src1 = p.in[I_WU] + (size_t)l * DM * DFF; w.gain = p.in[I_NFFN] + l * DM; w.dst = (bf16_t*)(p.ws + WS_WGU) + (size_t)l * 2 * DFF * DM; }
    else if (t < 2464) { t -= 1760; const int l = t / 176, r = t % 176; w.n0m = (r / 44) * 256; kt = r % 44; w.K = DFF; w.ld = DM; w.mode = 0;
        w.src0 = p.in[I_WD] + (size_t)l * DFF * DM; w.src1 = w.src0; w.dst = (bf16_t*)(p.ws + WS_WDN) + (size_t)l * DM * DFF; }
    else { t -= 2464; const int ig = t / 4; w.n0m = 0; kt = t % 4; w.K = 256; w.ld = 256; w.mode = 0;
        w.src0 = p.in[I_WPOOL] + (size_t)ig * 65536; w.src1 = w.src0; w.dst = (bf16_t*)(p.ws + WS_WPL) + (size_t)ig * 65536; }
    w.k0 = kt * 64;
}
__device__ __forceinline__ void wt_load(const WTile& w, int tid, f32x4 (&v)[4][2], float& gs0, float& gs1) {
    const int row = tid >> 4, col4 = (tid & 15) * 4;
    gs0 = w.gain ? w.gain[w.k0 + row] : 1.0f; gs1 = w.gain ? w.gain[w.k0 + row + 32] : 1.0f;
#pragma unroll
    for (int q = 0; q < 4; ++q) {
        const int n0 = w.n0m + 64 * q; int c0 = n0; const float* src = w.src0;
        if (w.mode == 1) { const int pn = n0 / 256, bj = (n0 / 128) & 1, cc = n0 % 128; c0 = bj * 512 + 128 * pn + cc; }
        else if (w.mode == 2) { const int pn = n0 / 256, bj = (n0 / 128) & 1, cc = n0 % 128; c0 = 128 * pn + cc; src = bj ? w.src1 : w.src0; }
        const float* sp = src + (size_t)(w.k0 + row) * w.ld + c0 + col4;
        v[q][0] = __builtin_nontemporal_load((const f32x4*)sp); v[q][1] = __builtin_nontemporal_load((const f32x4*)(sp + (size_t)32 * w.ld));
    }
}
__device__ __forceinline__ void prep_phase(const Params& p, LAS unsigned char* lds) {
    int tid = threadIdx.x; asm volatile("" : "+v"(tid));
    const int G = gridDim.x, bid = blockIdx.x, wave = tid >> 6, lane = tid & 63;
    bf16_t* XB = (bf16_t*)(p.ws + WS_XB); ssq_t* SSQ = (ssq_t*)(p.ws + WS_SSQ);
    for (int r0 = bid * 8 + wave; r0 < MT; r0 += G * 16) {
        const int r1 = r0 + G * 8; const bool h1 = r1 < MT; const int r1c = h1 ? r1 : r0;
        const float* s0 = r0 < MP ? p.in[I_XP] + (size_t)r0 * DM : p.in[I_XS] + (size_t)(r0 - MP) * DM;
        const float* s1 = r1c < MP ? p.in[I_XP] + (size_t)r1c * DM : p.in[I_XS] + (size_t)(r1c - MP) * DM;
        f32x4 va[4], vb[4];
#pragma unroll
        for (int q = 0; q < 4; ++q) { va[q] = __builtin_nontemporal_load((const f32x4*)(s0 + q * 256 + lane * 4)); vb[q] = __builtin_nontemporal_load((const f32x4*)(s1 + q * 256 + lane * 4)); }
        float ssa = 0.f, ssb = 0.f;
#pragma unroll
        for (int q = 0; q < 4; ++q) {
            u32x2 w; w.x = cvt_pk_bf16(va[q][0], va[q][1]); w.y = cvt_pk_bf16(va[q][2], va[q][3]);
            *(u32x2*)(XB + (size_t)r0 * DM + q * 256 + lane * 4) = w;
            ssa += (va[q][0] * va[q][0] + va[q][1] * va[q][1]) + (va[q][2] * va[q][2] + va[q][3] * va[q][3]);
            if (h1) {
                u32x2 w2; w2.x = cvt_pk_bf16(vb[q][0], vb[q][1]); w2.y = cvt_pk_bf16(vb[q][2], vb[q][3]);
                *(u32x2*)(XB + (size_t)r1 * DM + q * 256 + lane * 4) = w2;
            }
            ssb += (vb[q][0] * vb[q][0] + vb[q][1] * vb[q][1]) + (vb[q][2] * vb[q][2] + vb[q][3] * vb[q][3]);
        }
        ssa = wave_sum(ssa); ssb = wave_sum(ssb);
        if (lane == 0) { SSQ[r0] = ssq_fix(ssa); if (h1) SSQ[r1] = ssq_fix(ssb); }
    }
    for (int idx = bid * 512 + tid; idx < 8 * MT; idx += G * 512) SSQ[MT + idx] = 0ull;
    LAS float* tile = (LAS float*)lds;
    WTile cur, nxt; f32x4 v[4][2]; float gs0 = 1.f, gs1 = 1.f;
    int t0 = bid;
    if (t0 < 2496) { wt_decode(p, t0, cur); wt_load(cur, tid, v, gs0, gs1); }
    for (; t0 < 2496; t0 += G) {
        __syncthreads();
        {
            const int row = tid >> 4, col4 = (tid & 15) * 4;
#pragma unroll
            for (int q = 0; q < 4; ++q)
#pragma unroll
                for (int h = 0; h < 2; ++h) { LAS float* tp = tile + q * 4160 + (row + 32 * h) * 65 + col4; const float gs = h ? gs1 : gs0;
                    tp[0] = v[q][h][0] * gs; tp[1] = v[q][h][1] * gs; tp[2] = v[q][h][2] * gs; tp[3] = v[q][h][3] * gs; }
        }
        __syncthreads();
        const bool hn = (t0 + G) < 2496;
        if (hn) { wt_decode(p, t0 + G, nxt); wt_load(nxt, tid, v, gs0, gs1); }
        {
            const int n = tid >> 3, kk = (tid & 7) * 8;
#pragma unroll
            for (int q = 0; q < 4; ++q) {
                float e[8];
#pragma unroll
                for (int j = 0; j < 8; ++j) e[j] = tile[q * 4160 + (kk + j) * 65 + n];
                u32x4 w; w.x = cvt_pk_bf16(e[0], e[1]); w.y = cvt_pk_bf16(e[2], e[3]); w.z = cvt_pk_bf16(e[4], e[5]); w.w = cvt_pk_bf16(e[6], e[7]);
                *(u32x4*)(cur.dst + (size_t)(cur.n0m + 64 * q + n) * cur.K + cur.k0 + kk) = w;
            }
        }
        if (hn) cur = nxt;
    }
    __syncthreads();
}

__device__ __forceinline__ f32x4 ld_bf4(const bf16_t* p) { const u32x2 w = *(const u32x2*)p; return (f32x4){bflo(w.x), bfhi(w.x), bflo(w.y), bfhi(w.y)}; }
template <int W>
__device__ __forceinline__ void pool_prompt_strip(const bf16_t* X, const ssq_t* ssq, int row0, int t0, int c, f32x4 gm, bf16_t* dgp, float* outp_seq) {
    constexpr int TT = 16, NR = TT + W - 1;
    f32x4 xr[NR];
    if (t0 >= W - 1) {
        const bf16_t* xp = X + (size_t)(row0 - (W - 1)) * DM + c; asm volatile("" : "+v"(xp));
        const ssq_t* sp = ssq + (row0 - (W - 1)); asm volatile("" : "+v"(sp));
#pragma unroll
        for (int j = 0; j < NR; ++j) { const float rs = ssq_rs(sp[j]); xr[j] = ld_bf4(xp + (size_t)j * DM) * rs * gm; }
    } else {
        int vz; asm volatile("v_mov_b32 %0, 0" : "=v"(vz));
        const bf16_t* xp = X + (size_t)(row0 - t0) * DM + c; const ssq_t* sp = ssq + (row0 - t0);
#pragma unroll
        for (int j = 0; j < NR; ++j) { const int tj = t0 - (W - 1) + j + vz, tc = tj < 0 ? 0 : tj; const float rs = ssq_rs(sp[tc]);
            const f32x4 v = ld_bf4(xp + (size_t)tc * DM) * rs * gm; xr[j] = tj < 0 ? (f32x4){0.f, 0.f, 0.f, 0.f} : v; }
    }
    f32x4 S = (f32x4){0.f, 0.f, 0.f, 0.f};
#pragma unroll
    for (int j = 0; j < W - 1; ++j) S += xr[j];
#pragma unroll
    for (int tt = 0; tt < TT; ++tt) {
        S += xr[tt + W - 1]; if (tt > 0) S -= xr[tt - 1];
        const int t = t0 + tt, cnt = (t + 1 < W) ? (t + 1) : W;
        const f32x4 cur = xr[tt + W - 1], d = S * __builtin_amdgcn_rcpf((float)cnt) - cur;
        u32x2 wv; wv.x = cvt_pk_bf16(d[0], d[1]); wv.y = cvt_pk_bf16(d[2], d[3]);
        *(u32x2*)(dgp + (size_t)tt * 256) = wv;
        if (t >= 4081) *(f32x4*)(outp_seq + (size_t)(t - 4081) * DM) = cur;
    }
}
template <int W>
__device__ __forceinline__ void pool_sample_strip(const bf16_t* X, const ssq_t* ssq, int row0, int c, f32x4 gm, const float* state_seq, bf16_t* dgp, float* outs_seq) {
    constexpr int TT = 8, NR = TT + W - 1;
    f32x4 xr[NR];
    { const float* stp = state_seq + (size_t)(15 - (W - 1)) * DM; asm volatile("" : "+v"(stp));
#pragma unroll
      for (int j = 0; j < W - 1; ++j) xr[j] = *(const f32x4*)(stp + (size_t)j * DM); }
    { const bf16_t* xp = X + (size_t)row0 * DM + c; asm volatile("" : "+v"(xp));
      const ssq_t* sp = ssq + row0;
#pragma unroll
      for (int j = 0; j < TT; ++j) { const float rs = ssq_rs(sp[j]); xr[W - 1 + j] = ld_bf4(xp + (size_t)j * DM) * rs * gm; } }
    f32x4 S = (f32x4){0.f, 0.f, 0.f, 0.f};
#pragma unroll
    for (int j = 0; j < W - 1; ++j) S += xr[j];
#pragma unroll
    for (int tt = 0; tt < TT; ++tt) {
        S += xr[tt + W - 1]; if (tt > 0) S -= xr[tt - 1];
        const f32x4 cur = xr[tt + W - 1], d = S * (1.0f / (float)W) - cur;
        u32x2 wv; wv.x = cvt_pk_bf16(d[0], d[1]); wv.y = cvt_pk_bf16(d[2], d[3]);
        *(u32x2*)(dgp + (size_t)tt * 256) = wv;
        *(f32x4*)(outs_seq + (size_t)(7 + tt) * DM) = cur;
    }
}
__device__ __forceinline__ void pool1_phase(const Params& p, int l, const ssq_t* ssq, int bid) {
    int tid = threadIdx.x; asm volatile("" : "+v"(tid));
    const int G = gridDim.x, i = l >> 1;
    const bf16_t* X = (const bf16_t*)(p.ws + WS_XB); bf16_t* DG = (bf16_t*)(p.ws + WS_DG);
    const int cq = tid & 255, c = cq * 4, half = tid >> 8, g = __builtin_amdgcn_readfirstlane(cq >> 6);
    const f32x4 gm = *(const f32x4*)(p.in[I_NMIX] + l * DM + c);
    const float* spool = p.in[I_SPOOL] + (size_t)i * 128 * 15 * DM;
    float* outp = p.out + O_POOLP + (size_t)i * 4 * 15 * DM; float* outs = p.out + O_POOLS + (size_t)i * 128 * 15 * DM;
    for (int u = bid; u < MP / 64 + 64; u += G) {
        if (u < MP / 64) {
#pragma unroll 1
            for (int k = 0; k < 2; ++k) {
                const int row0 = u * 64 + k * 32 + half * 16, t0 = row0 & 4095, b = row0 >> 12;
                bf16_t* dgp = DG + ((size_t)g * MT + row0) * 256 + (c - 256 * g); float* op = outp + (size_t)b * 15 * DM + c;
                if (g == 0) pool_prompt_strip<2>(X, ssq, row0, t0, c, gm, dgp, op);
                else if (g == 1) pool_prompt_strip<4>(X, ssq, row0, t0, c, gm, dgp, op);
                else if (g == 2) pool_prompt_strip<8>(X, ssq, row0, t0, c, gm, dgp, op);
                else pool_prompt_strip<16>(X, ssq, row0, t0, c, gm, dgp, op);
            }
        } else {
            const int s0 = (u - MP / 64) * 2;
            {
                const int s = s0 + half, row0 = MP + s * 8;
                bf16_t* dgp = DG + ((size_t)g * MT + row0) * 256 + (c - 256 * g); float* op = outs + (size_t)s * 15 * DM + c; const float* st = spool + (size_t)s * 15 * DM + c;
                if (g == 0) pool_sample_strip<2>(X, ssq, row0, c, gm, st, dgp, op);
                else if (g == 1) pool_sample_strip<4>(X, ssq, row0, c, gm, st, dgp, op);
                else if (g == 2) pool_sample_strip<8>(X, ssq, row0, c, gm, st, dgp, op);
                else pool_sample_strip<16>(X, ssq, row0, c, gm, st, dgp, op);
            }
            for (int idx = tid; idx < 2 * 7 * 256; idx += 512) { const int c4 = (idx & 255) * 4, rr = (idx >> 8) % 7, sl = idx / (7 * 256);
                *(f32x4*)(outs + ((size_t)(s0 + sl) * 15 + rr) * DM + c4) = *(const f32x4*)(spool + ((size_t)(s0 + sl) * 15 + 8 + rr) * DM + c4); }
        }
    }
}

constexpr int KS_STRIDE = 72, VT_STRIDE = 264;

__device__ __forceinline__ void attn_item(const LAS bf16_t* Ks, const LAS bf16_t* Vt, int tile0, int r0, bool first, bool qvalid,
                                          const bf16_t* qptr, const float* qn, float slope, float sink, bf16_t* optr, int fr, int fq) {
    u32x4 raw0 = (u32x4){0u, 0u, 0u, 0u}, raw1 = raw0;
    if (qvalid) { raw0 = *(const u32x4*)(qptr); raw1 = *(const u32x4*)(qptr + 32); }
    float qf[16];
#pragma unroll
    for (int j = 0; j < 4; ++j) { qf[2 * j] = bflo(raw0[j]); qf[2 * j + 1] = bfhi(raw0[j]); qf[8 + 2 * j] = bflo(raw1[j]); qf[8 + 2 * j + 1] = bfhi(raw1[j]); }
    float ss = 0.f;
#pragma unroll
    for (int j = 0; j < 16; ++j) ss += qf[j] * qf[j];
    ss += __shfl_xor(ss, 16); ss += __shfl_xor(ss, 32);
    const float rq = rsqrtf(ss * (1.0f / 64.0f) + RMS_EPS) * 0.125f;
    bf16x8 q0, q1;
    {
        const f32x4 n0 = *(const f32x4*)(qn + fq * 8), n1 = *(const f32x4*)(qn + fq * 8 + 4), n2 = *(const f32x4*)(qn + 32 + fq * 8), n3 = *(const f32x4*)(qn + 32 + fq * 8 + 4);
        u32x4 a, b;
        a.x = cvt_pk_bf16(qf[0] * rq * n0[0], qf[1] * rq * n0[1]); a.y = cvt_pk_bf16(qf[2] * rq * n0[2], qf[3] * rq * n0[3]);
        a.z = cvt_pk_bf16(qf[4] * rq * n1[0], qf[5] * rq * n1[1]); a.w = cvt_pk_bf16(qf[6] * rq * n1[2], qf[7] * rq * n1[3]);
        b.x = cvt_pk_bf16(qf[8] * rq * n2[0], qf[9] * rq * n2[1]); b.y = cvt_pk_bf16(qf[10] * rq * n2[2], qf[11] * rq * n2[3]);
        b.z = cvt_pk_bf16(qf[12] * rq * n3[0], qf[13] * rq * n3[1]); b.w = cvt_pk_bf16(qf[14] * rq * n3[2], qf[15] * rq * n3[3]);
        q0 = __builtin_bit_cast(bf16x8, a); q1 = __builtin_bit_cast(bf16x8, b);
    }
    f32x4 s[9];
#pragma unroll
    for (int T = 0; T < 9; ++T) {
        const LAS bf16_t* kp = Ks + ((tile0 + T) * 16 + fr) * KS_STRIDE + fq * 8;
        const bf16x8 a0 = *(const LAS bf16x8*)(kp), a1 = *(const LAS bf16x8*)(kp + 32);
        f32x4 z = (f32x4){0.f, 0.f, 0.f, 0.f};
        z = __builtin_amdgcn_mfma_f32_16x16x32_bf16(a0, q0, z, 0, 0, 0);
        s[T] = __builtin_amdgcn_mfma_f32_16x16x32_bf16(a1, q1, z, 0, 0, 0);
    }
    __builtin_amdgcn_sched_barrier(0);
    int qi = r0 + fr; asm volatile("" : "+v"(qi));
    const int lim = first ? qi + 1 : 128;
    float mx = sink;
#pragma unroll
    for (int T = 0; T < 9; ++T)
#pragma unroll
        for (int j = 0; j < 4; ++j) {
            const int jk = (tile0 + T) * 16 + 4 * fq + j, dist = 128 + qi - jk;
            const bool valid = (unsigned)dist < (unsigned)lim;
            const float v = valid ? (s[T][j] - slope * (float)dist) : -1e30f;
            s[T][j] = v; mx = fmaxf(mx, v);
        }
    mx = fmaxf(mx, __shfl_xor(mx, 16)); mx = fmaxf(mx, __shfl_xor(mx, 32));
    float sum = 0.f;
#pragma unroll
    for (int T = 0; T < 9; ++T)
#pragma unroll
        for (int j = 0; j < 4; ++j) { const float e = __expf(s[T][j] - mx); s[T][j] = e; sum += e; }
    sum += __shfl_xor(sum, 16); sum += __shfl_xor(sum, 32);
    sum += __expf(sink - mx);
    const float inv = 1.0f / sum;
    __builtin_amdgcn_sched_barrier(0);
    f32x4 o[4];
#pragma unroll
    for (int dt = 0; dt < 4; ++dt) o[dt] = (f32x4){0.f, 0.f, 0.f, 0.f};
#pragma unroll
    for (int pp = 0; pp < 5; ++pp) {
        const int T0 = 2 * pp, T1 = (pp < 4) ? 2 * pp + 1 : 8;
        u32x4 pw;
        pw.x = cvt_pk_bf16(s[T0][0] * inv, s[T0][1] * inv); pw.y = cvt_pk_bf16(s[T0][2] * inv, s[T0][3] * inv);
        if (pp < 4) { pw.z = cvt_pk_bf16(s[T1][0] * inv, s[T1][1] * inv); pw.w = cvt_pk_bf16(s[T1][2] * inv, s[T1][3] * inv); } else { pw.z = 0u; pw.w = 0u; }
        const bf16x8 pf = __builtin_bit_cast(bf16x8, pw);
#pragma unroll
        for (int dt = 0; dt < 4; ++dt) {
            const LAS bf16_t* vp = Vt + (dt * 16 + fr) * VT_STRIDE + 4 * fq;
            const u32x2 v0 = *(const LAS u32x2*)(vp + (tile0 + T0) * 16), v1 = *(const LAS u32x2*)(vp + (tile0 + T1) * 16);
            u32x4 vw; vw.x = v0.x; vw.y = v0.y; vw.z = v1.x; vw.w = v1.y;
            o[dt] = __builtin_amdgcn_mfma_f32_16x16x32_bf16(__builtin_bit_cast(bf16x8, vw), pf, o[dt], 0, 0, 0);
        }
    }
    if (qvalid) {
#pragma unroll
        for (int dt = 0; dt < 4; ++dt) { u32x2 w; w.x = cvt_pk_bf16(o[dt][0], o[dt][1]); w.y = cvt_pk_bf16(o[dt][2], o[dt][3]); *(u32x2*)(optr + dt * 16) = w; }
    }
}

__device__ __forceinline__ void mixer_phase(const Params& p, int l, LAS unsigned char* lds, int bid) {
    const int G = gridDim.x, i = l >> 1;
    const bf16_t* QKV = (const bf16_t*)(p.ws + WS_QKV); const bf16_t* GLU = (const bf16_t*)(p.ws + WS_GLU); bf16_t* CAT = (bf16_t*)(p.ws + WS_CAT);
    const float* qn = p.in[I_QN] + i * 64; const float* kn = p.in[I_KN] + i * 64; const float* sinks = p.in[I_SINK] + i * 8;
    constexpr int N_PA = 256, N_CV = 640, N_SA = 128;
#define MIX_PRE int tid = threadIdx.x; asm volatile("" : "+v"(tid)); const int wave = tid >> 6, lane = tid & 63, fr = lane & 15, fq = lane >> 4; (void)wave; (void)fr; (void)fq;
    for (int u = bid; u < N_PA; u += G) {
        MIX_PRE
        {
#ifndef X_NOPA
            const int kh = u & 1, blk = (u >> 1) & 31, b = u >> 6;
            const int rowQ0 = b * 4096 + blk * 128, rowK0 = rowQ0 - 128;
            LAS bf16_t* Ks = (LAS bf16_t*)lds; LAS bf16_t* Vt = (LAS bf16_t*)(lds + 256 * KS_STRIDE * 2);
            const int chunk = tid & 7;
            const f32x4 kn0 = *(const f32x4*)(kn + chunk * 8), kn1 = *(const f32x4*)(kn + chunk * 8 + 4);
#pragma unroll 1
            for (int ps = 0; ps < 4; ++ps) {
                const int key = (tid >> 3) + 64 * ps;
                u32x4 kr = (u32x4){0u, 0u, 0u, 0u}, vr = kr;
                const bool have = (blk > 0) || (key >= 128);
                if (have) { const bf16_t* rp = QKV + (size_t)(rowK0 + key) * 768 + 512 + kh * 64 + chunk * 8; kr = *(const u32x4*)rp; vr = *(const u32x4*)(rp + 128); }
                float kf[8], vf[8];
#pragma unroll
                for (int j = 0; j < 4; ++j) { kf[2 * j] = bflo(kr[j]); kf[2 * j + 1] = bfhi(kr[j]); vf[2 * j] = bflo(vr[j]); vf[2 * j + 1] = bfhi(vr[j]); }
                float ss = 0.f;
#pragma unroll
                for (int j = 0; j < 8; ++j) ss += kf[j] * kf[j];
                ss += __shfl_xor(ss, 1); ss += __shfl_xor(ss, 2); ss += __shfl_xor(ss, 4);
                const float rk = rsqrtf(ss * (1.0f / 64.0f) + RMS_EPS);
#pragma unroll
                for (int j = 0; j < 4; ++j) { kf[j] *= rk * kn0[j]; kf[4 + j] *= rk * kn1[j]; }
                u32x4 kw; kw.x = cvt_pk_bf16(kf[0], kf[1]); kw.y = cvt_pk_bf16(kf[2], kf[3]); kw.z = cvt_pk_bf16(kf[4], kf[5]); kw.w = cvt_pk_bf16(kf[6], kf[7]);
                *(LAS u32x4*)(Ks + key * KS_STRIDE + chunk * 8) = kw;
#pragma unroll
                for (int j = 0; j < 4; ++j) { Vt[(chunk * 8 + 2 * j) * VT_STRIDE + key] = (bf16_t)(vr[j] & 0xffffu); Vt[(chunk * 8 + 2 * j + 1) * VT_STRIDE + key] = (bf16_t)(vr[j] >> 16); }
                if (blk == 31 && key >= 128) {
                    float* ko = p.out + O_KP + ((((size_t)i * 4 + b) * 128 + (key - 128)) * 2 + kh) * 64 + chunk * 8;
                    float* vo = p.out + O_VP + ((((size_t)i * 4 + b) * 128 + (key - 128)) * 2 + kh) * 64 + chunk * 8;
                    *(f32x4*)ko = (f32x4){kf[0], kf[1], kf[2], kf[3]}; *(f32x4*)(ko + 4) = (f32x4){kf[4], kf[5], kf[6], kf[7]};
                    *(f32x4*)vo = (f32x4){vf[0], vf[1], vf[2], vf[3]}; *(f32x4*)(vo + 4) = (f32x4){vf[4], vf[5], vf[6], vf[7]};
                }
            }
            __syncthreads();
            const int r0 = wave * 16;
#pragma unroll 1
            for (int g = 0; g < 4; ++g) {
                const int h = kh * 4 + g;
                const float slope = exp2f(-(float)(h + 1)), sink = sinks[h];
                const size_t row = (size_t)(rowQ0 + r0 + fr);
                attn_item(Ks, Vt, wave, r0, blk == 0, true, QKV + row * 768 + h * 64 + fq * 8, qn, slope, sink, CAT + row * DM + 512 + h * 64 + 4 * fq, fr, fq);
            }
            __syncthreads();
#endif
        }
    }
#ifndef X_NOCV
    f32x2 wdw[31]; f32x2 bias;
    { int t0 = threadIdx.x; asm volatile("" : "+v"(t0)); const int c0 = (t0 & 255) * 2;
      const float* wp = p.in[I_WDW] + (size_t)i * 31 * 512 + c0; asm volatile("" : "+v"(wp));
#pragma unroll
      for (int j = 0; j < 31; ++j) { wdw[j] = *(const f32x2*)wp; wp += 512; asm volatile("" : "+v"(wp)); }
      bias = *(const f32x2*)(p.in[I_BDW] + i * 512 + c0); }
    for (int kq = 0; kq < 3; ++kq) {
        const int cu = kq < 2 ? bid + 256 * kq : ((bid & 1) ? N_CV : 512 + (bid >> 1));
        if (cu >= N_CV) continue;
        MIX_PRE
        {
            const int c2 = tid & 255, half = tid >> 8, c = c2 * 2; const bool prm = cu < 512;
            LAS float* ybuf = (LAS float*)lds;
            if (prm && ((cu & 127) * 32 + half * 16) >= 30) {
                const int b = cu >> 7, tb0 = (cu & 127) * 32 + half * 16;
                unsigned raw[46];
                { const bf16_t* gp = GLU + ((size_t)b * 4096 + tb0 - 30) * 512 + c; asm volatile("" : "+v"(gp));
#pragma unroll
                  for (int j = 0; j < 46; ++j) { raw[j] = *(const unsigned*)gp; gp += 512; asm volatile("" : "+v"(gp)); } }
                if (tb0 >= 4064) {
                    float* oc = p.out + O_CONVP + (((size_t)i * 4 + b) * 30) * 512 + c; asm volatile("" : "+v"(oc));
#pragma unroll
                    for (int j = 0; j < 16; ++j) { const int t = tb0 + j; if (t >= 4066) *(f32x2*)(oc + (size_t)(t - 4066) * 512) = (f32x2){bflo(raw[30 + j]), bfhi(raw[30 + j])}; }
                }
#pragma unroll
                for (int q = 0; q < 2; ++q) {
                    f32x2 win[38];
#pragma unroll
                    for (int j = 0; j < 38; ++j) win[j] = (f32x2){bflo(raw[q * 8 + j]), bfhi(raw[q * 8 + j])};
#pragma unroll
                    for (int t = 0; t < 8; ++t) {
                        f32x2 y = bias;
#pragma unroll
                        for (int j = 0; j < 31; ++j) y += wdw[j] * win[t + j];
                        *(LAS f32x2*)(ybuf + (half * 16 + q * 8 + t) * 512 + c) = y;
                    }
                    __builtin_amdgcn_sched_barrier(0);
                }
            } else if (prm) {
#pragma unroll 1
                for (int q = 0; q < 2; ++q) {
                    const int b = cu >> 7, tl = half * 16 + q * 8, tb = (cu & 127) * 32 + tl;
                    f32x2 win[38];
                    {
                        int vz; asm volatile("v_mov_b32 %0, 0" : "=v"(vz));
                        const bf16_t* gp = GLU + (size_t)b * 4096 * 512 + c; asm volatile("" : "+v"(gp));
#pragma unroll
                        for (int j = 0; j < 38; ++j) { const int tj = tb - 30 + j + vz; const unsigned w = *(const unsigned*)gp; if (tj >= 0) gp += 512; asm volatile("" : "+v"(gp));
                            win[j] = tj < 0 ? (f32x2){0.f, 0.f} : (f32x2){bflo(w), bfhi(w)}; }
                    }
#pragma unroll
                    for (int t = 0; t < 8; ++t) {
                        f32x2 y = bias;
#pragma unroll
                        for (int j = 0; j < 31; ++j) y += wdw[j] * win[t + j];
                        *(LAS f32x2*)(ybuf + (tl + t) * 512 + c) = y;
                    }
                }
            } else {
                const int sq = cu - 512;
                f32x2 win[34];
                const float* cc = p.in[I_CCONV] + (((size_t)i * 128 + sq) * 30 + half * 4) * 512 + c; asm volatile("" : "+v"(cc));
                const bf16_t* gs = GLU + ((size_t)MP + sq * 8) * 512 + c; asm volatile("" : "+v"(gs));
                float* oc = p.out + O_CONVS + (((size_t)i * 128 + sq) * 30 + half * 15) * 512 + c; asm volatile("" : "+v"(oc));
                if (half == 0) {
#pragma unroll
                    for (int j = 0; j < 30; ++j) { win[j] = *(const f32x2*)cc; cc += 512; asm volatile("" : "+v"(cc)); }
#pragma unroll
                    for (int j = 0; j < 4; ++j) { const unsigned w = *(const unsigned*)gs; gs += 512; asm volatile("" : "+v"(gs)); win[30 + j] = (f32x2){bflo(w), bfhi(w)}; }
#pragma unroll
                    for (int j = 0; j < 15; ++j) { *(f32x2*)oc = win[8 + j]; oc += 512; asm volatile("" : "+v"(oc)); }
                } else {
#pragma unroll
                    for (int j = 0; j < 26; ++j) { win[j] = *(const f32x2*)cc; cc += 512; asm volatile("" : "+v"(cc)); }
#pragma unroll
                    for (int j = 0; j < 8; ++j) { const unsigned w = *(const unsigned*)gs; gs += 512; asm volatile("" : "+v"(gs)); win[26 + j] = (f32x2){bflo(w), bfhi(w)}; }
#pragma unroll
                    for (int j = 0; j < 15; ++j) { *(f32x2*)oc = win[19 + j]; oc += 512; asm volatile("" : "+v"(oc)); }
                }
#pragma unroll
                for (int t = 0; t < 4; ++t) {
                    f32x2 y = bias;
#pragma unroll
                    for (int j = 0; j < 31; ++j) y += wdw[j] * win[t + j];
                    *(LAS f32x2*)(ybuf + (half * 4 + t) * 512 + c) = y;
                }
            }
            __syncthreads();
            {
                const float* gp = p.in[I_CNG] + i * 512 + lane * 8; const float* bp = p.in[I_CNB] + i * 512 + lane * 8;
                const f32x4 g0 = *(const f32x4*)gp, g1 = *(const f32x4*)(gp + 4), b0 = *(const f32x4*)bp, b1 = *(const f32x4*)(bp + 4);
#pragma unroll 1
                for (int q = 0; q < (prm ? 4 : 1); ++q) {
                    const int tk = prm ? wave * 4 + q : wave; const size_t row = prm ? (size_t)cu * 32 + tk : (size_t)MP + (size_t)(cu - 512) * 8 + tk;
                    const f32x4 v0 = *(const LAS f32x4*)(ybuf + tk * 512 + lane * 8), v1 = *(const LAS f32x4*)(ybuf + tk * 512 + lane * 8 + 4);
                    const float mean = wave_sum((v0[0] + v0[1]) + (v0[2] + v0[3]) + (v1[0] + v1[1]) + (v1[2] + v1[3])) * (1.0f / 512.0f);
                    const f32x4 d0 = v0 - mean, d1 = v1 - mean;
                    const float var = wave_sum((d0[0] * d0[0] + d0[1] * d0[1]) + (d0[2] * d0[2] + d0[3] * d0[3]) + (d1[0] * d1[0] + d1[1] * d1[1]) + (d1[2] * d1[2] + d1[3] * d1[3])) * (1.0f / 512.0f);
                    const float rs = rsqrtf(var + LN_EPS);
                    f32x4 o0 = d0 * rs * g0 + b0, o1 = d1 * rs * g1 + b1;
#pragma unroll
                    for (int j = 0; j < 4; ++j) { o0[j] = o0[j] * fast_sigmoid(o0[j]); o1[j] = o1[j] * fast_sigmoid(o1[j]); }
                    u32x4 w; w.x = cvt_pk_bf16(o0[0], o0[1]); w.y = cvt_pk_bf16(o0[2], o0[3]); w.z = cvt_pk_bf16(o1[0], o1[1]); w.w = cvt_pk_bf16(o1[2], o1[3]);
                    *(u32x4*)(CAT + row * DM + lane * 8) = w;
                }
            }
            __syncthreads();
        }
    }
#endif
    for (int s = (bid & 1) ? (bid >> 1) : N_SA; s < N_SA; s += N_SA) {
        MIX_PRE
        {
#ifndef X_NOSA
            LAS bf16_t* Ks = (LAS bf16_t*)lds; LAS bf16_t* Vt = (LAS bf16_t*)(lds + 2 * 144 * KS_STRIDE * 2);
            const int chunk = tid & 7;
            const f32x4 kn0 = *(const f32x4*)(kn + chunk * 8), kn1 = *(const f32x4*)(kn + chunk * 8 + 4);
#pragma unroll 1
            for (int it = tid; it < 2 * 144 * 8; it += 512) {
                const int kk = it >> 3, kh = kk / 144, key = kk % 144;
                float kf[8], vf[8];
#pragma unroll
                for (int j = 0; j < 8; ++j) { kf[j] = 0.f; vf[j] = 0.f; }
                const bool isnew = (key >= 128) && (key < 136);
                if (key < 128) {
                    const size_t off = ((((size_t)i * 128 + s) * 128 + key) * 2 + kh) * 64 + chunk * 8;
                    const f32x4 a0 = *(const f32x4*)(p.in[I_CK] + off), a1 = *(const f32x4*)(p.in[I_CK] + off + 4), c0 = *(const f32x4*)(p.in[I_CV] + off), c1 = *(const f32x4*)(p.in[I_CV] + off + 4);
#pragma unroll
                    for (int j = 0; j < 4; ++j) { kf[j] = a0[j]; kf[4 + j] = a1[j]; vf[j] = c0[j]; vf[4 + j] = c1[j]; }
                } else if (isnew) {
                    const bf16_t* rp = QKV + ((size_t)MP + s * 8 + (key - 128)) * 768 + 512 + kh * 64 + chunk * 8;
                    const u32x4 kr = *(const u32x4*)rp, vr = *(const u32x4*)(rp + 128);
#pragma unroll
                    for (int j = 0; j < 4; ++j) { kf[2 * j] = bflo(kr[j]); kf[2 * j + 1] = bfhi(kr[j]); vf[2 * j] = bflo(vr[j]); vf[2 * j + 1] = bfhi(vr[j]); }
                }
                float ss = 0.f;
#pragma unroll
                for (int j = 0; j < 8; ++j) ss += kf[j] * kf[j];
                ss += __shfl_xor(ss, 1); ss += __shfl_xor(ss, 2); ss += __shfl_xor(ss, 4);
                const float rk = rsqrtf(ss * (1.0f / 64.0f) + RMS_EPS);
                if (isnew) {
#pragma unroll
                    for (int j = 0; j < 4; ++j) { kf[j] *= rk * kn0[j]; kf[4 + j] *= rk * kn1[j]; }
                }
                u32x4 kw; kw.x = cvt_pk_bf16(kf[0], kf[1]); kw.y = cvt_pk_bf16(kf[2], kf[3]); kw.z = cvt_pk_bf16(kf[4], kf[5]); kw.w = cvt_pk_bf16(kf[6], kf[7]);
                *(LAS u32x4*)(Ks + (kh * 144 + key) * KS_STRIDE + chunk * 8) = kw;
                u32x4 vw; vw.x = cvt_pk_bf16(vf[0], vf[1]); vw.y = cvt_pk_bf16(vf[2], vf[3]); vw.z = cvt_pk_bf16(vf[4], vf[5]); vw.w = cvt_pk_bf16(vf[6], vf[7]);
#pragma unroll
                for (int j = 0; j < 4; ++j) { Vt[(kh * 64 + chunk * 8 + 2 * j) * VT_STRIDE + key] = (bf16_t)(vw[j] & 0xffffu); Vt[(kh * 64 + chunk * 8 + 2 * j + 1) * VT_STRIDE + key] = (bf16_t)(vw[j] >> 16); }
                if (key >= 8 && key < 136) {
                    const size_t oo = ((((size_t)i * 128 + s) * 128 + (key - 8)) * 2 + kh) * 64 + chunk * 8;
                    float* ko = p.out + O_KS + oo; float* vo = p.out + O_VS + oo;
                    *(f32x4*)ko = (f32x4){kf[0], kf[1], kf[2], kf[3]}; *(f32x4*)(ko + 4) = (f32x4){kf[4], kf[5], kf[6], kf[7]};
                    *(f32x4*)vo = (f32x4){vf[0], vf[1], vf[2], vf[3]}; *(f32x4*)(vo + 4) = (f32x4){vf[4], vf[5], vf[6], vf[7]};
                }
            }
            __syncthreads();
            {
                const int kh = wave >> 2, g = wave & 3, h = kh * 4 + g;
                const float slope = exp2f(-(float)(h + 1)), sink = sinks[h];
                const size_t row = (size_t)MP + s * 8 + (fr & 7);
                attn_item(Ks + kh * 144 * KS_STRIDE, Vt + kh * 64 * VT_STRIDE, 0, 0, false, fr < 8, QKV + row * 768 + h * 64 + fq * 8, qn, slope, sink, CAT + row * DM + 512 + h * 64 + 4 * fq, fr, fq);
            }
            __syncthreads();
#endif
        }
    }
}


__device__ __forceinline__ void splitk_reduce(float* Y, bf16_t* XB, ssq_t* ssq, const float* part, const pg8::StaticOrder& S, int KS) {
    int tid = threadIdx.x; asm volatile("" : "+v"(tid));
    const int wid = tid >> 6, lane = tid & 63, wr = wid >> 2, wc = wid & 3, fr = lane & 15, fq = lane >> 4;
    for (int task = blockIdx.x; task < 256; task += gridDim.x) {
        const int e = task >> 4, ai = (task >> 3) & 1, m = (task >> 1) & 3, bj = task & 1;
        pg8::Unit u; S.tile(256 + e, u);
        const float* pp = part + (size_t)(e * KS) * 65536 + (size_t)((((ai * 4 + m) * 2 + bj) * 2) * 2048) + (size_t)tid * 4;
        f32x4 a0 = (f32x4){0.f, 0.f, 0.f, 0.f}, a1 = a0;
        for (int k = 0; k < KS; ++k) { a0 += *(const f32x4*)(pp + (size_t)k * 65536); a1 += *(const f32x4*)(pp + (size_t)k * 65536 + 2048); }
        const int r = u.pm * 256 + ai * 128 + wr * 64 + m * 16 + fr, col = u.pn * 256 + bj * 128 + wc * 32 + 8 * fq;
        bf16_t* bp = XB + (size_t)r * DM + col;
        f32x4 x0, x1; bf8_to_f32(*(const u32x4*)bp, x0, x1);
        const f32x4 v0 = x0 + a0, v1 = x1 + a1;
        if (Y) { float* yp = Y + (size_t)r * DM + col; *(f32x4*)yp = v0; *(f32x4*)(yp + 4) = v1; continue; }
        u32x4 w; w.x = cvt_pk_bf16(v0[0], v0[1]); w.y = cvt_pk_bf16(v0[2], v0[3]); w.z = cvt_pk_bf16(v1[0], v1[1]); w.w = cvt_pk_bf16(v1[2], v1[3]);
        *(u32x4*)bp = w;
        float ss = (v0[0] * v0[0] + v0[1] * v0[1]) + (v0[2] * v0[2] + v0[3] * v0[3]) + (v1[0] * v1[0] + v1[1] * v1[1]) + (v1[2] * v1[2] + v1[3] * v1[3]);
        ss += __shfl_xor(ss, 16); ss += __shfl_xor(ss, 32);
        if (fq == 0) ssq_add(ssq + r, ss);
    }
}

#define XB_TMO      128
#define XB_XCNT(j)  (256  + 64 * (j))
#define XB_XSUB(j)  (1280 + 64 * (j))
#define XB_XGEN(j)  (2304 + 64 * (j))
#define XB_TOP      3328
#define XB_TOPGEN   3392
#define XCD_BAR_WORDS 3456
#define XB_SPIN_CAP (1u << 22)
__device__ __forceinline__ unsigned xb_ld(unsigned* p)              { return __hip_atomic_load(p, __ATOMIC_RELAXED, __HIP_MEMORY_SCOPE_AGENT); }
__device__ __forceinline__ unsigned xb_add(unsigned* p, unsigned v) { return __hip_atomic_fetch_add(p, v, __ATOMIC_RELAXED, __HIP_MEMORY_SCOPE_AGENT); }
__device__ __forceinline__ unsigned xb_xcc_id() { return (unsigned)__builtin_amdgcn_s_getreg((3 << 11) | 20) & 0xFu; }
#define XB_SPIN(cond, bar) do { unsigned _sp = 0; while (cond) { __builtin_amdgcn_s_sleep(1); \
    if ((++_sp & 255u) == 0u) { if (xb_ld(&(bar)[XB_TMO])) break; if (_sp > XB_SPIN_CAP) { atomicAdd(&(bar)[XB_TMO], 1u); break; } } } } while (0)
struct XcdBarrier { unsigned* bar; unsigned x; volatile LAS unsigned* st; };
__device__ __forceinline__ XcdBarrier xcd_barrier_post(unsigned* bar, volatile LAS unsigned* st) {
    XcdBarrier b; b.bar = bar; b.x = xb_xcc_id(); b.st = st;
    if (threadIdx.x == 0) st[2] = xb_add(&bar[XB_XCNT(b.x)], 1u);
    return b;
}
__device__ __forceinline__ void xcd_barrier_complete(unsigned* bar, unsigned x, unsigned& nloc, unsigned& nx) {
    const unsigned G = gridDim.x * gridDim.y * gridDim.z;
    unsigned sum, cnt, mine, sp = 0u;
    for (;;) {
        sum = 0u; cnt = 0u; mine = 0u;
#pragma unroll
        for (unsigned j = 0; j < 16; ++j) { const unsigned c = xb_ld(&bar[XB_XCNT(j)]); sum += c; cnt += (c > 0u) ? 1u : 0u; mine = (j == x) ? c : mine; }
        if (sum == G) break;
        __builtin_amdgcn_s_sleep(1);
        if ((++sp & 255u) == 0u) { if (xb_ld(&bar[XB_TMO])) break; if (sp > XB_SPIN_CAP) { atomicAdd(&bar[XB_TMO], 1u); break; } }
    }
    nloc = mine > 0u ? mine : 1u; nx = cnt > 0u ? cnt : 1u;
}
__device__ __forceinline__ void xcd_barrier(const XcdBarrier& b) {
    asm volatile("s_waitcnt vmcnt(0)" ::: "memory");
    __syncthreads();
    if (threadIdx.x == 0) {
        unsigned* bar = b.bar;
        __builtin_amdgcn_s_waitcnt(0);
        unsigned nloc = b.st[0], nx = b.st[1];
        if (nloc == 0u) { xcd_barrier_complete(bar, b.x, nloc, nx); b.st[0] = nloc; b.st[1] = nx; }
        const unsigned old = xb_add(&bar[XB_XSUB(b.x)], 1u);
        const unsigned gen = old / nloc;
        if (old + 1u == (gen + 1u) * nloc) {
            __builtin_amdgcn_fence(__ATOMIC_RELEASE, "agent");
            asm volatile("s_waitcnt vmcnt(0)" ::: "memory");
            const unsigned og = xb_add(&bar[XB_TOP], 1u);
            const unsigned tg = og / nx;
            if (og + 1u == (tg + 1u) * nx) xb_add(&bar[XB_TOPGEN], 1u);
            else XB_SPIN(xb_ld(&bar[XB_TOPGEN]) == tg, bar);
            __builtin_amdgcn_fence(__ATOMIC_ACQUIRE, "agent");
            xb_add(&bar[XB_XGEN(b.x)], 1u);
            asm volatile("s_waitcnt vmcnt(0)" ::: "memory");
        } else {
            XB_SPIN(xb_ld(&bar[XB_XGEN(b.x)]) == gen, bar);
            __builtin_amdgcn_fence(__ATOMIC_ACQUIRE, "agent");
            asm volatile("s_waitcnt vmcnt(0)" ::: "memory");
        }
    }
    __syncthreads();
}

__global__ void __launch_bounds__(512, 2) fwd_megakernel(Params p) {
    extern __shared__ __attribute__((aligned(16))) unsigned char lds_raw[];
    LAS unsigned char* lds = (LAS unsigned char*)lds_raw;
    cg::grid_group grid = cg::this_grid();
    const int G = gridDim.x, bid = blockIdx.x;
    bf16_t* XB = (bf16_t*)(p.ws + WS_XB); ssq_t* SSQ = (ssq_t*)(p.ws + WS_SSQ); float* PART = (float*)(p.ws + WS_PART);
#define IN(k) (p.ph_lo <= (k) && (k) < p.ph_hi)
#define SYNC(k) do { if (p.ph_hi > (k) + 1) xcd_barrier(bar); } while (0)
    unsigned* barw = (unsigned*)(p.ws + WS_BAR);
    volatile LAS unsigned* bst = (volatile LAS unsigned*)(lds + 131072);
    if (threadIdx.x < 4) bst[threadIdx.x] = 0u;
    __syncthreads();
    XcdBarrier bar = xcd_barrier_post(barw, bst);
#ifndef X_NOPREP
    if (IN(0)) prep_phase(p, lds);
    if (p.ph_lo < 0) grid.sync();
    xcd_barrier(bar);
    for (int rep = 0; rep < DUP_SYNC; ++rep) xcd_barrier(bar);
    int vbid = bid, cbid = bid;
    { bool okc = (G == 256);
#pragma unroll
      for (int j = 0; j < 16; ++j) { const unsigned cj = xb_ld(&barw[XB_XCNT(j)]); okc = okc && (cj == (j < 8 ? 32u : 0u)); }
      if (okc) { vbid = (int)(bar.x + 8u * bst[2]); cbid = (int)(bar.x * 32u + bst[2]); } }
#endif
#pragma unroll 1
    for (int l = 0; l < 4; ++l) {
        const int pb = 1 + 5 * l, i = l >> 1;
        ssq_t* ssq_in = SSQ + (size_t)(2 * l) * MT;
        ssq_t* ssq_mid = SSQ + (size_t)(2 * l + 1) * MT;
        ssq_t* ssq_out = SSQ + (size_t)(2 * l + 2) * MT;
        if ((l & 1) == 0) {
            if (IN(pb) && X_GIN) {
                pg8::Gemm g{XB, (const bf16_t*)(p.ws + WS_WIN) + (size_t)i * DIN * DM, MT, DIN, DM}; pg8::StaticOrder S; S.init(MT, DIN, DM, G, vbid);
                EpiIn E{ssq_in, (bf16_t*)(p.ws + WS_GLU), (bf16_t*)(p.ws + WS_QKV)};
                for (int rep = 0; rep <= DUP_IN; ++rep) { pg8::gemm_phase(lds, g, S, E); SYNC(pb); }
            }
#ifndef X_NOMIX
            if (IN(pb + 1)) { for (int rep = 0; rep <= DUP_MIX; ++rep) { mixer_phase(p, l, lds, cbid); SYNC(pb + 1); } }
#endif
            if (IN(pb + 2) && X_GOUT) {
                pg8::Gemm g{(const bf16_t*)(p.ws + WS_CAT), (const bf16_t*)(p.ws + WS_WOUT) + (size_t)i * DM * DM, MT, DM, DM}; pg8::SplitOrder<false> S; S.init2(MT, DM, DM, G, vbid, 4);
                EpiRes<false> E{nullptr, XB, ssq_mid, nullptr, PART};
                pg8::gemm_phase(lds, g, S, E);
                xcd_barrier(bar);
                splitk_reduce(nullptr, XB, ssq_mid, PART, S, 4);
                SYNC(pb + 2);
            }
        } else {
#ifndef X_NOPOOL1
            if (IN(pb)) { for (int rep = 0; rep <= DUP_POOL1; ++rep) { pool1_phase(p, l, ssq_in, cbid); SYNC(pb); } }
#endif
            if (IN(pb + 1) && X_GPOOL) {
                pg8::Gemm g{(const bf16_t*)(p.ws + WS_DG), (const bf16_t*)(p.ws + WS_WPL) + (size_t)i * 4 * 65536, 4 * MT, 256, 256}; pg8::PoolOrder S{G, vbid};
                EpiRes<true> E{nullptr, XB, ssq_mid, p.in[I_PSCALE] + i * DM, PART};
                pg8::gemm_phase(lds, g, S, E);
                SYNC(pb + 2);
            }
        }
        if (IN(pb + 3) && X_GGU) {
            pg8::Gemm g{XB, (const bf16_t*)(p.ws + WS_WGU) + (size_t)l * 2 * DFF * DM, MT, 2 * DFF, DM}; pg8::StaticOrder S; S.init(MT, 2 * DFF, DM, G, vbid);
            EpiGU E{ssq_mid, (bf16_t*)(p.ws + WS_ACT)};
            for (int rep = 0; rep <= DUP_GU; ++rep) { pg8::gemm_phase(lds, g, S, E); SYNC(pb + 3); }
        }
        if (IN(pb + 4) && X_GDN) {
            pg8::Gemm g{(const bf16_t*)(p.ws + WS_ACT), (const bf16_t*)(p.ws + WS_WDN) + (size_t)l * DM * DFF, MT, DM, DFF}; pg8::SplitOrder<true> S; S.init2(MT, DM, DFF, G, vbid, 11);
            float* Yout = (l == 3) ? p.out : nullptr;
            EpiRes<false> E{Yout, XB, ssq_out, nullptr, PART};
            pg8::gemm_phase(lds, g, S, E);
            xcd_barrier(bar);
            splitk_reduce(Yout, XB, ssq_out, PART, S, 11);
            SYNC(pb + 4);
        }
    }
#undef IN
#undef SYNC
}

extern "C" void kernel_launch(void* const* d_in, const int* in_sizes, int n_in, void* d_out, int out_size, void* d_ws, size_t ws_size, hipStream_t stream) {
    static int grid_blocks = 0;
    if (grid_blocks == 0) {
        if (n_in != N_IN || ws_size < WS_END) { fprintf(stderr, "kernel_launch: unexpected n_in %d or ws_size %zu (< %zu)\n", n_in, ws_size, (size_t)WS_END); grid_blocks = -1; return; }
        int dev = 0, cus = 0, per_cu = 0;
        hipGetDevice(&dev);
        hipDeviceGetAttribute(&cus, hipDeviceAttributeMultiprocessorCount, dev);
        hipFuncSetAttribute((const void*)fwd_megakernel, hipFuncAttributeMaxDynamicSharedMemorySize, LDS_BYTES);
        hipOccupancyMaxActiveBlocksPerMultiprocessor(&per_cu, (const void*)fwd_megakernel, 512, LDS_BYTES);
        if (per_cu < 1) { fprintf(stderr, "kernel_launch: occupancy query reports %d blocks per CU\n", per_cu); per_cu = 1; }
        grid_blocks = cus * 1;
    }
    if (grid_blocks < 0) return;
    Params p{};
    for (int k = 0; k < N_IN; ++k) p.in[k] = (const float*)d_in[k];
    p.out = (float*)d_out; p.ws = (unsigned char*)d_ws; p.ph_lo = 0; p.ph_hi = N_PHASES;
    void* args[] = {&p};
    if (hipMemsetAsync((unsigned char*)d_ws + WS_BAR, 0, 16384, stream) != hipSuccess) { fprintf(stderr, "kernel_launch: memset of the barrier words failed\n"); return; }
    hipError_t e = hipLaunchCooperativeKernel((const void*)fwd_megakernel, dim3(grid_blocks), dim3(512), args, LDS_BYTES, stream);
    if (e != hipSuccess) fprintf(stderr, "cooperative launch failed: %s (grid %d)\n", hipGetErrorString(e), grid_blocks);
}
```

```cpp
#include <hip/hip_runtime.h>
#include <hip/hip_cooperative_groups.h>
#include <cstdio>
namespace cg = cooperative_groups;

#define LAS __attribute__((address_space(3)))
#ifndef DUP_PREP
#define DUP_PREP 0
#define DUP_IN 0
#define DUP_MIX 0
#define DUP_POOL1 0
#define DUP_GU 0
#define DUP_SYNC 0
#define DUP_DN 0
#endif
#ifndef X_GIN
#define X_GIN 1
#define X_GOUT 1
#define X_GPOOL 1
#define X_GGU 1
#define X_GDN 1
#endif
typedef unsigned short bf16_t;
typedef short bf16x8 __attribute__((ext_vector_type(8)));
typedef float f32x4 __attribute__((ext_vector_type(4)));
typedef unsigned u32x4 __attribute__((ext_vector_type(4)));
typedef unsigned u32x2 __attribute__((ext_vector_type(2)));
typedef float f32x2 __attribute__((ext_vector_type(2)));
typedef unsigned long long ssq_t;

constexpr int DM = 1024, MP = 16384, MS = 1024, MT = 17408, NTM = 68, DFF = 2816, DIN = 1792;
constexpr float RMS_EPS = 1e-6f, LN_EPS = 1e-5f;
enum { I_XP = 0, I_XS, I_CCONV, I_CK, I_CV, I_SPOOL, I_NMIX, I_NFFN, I_WIN, I_QN, I_KN, I_SINK, I_WDW, I_BDW, I_CNG, I_CNB, I_WOUT, I_WPOOL, I_PSCALE, I_WG, I_WU, I_WD, N_IN };
constexpr size_t O_Y = 0;
constexpr size_t O_CONVP = (size_t)MT * DM;
constexpr size_t O_KP = O_CONVP + 2 * 4 * 30 * 512;
constexpr size_t O_VP = O_KP + 2 * 4 * 128 * 128;
constexpr size_t O_POOLP = O_VP + 2 * 4 * 128 * 128;
constexpr size_t O_CONVS = O_POOLP + 2 * 4 * 15 * 1024;
constexpr size_t O_KS = O_CONVS + (size_t)2 * 128 * 30 * 512;
constexpr size_t O_VS = O_KS + (size_t)2 * 128 * 128 * 128;
constexpr size_t O_POOLS = O_VS + (size_t)2 * 128 * 128 * 128;
constexpr size_t WS_WIN = 0;
constexpr size_t WS_WOUT = WS_WIN + (size_t)2 * DIN * DM * 2;
constexpr size_t WS_WGU = WS_WOUT + (size_t)2 * DM * DM * 2;
constexpr size_t WS_WDN = WS_WGU + (size_t)4 * 2 * DFF * DM * 2;
constexpr size_t WS_WPL = WS_WDN + (size_t)4 * DM * DFF * 2;
constexpr size_t WS_XB = WS_WPL + (size_t)2 * 4 * 256 * 256 * 2;
constexpr size_t WS_SSQ = WS_XB + (size_t)MT * DM * 2;
constexpr size_t WS_ACT = WS_SSQ + (size_t)9 * MT * 8;
constexpr size_t WS_QKV = WS_ACT;
constexpr size_t WS_GLU = WS_QKV + (size_t)MT * 768 * 2;
constexpr size_t WS_CAT = WS_GLU + (size_t)MT * 512 * 2;
constexpr size_t WS_DG = WS_ACT;
constexpr size_t WS_BAR = WS_ACT + (size_t)MT * DFF * 2;
constexpr size_t WS_PART = WS_BAR + 16384;
constexpr size_t WS_END = WS_PART + (size_t)176 * 65536 * 4;
constexpr int LDS_BYTES = 131072 + 16;
constexpr int N_PHASES = 21;

struct Params { const float* in[N_IN]; float* out; unsigned char* ws; int ph_lo, ph_hi; };

__device__ __forceinline__ unsigned cvt_pk_bf16(float lo, float hi) { unsigned r; asm("v_cvt_pk_bf16_f32 %0, %1, %2" : "=v"(r) : "v"(lo), "v"(hi)); return r; }
__device__ __forceinline__ float bflo(unsigned w) { return __uint_as_float(w << 16); }
__device__ __forceinline__ float bfhi(unsigned w) { return __uint_as_float(w & 0xffff0000u); }
__device__ __forceinline__ float bf2f(bf16_t b) { return __uint_as_float(((unsigned)b) << 16); }
__device__ __forceinline__ float wave_sum(float v) {
#pragma unroll
    for (int o = 32; o >= 1; o >>= 1) v += __shfl_xor(v, o);
    return v;
}
__device__ __forceinline__ float ssq_rs(ssq_t v) { return rsqrtf((float)v * (1.0f / (1048576.0f * 1024.0f)) + RMS_EPS); }
__device__ __forceinline__ ssq_t ssq_fix(float ss) { return (ssq_t)(ss * 1048576.0f); }
__device__ __forceinline__ void ssq_add(ssq_t* p, float ss) { (void)__hip_atomic_fetch_add(p, ssq_fix(ss), __ATOMIC_RELAXED, __HIP_MEMORY_SCOPE_AGENT); }
__device__ __forceinline__ float fast_sigmoid(float x) { return __builtin_amdgcn_rcpf(1.0f + __expf(-x)); }
__device__ __forceinline__ f32x2 pk_exp2(f32x2 v) { f32x2 r; r.x = __builtin_amdgcn_exp2f(v.x); r.y = __builtin_amdgcn_exp2f(v.y); return r; }
__device__ __forceinline__ f32x2 pk_rcp(f32x2 v) { f32x2 r; r.x = __builtin_amdgcn_rcpf(v.x); r.y = __builtin_amdgcn_rcpf(v.y); return r; }
__device__ __forceinline__ f32x2 pk_sig(f32x2 g, float k2) { return pk_rcp(pk_exp2(g * k2) + 1.0f); }

namespace pg8 {
constexpr int BM = 256, BK = 64, HALF = 128, HTB = HALF * BK * 2, STAGE_BYTES = 8 * HTB, NXCD = 8, WGM = 8;
__host__ __device__ __forceinline__ int lds_byte(int r, int c) { const int st = (r >> 4) * 2 + (c >> 5), rr = r & 15, cc = c & 31, ob = rr * 64 + cc * 2; return st * 1024 + (ob ^ (((ob >> 9) & 1) << 5)); }
__host__ __device__ __forceinline__ void stage_rc(int b, int& R, int& C) { const int st = b / 1024, sb = b % 1024, swz = sb ^ (((sb >> 9) & 1) << 5); R = (st >> 1) * 16 + swz / 64; C = (st & 1) * 32 + (swz % 64) / 2; }
__host__ __device__ __forceinline__ int perm32(int rho) { const int n = rho >> 4, i = rho & 15; return 8 * (i >> 2) + 4 * n + (i & 3); }
struct Unit { int pm, pn, k0, nt, part; };
struct Gemm { const bf16_t* A; const bf16_t* Bt; int M, N, K; };
struct StaticOrder {
    static constexpr bool SPLIT = false, ABLK = false;
    int nM, nN, nwg, G, c, ntk;
    __device__ void init(int M, int N, int K, int G_, int c_) { nM = M / BM; nN = N / BM; nwg = nM * nN; G = G_; c = c_; ntk = K / BK; }
    __device__ void tile(int L, Unit& u) const {
        int wgid = L; { const int q = nwg / NXCD, r = nwg % NXCD, xcd = wgid % NXCD, off = wgid / NXCD; wgid = (xcd < r ? xcd * (q + 1) : r * (q + 1) + (xcd - r) * q) + off; }
        const int nig = WGM * nN, gid = wgid / nig, fm = gid * WGM, gsz = (nM - fm) < WGM ? (nM - fm) : WGM;
        u.pm = fm + ((wgid % nig) % gsz); u.pn = (wgid % nig) / gsz;
    }
    __device__ bool next(int i, Unit& u) const {
        const long L = (long)i * G + c; if (L >= nwg) return false;
        tile((int)L, u); u.k0 = 0; u.nt = ntk; u.part = -1; return true;
    }
};
template <bool ABLK_> struct SplitOrder : StaticOrder {
    static constexpr bool SPLIT = true, ABLK = ABLK_;
    int KS, ntp;
    __device__ void init2(int M, int N, int K, int G_, int c_, int KS_) { init(M, N, K, G_, c_); KS = KS_; ntp = ntk / KS_; }
    __device__ bool next(int i, Unit& u) const {
        const int np = (nwg - G) * KS;
        int j = i;
        if (c < np) { if (i == 0) { tile(G + c / KS, u); u.k0 = (c % KS) * ntp; u.nt = ntp; u.part = c; return true; } j = i - 1; }
        if (j > 0) return false;
        tile(c, u); u.k0 = 0; u.nt = ntk; u.part = -1; return true;
    }
};
struct PoolOrder {
    static constexpr bool SPLIT = false, ABLK = false;
    int G, c;
    __device__ bool next(int i, Unit& u) const { const int L = i * G + c; if (L >= 4 * NTM) return false; u.pm = L; u.pn = L / NTM; u.k0 = 0; u.nt = 4; u.part = -1; return true; }
};

template <class Epi, class Sched>
__device__ __forceinline__ void gemm_phase(LAS unsigned char* lds, const Gemm g, const Sched& S, const Epi& E) {
    int tid = threadIdx.x; asm volatile("" : "+v"(tid));
    const int wid = __builtin_amdgcn_readfirstlane(tid >> 6), lane = tid & 63, wr = wid >> 2, wc = wid & 3, fr = lane & 15, fq = lane >> 4;
    int K = g.K; asm volatile("" : "+s"(K));
    unsigned voffA[2], voffB[2];
#pragma unroll
    for (int i = 0; i < 2; ++i) { int R, C; stage_rc(tid * 16 + i * 8192, R, C); const int Rb = (R & ~31) + perm32(R & 31);
        voffA[i] = Sched::ABLK ? (unsigned)(R * 64 + C) * 2u : (unsigned)(R * K + C) * 2u; voffB[i] = (unsigned)(Rb * K + C) * 2u; }
    const size_t kstep = (size_t)(BK * 2);
    const size_t hstep = (size_t)HALF * K * 2;
    const size_t tstep = 2 * hstep;
    const size_t kstepA = Sched::ABLK ? (size_t)32768 : kstep, hstepA = Sched::ABLK ? (size_t)16384 : hstep;
    const unsigned ldsw = (unsigned)wid * 1024u;
    const int aoff = lds_byte(wr * 64 + fr, fq * 8), boff = lds_byte(wc * 32 + fr, fq * 8);
#define PG8_SA(b, h) (((b) * 2 + (h)) * HTB)
#define PG8_SB(b, h) ((4 + (b) * 2 + (h)) * HTB)
#define PG8_STAGE(bufoff, gbase, voff) do { _Pragma("unroll") for (int _i = 0; _i < 2; ++_i) \
        __builtin_amdgcn_global_load_lds((const unsigned*)((const char*)(gbase) + (voff)[_i]), (LAS unsigned*)(lds + (bufoff) + ldsw + _i * 8192), 16, 0, 0); } while (0)
#define PG8_LDA(dst, b, h) do { _Pragma("unroll") for (int m = 0; m < 4; ++m) _Pragma("unroll") for (int k = 0; k < 2; ++k) dst[m][k] = *(const LAS bf16x8*)(lds + PG8_SA(b, h) + aoff + m * 2048 + k * 1024); } while (0)
#define PG8_LDB(dst, b, h) do { _Pragma("unroll") for (int n = 0; n < 2; ++n) _Pragma("unroll") for (int k = 0; k < 2; ++k) dst[n][k] = *(const LAS bf16x8*)(lds + PG8_SB(b, h) + boff + n * 2048 + k * 1024); } while (0)
#define PG8_MMA(ai, bj, At, Bt) do { __builtin_amdgcn_s_setprio(1); _Pragma("unroll") for (int m = 0; m < 4; ++m) _Pragma("unroll") for (int n = 0; n < 2; ++n) _Pragma("unroll") for (int k = 0; k < 2; ++k) \
        acc[ai][bj][m][n] = __builtin_amdgcn_mfma_f32_16x16x32_bf16(Bt[n][k], At[m][k], acc[ai][bj][m][n], 0, 0, 0); __builtin_amdgcn_s_setprio(0); } while (0)
#define PG8_WAIT_V(n) asm volatile("s_waitcnt vmcnt(" #n ")" ::: "memory")
#define PG8_WAIT_L(n) asm volatile("s_waitcnt lgkmcnt(" #n ")" ::: "memory")
#define PG8_BAR __builtin_amdgcn_s_barrier()
#define PG8_SCHED __builtin_amdgcn_sched_barrier(0)
    Unit cur, nxt; int ui = 0;
    if (!S.next(0, cur)) return;
    f32x4 acc[2][2][4][2];
    E.init(acc, cur, wr, wc, fr, fq);
    bf16x8 At[4][2], B0[2][2], B1[2][2];
    const char* cA = (const char*)g.A + (size_t)cur.pm * tstep; const char* cB = (const char*)g.Bt + (size_t)cur.pn * tstep;
    if constexpr (Sched::SPLIT) { cA += (size_t)cur.k0 * kstepA; cB += (size_t)cur.k0 * kstep; }
    const int ntc = K / BK;
    PG8_STAGE(PG8_SB(0, 0), cB, voffB); PG8_STAGE(PG8_SA(0, 0), cA, voffA); PG8_STAGE(PG8_SB(0, 1), cB + hstep, voffB); PG8_STAGE(PG8_SA(0, 1), cA + hstepA, voffA);
    if (wr == 1) PG8_BAR;
    PG8_WAIT_V(4); PG8_BAR;
    PG8_STAGE(PG8_SB(1, 0), cB + kstep, voffB); PG8_STAGE(PG8_SA(1, 0), cA + kstepA, voffA); PG8_STAGE(PG8_SB(1, 1), cB + hstep + kstep, voffB);
    PG8_WAIT_V(6); PG8_BAR;
    for (;;) {
        const bool has_next = S.next(ui + 1, nxt);
        const char* nA = has_next ? (const char*)g.A + (size_t)nxt.pm * tstep : cA; const char* nB = has_next ? (const char*)g.Bt + (size_t)nxt.pn * tstep : cB;
        if constexpr (Sched::SPLIT) { if (has_next) { nA += (size_t)nxt.k0 * kstepA; nB += (size_t)nxt.k0 * kstep; } }
        const int nt = Sched::SPLIT ? cur.nt : ntc;
        for (int t = 0; t < nt; t += 2) {
            const bool last = (t == nt - 2);
            const char* a1 = cA + (size_t)(t + 1) * kstepA;
            const char* a2 = last ? nA : cA + (size_t)(t + 2) * kstepA; const char* b2 = last ? nB : cB + (size_t)(t + 2) * kstep;
            const char* a3 = a2 + kstepA; const char* b3 = b2 + kstep;
            PG8_LDB(B0, 0, 0); PG8_SCHED; PG8_LDA(At, 0, 0); PG8_STAGE(PG8_SA(1, 1), a1 + hstepA, voffA);
            PG8_WAIT_L(8); PG8_BAR; PG8_WAIT_L(0); PG8_MMA(0, 0, At, B0); PG8_BAR; PG8_SCHED;
            PG8_LDB(B1, 0, 1); PG8_STAGE(PG8_SB(0, 0), b2, voffB);
            PG8_BAR; PG8_WAIT_L(0); PG8_MMA(0, 1, At, B1); PG8_BAR;
            PG8_LDA(At, 0, 1); PG8_STAGE(PG8_SA(0, 0), a2, voffA);
            PG8_BAR; PG8_WAIT_L(0); PG8_MMA(1, 0, At, B0); PG8_BAR; PG8_SCHED;
            PG8_STAGE(PG8_SB(0, 1), b2 + hstep, voffB);
            PG8_WAIT_V(6); PG8_BAR; PG8_MMA(1, 1, At, B1); PG8_BAR;
            PG8_LDB(B0, 1, 0); PG8_SCHED; PG8_LDA(At, 1, 0); PG8_STAGE(PG8_SA(0, 1), a2 + hstepA, voffA);
            PG8_WAIT_L(8); PG8_BAR; PG8_WAIT_L(0); PG8_MMA(0, 0, At, B0); PG8_BAR; PG8_SCHED;
            PG8_LDB(B1, 1, 1); PG8_STAGE(PG8_SB(1, 0), b3, voffB);
            PG8_BAR; PG8_WAIT_L(0); PG8_MMA(0, 1, At, B1); PG8_BAR;
            PG8_LDA(At, 1, 1); PG8_STAGE(PG8_SA(1, 0), a3, voffA);
            PG8_BAR; PG8_WAIT_L(0); PG8_MMA(1, 0, At, B0); PG8_BAR; PG8_SCHED;
            PG8_STAGE(PG8_SB(1, 1), b3 + hstep, voffB);
            PG8_WAIT_V(6); PG8_BAR; PG8_MMA(1, 1, At, B1); PG8_BAR;
        }
        E(acc, cur, wr, wc, fr, fq);
        if (!has_next) break;
        E.init(acc, nxt, wr, wc, fr, fq);
        cur = nxt; cA = nA; cB = nB; ++ui;
    }
    PG8_WAIT_V(0);
    if (wr == 0) PG8_BAR;
    PG8_BAR;
#undef PG8_SA
#undef PG8_SB
#undef PG8_STAGE
#undef PG8_LDA
#undef PG8_LDB
#undef PG8_MMA
#undef PG8_WAIT_V
#undef PG8_WAIT_L
#undef PG8_BAR
#undef PG8_SCHED
}
}

__device__ __forceinline__ void acc_zero(f32x4 (&acc)[2][2][4][2]) {
#pragma unroll
    for (int a = 0; a < 2; ++a)
#pragma unroll
        for (int b = 0; b < 2; ++b)
#pragma unroll
            for (int m = 0; m < 4; ++m)
#pragma unroll
                for (int n = 0; n < 2; ++n) acc[a][b][m][n] = (f32x4){0.f, 0.f, 0.f, 0.f};
}
struct EpiIn {
    const ssq_t* ssq; bf16_t* glu; bf16_t* qkv;
    __device__ __forceinline__ void init(f32x4 (&acc)[2][2][4][2], const pg8::Unit&, int, int, int, int) const { acc_zero(acc); }
    __device__ __forceinline__ void operator()(const f32x4 (&acc)[2][2][4][2], const pg8::Unit& u, int wr, int wc, int fr, int fq) const {
        const int row0 = u.pm * 256 + wr * 64 + fr;
        if (u.pn < 4) {
            const int col0 = u.pn * 128 + wc * 32 + 8 * fq;
#pragma unroll
            for (int ai = 0; ai < 2; ++ai)
#pragma unroll
                for (int m = 0; m < 4; ++m) {
                    const int r = row0 + ai * 128 + m * 16;
                    const float rs = ssq_rs(ssq[r]);
                    const float k2 = rs * -1.4426950408889634f;
                    f32x2 o[4];
#pragma unroll
                    for (int n = 0; n < 2; ++n)
#pragma unroll
                        for (int h = 0; h < 2; ++h) {
                            const f32x2 a = (f32x2){acc[ai][0][m][n][2 * h], acc[ai][0][m][n][2 * h + 1]}, gt = (f32x2){acc[ai][1][m][n][2 * h], acc[ai][1][m][n][2 * h + 1]};
                            o[n * 2 + h] = (a * rs) * pk_sig(gt, k2);
                        }
                    u32x4 w; w.x = cvt_pk_bf16(o[0].x, o[0].y); w.y = cvt_pk_bf16(o[1].x, o[1].y); w.z = cvt_pk_bf16(o[2].x, o[2].y); w.w = cvt_pk_bf16(o[3].x, o[3].y);
                    *(u32x4*)(glu + (size_t)r * 512 + col0) = w;
                }
        } else {
            const int col0 = (u.pn - 4) * 256 + wc * 32 + 8 * fq;
#pragma unroll
            for (int ai = 0; ai < 2; ++ai)
#pragma unroll
                for (int m = 0; m < 4; ++m) {
                    const int r = row0 + ai * 128 + m * 16;
                    const float rs = ssq_rs(ssq[r]);
#pragma unroll
                    for (int bj = 0; bj < 2; ++bj) {
                        const f32x4 v0 = acc[ai][bj][m][0] * rs, v1 = acc[ai][bj][m][1] * rs;
                        u32x4 w; w.x = cvt_pk_bf16(v0[0], v0[1]); w.y = cvt_pk_bf16(v0[2], v0[3]); w.z = cvt_pk_bf16(v1[0], v1[1]); w.w = cvt_pk_bf16(v1[2], v1[3]);
                        *(u32x4*)(qkv + (size_t)r * 768 + col0 + bj * 128) = w;
                    }
                }
        }
    }
};
struct EpiGU {
    const ssq_t* ssq; bf16_t* act;
    __device__ __forceinline__ void init(f32x4 (&acc)[2][2][4][2], const pg8::Unit&, int, int, int, int) const { acc_zero(acc); }
    __device__ __forceinline__ void operator()(const f32x4 (&acc)[2][2][4][2], const pg8::Unit& u, int wr, int wc, int fr, int fq) const {
        const int row0 = u.pm * 256 + wr * 64 + fr, col0 = u.pn * 128 + wc * 32 + 8 * fq;
#pragma unroll
        for (int ai = 0; ai < 2; ++ai)
#pragma unroll
            for (int m = 0; m < 4; ++m) {
                const int r = row0 + ai * 128 + m * 16;
                const float rs = ssq_rs(ssq[r]);
                const float k2 = rs * -1.4426950408889634f, rs2 = rs * rs;
                f32x2 o[4];
#pragma unroll
                for (int n = 0; n < 2; ++n)
#pragma unroll
                    for (int h = 0; h < 2; ++h) {
                        const f32x2 gt = (f32x2){acc[ai][0][m][n][2 * h], acc[ai][0][m][n][2 * h + 1]}, up = (f32x2){acc[ai][1][m][n][2 * h], acc[ai][1][m][n][2 * h + 1]};
                        o[n * 2 + h] = (gt * up) * rs2 * pk_sig(gt, k2);
                    }
                u32x4 w; w.x = cvt_pk_bf16(o[0].x, o[0].y); w.y = cvt_pk_bf16(o[1].x, o[1].y); w.z = cvt_pk_bf16(o[2].x, o[2].y); w.w = cvt_pk_bf16(o[3].x, o[3].y);
                *(u32x4*)(act + (size_t)(r >> 8) * (256 * DFF) + (size_t)(col0 >> 6) * (256 * 64) + (size_t)(r & 255) * 64 + (col0 & 63)) = w;
            }
    }
};
__device__ __forceinline__ void bf8_to_f32(u32x4 w, f32x4& lo, f32x4& hi) { lo = (f32x4){bflo(w.x), bfhi(w.x), bflo(w.y), bfhi(w.y)}; hi = (f32x4){bflo(w.z), bfhi(w.z), bflo(w.w), bfhi(w.w)}; }
template <bool POOL> struct EpiRes {
    float* Y; bf16_t* XB; ssq_t* ssq; const float* cscale; float* part;
    __device__ __forceinline__ void init(f32x4 (&acc)[2][2][4][2], const pg8::Unit& u, int wr, int wc, int fr, int fq) const {
        if (!POOL && u.part >= 0) { acc_zero(acc); return; }
        const int pmr = POOL ? (u.pm % NTM) : u.pm, ct = POOL ? (u.pm / NTM) : u.pn;
        const bf16_t* xq = XB + (size_t)(pmr * 256 + wr * 64 + fr) * DM + ct * 256 + wc * 32 + 8 * fq;
#pragma unroll
        for (int ai = 0; ai < 2; ++ai)
#pragma unroll
            for (int bj = 0; bj < 2; ++bj)
#pragma unroll
                for (int m = 0; m < 4; ++m) bf8_to_f32(*(const u32x4*)(xq + (size_t)(ai * 128 + m * 16) * DM + bj * 128), acc[ai][bj][m][0], acc[ai][bj][m][1]);
        if (POOL) {
            const float* cq = cscale + ct * 256 + wc * 32 + 8 * fq;
#pragma unroll
            for (int bj = 0; bj < 2; ++bj)
#pragma unroll
                for (int n = 0; n < 2; ++n) {
                    const f32x4 cv = *(const f32x4*)(cq + bj * 128 + 4 * n);
                    const f32x4 ic = (f32x4){__builtin_amdgcn_rcpf(cv[0]), __builtin_amdgcn_rcpf(cv[1]), __builtin_amdgcn_rcpf(cv[2]), __builtin_amdgcn_rcpf(cv[3])};
#pragma unroll
                    for (int ai = 0; ai < 2; ++ai)
#pragma unroll
                        for (int m = 0; m < 4; ++m) acc[ai][bj][m][n] = acc[ai][bj][m][n] * ic;
                }
        }
    }
    __device__ __forceinline__ void operator()(const f32x4 (&acc)[2][2][4][2], const pg8::Unit& u, int wr, int wc, int fr, int fq) const {
        if (!POOL && u.part >= 0) {
            float* pp = part + (size_t)u.part * 65536 + (size_t)(((wr * 4 + wc) * 64) + fq * 16 + fr) * 4;
#pragma unroll
            for (int ai = 0; ai < 2; ++ai)
#pragma unroll
                for (int m = 0; m < 4; ++m)
#pragma unroll
                    for (int bj = 0; bj < 2; ++bj)
#pragma unroll
                        for (int n = 0; n < 2; ++n) *(f32x4*)(pp + (size_t)((((ai * 4 + m) * 2 + bj) * 2 + n) * 2048)) = acc[ai][bj][m][n];
            return;
        }
        const int pmr = POOL ? (u.pm % NTM) : u.pm, ct = POOL ? (u.pm / NTM) : u.pn;
        const int row0 = pmr * 256 + wr * 64 + fr, col0 = ct * 256 + wc * 32 + 8 * fq;
#pragma unroll
        for (int ai = 0; ai < 2; ++ai)
#pragma unroll
            for (int m = 0; m < 4; ++m) {
                const int r = row0 + ai * 128 + m * 16;
                bf16_t* bp = XB + (size_t)r * DM + col0;
                float ss = 0.f;
#pragma unroll
                for (int bj = 0; bj < 2; ++bj) {
                    f32x4 v0 = acc[ai][bj][m][0], v1 = acc[ai][bj][m][1];
                    if (POOL) { v0 = v0 * *(const f32x4*)(cscale + col0 + bj * 128); v1 = v1 * *(const f32x4*)(cscale + col0 + bj * 128 + 4); }
                    if (Y) { float* yp = Y + (size_t)r * DM + col0 + bj * 128; *(f32x4*)yp = v0; *(f32x4*)(yp + 4) = v1; continue; }
                    u32x4 w; w.x = cvt_pk_bf16(v0[0], v0[1]); w.y = cvt_pk_bf16(v0[2], v0[3]); w.z = cvt_pk_bf16(v1[0], v1[1]); w.w = cvt_pk_bf16(v1[2], v1[3]);
                    *(u32x4*)(bp + bj * 128) = w;
                    ss += (v0[0] * v0[0] + v0[1] * v0[1]) + (v0[2] * v0[2] + v0[3] * v0[3]) + (v1[0] * v1[0] + v1[1] * v1[1]) + (v1[2] * v1[2] + v1[3] * v1[3]);
                }
                if (Y) continue;
                ss += __shfl_xor(ss, 16); ss += __shfl_xor(ss, 32);
                if (fq == 0) ssq_add(ssq + r, ss);
            }
    }
};

struct WTile { const float* src0; const float* src1; const float* gain; bf16_t* dst; int ld, K, k0, n0m, mode; };
__device__ __forceinline__ void wt_decode(const Params& p, int t, WTile& w) {
    int kt; w.gain = nullptr;
    if (t < 224) { const int i = t / 112, r = t % 112; w.n0m = (r / 16) * 256; kt = r % 16; w.K = 1024; w.ld = DIN; w.mode = (w.n0m < 1024) ? 1 : 0;
        w.src0 = p.in[I_WIN] + (size_t)i * DM * DIN; w.src1 = w.src0; w.gain = p.in[I_NMIX] + (2 * i) * DM; w.dst = (bf16_t*)(p.ws + WS_WIN) + (size_t)i * DIN * DM; }
    else if (t < 352) { t -= 224; const int i = t / 64, r = t % 64; w.n0m = (r / 16) * 256; kt = r % 16; w.K = 1024; w.ld = DM; w.mode = 0;
        w.src0 = p.in[I_WOUT] + (size_t)i * DM * DM; w.src1 = w.src0; w.dst = (bf16_t*)(p.ws + WS_WOUT) + (size_t)i * DM * DM; }
    else if (t < 1760) { t -= 352; const int l = t / 352, r = t % 352; w.n0m = (r / 16) * 256; kt = r % 16; w.K = 1024; w.ld = DFF; w.mode = 2;
        w.src0 = p.in[I_WG] + (size_t)l * DM * DFF; w.src1 = p.in[I_WU] + (size_t)l * DM * DFF; w.gain = p.in[I_NFFN] + l * DM; w.dst = (bf16_t*)(p.ws + WS_WGU) + (size_t)l * 2 * DFF * DM; }
    else if (t < 2464) { t -= 1760; const int l = t / 176, r = t % 176; w.n0m = (r / 44) * 256; kt = r % 44; w.K = DFF; w.ld = DM; w.mode = 0;
        w.src0 = p.in[I_WD] + (size_t)l * DFF * DM; w.src1 = w.src0; w.dst = (bf16_t*)(p.ws + WS_WDN) + (size_t)l * DM * DFF; }
    else { t -= 2464; const int ig = t / 4; w.n0m = 0; kt = t % 4; w.K = 256; w.ld = 256; w.mode = 0;
        w.src0 = p.in[I_WPOOL] + (size_t)ig * 65536; w.src1 = w.src0; w.dst = (bf16_t*)(p.ws + WS_WPL) + (size_t)ig * 65536; }
    w.k0 = kt * 64;
}
__device__ __forceinline__ void wt_load(const WTile& w, int tid, f32x4 (&v)[4][2], float& gs0, float& gs1) {
    const int row = tid >> 4, col4 = (tid & 15) * 4;
    gs0 = w.gain ? w.gain[w.k0 + row] : 1.0f; gs1 = w.gain ? w.gain[w.k0 + row + 32] : 1.0f;
#pragma unroll
    for (int q = 0; q < 4; ++q) {
        const int n0 = w.n0m + 64 * q; int c0 = n0; const float* src = w.src0;
        if (w.mode == 1) { const int pn = n0 / 256, bj = (n0 / 128) & 1, cc = n0 % 128; c0 = bj * 512 + 128 * pn + cc; }
        else if (w.mode == 2) { const int pn = n0 / 256, bj = (n0 / 128) & 1, cc = n0 % 128; c0 = 128 * pn + cc; src = bj ? w.src1 : w.src0; }
        const float* sp = src + (size_t)(w.k0 + row) * w.ld + c0 + col4;
        v[q][0] = __builtin_nontemporal_load((const f32x4*)sp); v[q][1] = __builtin_nontemporal_load((const f32x4*)(sp + (size_t)32 * w.ld));
    }
}
__device__ __forceinline__ void prep_phase(const Params& p, LAS unsigned char* lds) {
    int tid = threadIdx.x; asm volatile("" : "+v"(tid));
    const int G = gridDim.x, bid = blockIdx.x, wave = tid >> 6, lane = tid & 63;
    bf16_t* XB = (bf16_t*)(p.ws + WS_XB); ssq_t* SSQ = (ssq_t*)(p.ws + WS_SSQ);
    for (int r0 = bid * 8 + wave; r0 < MT; r0 += G * 16) {
        const int r1 = r0 + G * 8; const bool h1 = r1 < MT; const int r1c = h1 ? r1 : r0;
        const float* s0 = r0 < MP ? p.in[I_XP] + (size_t)r0 * DM : p.in[I_XS] + (size_t)(r0 - MP) * DM;
        const float* s1 = r1c < MP ? p.in[I_XP] + (size_t)r1c * DM : p.in[I_XS] + (size_t)(r1c - MP) * DM;
        f32x4 va[4], vb[4];
#pragma unroll
        for (int q = 0; q < 4; ++q) { va[q] = __builtin_nontemporal_load((const f32x4*)(s0 + q * 256 + lane * 4)); vb[q] = __builtin_nontemporal_load((const f32x4*)(s1 + q * 256 + lane * 4)); }
        float ssa = 0.f, ssb = 0.f;
#pragma unroll
        for (int q = 0; q < 4; ++q) {
            u32x2 w; w.x = cvt_pk_bf16(va[q][0], va[q][1]); w.y = cvt_pk_bf16(va[q][2], va[q][3]);
            *(u32x2*)(XB + (size_t)r0 * DM + q * 256 + lane * 4) = w;
            ssa += (va[q][0] * va[q][0] + va[q][1] * va[q][1]) + (va[q][2] * va[q][2] + va[q][3] * va[q][3]);
            if (h1) {
                u32x2 w2; w2.x = cvt_pk_bf16(vb[q][0], vb[q][1]); w2.y = cvt_pk_bf16(vb[q][2], vb[q][3]);
                *(u32x2*)(XB + (size_t)r1 * DM + q * 256 + lane * 4) = w2;
            }
            ssb += (vb[q][0] * vb[q][0] + vb[q][1] * vb[q][1]) + (vb[q][2] * vb[q][2] + vb[q][3] * vb[q][3]);
        }
        ssa = wave_sum(ssa); ssb = wave_sum(ssb);
        if (lane == 0) { SSQ[r0] = ssq_fix(ssa); if (h1) SSQ[r1] = ssq_fix(ssb); }
    }
    for (int idx = bid * 512 + tid; idx < 8 * MT; idx += G * 512) SSQ[MT + idx] = 0ull;
    LAS float* tile = (LAS float*)lds;
    WTile cur, nxt; f32x4 v[4][2]; float gs0 = 1.f, gs1 = 1.f;
    int t0 = bid;
    if (t0 < 2496) { wt_decode(p, t0, cur); wt_load(cur, tid, v, gs0, gs1); }
    for (; t0 < 2496; t0 += G) {
        __syncthreads();
        {
            const int row = tid >> 4, col4 = (tid & 15) * 4;
#pragma unroll
            for (int q = 0; q < 4; ++q)
#pragma unroll
                for (int h = 0; h < 2; ++h) { LAS float* tp = tile + q * 4160 + (row + 32 * h) * 65 + col4; const float gs = h ? gs1 : gs0;
                    tp[0] = v[q][h][0] * gs; tp[1] = v[q][h][1] * gs; tp[2] = v[q][h][2] * gs; tp[3] = v[q][h][3] * gs; }
        }
        __syncthreads();
        const bool hn = (t0 + G) < 2496;
        if (hn) { wt_decode(p, t0 + G, nxt); wt_load(nxt, tid, v, gs0, gs1); }
        {
            const int n = tid >> 3, kk = (tid & 7) * 8;
#pragma unroll
            for (int q = 0; q < 4; ++q) {
                float e[8];
#pragma unroll
                for (int j = 0; j < 8; ++j) e[j] = tile[q * 4160 + (kk + j) * 65 + n];
                u32x4 w; w.x = cvt_pk_bf16(e[0], e[1]); w.y = cvt_pk_bf16(e[2], e[3]); w.z = cvt_pk_bf16(e[4], e[5]); w.w = cvt_pk_bf16(e[6], e[7]);
                *(u32x4*)(cur.dst + (size_t)(cur.n0m + 64 * q + n) * cur.K + cur.k0 + kk) = w;
            }
        }
        if (hn) cur = nxt;
    }
    __syncthreads();
}

__device__ __forceinline__ f32x4 ld_bf4(const bf16_t* p) { const u32x2 w = *(const u32x2*)p; return (f32x4){bflo(w.x), bfhi(w.x), bflo(w.y), bfhi(w.y)}; }
template <int W>
__device__ __forceinline__ void pool_prompt_strip(const bf16_t* X, const ssq_t* ssq, int row0, int t0, int c, f32x4 gm, bf16_t* dgp, float* outp_seq) {
    constexpr int TT = 16, NR = TT + W - 1;
    f32x4 xr[NR];
    if (t0 >= W - 1) {
        const bf16_t* xp = X + (size_t)(row0 - (W - 1)) * DM + c; asm volatile("" : "+v"(xp));
        const ssq_t* sp = ssq + (row0 - (W - 1)); asm volatile("" : "+v"(sp));
#pragma unroll
        for (int j = 0; j < NR; ++j) { const float rs = ssq_rs(sp[j]); xr[j] = ld_bf4(xp + (size_t)j * DM) * rs * gm; }
    } else {
        int vz; asm volatile("v_mov_b32 %0, 0" : "=v"(vz));
        const bf16_t* xp = X + (size_t)(row0 - t0) * DM + c; const ssq_t* sp = ssq + (row0 - t0);
#pragma unroll
        for (int j = 0; j < NR; ++j) { const int tj = t0 - (W - 1) + j + vz, tc = tj < 0 ? 0 : tj; const float rs = ssq_rs(sp[tc]);
            const f32x4 v = ld_bf4(xp + (size_t)tc * DM) * rs * gm; xr[j] = tj < 0 ? (f32x4){0.f, 0.f, 0.f, 0.f} : v; }
    }
    f32x4 S = (f32x4){0.f, 0.f, 0.f, 0.f};
#pragma unroll
    for (int j = 0; j < W - 1; ++j) S += xr[j];
#pragma unroll
    for (int tt = 0; tt < TT; ++tt) {
        S += xr[tt + W - 1]; if (tt > 0) S -= xr[tt - 1];
        const int t = t0 + tt, cnt = (t + 1 < W) ? (t + 1) : W;
        const f32x4 cur = xr[tt + W - 1], d = S * __builtin_amdgcn_rcpf((float)cnt) - cur;
        u32x2 wv; wv.x = cvt_pk_bf16(d[0], d[1]); wv.y = cvt_pk_bf16(d[2], d[3]);
        *(u32x2*)(dgp + (size_t)tt * 256) = wv;
        if (t >= 4081) *(f32x4*)(outp_seq + (size_t)(t - 4081) * DM) = cur;
    }
}
template <int W>
__device__ __forceinline__ void pool_sample_strip(const bf16_t* X, const ssq_t* ssq, int row0, int c, f32x4 gm, const float* state_seq, bf16_t* dgp, float* outs_seq) {
    constexpr int TT = 8, NR = TT + W - 1;
    f32x4 xr[NR];
    { const float* stp = state_seq + (size_t)(15 - (W - 1)) * DM; asm volatile("" : "+v"(stp));
#pragma unroll
      for (int j = 0; j < W - 1; ++j) xr[j] = *(const f32x4*)(stp + (size_t)j * DM); }
    { const bf16_t* xp = X + (size_t)row0 * DM + c; asm volatile("" : "+v"(xp));
      const ssq_t* sp = ssq + row0;
#pragma unroll
      for (int j = 0; j < TT; ++j) { const float rs = ssq_rs(sp[j]); xr[W - 1 + j] = ld_bf4(xp + (size_t)j * DM) * rs * gm; } }
    f32x4 S = (f32x4){0.f, 0.f, 0.f, 0.f};
#pragma unroll
    for (int j = 0; j < W - 1; ++j) S += xr[j];
#pragma unroll
    for (int tt = 0; tt < TT; ++tt) {
        S += xr[tt + W - 1]; if (tt > 0) S -= xr[tt - 1];
        const f32x4 cur = xr[tt + W - 1], d = S * (1.0f / (float)W) - cur;
        u32x2 wv; wv.x = cvt_pk_bf16(d[0], d[1]); wv.y = cvt_pk_bf16(d[2], d[3]);
        *(u32x2*)(dgp + (size_t)tt * 256) = wv;
        *(f32x4*)(outs_seq + (size_t)(7 + tt) * DM) = cur;
    }
}
__device__ __forceinline__ void pool1_phase(const Params& p, int l, const ssq_t* ssq, int bid) {
    int tid = threadIdx.x; asm volatile("" : "+v"(tid));
    const int G = gridDim.x, i = l >> 1;
    const bf16_t* X = (const bf16_t*)(p.ws + WS_XB); bf16_t* DG = (bf16_t*)(p.ws + WS_DG);
    const int cq = tid & 255, c = cq * 4, half = tid >> 8, g = __builtin_amdgcn_readfirstlane(cq >> 6);
    const f32x4 gm = *(const f32x4*)(p.in[I_NMIX] + l * DM + c);
    const float* spool = p.in[I_SPOOL] + (size_t)i * 128 * 15 * DM;
    float* outp = p.out + O_POOLP + (size_t)i * 4 * 15 * DM; float* outs = p.out + O_POOLS + (size_t)i * 128 * 15 * DM;
    for (int kq = 0; kq < 2; ++kq) {
        const int u = kq == 0 ? bid : ((bid & 3) ? MP / 64 + 64 : MP / 64 + (bid >> 2));
        if (u >= MP / 64 + 64) continue;
        if (u < MP / 64) {
#pragma unroll 1
            for (int k = 0; k < 2; ++k) {
                const int row0 = u * 64 + k * 32 + half * 16, t0 = row0 & 4095, b = row0 >> 12;
                bf16_t* dgp = DG + ((size_t)g * MT + row0) * 256 + (c - 256 * g); float* op = outp + (size_t)b * 15 * DM + c;
                if (g == 0) pool_prompt_strip<2>(X, ssq, row0, t0, c, gm, dgp, op);
                else if (g == 1) pool_prompt_strip<4>(X, ssq, row0, t0, c, gm, dgp, op);
                else if (g == 2) pool_prompt_strip<8>(X, ssq, row0, t0, c, gm, dgp, op);
                else pool_prompt_strip<16>(X, ssq, row0, t0, c, gm, dgp, op);
            }
        } else {
            const int s0 = (u - MP / 64) * 2;
            {
                const int s = s0 + half, row0 = MP + s * 8;
                bf16_t* dgp = DG + ((size_t)g * MT + row0) * 256 + (c - 256 * g); float* op = outs + (size_t)s * 15 * DM + c; const float* st = spool + (size_t)s * 15 * DM + c;
                if (g == 0) pool_sample_strip<2>(X, ssq, row0, c, gm, st, dgp, op);
                else if (g == 1) pool_sample_strip<4>(X, ssq, row0, c, gm, st, dgp, op);
                else if (g == 2) pool_sample_strip<8>(X, ssq, row0, c, gm, st, dgp, op);
                else pool_sample_strip<16>(X, ssq, row0, c, gm, st, dgp, op);
            }
            for (int idx = tid; idx < 2 * 7 * 256; idx += 512) { const int c4 = (idx & 255) * 4, rr = (idx >> 8) % 7, sl = idx / (7 * 256);
                *(f32x4*)(outs + ((size_t)(s0 + sl) * 15 + rr) * DM + c4) = *(const f32x4*)(spool + ((size_t)(s0 + sl) * 15 + 8 + rr) * DM + c4); }
        }
    }
}

constexpr int KS_STRIDE = 72, VT_STRIDE = 264;

__device__ __forceinline__ void attn_item(const LAS bf16_t* Ks, const LAS bf16_t* Vt, int tile0, int r0, bool first, bool qvalid,
                                          const bf16_t* qptr, const float* qn, float slope, float sink, bf16_t* optr, int fr, int fq) {
    u32x4 raw0 = (u32x4){0u, 0u, 0u, 0u}, raw1 = raw0;
    if (qvalid) { raw0 = *(const u32x4*)(qptr); raw1 = *(const u32x4*)(qptr + 32); }
    float qf[16];
#pragma unroll
    for (int j = 0; j < 4; ++j) { qf[2 * j] = bflo(raw0[j]); qf[2 * j + 1] = bfhi(raw0[j]); qf[8 + 2 * j] = bflo(raw1[j]); qf[8 + 2 * j + 1] = bfhi(raw1[j]); }
    float ss = 0.f;
#pragma unroll
    for (int j = 0; j < 16; ++j) ss += qf[j] * qf[j];
    ss += __shfl_xor(ss, 16); ss += __shfl_xor(ss, 32);
    const float rq = rsqrtf(ss * (1.0f / 64.0f) + RMS_EPS) * 0.125f;
    bf16x8 q0, q1;
    {
        const f32x4 n0 = *(const f32x4*)(qn + fq * 8), n1 = *(const f32x4*)(qn + fq * 8 + 4), n2 = *(const f32x4*)(qn + 32 + fq * 8), n3 = *(const f32x4*)(qn + 32 + fq * 8 + 4);
        u32x4 a, b;
        a.x = cvt_pk_bf16(qf[0] * rq * n0[0], qf[1] * rq * n0[1]); a.y = cvt_pk_bf16(qf[2] * rq * n0[2], qf[3] * rq * n0[3]);
        a.z = cvt_pk_bf16(qf[4] * rq * n1[0], qf[5] * rq * n1[1]); a.w = cvt_pk_bf16(qf[6] * rq * n1[2], qf[7] * rq * n1[3]);
        b.x = cvt_pk_bf16(qf[8] * rq * n2[0], qf[9] * rq * n2[1]); b.y = cvt_pk_bf16(qf[10] * rq * n2[2], qf[11] * rq * n2[3]);
        b.z = cvt_pk_bf16(qf[12] * rq * n3[0], qf[13] * rq * n3[1]); b.w = cvt_pk_bf16(qf[14] * rq * n3[2], qf[15] * rq * n3[3]);
        q0 = __builtin_bit_cast(bf16x8, a); q1 = __builtin_bit_cast(bf16x8, b);
    }
    f32x4 s[9];
#pragma unroll
    for (int T = 0; T < 9; ++T) {
        const LAS bf16_t* kp = Ks + ((tile0 + T) * 16 + fr) * KS_STRIDE + fq * 8;
        const bf16x8 a0 = *(const LAS bf16x8*)(kp), a1 = *(const LAS bf16x8*)(kp + 32);
        f32x4 z = (f32x4){0.f, 0.f, 0.f, 0.f};
        z = __builtin_amdgcn_mfma_f32_16x16x32_bf16(a0, q0, z, 0, 0, 0);
        s[T] = __builtin_amdgcn_mfma_f32_16x16x32_bf16(a1, q1, z, 0, 0, 0);
    }
    __builtin_amdgcn_sched_barrier(0);
    int qi = r0 + fr; asm volatile("" : "+v"(qi));
    const int lim = first ? qi + 1 : 128;
    float mx = sink;
#pragma unroll
    for (int T = 0; T < 9; ++T)
#pragma unroll
        for (int j = 0; j < 4; ++j) {
            const int jk = (tile0 + T) * 16 + 4 * fq + j, dist = 128 + qi - jk;
            const bool valid = (unsigned)dist < (unsigned)lim;
            const float v = valid ? (s[T][j] - slope * (float)dist) : -1e30f;
            s[T][j] = v; mx = fmaxf(mx, v);
        }
    mx = fmaxf(mx, __shfl_xor(mx, 16)); mx = fmaxf(mx, __shfl_xor(mx, 32));
    float sum = 0.f;
#pragma unroll
    for (int T = 0; T < 9; ++T)
#pragma unroll
        for (int j = 0; j < 4; ++j) { const float e = __expf(s[T][j] - mx); s[T][j] = e; sum += e; }
    sum += __shfl_xor(sum, 16); sum += __shfl_xor(sum, 32);
    sum += __expf(sink - mx);
    const float inv = 1.0f / sum;
    __builtin_amdgcn_sched_barrier(0);
    f32x4 o[4];
#pragma unroll
    for (int dt = 0; dt < 4; ++dt) o[dt] = (f32x4){0.f, 0.f, 0.f, 0.f};
#pragma unroll
    for (int pp = 0; pp < 5; ++pp) {
        const int T0 = 2 * pp, T1 = (pp < 4) ? 2 * pp + 1 : 8;
        u32x4 pw;
        pw.x = cvt_pk_bf16(s[T0][0] * inv, s[T0][1] * inv); pw.y = cvt_pk_bf16(s[T0][2] * inv, s[T0][3] * inv);
        if (pp < 4) { pw.z = cvt_pk_bf16(s[T1][0] * inv, s[T1][1] * inv); pw.w = cvt_pk_bf16(s[T1][2] * inv, s[T1][3] * inv); } else { pw.z = 0u; pw.w = 0u; }
        const bf16x8 pf = __builtin_bit_cast(bf16x8, pw);
#pragma unroll
        for (int dt = 0; dt < 4; ++dt) {
            const LAS bf16_t* vp = Vt + (dt * 16 + fr) * VT_STRIDE + 4 * fq;
            const u32x2 v0 = *(const LAS u32x2*)(vp + (tile0 + T0) * 16), v1 = *(const LAS u32x2*)(vp + (tile0 + T1) * 16);
            u32x4 vw; vw.x = v0.x; vw.y = v0.y; vw.z = v1.x; vw.w = v1.y;
            o[dt] = __builtin_amdgcn_mfma_f32_16x16x32_bf16(__builtin_bit_cast(bf16x8, vw), pf, o[dt], 0, 0, 0);
        }
    }
    if (qvalid) {
#pragma unroll
        for (int dt = 0; dt < 4; ++dt) { u32x2 w; w.x = cvt_pk_bf16(o[dt][0], o[dt][1]); w.y = cvt_pk_bf16(o[dt][2], o[dt][3]); *(u32x2*)(optr + dt * 16) = w; }
    }
}

__device__ __forceinline__ void mixer_phase(const Params& p, int l, LAS unsigned char* lds, int bid) {
    const int G = gridDim.x, i = l >> 1;
    const bf16_t* QKV = (const bf16_t*)(p.ws + WS_QKV); const bf16_t* GLU = (const bf16_t*)(p.ws + WS_GLU); bf16_t* CAT = (bf16_t*)(p.ws + WS_CAT);
    const float* qn = p.in[I_QN] + i * 64; const float* kn = p.in[I_KN] + i * 64; const float* sinks = p.in[I_SINK] + i * 8;
    constexpr int N_PA = 256, N_CV = 640, N_SA = 128;
#define MIX_PRE int tid = threadIdx.x; asm volatile("" : "+v"(tid)); const int wave = tid >> 6, lane = tid & 63, fr = lane & 15, fq = lane >> 4; (void)wave; (void)fr; (void)fq;
    for (int u = bid; u < N_PA; u += G) {
        MIX_PRE
        {
#ifndef X_NOPA
            const int kh = u & 1, blk = (u >> 1) & 31, b = u >> 6;
            const int rowQ0 = b * 4096 + blk * 128, rowK0 = rowQ0 - 128;
            LAS bf16_t* Ks = (LAS bf16_t*)lds; LAS bf16_t* Vt = (LAS bf16_t*)(lds + 256 * KS_STRIDE * 2);
            const int chunk = tid & 7;
            const f32x4 kn0 = *(const f32x4*)(kn + chunk * 8), kn1 = *(const f32x4*)(kn + chunk * 8 + 4);
#pragma unroll 1
            for (int ps = 0; ps < 4; ++ps) {
                const int key = (tid >> 3) + 64 * ps;
                u32x4 kr = (u32x4){0u, 0u, 0u, 0u}, vr = kr;
                const bool have = (blk > 0) || (key >= 128);
                if (have) { const bf16_t* rp = QKV + (size_t)(rowK0 + key) * 768 + 512 + kh * 64 + chunk * 8; kr = *(const u32x4*)rp; vr = *(const u32x4*)(rp + 128); }
                float kf[8], vf[8];
#pragma unroll
                for (int j = 0; j < 4; ++j) { kf[2 * j] = bflo(kr[j]); kf[2 * j + 1] = bfhi(kr[j]); vf[2 * j] = bflo(vr[j]); vf[2 * j + 1] = bfhi(vr[j]); }
                float ss = 0.f;
#pragma unroll
                for (int j = 0; j < 8; ++j) ss += kf[j] * kf[j];
                ss += __shfl_xor(ss, 1); ss += __shfl_xor(ss, 2); ss += __shfl_xor(ss, 4);
                const float rk = rsqrtf(ss * (1.0f / 64.0f) + RMS_EPS);
#pragma unroll
                for (int j = 0; j < 4; ++j) { kf[j] *= rk * kn0[j]; kf[4 + j] *= rk * kn1[j]; }
                u32x4 kw; kw.x = cvt_pk_bf16(kf[0], kf[1]); kw.y = cvt_pk_bf16(kf[2], kf[3]); kw.z = cvt_pk_bf16(kf[4], kf[5]); kw.w = cvt_pk_bf16(kf[6], kf[7]);
                *(LAS u32x4*)(Ks + key * KS_STRIDE + chunk * 8) = kw;
#pragma unroll
                for (int j = 0; j < 4; ++j) { Vt[(chunk * 8 + 2 * j) * VT_STRIDE + key] = (bf16_t)(vr[j] & 0xffffu); Vt[(chunk * 8 + 2 * j + 1) * VT_STRIDE + key] = (bf16_t)(vr[j] >> 16); }
                if (blk == 31 && key >= 128) {
                    float* ko = p.out + O_KP + ((((size_t)i * 4 + b) * 128 + (key - 128)) * 2 + kh) * 64 + chunk * 8;
                    float* vo = p.out + O_VP + ((((size_t)i * 4 + b) * 128 + (key - 128)) * 2 + kh) * 64 + chunk * 8;
                    *(f32x4*)ko = (f32x4){kf[0], kf[1], kf[2], kf[3]}; *(f32x4*)(ko + 4) = (f32x4){kf[4], kf[5], kf[6], kf[7]};
                    *(f32x4*)vo = (f32x4){vf[0], vf[1], vf[2], vf[3]}; *(f32x4*)(vo + 4) = (f32x4){vf[4], vf[5], vf[6], vf[7]};
                }
            }
            __syncthreads();
            const int r0 = wave * 16;
#pragma unroll 1
            for (int g = 0; g < 4; ++g) {
                const int h = kh * 4 + g;
                const float slope = exp2f(-(float)(h + 1)), sink = sinks[h];
                const size_t row = (size_t)(rowQ0 + r0 + fr);
                attn_item(Ks, Vt, wave, r0, blk == 0, true, QKV + row * 768 + h * 64 + fq * 8, qn, slope, sink, CAT + row * DM + 512 + h * 64 + 4 * fq, fr, fq);
            }
            __syncthreads();
#endif
        }
    }
#ifndef X_NOCV
    f32x2 wdw[31]; f32x2 bias;
    { int t0 = threadIdx.x; asm volatile("" : "+v"(t0)); const int c0 = (t0 & 255) * 2;
      const float* wp = p.in[I_WDW] + (size_t)i * 31 * 512 + c0; asm volatile("" : "+v"(wp));
#pragma unroll
      for (int j = 0; j < 31; ++j) { wdw[j] = *(const f32x2*)wp; wp += 512; asm volatile("" : "+v"(wp)); }
      bias = *(const f32x2*)(p.in[I_BDW] + i * 512 + c0); }
    for (int kq = 0; kq < 3; ++kq) {
        const int cu = kq < 2 ? bid + 256 * kq : ((bid & 1) ? N_CV : 512 + (bid >> 1));
        if (cu >= N_CV) continue;
        MIX_PRE
        {
            const int c2 = tid & 255, half = tid >> 8, c = c2 * 2; const bool prm = cu < 512;
            LAS float* ybuf = (LAS float*)lds;
            if (prm && ((cu & 127) * 32 + half * 16) >= 30) {
                const int b = cu >> 7, tb0 = (cu & 127) * 32 + half * 16;
                unsigned raw[46];
                { const bf16_t* gp = GLU + ((size_t)b * 4096 + tb0 - 30) * 512 + c; asm volatile("" : "+v"(gp));
#pragma unroll
                  for (int j = 0; j < 46; ++j) { raw[j] = *(const unsigned*)gp; gp += 512; asm volatile("" : "+v"(gp)); } }
                if (tb0 >= 4064) {
                    float* oc = p.out + O_CONVP + (((size_t)i * 4 + b) * 30) * 512 + c; asm volatile("" : "+v"(oc));
#pragma unroll
                    for (int j = 0; j < 16; ++j) { const int t = tb0 + j; if (t >= 4066) *(f32x2*)(oc + (size_t)(t - 4066) * 512) = (f32x2){bflo(raw[30 + j]), bfhi(raw[30 + j])}; }
                }
#pragma unroll
                for (int q = 0; q < 2; ++q) {
                    f32x2 win[38];
#pragma unroll
                    for (int j = 0; j < 38; ++j) win[j] = (f32x2){bflo(raw[q * 8 + j]), bfhi(raw[q * 8 + j])};
#pragma unroll
                    for (int t = 0; t < 8; ++t) {
                        f32x2 y = bias;
#pragma unroll
                        for (int j = 0; j < 31; ++j) y += wdw[j] * win[t + j];
                        *(LAS f32x2*)(ybuf + (half * 16 + q * 8 + t) * 512 + c) = y;
                    }
                    __builtin_amdgcn_sched_barrier(0);
                }
            } else if (prm) {
#pragma unroll 1
                for (int q = 0; q < 2; ++q) {
                    const int b = cu >> 7, tl = half * 16 + q * 8, tb = (cu & 127) * 32 + tl;
                    f32x2 win[38];
                    {
                        int vz; asm volatile("v_mov_b32 %0, 0" : "=v"(vz));
                        const bf16_t* gp = GLU + (size_t)b * 4096 * 512 + c; asm volatile("" : "+v"(gp));
#pragma unroll
                        for (int j = 0; j < 38; ++j) { const int tj = tb - 30 + j + vz; const unsigned w = *(const unsigned*)gp; if (tj >= 0) gp += 512; asm volatile("" : "+v"(gp));
                            win[j] = tj < 0 ? (f32x2){0.f, 0.f} : (f32x2){bflo(w), bfhi(w)}; }
                    }
#pragma unroll
                    for (int t = 0; t < 8; ++t) {
                        f32x2 y = bias;
#pragma unroll
                        for (int j = 0; j < 31; ++j) y += wdw[j] * win[t + j];
                        *(LAS f32x2*)(ybuf + (tl + t) * 512 + c) = y;
                    }
                }
            } else {
                const int sq = cu - 512;
                f32x2 win[34];
                const float* cc = p.in[I_CCONV] + (((size_t)i * 128 + sq) * 30 + half * 4) * 512 + c; asm volatile("" : "+v"(cc));
                const bf16_t* gs = GLU + ((size_t)MP + sq * 8) * 512 + c; asm volatile("" : "+v"(gs));
                float* oc = p.out + O_CONVS + (((size_t)i * 128 + sq) * 30 + half * 15) * 512 + c; asm volatile("" : "+v"(oc));
                if (half == 0) {
#pragma unroll
                    for (int j = 0; j < 30; ++j) { win[j] = *(const f32x2*)cc; cc += 512; asm volatile("" : "+v"(cc)); }
#pragma unroll
                    for (int j = 0; j < 4; ++j) { const unsigned w = *(const unsigned*)gs; gs += 512; asm volatile("" : "+v"(gs)); win[30 + j] = (f32x2){bflo(w), bfhi(w)}; }
#pragma unroll
                    for (int j = 0; j < 15; ++j) { *(f32x2*)oc = win[8 + j]; oc += 512; asm volatile("" : "+v"(oc)); }
                } else {
#pragma unroll
                    for (int j = 0; j < 26; ++j) { win[j] = *(const f32x2*)cc; cc += 512; asm volatile("" : "+v"(cc)); }
#pragma unroll
                    for (int j = 0; j < 8; ++j) { const unsigned w = *(const unsigned*)gs; gs += 512; asm volatile("" : "+v"(gs)); win[26 + j] = (f32x2){bflo(w), bfhi(w)}; }
#pragma unroll
                    for (int j = 0; j < 15; ++j) { *(f32x2*)oc = win[19 + j]; oc += 512; asm volatile("" : "+v"(oc)); }
                }
#pragma unroll
                for (int t = 0; t < 4; ++t) {
                    f32x2 y = bias;
#pragma unroll
                    for (int j = 0; j < 31; ++j) y += wdw[j] * win[t + j];
                    *(LAS f32x2*)(ybuf + (half * 4 + t) * 512 + c) = y;
                }
            }
            __syncthreads();
            {
                const float* gp = p.in[I_CNG] + i * 512 + lane * 8; const float* bp = p.in[I_CNB] + i * 512 + lane * 8;
                const f32x4 g0 = *(const f32x4*)gp, g1 = *(const f32x4*)(gp + 4), b0 = *(const f32x4*)bp, b1 = *(const f32x4*)(bp + 4);
#pragma unroll 1
                for (int q = 0; q < (prm ? 4 : 1); ++q) {
                    const int tk = prm ? wave * 4 + q : wave; const size_t row = prm ? (size_t)cu * 32 + tk : (size_t)MP + (size_t)(cu - 512) * 8 + tk;
                    const f32x4 v0 = *(const LAS f32x4*)(ybuf + tk * 512 + lane * 8), v1 = *(const LAS f32x4*)(ybuf + tk * 512 + lane * 8 + 4);
                    const float mean = wave_sum((v0[0] + v0[1]) + (v0[2] + v0[3]) + (v1[0] + v1[1]) + (v1[2] + v1[3])) * (1.0f / 512.0f);
                    const f32x4 d0 = v0 - mean, d1 = v1 - mean;
                    const float var = wave_sum((d0[0] * d0[0] + d0[1] * d0[1]) + (d0[2] * d0[2] + d0[3] * d0[3]) + (d1[0] * d1[0] + d1[1] * d1[1]) + (d1[2] * d1[2] + d1[3] * d1[3])) * (1.0f / 512.0f);
                    const float rs = rsqrtf(var + LN_EPS);
                    f32x4 o0 = d0 * rs * g0 + b0, o1 = d1 * rs * g1 + b1;
#pragma unroll
                    for (int j = 0; j < 4; ++j) { o0[j] = o0[j] * fast_sigmoid(o0[j]); o1[j] = o1[j] * fast_sigmoid(o1[j]); }
                    u32x4 w; w.x = cvt_pk_bf16(o0[0], o0[1]); w.y = cvt_pk_bf16(o0[2], o0[3]); w.z = cvt_pk_bf16(o1[0], o1[1]); w.w = cvt_pk_bf16(o1[2], o1[3]);
                    *(u32x4*)(CAT + row * DM + lane * 8) = w;
                }
            }
            __syncthreads();
        }
    }
#endif
    for (int s = (bid & 1) ? (bid >> 1) : N_SA; s < N_SA; s += N_SA) {
        MIX_PRE
        {
#ifndef X_NOSA
            LAS bf16_t* Ks = (LAS bf16_t*)lds; LAS bf16_t* Vt = (LAS bf16_t*)(lds + 2 * 144 * KS_STRIDE * 2);
            const int chunk = tid & 7;
            const f32x4 kn0 = *(const f32x4*)(kn + chunk * 8), kn1 = *(const f32x4*)(kn + chunk * 8 + 4);
#pragma unroll 1
            for (int it = tid; it < 2 * 144 * 8; it += 512) {
                const int kk = it >> 3, kh = kk / 144, key = kk % 144;
                float kf[8], vf[8];
#pragma unroll
                for (int j = 0; j < 8; ++j) { kf[j] = 0.f; vf[j] = 0.f; }
                const bool isnew = (key >= 128) && (key < 136);
                if (key < 128) {
                    const size_t off = ((((size_t)i * 128 + s) * 128 + key) * 2 + kh) * 64 + chunk * 8;
                    const f32x4 a0 = *(const f32x4*)(p.in[I_CK] + off), a1 = *(const f32x4*)(p.in[I_CK] + off + 4), c0 = *(const f32x4*)(p.in[I_CV] + off), c1 = *(const f32x4*)(p.in[I_CV] + off + 4);
#pragma unroll
                    for (int j = 0; j < 4; ++j) { kf[j] = a0[j]; kf[4 + j] = a1[j]; vf[j] = c0[j]; vf[4 + j] = c1[j]; }
                } else if (isnew) {
                    const bf16_t* rp = QKV + ((size_t)MP + s * 8 + (key - 128)) * 768 + 512 + kh * 64 + chunk * 8;
                    const u32x4 kr = *(const u32x4*)rp, vr = *(const u32x4*)(rp + 128);
#pragma unroll
                    for (int j = 0; j < 4; ++j) { kf[2 * j] = bflo(kr[j]); kf[2 * j + 1] = bfhi(kr[j]); vf[2 * j] = bflo(vr[j]); vf[2 * j + 1] = bfhi(vr[j]); }
                }
                float ss = 0.f;
#pragma unroll
                for (int j = 0; j < 8; ++j) ss += kf[j] * kf[j];
                ss += __shfl_xor(ss, 1); ss += __shfl_xor(ss, 2); ss += __shfl_xor(ss, 4);
                const float rk = rsqrtf(ss * (1.0f / 64.0f) + RMS_EPS);
                if (isnew) {
#pragma unroll
                    for (int j = 0; j < 4; ++j) { kf[j] *= rk * kn0[j]; kf[4 + j] *= rk * kn1[j]; }
                }
                u32x4 kw; kw.x = cvt_pk_bf16(kf[0], kf[1]); kw.y = cvt_pk_bf16(kf[2], kf[3]); kw.z = cvt_pk_bf16(kf[4], kf[5]); kw.w = cvt_pk_bf16(kf[6], kf[7]);
                *(LAS u32x4*)(Ks + (kh * 144 + key) * KS_STRIDE + chunk * 8) = kw;
                u32x4 vw; vw.x = cvt_pk_bf16(vf[0], vf[1]); vw.y = cvt_pk_bf16(vf[2], vf[3]); vw.z = cvt_pk_bf16(vf[4], vf[5]); vw.w = cvt_pk_bf16(vf[6], vf[7]);
#pragma unroll
                for (int j = 0; j < 4; ++j) { Vt[(kh * 64 + chunk * 8 + 2 * j) * VT_STRIDE + key] = (bf16_t)(vw[j] & 0xffffu); Vt[(kh * 64 + chunk * 8 + 2 * j + 1) * VT_STRIDE + key] = (bf16_t)(vw[j] >> 16); }
                if (key >= 8 && key < 136) {
                    const size_t oo = ((((size_t)i * 128 + s) * 128 + (key - 8)) * 2 + kh) * 64 + chunk * 8;
                    float* ko = p.out + O_KS + oo; float* vo = p.out + O_VS + oo;
                    *(f32x4*)ko = (f32x4){kf[0], kf[1], kf[2], kf[3]}; *(f32x4*)(ko + 4) = (f32x4){kf[4], kf[5], kf[6], kf[7]};
                    *(f32x4*)vo = (f32x4){vf[0], vf[1], vf[2], vf[3]}; *(f32x4*)(vo + 4) = (f32x4){vf[4], vf[5], vf[6], vf[7]};
                }
            }
            __syncthreads();
            {
                const int kh = wave >> 2, g = wave & 3, h = kh * 4 + g;
                const float slope = exp2f(-(float)(h + 1)), sink = sinks[h];
                const size_t row = (size_t)MP + s * 8 + (fr & 7);
                attn_item(Ks + kh * 144 * KS_STRIDE, Vt + kh * 64 * VT_STRIDE, 0, 0, false, fr < 8, QKV + row * 768 + h * 64 + fq * 8, qn, slope, sink, CAT + row * DM + 512 + h * 64 + 4 * fq, fr, fq);
            }
            __syncthreads();
#endif
        }
    }
}


__device__ __forceinline__ void splitk_reduce(float* Y, bf16_t* XB, ssq_t* ssq, const float* part, const pg8::StaticOrder& S, int KS) {
    int tid = threadIdx.x; asm volatile("" : "+v"(tid));
    const int wid = tid >> 6, lane = tid & 63, wr = wid >> 2, wc = wid & 3, fr = lane & 15, fq = lane >> 4;
    for (int task = blockIdx.x; task < 256; task += gridDim.x) {
        const int e = task >> 4, ai = (task >> 3) & 1, m = (task >> 1) & 3, bj = task & 1;
        pg8::Unit u; S.tile(256 + e, u);
        const float* pp = part + (size_t)(e * KS) * 65536 + (size_t)((((ai * 4 + m) * 2 + bj) * 2) * 2048) + (size_t)tid * 4;
        f32x4 a0 = (f32x4){0.f, 0.f, 0.f, 0.f}, a1 = a0;
        for (int k = 0; k < KS; ++k) { a0 += *(const f32x4*)(pp + (size_t)k * 65536); a1 += *(const f32x4*)(pp + (size_t)k * 65536 + 2048); }
        const int r = u.pm * 256 + ai * 128 + wr * 64 + m * 16 + fr, col = u.pn * 256 + bj * 128 + wc * 32 + 8 * fq;
        bf16_t* bp = XB + (size_t)r * DM + col;
        f32x4 x0, x1; bf8_to_f32(*(const u32x4*)bp, x0, x1);
        const f32x4 v0 = x0 + a0, v1 = x1 + a1;
        if (Y) { float* yp = Y + (size_t)r * DM + col; *(f32x4*)yp = v0; *(f32x4*)(yp + 4) = v1; continue; }
        u32x4 w; w.x = cvt_pk_bf16(v0[0], v0[1]); w.y = cvt_pk_bf16(v0[2], v0[3]); w.z = cvt_pk_bf16(v1[0], v1[1]); w.w = cvt_pk_bf16(v1[2], v1[3]);
        *(u32x4*)bp = w;
        float ss = (v0[0] * v0[0] + v0[1] * v0[1]) + (v0[2] * v0[2] + v0[3] * v0[3]) + (v1[0] * v1[0] + v1[1] * v1[1]) + (v1[2] * v1[2] + v1[3] * v1[3]);
        ss += __shfl_xor(ss, 16); ss += __shfl_xor(ss, 32);
        if (fq == 0) ssq_add(ssq + r, ss);
    }
}

#define XB_TMO      128
#define XB_XCNT(j)  (256  + 64 * (j))
#define XB_XSUB(j)  (1280 + 64 * (j))
#define XB_XGEN(j)  (2304 + 64 * (j))
#define XB_TOP      3328
#define XB_TOPGEN   3392
#define XCD_BAR_WORDS 3456
#define XB_SPIN_CAP (1u << 22)
__device__ __forceinline__ unsigned xb_ld(unsigned* p)              { return __hip_atomic_load(p, __ATOMIC_RELAXED, __HIP_MEMORY_SCOPE_AGENT); }
__device__ __forceinline__ unsigned xb_add(unsigned* p, unsigned v) { return __hip_atomic_fetch_add(p, v, __ATOMIC_RELAXED, __HIP_MEMORY_SCOPE_AGENT); }
__device__ __forceinline__ unsigned xb_xcc_id() { return (unsigned)__builtin_amdgcn_s_getreg((3 << 11) | 20) & 0xFu; }
#define XB_SPIN(cond, bar) do { unsigned _sp = 0; while (cond) { __builtin_amdgcn_s_sleep(1); \
    if ((++_sp & 255u) == 0u) { if (xb_ld(&(bar)[XB_TMO])) break; if (_sp > XB_SPIN_CAP) { atomicAdd(&(bar)[XB_TMO], 1u); break; } } } } while (0)
struct XcdBarrier { unsigned* bar; unsigned x; volatile LAS unsigned* st; };
__device__ __forceinline__ XcdBarrier xcd_barrier_post(unsigned* bar, volatile LAS unsigned* st) {
    XcdBarrier b; b.bar = bar; b.x = xb_xcc_id(); b.st = st;
    if (threadIdx.x == 0) st[2] = xb_add(&bar[XB_XCNT(b.x)], 1u);
    return b;
}
__device__ __forceinline__ void xcd_barrier_complete(unsigned* bar, unsigned x, unsigned& nloc, unsigned& nx) {
    const unsigned G = gridDim.x * gridDim.y * gridDim.z;
    unsigned sum, cnt, mine, sp = 0u;
    for (;;) {
        sum = 0u; cnt = 0u; mine = 0u;
#pragma unroll
        for (unsigned j = 0; j < 16; ++j) { const unsigned c = xb_ld(&bar[XB_XCNT(j)]); sum += c; cnt += (c > 0u) ? 1u : 0u; mine = (j == x) ? c : mine; }
        if (sum == G) break;
        __builtin_amdgcn_s_sleep(1);
        if ((++sp & 255u) == 0u) { if (xb_ld(&bar[XB_TMO])) break; if (sp > XB_SPIN_CAP) { atomicAdd(&bar[XB_TMO], 1u); break; } }
    }
    nloc = mine > 0u ? mine : 1u; nx = cnt > 0u ? cnt : 1u;
}
__device__ __forceinline__ void xcd_barrier(const XcdBarrier& b) {
    asm volatile("s_waitcnt vmcnt(0)" ::: "memory");
    __syncthreads();
    if (threadIdx.x == 0) {
        unsigned* bar = b.bar;
        __builtin_amdgcn_s_waitcnt(0);
        unsigned nloc = b.st[0], nx = b.st[1];
        if (nloc == 0u) { xcd_barrier_complete(bar, b.x, nloc, nx); b.st[0] = nloc; b.st[1] = nx; }
        const unsigned old = xb_add(&bar[XB_XSUB(b.x)], 1u);
        const unsigned gen = old / nloc;
        if (old + 1u == (gen + 1u) * nloc) {
            __builtin_amdgcn_fence(__ATOMIC_RELEASE, "agent");
            asm volatile("s_waitcnt vmcnt(0)" ::: "memory");
            const unsigned og = xb_add(&bar[XB_TOP], 1u);
            const unsigned tg = og / nx;
            if (og + 1u == (tg + 1u) * nx) xb_add(&bar[XB_TOPGEN], 1u);
            else XB_SPIN(xb_ld(&bar[XB_TOPGEN]) == tg, bar);
            __builtin_amdgcn_fence(__ATOMIC_ACQUIRE, "agent");
            xb_add(&bar[XB_XGEN(b.x)], 1u);
            asm volatile("s_waitcnt vmcnt(0)" ::: "memory");
        } else {
            XB_SPIN(xb_ld(&bar[XB_XGEN(b.x)]) == gen, bar);
            __builtin_amdgcn_fence(__ATOMIC_ACQUIRE, "agent");
            asm volatile("s_waitcnt vmcnt(0)" ::: "memory");
        }
    }
    __syncthreads();
}

__global__ void __launch_bounds__(512, 2) fwd_megakernel(Params p) {
    extern __shared__ __attribute__((aligned(16))) unsigned char lds_raw[];
    LAS unsigned char* lds = (LAS unsigned char*)lds_raw;
    cg::grid_group grid = cg::this_grid();
    const int G = gridDim.x, bid = blockIdx.x;
    bf16_t* XB = (bf16_t*)(p.ws + WS_XB); ssq_t* SSQ = (ssq_t*)(p.ws + WS_SSQ); float* PART = (float*)(p.ws + WS_PART);
#define IN(k) (p.ph_lo <= (k) && (k) < p.ph_hi)
#define SYNC(k) do { if (p.ph_hi > (k) + 1) xcd_barrier(bar); } while (0)
    unsigned* barw = (unsigned*)(p.ws + WS_BAR);
    volatile LAS unsigned* bst = (volatile LAS unsigned*)(lds + 131072);
    if (threadIdx.x < 4) bst[threadIdx.x] = 0u;
    __syncthreads();
    XcdBarrier bar = xcd_barrier_post(barw, bst);
#ifndef X_NOPREP
    if (IN(0)) prep_phase(p, lds);
    if (p.ph_lo < 0) grid.sync();
    xcd_barrier(bar);
    for (int rep = 0; rep < DUP_SYNC; ++rep) xcd_barrier(bar);
    int vbid = bid, cbid = bid;
    { bool okc = (G == 256);
#pragma unroll
      for (int j = 0; j < 16; ++j) { const unsigned cj = xb_ld(&barw[XB_XCNT(j)]); okc = okc && (cj == (j < 8 ? 32u : 0u)); }
      if (okc) { vbid = (int)(bar.x + 8u * bst[2]); cbid = (int)(bar.x * 32u + bst[2]); } }
#endif
#pragma unroll 1
    for (int l = 0; l < 4; ++l) {
        const int pb = 1 + 5 * l, i = l >> 1;
        ssq_t* ssq_in = SSQ + (size_t)(2 * l) * MT;
        ssq_t* ssq_mid = SSQ + (size_t)(2 * l + 1) * MT;
        ssq_t* ssq_out = SSQ + (size_t)(2 * l + 2) * MT;
        if ((l & 1) == 0) {
            if (IN(pb) && X_GIN) {
                pg8::Gemm g{XB, (const bf16_t*)(p.ws + WS_WIN) + (size_t)i * DIN * DM, MT, DIN, DM}; pg8::StaticOrder S; S.init(MT, DIN, DM, G, vbid);
                EpiIn E{ssq_in, (bf16_t*)(p.ws + WS_GLU), (bf16_t*)(p.ws + WS_QKV)};
                for (int rep = 0; rep <= DUP_IN; ++rep) { pg8::gemm_phase(lds, g, S, E); SYNC(pb); }
            }
#ifndef X_NOMIX
            if (IN(pb + 1)) { for (int rep = 0; rep <= DUP_MIX; ++rep) { mixer_phase(p, l, lds, cbid); SYNC(pb + 1); } }
#endif
            if (IN(pb + 2) && X_GOUT) {
                pg8::Gemm g{(const bf16_t*)(p.ws + WS_CAT), (const bf16_t*)(p.ws + WS_WOUT) + (size_t)i * DM * DM, MT, DM, DM}; pg8::SplitOrder<false> S; S.init2(MT, DM, DM, G, vbid, 4);
                EpiRes<false> E{nullptr, XB, ssq_mid, nullptr, PART};
                pg8::gemm_phase(lds, g, S, E);
                xcd_barrier(bar);
                splitk_reduce(nullptr, XB, ssq_mid, PART, S, 4);
                SYNC(pb + 2);
            }
        } else {
#ifndef X_NOPOOL1
            if (IN(pb)) { for (int rep = 0; rep <= DUP_POOL1; ++rep) { pool1_phase(p, l, ssq_in, cbid); SYNC(pb); } }
#endif
            if (IN(pb + 1) && X_GPOOL) {
                pg8::Gemm g{(const bf16_t*)(p.ws + WS_DG), (const bf16_t*)(p.ws + WS_WPL) + (size_t)i * 4 * 65536, 4 * MT, 256, 256}; pg8::PoolOrder S{G, vbid};
                EpiRes<true> E{nullptr, XB, ssq_mid, p.in[I_PSCALE] + i * DM, PART};
                pg8::gemm_phase(lds, g, S, E);
                SYNC(pb + 2);
            }
        }
        if (IN(pb + 3) && X_GGU) {
            pg8::Gemm g{XB, (const bf16_t*)(p.ws + WS_WGU) + (size_t)l * 2 * DFF * DM, MT, 2 * DFF, DM}; pg8::StaticOrder S; S.init(MT, 2 * DFF, DM, G, vbid);
            EpiGU E{ssq_mid, (bf16_t*)(p.ws + WS_ACT)};
            for (int rep = 0; rep <= DUP_GU; ++rep) { pg8::gemm_phase(lds, g, S, E); SYNC(pb + 3); }
        }
        if (IN(pb + 4) && X_GDN) {
            pg8::Gemm g{(const bf16_t*)(p.ws + WS_ACT), (const bf16_t*)(p.ws + WS_WDN) + (size_t)l * DM * DFF, MT, DM, DFF}; pg8::SplitOrder<true> S; S.init2(MT, DM, DFF, G, vbid, 11);
            float* Yout = (l == 3) ? p.out : nullptr;
            EpiRes<false> E{Yout, XB, ssq_out, nullptr, PART};
            pg8::gemm_phase(lds, g, S, E);
            xcd_barrier(bar);
            splitk_reduce(Yout, XB, ssq_out, PART, S, 11);
            SYNC(pb + 4);
        }
    }
#undef IN
#undef SYNC
}

extern "C" void kernel_launch(void* const* d_in, const int* in_sizes, int n_in, void* d_out, int out_size, void* d_ws, size_t ws_size, hipStream_t stream) {
    static int grid_blocks = 0;
    if (grid_blocks == 0) {
        if (n_in != N_IN || ws_size < WS_END) { fprintf(stderr, "kernel_launch: unexpected n_in %d or ws_size %zu (< %zu)\n", n_in, ws_size, (size_t)WS_END); grid_blocks = -1; return; }
        int dev = 0, cus = 0, per_cu = 0;
        hipGetDevice(&dev);
        hipDeviceGetAttribute(&cus, hipDeviceAttributeMultiprocessorCount, dev);
        hipFuncSetAttribute((const void*)fwd_megakernel, hipFuncAttributeMaxDynamicSharedMemorySize, LDS_BYTES);
        hipOccupancyMaxActiveBlocksPerMultiprocessor(&per_cu, (const void*)fwd_megakernel, 512, LDS_BYTES);
        if (per_cu < 1) { fprintf(stderr, "kernel_launch: occupancy query reports %d blocks per CU\n", per_cu); per_cu = 1; }
        grid_blocks = cus * 1;
    }
    if (grid_blocks < 0) return;
    Params p{};
    for (int k = 0; k < N_IN; ++k) p.in[k] = (const float*)d_in[k];
    p.out = (float*)d_out; p.ws = (unsigned char*)d_ws; p.ph_lo = 0; p.ph_hi = N_PHASES;
    void* args[] = {&p};
    if (hipMemsetAsync((unsigned char*)d_ws + WS_BAR, 0, 16384, stream) != hipSuccess) { fprintf(stderr, "kernel_launch: memset of the barrier words failed\n"); return; }
    hipError_t e = hipLaunchCooperativeKernel((const void*)fwd_megakernel, dim3(grid_blocks), dim3(512), args, LDS_BYTES, stream);
    if (e != hipSuccess) fprintf(stderr, "cooperative launch failed: %s (grid %d)\n", hipGetErrorString(e), grid_blocks);
}
```
